# Optimizing an MI355X kernel written in HIP

```python
import numpy as np
import jax, jax.numpy as jnp
from jax import lax

D_MODEL = 1024
BATCH = 16
SEQ = 2048
DEPTH = 2

N_A_LAYERS = DEPTH // 2
N_B_LAYERS = DEPTH - N_A_LAYERS
EPS = 1e-6
NEG_INF = -1e30
ROPE_THETA = 10000.0

GLA_HEADS = 4
GLA_DK = D_MODEL // (2 * GLA_HEADS)
GLA_DV = D_MODEL // GLA_HEADS
GLA_GATE_RANK = 16
GLA_TAU = 16.0
GLA_CHUNK = 64
GLA_IN = 2 * GLA_HEADS * GLA_DK + 2 * GLA_HEADS * GLA_DV + GLA_GATE_RANK

NSA_HEADS = 16
NSA_KV_HEADS = 4
NSA_GROUP = NSA_HEADS // NSA_KV_HEADS
NSA_HEAD_DIM = D_MODEL // NSA_HEADS
CMP_BLOCK = 32
CMP_STRIDE = 16
CMP_HIDDEN = 4 * NSA_HEAD_DIM
SEL_BLOCK = 64
SEL_TOPK = 16
WINDOW = 512
NSA_QCHUNK = 32
NSA_IN = NSA_HEADS * NSA_HEAD_DIM + 3 * NSA_HEADS
NSA_KV_OUT = 6 * NSA_KV_HEADS * NSA_HEAD_DIM
FORCE_SCORE = 1e4

FFN_DIM = 2816
CONV_WIDTH = 3

kernel_name = 'yoco_gla_nsa_convffn_trunk'


def rmsnorm(x, g):
    x32 = x.astype(jnp.float32)
    y = x32 * lax.rsqrt(jnp.mean(x32 * x32, axis=-1, keepdims=True) + EPS)
    return (y * g).astype(x.dtype)


def rope(x, pos):
    half = x.shape[-1] // 2
    inv = ROPE_THETA ** (-jnp.arange(half, dtype=jnp.float32) / half)
    ang = pos.astype(jnp.float32)[:, None] * inv[None, :]
    cos, sin = jnp.cos(ang), jnp.sin(ang)
    x1 = x[..., :half].astype(jnp.float32)
    x2 = x[..., half:].astype(jnp.float32)
    return jnp.concatenate([x1 * cos - x2 * sin, x1 * sin + x2 * cos], axis=-1).astype(x.dtype)


def masked_softmax(s, mask):
    s = jnp.where(mask, s.astype(jnp.float32), NEG_INF)
    return jnp.where(mask, jax.nn.softmax(s, axis=-1), 0.0)


def conv_ffn(h, w_up, conv_w, conv_b, w_down):
    S = h.shape[1]
    u = h @ w_up
    up = jnp.pad(u, ((0, 0), (CONV_WIDTH - 1, 0), (0, 0)))
    u = conv_b + up[:, 0:S] * conv_w[0]
    for j in range(1, CONV_WIDTH):
        u = u + up[:, j:j + S] * conv_w[j]
    gate, val = jnp.split(u, 2, axis=-1)
    return (jax.nn.silu(gate) * val) @ w_down


def gla_mixer(h, w_in, w_alpha_up, b_alpha, g_out, w_o):
    Bsz, S, _ = h.shape
    H, DK, DV, C = GLA_HEADS, GLA_DK, GLA_DV, GLA_CHUNK
    NC = S // C
    proj = h @ w_in
    splits = [H * DK, 2 * H * DK, 2 * H * DK + H * DV, 2 * H * DK + 2 * H * DV]
    q, k, v, r, a_low = jnp.split(proj, splits, axis=-1)
    log_a = jax.nn.log_sigmoid((a_low @ w_alpha_up + b_alpha).astype(jnp.float32)) / GLA_TAU

    def to_chunks(t, d):
        return t.astype(jnp.float32).reshape(Bsz, NC, C, H, d).transpose(1, 0, 3, 2, 4)

    qc = to_chunks(q, DK) * DK ** -0.5
    kc = to_chunks(k, DK)
    vc = to_chunks(v, DV)
    gc = to_chunks(log_a, DK)
    causal = jnp.tril(jnp.ones((C, C), dtype=bool))[:, :, None]

    def step(state, inp):
        q_, k_, v_, g_ = inp
        b = jnp.cumsum(g_, axis=2)
        o_inter = jnp.einsum('bhtk,bhkv->bhtv', q_ * jnp.exp(b), state)
        diff = b[:, :, :, None, :] - b[:, :, None, :, :]
        decay = jnp.where(causal, jnp.exp(jnp.minimum(diff, 0.0)), 0.0)
        att = jnp.einsum('bhtk,bhsk,bhtsk->bhts', q_, k_, decay)
        o_intra = jnp.einsum('bhts,bhsv->bhtv', att, v_)
        b_last = b[:, :, -1:, :]
        new_state = state * jnp.exp(b_last[:, :, 0, :, None]) + jnp.einsum(
            'bhsk,bhsv->bhkv', k_ * jnp.exp(b_last - b), v_)
        return new_state, o_inter + o_intra

    state0 = jnp.zeros((Bsz, H, DK, DV), jnp.float32)
    _, o = lax.scan(step, state0, (qc, kc, vc, gc))
    o = o.transpose(1, 0, 3, 2, 4).reshape(Bsz, S, H, DV)
    o = o * lax.rsqrt(jnp.mean(o * o, axis=-1, keepdims=True) + EPS) * g_out
    o = o.reshape(Bsz, S, H * DV).astype(h.dtype) * jax.nn.silu(r)
    return o @ w_o


def compress_blocks(t_raw, pe, w1, w2):
    Bsz, Hk, S, Dh = t_raw.shape
    n_cmp = (S - CMP_BLOCK) // CMP_STRIDE + 1
    idx = np.arange(n_cmp)[:, None] * CMP_STRIDE + np.arange(CMP_BLOCK)[None, :]
    blocks = (t_raw[:, :, idx, :] + pe).reshape(Bsz, Hk, n_cmp, CMP_BLOCK * Dh)
    return jax.nn.gelu(blocks @ w1) @ w2


def cmp_to_sel_weights(S):
    n_cmp = (S - CMP_BLOCK) // CMP_STRIDE + 1
    n_sel = S // SEL_BLOCK
    c0 = np.arange(n_cmp)[:, None] * CMP_STRIDE
    s0 = np.arange(n_sel)[None, :] * SEL_BLOCK
    ov = np.clip(np.minimum(c0 + CMP_BLOCK, s0 + SEL_BLOCK) - np.maximum(c0, s0), 0, None)
    return (ov / CMP_BLOCK).astype(np.float32)


def nsa_shared_kv(x, g_kv, w_kv, pe_k, pe_v, wk1, wk2, wv1, wv2):
    Bsz, S, _ = x.shape
    hn = rmsnorm(x, g_kv)
    kv = (hn @ w_kv).reshape(Bsz, S, 6, NSA_KV_HEADS, NSA_HEAD_DIM).transpose(2, 0, 3, 1, 4)
    pos = jnp.arange(S)
    k_cmp = compress_blocks(kv[0], pe_k, wk1, wk2)
    v_cmp = compress_blocks(kv[1], pe_v, wv1, wv2)
    k_sel = rope(kv[2], pos)
    k_win = rope(kv[4], pos)
    return k_cmp, v_cmp, k_sel, kv[3], k_win, kv[5]


gather_blocks = jax.vmap(jax.vmap(lambda blocks, ix: blocks[ix]))


def nsa_mixer(h, w_in, w_o, k_cmp, v_cmp, k_sel, v_sel, k_win, v_win):
    Bsz, S, _ = h.shape
    Hk, G, Dh, SB, QC = NSA_KV_HEADS, NSA_GROUP, NSA_HEAD_DIM, SEL_BLOCK, NSA_QCHUNK
    n_cmp = k_cmp.shape[2]
    n_sel = S // SB
    top = min(SEL_TOPK, n_sel)
    scale = Dh ** -0.5
    pos = jnp.arange(S)
    proj = h @ w_in
    q = proj[..., :NSA_HEADS * Dh].reshape(Bsz, S, Hk, G, Dh).transpose(0, 2, 3, 1, 4)
    gates = jax.nn.sigmoid(proj[..., NSA_HEADS * Dh:].astype(jnp.float32))
    gates = gates.reshape(Bsz, S, 3, Hk, G).transpose(2, 0, 3, 4, 1)[..., None]

    cmp_end = jnp.arange(n_cmp) * CMP_STRIDE + CMP_BLOCK - 1
    p_cmp = masked_softmax(jnp.einsum('bkgsd,bknd->bkgsn', q, k_cmp) * scale,
                           cmp_end[None, :] <= pos[:, None])
    o_cmp = jnp.einsum('bkgsn,bknd->bkgsd', p_cmp, v_cmp)

    imp = jnp.einsum('bkgsn,nj->bksj', p_cmp, jnp.asarray(cmp_to_sel_weights(S)))
    blk = jnp.arange(n_sel)[None, :]
    cur = (pos // SB)[:, None]
    forced = (blk == 0) | (blk == cur) | (blk == cur - 1)
    imp = jnp.where(blk > cur, -1.0, jnp.where(forced, FORCE_SCORE, imp))
    _, sel_idx = lax.top_k(imp, top)

    q_rot = rope(q, pos)
    k_blocks = k_sel.reshape(Bsz, Hk, n_sel, SB, Dh)
    v_blocks = v_sel.reshape(Bsz, Hk, n_sel, SB, Dh)
    pad = ((0, 0), (0, 0), (WINDOW, 0), (0, 0))
    k_win_pad = jnp.pad(k_win, pad)
    v_win_pad = jnp.pad(v_win, pad)

    def chunk(c):
        t0 = c * QC
        qc = lax.dynamic_slice_in_dim(q_rot, t0, QC, axis=3)
        qpos = t0 + jnp.arange(QC)
        idx = lax.dynamic_slice_in_dim(sel_idx, t0, QC, axis=2)
        ks = gather_blocks(k_blocks, idx).reshape(Bsz, Hk, QC, top * SB, Dh)
        vs = gather_blocks(v_blocks, idx).reshape(Bsz, Hk, QC, top * SB, Dh)
        kpos = (idx[..., None] * SB + jnp.arange(SB)).reshape(Bsz, Hk, 1, QC, top * SB)
        p_sel = masked_softmax(jnp.einsum('bkgqd,bkqmd->bkgqm', qc, ks) * scale,
                               kpos <= qpos[:, None])
        o_sel = jnp.einsum('bkgqm,bkqmd->bkgqd', p_sel, vs)
        kw = lax.dynamic_slice_in_dim(k_win_pad, t0, WINDOW + QC, axis=2)
        vw = lax.dynamic_slice_in_dim(v_win_pad, t0, WINDOW + QC, axis=2)
        kwpos = t0 - WINDOW + jnp.arange(WINDOW + QC)
        dist = qpos[:, None] - kwpos[None, :]
        win_mask = (kwpos[None, :] >= 0) & (dist >= 0) & (dist < WINDOW)
        p_win = masked_softmax(jnp.einsum('bkgqd,bknd->bkgqn', qc, kw) * scale, win_mask)
        o_win = jnp.einsum('bkgqn,bknd->bkgqd', p_win, vw)
        return o_sel, o_win

    o_sel, o_win = lax.map(chunk, jnp.arange(S // QC))
    o_sel = jnp.moveaxis(o_sel, 0, 3).reshape(Bsz, Hk, G, S, Dh)
    o_win = jnp.moveaxis(o_win, 0, 3).reshape(Bsz, Hk, G, S, Dh)
    o = gates[0] * o_cmp + gates[1] * o_sel + gates[2] * o_win
    o = o.transpose(0, 3, 1, 2, 4).reshape(Bsz, S, NSA_HEADS * Dh).astype(h.dtype)
    return o @ w_o


def setup_inputs(seed: int = 0) -> dict:
    key = jax.random.key(seed)
    ks = jax.random.split(key, 32)
    f32 = jnp.float32

    def nrm(k, shape, fan_in):
        return jax.random.normal(k, shape, f32) * fan_in ** -0.5

    def gain(k, shape):
        return 1.0 + 0.02 * jax.random.normal(k, shape, f32)

    two_f = 2 * FFN_DIM
    return {
        'x': jax.random.normal(ks[0], (BATCH, SEQ, D_MODEL), f32),
        'norm_mix': gain(ks[1], (DEPTH, D_MODEL)),
        'norm_ffn': gain(ks[2], (DEPTH, D_MODEL)),
        'gla_w_in': nrm(ks[3], (N_A_LAYERS, D_MODEL, GLA_IN), D_MODEL),
        'gla_w_alpha_up': nrm(ks[4], (N_A_LAYERS, GLA_GATE_RANK, GLA_HEADS * GLA_DK), GLA_GATE_RANK),
        'gla_b_alpha': 0.1 * jax.random.normal(ks[5], (N_A_LAYERS, GLA_HEADS * GLA_DK), f32),
        'gla_norm': gain(ks[6], (N_A_LAYERS, GLA_HEADS, GLA_DV)),
        'gla_w_o': nrm(ks[7], (N_A_LAYERS, GLA_HEADS * GLA_DV, D_MODEL), GLA_HEADS * GLA_DV),
        'kv_norm': gain(ks[8], (D_MODEL,)),
        'nsa_w_kv': nrm(ks[9], (D_MODEL, NSA_KV_OUT), D_MODEL),
        'cmp_pe_k': 0.02 * jax.random.normal(ks[10], (CMP_BLOCK, NSA_HEAD_DIM), f32),
        'cmp_pe_v': 0.02 * jax.random.normal(ks[11], (CMP_BLOCK, NSA_HEAD_DIM), f32),
        'cmp_k_w1': nrm(ks[12], (CMP_BLOCK * NSA_HEAD_DIM, CMP_HIDDEN), CMP_BLOCK * NSA_HEAD_DIM),
        'cmp_k_w2': nrm(ks[13], (CMP_HIDDEN, NSA_HEAD_DIM), CMP_HIDDEN),
        'cmp_v_w1': nrm(ks[14], (CMP_BLOCK * NSA_HEAD_DIM, CMP_HIDDEN), CMP_BLOCK * NSA_HEAD_DIM),
        'cmp_v_w2': nrm(ks[15], (CMP_HIDDEN, NSA_HEAD_DIM), CMP_HIDDEN),
        'nsa_w_in': nrm(ks[16], (N_B_LAYERS, D_MODEL, NSA_IN), D_MODEL),
        'nsa_w_o': nrm(ks[17], (N_B_LAYERS, NSA_HEADS * NSA_HEAD_DIM, D_MODEL), NSA_HEADS * NSA_HEAD_DIM),
        'ffn_w_up': nrm(ks[18], (DEPTH, D_MODEL, two_f), D_MODEL),
        'ffn_conv_w': nrm(ks[19], (DEPTH, CONV_WIDTH, two_f), CONV_WIDTH),
        'ffn_conv_b': 0.02 * jax.random.normal(ks[20], (DEPTH, two_f), f32),
        'ffn_w_down': nrm(ks[21], (DEPTH, FFN_DIM, D_MODEL), FFN_DIM),
        'norm_final': gain(ks[22], (D_MODEL,)),
    }


def reference(x, norm_mix, norm_ffn, gla_w_in, gla_w_alpha_up, gla_b_alpha, gla_norm, gla_w_o,
              kv_norm, nsa_w_kv, cmp_pe_k, cmp_pe_v, cmp_k_w1, cmp_k_w2, cmp_v_w1, cmp_v_w2,
              nsa_w_in, nsa_w_o, ffn_w_up, ffn_conv_w, ffn_conv_b, ffn_w_down, norm_final):
    shared = None
    for layer in range(DEPTH):
        if layer < N_A_LAYERS:
            hn = rmsnorm(x, norm_mix[layer])
            x = x + gla_mixer(hn, gla_w_in[layer], gla_w_alpha_up[layer], gla_b_alpha[layer],
                              gla_norm[layer], gla_w_o[layer])
        else:
            if layer == N_A_LAYERS:
                shared = nsa_shared_kv(x, kv_norm, nsa_w_kv, cmp_pe_k, cmp_pe_v,
                                       cmp_k_w1, cmp_k_w2, cmp_v_w1, cmp_v_w2)
            b = layer - N_A_LAYERS
            hn = rmsnorm(x, norm_mix[layer])
            x = x + nsa_mixer(hn, nsa_w_in[b], nsa_w_o[b], *shared)
        hn = rmsnorm(x, norm_ffn[layer])
        x = x + conv_ffn(hn, ffn_w_up[layer], ffn_conv_w[layer], ffn_conv_b[layer], ffn_w_down[layer])
    return rmsnorm(x, norm_final)
```

```cpp
#include <hip/hip_runtime.h>
#include <hip/hip_cooperative_groups.h>
#include <cstdio>
#include <cstdint>
constexpr size_t MiB = 1u << 20;
constexpr int M_TOK = 32768;
constexpr size_t WS_RSS = 0;
constexpr size_t WS_BAR = 768 * 1024;
constexpr size_t WS_ROPE = 1 * MiB, WS_BIASC = 800 * 1024;
constexpr size_t WS_WGI = 2 * MiB, WS_WGO = 9 * MiB, WS_WKQ = 11 * MiB, WS_WC1 = 17 * MiB, WS_WC2 = 19 * MiB, WS_WNO = 20 * MiB, WS_WUP = 22 * MiB, WS_WDN = 44 * MiB;
constexpr size_t WS_XB = 56 * MiB;
constexpr size_t WS_BIG = 120 * MiB;
constexpr size_t WS_GQ = WS_BIG, WS_GK = WS_BIG + 32 * MiB, WS_GV = WS_BIG + 64 * MiB, WS_GR = WS_BIG + 128 * MiB, WS_GG = WS_BIG + 192 * MiB;
constexpr size_t WS_ACT = WS_BIG, WS_HALO = WS_BIG + 176 * MiB;
constexpr size_t WS_KV = WS_BIG, WS_NQ = WS_BIG + 96 * MiB, WS_NQR = WS_BIG + 160 * MiB, WS_GATES = WS_BIG + 224 * MiB, WS_HP = WS_BIG + 230 * MiB, WS_KCVC = WS_BIG + 294 * MiB, WS_OATT = WS_BIG + 296 * MiB;
constexpr size_t WS_END = WS_BIG + 376 * MiB;
constexpr int LDS_BYTES = 160 * 1024, EPI_OFF = 131072;


#define LAS __attribute__((address_space(3)))
#define XB_TMO      128
#define XB_XCNT(j)  (256  + 64 * (j))
#define XB_XSUB(j)  (1280 + 64 * (j))
#define XB_XGEN(j)  (2304 + 64 * (j))
#define XB_TOP      3328
#define XB_TOPGEN   3392
#define XCD_BAR_WORDS 3456
#define XB_SPIN_CAP (1u << 18)

__device__ __forceinline__ unsigned xb_ld(unsigned* p)              { return __hip_atomic_load(p, __ATOMIC_RELAXED, __HIP_MEMORY_SCOPE_AGENT); }
__device__ __forceinline__ unsigned xb_add(unsigned* p, unsigned v) { return __hip_atomic_fetch_add(p, v, __ATOMIC_RELAXED, __HIP_MEMORY_SCOPE_AGENT); }
__device__ __forceinline__ unsigned xb_xcc_id() { return (unsigned)__builtin_amdgcn_s_getreg((3 << 11) | 20) & 0xFu; }
#define XB_SPIN(cond, bar) do { unsigned _sp = 0; while (cond) { __builtin_amdgcn_s_sleep(1); \
    if ((++_sp & 255u) == 0u) { if (xb_ld(&(bar)[XB_TMO])) break; if (_sp > XB_SPIN_CAP) { atomicAdd(&(bar)[XB_TMO], 1u); break; } } } } while (0)

struct XcdBarrier {
    unsigned* bar; unsigned x;
    volatile LAS unsigned* st;
};

__device__ __forceinline__ XcdBarrier xcd_barrier_post(unsigned* bar, volatile LAS unsigned* st, int tid) {
    XcdBarrier b; b.bar = bar; b.x = xb_xcc_id(); b.st = st;
    if (tid == 0) (void)xb_add(&bar[XB_XCNT(b.x)], 1u);
    return b;
}
__device__ __forceinline__ void xcd_barrier_complete(unsigned* bar, unsigned x, unsigned& nloc, unsigned& nx) {
    const unsigned G = gridDim.x * gridDim.y * gridDim.z;
    unsigned sum, cnt, mine, sp = 0u;
    for (;;) {
        sum = 0u; cnt = 0u; mine = 0u;
#pragma unroll
        for (unsigned j = 0; j < 16; ++j) { const unsigned c = xb_ld(&bar[XB_XCNT(j)]); sum += c; cnt += (c > 0u) ? 1u : 0u; mine = (j == x) ? c : mine; }
        if (sum == G) break;
        __builtin_amdgcn_s_sleep(1);
        if ((++sp & 255u) == 0u) { if (xb_ld(&bar[XB_TMO])) break; if (sp > XB_SPIN_CAP) { atomicAdd(&bar[XB_TMO], 1u); break; } }
    }
    nloc = mine > 0u ? mine : 1u; nx = cnt > 0u ? cnt : 1u;
}

__device__ __forceinline__ void xcd_barrier(const XcdBarrier& b, int tid) {
    asm volatile("s_waitcnt vmcnt(0)" ::: "memory");
    __syncthreads();
    if (tid == 0) {
        unsigned* bar = b.bar;
        __builtin_amdgcn_s_waitcnt(0);
        unsigned nloc = b.st[0], nx = b.st[1];
        if (nloc == 0u) { xcd_barrier_complete(bar, b.x, nloc, nx); b.st[0] = nloc; b.st[1] = nx; }
        const unsigned old = xb_add(&bar[XB_XSUB(b.x)], 1u);
        const unsigned gen = old / nloc;
        if (old + 1u == (gen + 1u) * nloc) {
            __builtin_amdgcn_fence(__ATOMIC_RELEASE, "agent");
            asm volatile("s_waitcnt vmcnt(0)" ::: "memory");
            const unsigned og = xb_add(&bar[XB_TOP], 1u);
            const unsigned tg = og / nx;
            if (og + 1u == (tg + 1u) * nx) xb_add(&bar[XB_TOPGEN], 1u);
            else XB_SPIN(xb_ld(&bar[XB_TOPGEN]) == tg, bar);
            __builtin_amdgcn_fence(__ATOMIC_ACQUIRE, "agent");
            xb_add(&bar[XB_XGEN(b.x)], 1u);
            asm volatile("s_waitcnt vmcnt(0)" ::: "memory");
        } else {
            XB_SPIN(xb_ld(&bar[XB_XGEN(b.x)]) == gen, bar);
            __builtin_amdgcn_fence(__ATOMIC_ACQUIRE, "agent");
            asm volatile("s_waitcnt vmcnt(0)" ::: "memory");
        }
    }
    __syncthreads();
}

__device__ __forceinline__ int lane_id() { return (int)__builtin_amdgcn_mbcnt_hi(~0u, __builtin_amdgcn_mbcnt_lo(~0u, 0u)); }
template <class T> __device__ __forceinline__ T dpp_xor1(T x) { return __builtin_bit_cast(T, __builtin_amdgcn_mov_dpp(__builtin_bit_cast(int, x), 0xB1, 0xf, 0xf, true)); }
template <class T> __device__ __forceinline__ T dpp_xor2(T x) { return __builtin_bit_cast(T, __builtin_amdgcn_mov_dpp(__builtin_bit_cast(int, x), 0x4E, 0xf, 0xf, true)); }
template <class T> __device__ __forceinline__ T dpp_hmirror(T x) { return __builtin_bit_cast(T, __builtin_amdgcn_mov_dpp(__builtin_bit_cast(int, x), 0x141, 0xf, 0xf, true)); }
template <class T> __device__ __forceinline__ T swz_xor16(T x) { return __builtin_bit_cast(T, __builtin_amdgcn_ds_swizzle(__builtin_bit_cast(int, x), 0x401F)); }
namespace pg8 {
#define PG8_LAS __attribute__((address_space(3)))
typedef unsigned short bf16_t;
typedef short bf16x8 __attribute__((ext_vector_type(8)));
typedef float f32x4 __attribute__((ext_vector_type(4)));
typedef float f32x2 __attribute__((ext_vector_type(2)));
typedef unsigned u32x4 __attribute__((ext_vector_type(4)));
typedef unsigned u32x2 __attribute__((ext_vector_type(2)));
constexpr int BM = 256, BK = 64, HALF = 128, HTB = HALF * BK * 2, STAGE_BYTES = 8 * HTB, NXCD = 8, WGM = 8;

__host__ __device__ __forceinline__ int lds_byte(int r, int c) { const int st = (r >> 4) * 2 + (c >> 5), rr = r & 15, cc = c & 31, ob = rr * 64 + cc * 2; return st * 1024 + (ob ^ (((ob >> 9) & 1) << 5)); }
__host__ __device__ __forceinline__ void stage_rc(int b, int& R, int& C) { const int st = b / 1024, sb = b % 1024, swz = sb ^ (((sb >> 9) & 1) << 5); R = (st >> 1) * 16 + swz / 64; C = (st & 1) * 32 + (swz % 64) / 2; }
__host__ __device__ __forceinline__ int perm32(int rho) { const int n = rho >> 4, i = rho & 15; return 8 * (i >> 2) + 4 * n + (i & 3); }

struct Unit { int pm, pn; };
struct Gemm { const bf16_t* A; const bf16_t* Bt; int M, N, K; int lda, ldb; size_t a_pm, a_pn, b_pn, b_hi; int b_split; };
__device__ __forceinline__ Gemm make_gemm(const bf16_t* A, const bf16_t* Bt, int M, int N, int K, int lda, int ldb) {
    Gemm g; g.A = A; g.Bt = Bt; g.M = M; g.N = N; g.K = K; g.lda = lda; g.ldb = ldb;
    g.a_pm = (size_t)BM * lda * 2; g.a_pn = 0; g.b_pn = (size_t)BM * ldb * 2; g.b_hi = 0; g.b_split = 0x7fffffff; return g;
}

struct StaticOrder {
    int nM, nN, nwg, G, c;
    __device__ void init(int M, int N, int G_, int c_) { nM = M / BM; nN = N / BM; nwg = nM * nN; G = G_; c = c_; }
    __device__ bool next(int i, Unit& u) const {
        const long L = (long)i * G + c; if (L >= nwg) return false;
        int wgid = (int)L; { const int q = nwg / NXCD, r = nwg % NXCD, xcd = wgid % NXCD, off = wgid / NXCD; wgid = (xcd < r ? xcd * (q + 1) : r * (q + 1) + (xcd - r) * q) + off; }
        const int nig = WGM * nN, gid = wgid / nig, fm = gid * WGM, gsz = (nM - fm) < WGM ? (nM - fm) : WGM;
        u.pm = fm + ((wgid % nig) % gsz); u.pn = (wgid % nig) / gsz; return true;
    }
};

__device__ __forceinline__ unsigned cvt_pk_bf16(float lo, float hi) {
    typedef __bf16 bf16x2_t __attribute__((ext_vector_type(2)));
    f32x2 v = {lo, hi}; bf16x2_t b = __builtin_convertvector(v, bf16x2_t); return __builtin_bit_cast(unsigned, b);
}

template <class Epi>
__device__ __forceinline__ void gemm_phase(PG8_LAS unsigned char* lds, PG8_LAS unsigned char* lds_epi, const Gemm g, const StaticOrder& S, const Epi& E, int tid0) {
    int tid_ = tid0; asm volatile("" : "+v"(tid_));
    const int tid = tid_, wid = __builtin_amdgcn_readfirstlane(tid >> 6), lane = tid & 63, wr = wid >> 2, wc = wid & 3, fr = lane & 15, fq = lane >> 4;
    const int K = g.K, nt = K / BK;
    unsigned voffA[2], voffB[2];
#pragma unroll
    for (int i = 0; i < 2; ++i) { int R, C; stage_rc(tid * 16 + i * 8192, R, C); const int Rb = (R & ~31) + perm32(R & 31);
        voffA[i] = (unsigned)(R * g.lda + C) * 2u; voffB[i] = (unsigned)(Rb * g.ldb + C) * 2u; }
    const size_t kstep = (size_t)(BK * 2);
    const size_t hstepA = (size_t)HALF * g.lda * 2, hstepB = (size_t)HALF * g.ldb * 2;
    const unsigned ldsw = (unsigned)wid * 1024u;
    const int aoff = lds_byte(wr * 64 + fr, fq * 8), boff = lds_byte(wc * 32 + fr, fq * 8);
#define PG8_SA(b, h) (((b) * 2 + (h)) * HTB)
#define PG8_SB(b, h) ((4 + (b) * 2 + (h)) * HTB)
#define PG8_STAGE(bufoff, gbase, voff) do { _Pragma("unroll") for (int _i = 0; _i < 2; ++_i) \
        __builtin_amdgcn_global_load_lds((const unsigned*)((const char*)(gbase) + (voff)[_i]), (PG8_LAS unsigned*)(lds + (bufoff) + ldsw + _i * 8192), 16, 0, 0); } while (0)
#define PG8_LDA(dst, b, h) do { _Pragma("unroll") for (int m = 0; m < 4; ++m) _Pragma("unroll") for (int k = 0; k < 2; ++k) dst[m][k] = *(const PG8_LAS bf16x8*)(lds + PG8_SA(b, h) + aoff + m * 2048 + k * 1024); } while (0)
#define PG8_LDB(dst, b, h) do { _Pragma("unroll") for (int n = 0; n < 2; ++n) _Pragma("unroll") for (int k = 0; k < 2; ++k) dst[n][k] = *(const PG8_LAS bf16x8*)(lds + PG8_SB(b, h) + boff + n * 2048 + k * 1024); } while (0)
#define PG8_MMA(ai, bj, At, Bt) do { __builtin_amdgcn_s_setprio(1); _Pragma("unroll") for (int m = 0; m < 4; ++m) _Pragma("unroll") for (int n = 0; n < 2; ++n) _Pragma("unroll") for (int k = 0; k < 2; ++k) \
        acc[ai][bj][m][n] = __builtin_amdgcn_mfma_f32_16x16x32_bf16(Bt[n][k], At[m][k], acc[ai][bj][m][n], 0, 0, 0); __builtin_amdgcn_s_setprio(0); } while (0)
#define PG8_WAIT_V(n) asm volatile("s_waitcnt vmcnt(" #n ")" ::: "memory")
#define PG8_WAIT_L(n) asm volatile("s_waitcnt lgkmcnt(" #n ")" ::: "memory")
#define PG8_BAR __builtin_amdgcn_s_barrier()
#define PG8_SCHED __builtin_amdgcn_sched_barrier(0)
    Unit cur, nxt; int ui = 0;
    if (!S.next(0, cur)) return;
    f32x4 acc[2][2][4][2];
#pragma unroll
    for (int a = 0; a < 2; ++a)
#pragma unroll
        for (int b = 0; b < 2; ++b)
#pragma unroll
            for (int m = 0; m < 4; ++m)
#pragma unroll
                for (int n = 0; n < 2; ++n) acc[a][b][m][n] = (f32x4){0.f, 0.f, 0.f, 0.f};
    bf16x8 At[4][2], B0[2][2], B1[2][2];
    const char* cA = (const char*)g.A + (size_t)cur.pm * g.a_pm + (size_t)cur.pn * g.a_pn;
    const char* cB = (const char*)g.Bt + (size_t)cur.pn * g.b_pn + (cur.pm >= g.b_split ? g.b_hi : (size_t)0);
    PG8_STAGE(PG8_SB(0, 0), cB, voffB); PG8_STAGE(PG8_SB(0, 1), cB + hstepB, voffB); PG8_STAGE(PG8_SA(0, 0), cA, voffA); PG8_STAGE(PG8_SA(0, 1), cA + hstepA, voffA);
    if (wr == 1) PG8_BAR;
    PG8_WAIT_V(2); PG8_BAR;
    PG8_STAGE(PG8_SB(1, 0), cB + kstep, voffB); PG8_STAGE(PG8_SA(1, 0), cA + kstep, voffA); PG8_STAGE(PG8_SB(1, 1), cB + hstepB + kstep, voffB);
    PG8_WAIT_V(6); PG8_BAR;
    for (;;) {
        const bool has_next = S.next(ui + 1, nxt);
        const char* nA = has_next ? (const char*)g.A + (size_t)nxt.pm * g.a_pm + (size_t)nxt.pn * g.a_pn : cA;
        const char* nB = has_next ? (const char*)g.Bt + (size_t)nxt.pn * g.b_pn + (nxt.pm >= g.b_split ? g.b_hi : (size_t)0) : cB;
        E.prefetch(cur, ui, lds_epi, wid, lane);
        for (int t = 0; t < nt; t += 2) {
            const bool last = (t == nt - 2);
            const char* a1 = cA + (size_t)(t + 1) * kstep;
            const char* a2 = last ? nA : cA + (size_t)(t + 2) * kstep; const char* b2 = last ? nB : cB + (size_t)(t + 2) * kstep;
            const char* a3 = a2 + kstep; const char* b3 = b2 + kstep;
            PG8_LDB(B0, 0, 0); PG8_LDB(B1, 0, 1); PG8_SCHED; PG8_LDA(At, 0, 0); PG8_STAGE(PG8_SA(1, 1), a1 + hstepA, voffA);
            PG8_WAIT_V(8); PG8_WAIT_L(0); PG8_BAR; PG8_MMA(0, 0, At, B0); PG8_MMA(0, 1, At, B1); PG8_BAR; PG8_SCHED;
            PG8_LDA(At, 0, 1); PG8_STAGE(PG8_SB(0, 0), b2, voffB); PG8_STAGE(PG8_SB(0, 1), b2 + hstepB, voffB); PG8_STAGE(PG8_SA(0, 0), a2, voffA);
            PG8_WAIT_V(8); PG8_WAIT_L(0); PG8_BAR; PG8_MMA(1, 0, At, B0); PG8_MMA(1, 1, At, B1); PG8_BAR; PG8_SCHED;
            PG8_LDB(B0, 1, 0); PG8_LDB(B1, 1, 1); PG8_SCHED; PG8_LDA(At, 1, 0); PG8_STAGE(PG8_SA(0, 1), a2 + hstepA, voffA);
            PG8_WAIT_V(8); PG8_WAIT_L(0); PG8_BAR; PG8_MMA(0, 0, At, B0); PG8_MMA(0, 1, At, B1); PG8_BAR; PG8_SCHED;
            PG8_LDA(At, 1, 1); PG8_STAGE(PG8_SB(1, 0), b3, voffB); PG8_STAGE(PG8_SB(1, 1), b3 + hstepB, voffB); PG8_STAGE(PG8_SA(1, 0), a3, voffA);
            PG8_WAIT_V(8); PG8_WAIT_L(0); PG8_BAR; PG8_MMA(1, 0, At, B0); PG8_MMA(1, 1, At, B1); PG8_BAR; PG8_SCHED;
        }
        if (wr == 0) PG8_BAR;
        E(acc, cur, ui, wr, wc, fr, fq, lds_epi);
        if (!has_next) break;
#pragma unroll
        for (int a = 0; a < 2; ++a)
#pragma unroll
            for (int b = 0; b < 2; ++b)
#pragma unroll
                for (int m = 0; m < 4; ++m)
#pragma unroll
                    for (int n = 0; n < 2; ++n) acc[a][b][m][n] = (f32x4){0.f, 0.f, 0.f, 0.f};
        cur = nxt; cA = nA; cB = nB; ++ui;
        if (wr == 1) PG8_BAR;
    }
    PG8_WAIT_V(0);
    PG8_BAR;
#undef PG8_SA
#undef PG8_SB
#undef PG8_STAGE
#undef PG8_LDA
#undef PG8_LDB
#undef PG8_MMA
#undef PG8_WAIT_V
#undef PG8_WAIT_L
#undef PG8_BAR
#undef PG8_SCHED
}
}
namespace epi {
using namespace pg8;
constexpr float EPS = 1e-6f;
__device__ __forceinline__ float rstd_of(float ss) { return rsqrtf(ss * (1.0f / 1024.0f) + EPS); }
__device__ __forceinline__ float sigmoidf_(float x) { return __builtin_amdgcn_rcpf(1.0f + __expf(-x)); }
__device__ __forceinline__ float siluf_(float x) { return x * __builtin_amdgcn_rcpf(1.0f + __expf(-x)); }
__device__ __forceinline__ u32x4 pack8(const f32x4& a, const f32x4& b) { u32x4 w; w.x = cvt_pk_bf16(a[0], a[1]); w.y = cvt_pk_bf16(a[2], a[3]); w.z = cvt_pk_bf16(b[0], b[1]); w.w = cvt_pk_bf16(b[2], b[3]); return w; }

constexpr int EC_OFF = 16384, EC_STRIDE = 6144;
__device__ __forceinline__ void dma16(const void* g, PG8_LAS unsigned char* l) { __builtin_amdgcn_global_load_lds((const unsigned*)g, (PG8_LAS unsigned*)l, 16, 0, 0); }
__device__ __forceinline__ void dma_rss(const float* rss, int pm, int ui, PG8_LAS unsigned char* le, int wid, int lane) {
    if (wid == 0) dma16(rss + pm * BM + 4 * lane, le + EC_OFF + (ui & 1) * EC_STRIDE);
}
struct EpiGlaIn {
    bf16_t* Q; bf16_t* Kk; bf16_t* V; bf16_t* R; float* G; const float* rss; const float* b_alpha;
    __device__ __forceinline__ void prefetch(const Unit& u, int ui, PG8_LAS unsigned char* le, int wid, int lane) const { dma_rss(rss, u.pm, ui, le, wid, lane); }
    __device__ __forceinline__ void operator()(f32x4 (&acc)[2][2][4][2], const Unit& u, int ui, int wr, int wc, int fr, int fq, PG8_LAS unsigned char* le) const {
        asm volatile("" : "+v"(fr), "+v"(fq));
        const int pn = u.pn;
        const int row0 = u.pm * BM + wr * 64 + fr;
        const int ct = wc * 32 + 8 * fq;
#pragma unroll
        for (int ai = 0; ai < 2; ++ai)
#pragma unroll
            for (int m = 0; m < 4; ++m) {
                const int row = row0 + ai * HALF + m * 16;
                const float rs = rstd_of(((const PG8_LAS float*)(le + EC_OFF + (ui & 1) * EC_STRIDE))[wr * 64 + fr + ai * HALF + m * 16]);
#pragma unroll
                for (int bj = 0; bj < 2; ++bj) {
                    f32x4 v0 = acc[ai][bj][m][0] * rs, v1 = acc[ai][bj][m][1] * rs;
                    const int c = bj * HALF + ct;
                    if (pn < 2) { const float sc = 0.08838834764831845f; *(u32x4*)(Q + (size_t)row * 512 + pn * 256 + c) = pack8(v0 * sc, v1 * sc); }
                    else if (pn < 4) { *(u32x4*)(Kk + (size_t)row * 512 + (pn - 2) * 256 + c) = pack8(v0, v1); }
                    else if (pn < 8) { *(u32x4*)(V + (size_t)row * 1024 + (pn - 4) * 256 + c) = pack8(v0, v1); }
                    else if (pn < 12) {
#pragma unroll
                        for (int j = 0; j < 4; ++j) { v0[j] = siluf_(v0[j]); v1[j] = siluf_(v1[j]); }
                        *(u32x4*)(R + (size_t)row * 1024 + (pn - 8) * 256 + c) = pack8(v0, v1); }
                    else {
                        const int gc = (pn - 12) * 256 + c;
                        const f32x4 b0 = *(const f32x4*)(b_alpha + gc), b1 = *(const f32x4*)(b_alpha + gc + 4);
                        f32x4 o0, o1;
#pragma unroll
                        for (int j = 0; j < 4; ++j) {
                            const float z0 = v0[j] + b0[j], z1 = v1[j] + b1[j];
                            o0[j] = (fminf(z0, 0.f) - __logf(1.0f + __expf(-fabsf(z0)))) * 0.0625f;
                            o1[j] = (fminf(z1, 0.f) - __logf(1.0f + __expf(-fabsf(z1)))) * 0.0625f; }
                        *(f32x4*)(G + (size_t)row * 512 + gc) = o0; *(f32x4*)(G + (size_t)row * 512 + gc + 4) = o1; }
                }
            }
    }
};

struct EpiRes {
    const float* xin; float* xout; bf16_t* XB; float* rss;
    __device__ __forceinline__ void prefetch(const Unit&, int, PG8_LAS unsigned char*, int, int) const {}
    __device__ __forceinline__ void operator()(f32x4 (&acc)[2][2][4][2], const Unit& u, int ui, int wr, int wc, int fr, int fq, PG8_LAS unsigned char* le) const {
        asm volatile("" : "+v"(fr), "+v"(fq));
        const int row0 = u.pm * BM + wr * 64 + fr;
        const int col0 = u.pn * BM + wc * 32 + 8 * fq;
#pragma unroll
        for (int ai = 0; ai < 2; ++ai)
#pragma unroll
            for (int m = 0; m < 4; ++m) {
                const int row = row0 + ai * HALF + m * 16;
                float ss = 0.f;
#pragma unroll
                for (int bj = 0; bj < 2; ++bj) {
                    const size_t off = (size_t)row * 1024 + col0 + bj * HALF;
                    const f32x4 x0 = *(const f32x4*)(xin + off), x1 = *(const f32x4*)(xin + off + 4);
                    const f32x4 v0 = x0 + acc[ai][bj][m][0], v1 = x1 + acc[ai][bj][m][1];
                    *(f32x4*)(xout + off) = v0; *(f32x4*)(xout + off + 4) = v1;
                    *(u32x4*)(XB + off) = pack8(v0, v1);
                    ss += (v0[0] * v0[0] + v0[1] * v0[1]) + (v0[2] * v0[2] + v0[3] * v0[3]) + (v1[0] * v1[0] + v1[1] * v1[1]) + (v1[2] * v1[2] + v1[3] * v1[3]);
                }
                ss += swz_xor16(ss); { auto rr_ = __builtin_amdgcn_permlane32_swap(__float_as_uint(ss), __float_as_uint(ss), false, false); ss = __uint_as_float(rr_[0]) + __uint_as_float(rr_[1]); }
                if (fq == 0) atomicAdd(rss + row, ss);
            }
    }
};

__device__ __forceinline__ float dpp_ror1(float x) { return __builtin_bit_cast(float, __builtin_amdgcn_update_dpp(0, __builtin_bit_cast(int, x), 0x121, 0xf, 0xf, false)); }
__device__ __forceinline__ float dpp_ror2(float x) { return __builtin_bit_cast(float, __builtin_amdgcn_update_dpp(0, __builtin_bit_cast(int, x), 0x122, 0xf, 0xf, false)); }
constexpr int FF = 2816;
struct EpiFfnUp {
    bf16_t* ACT; float* HALO; const float* rss; const float* cw; const float* cb;
    __device__ __forceinline__ void prefetch(const Unit& u, int ui, PG8_LAS unsigned char* le, int wid, int lane) const {
        dma_rss(rss, u.pm, ui, le, wid, lane);
        if (wid >= 1 && wid <= 4) { const int k = wid - 1; const float* src = (k == 0 ? cb : cw + (k - 1) * 2 * FF) + u.pn * 128 + ((lane < 32) ? 4 * lane : FF + 4 * (lane - 32));
            dma16(src, le + EC_OFF + (ui & 1) * EC_STRIDE + 1024 + k * 1024); }
    }
    __device__ __forceinline__ void operator()(f32x4 (&acc)[2][2][4][2], const Unit& u, int ui, int wr, int wc, int fr, int fq, PG8_LAS unsigned char* le) const {
        asm volatile("" : "+v"(fr), "+v"(fq));
        const int row0 = u.pm * BM + wr * 64 + fr;
        const PG8_LAS float* EC = (const PG8_LAS float*)(le + EC_OFF + (ui & 1) * EC_STRIDE);
#pragma unroll
        for (int ai = 0; ai < 2; ++ai)
#pragma unroll
            for (int m = 0; m < 4; ++m) {
                const float rs = rstd_of(EC[wr * 64 + fr + ai * HALF + m * 16]);
#pragma unroll
                for (int bj = 0; bj < 2; ++bj) { acc[ai][bj][m][0] = acc[ai][bj][m][0] * rs; acc[ai][bj][m][1] = acc[ai][bj][m][1] * rs; }
            }
        PG8_LAS float* HL = (PG8_LAS float*)le + (ui & 1) * 2048;
        if (fr >= 14) {
#pragma unroll
            for (int ai = 0; ai < 2; ++ai)
#pragma unroll
                for (int bj = 0; bj < 2; ++bj)
#pragma unroll
                    for (int n = 0; n < 2; ++n)
                        *(PG8_LAS f32x4*)(HL + ((((wr * 4 + wc) * 2 + ai) * 2 + (fr - 14)) * 64) + bj * 32 + fq * 8 + n * 4) = acc[ai][bj][3][n];
        }
        {
            float* hb = HALO + ((size_t)(u.pm * 22 + u.pn) * 4) * 256 + wc * 32 + fq * 8;
            if (wr == 0 && fr < 2) {
#pragma unroll
                for (int bj = 0; bj < 2; ++bj)
#pragma unroll
                    for (int n = 0; n < 2; ++n) *(f32x4*)(hb + fr * 256 + bj * HALF + n * 4) = acc[0][bj][0][n];
            }
            if (wr == 1 && fr >= 14) {
#pragma unroll
                for (int bj = 0; bj < 2; ++bj)
#pragma unroll
                    for (int n = 0; n < 2; ++n) *(f32x4*)(hb + (fr - 12) * 256 + bj * HALF + n * 4) = acc[1][bj][3][n];
            }
        }
        asm volatile("s_waitcnt lgkmcnt(0)" ::: "memory"); __builtin_amdgcn_s_barrier(); asm volatile("" ::: "memory");
        const bool seq_start = (u.pm & 7) == 0;
        const int cc0 = wc * 32 + fq * 8;
        const bool is15 = (fr == 15), ge14 = (fr >= 14);
        const PG8_LAS float* WB = EC + 256 + cc0;
#pragma unroll
        for (int ai = 0; ai < 2; ++ai) {
            f32x4 pg[2], pv[2];
            if (ai == 0 && wr == 0) { pg[0] = pg[1] = pv[0] = pv[1] = (f32x4){0.f, 0.f, 0.f, 0.f}; }
            else {
                const int swr = (ai == 1 && wr == 1) ? 0 : (ai == 0 ? 0 : 1), sai = (ai == 1 && wr == 1) ? 1 : 0;
                const PG8_LAS float* hp = HL + (((swr * 4 + wc) * 2 + sai) * 2 + (is15 ? 1 : 0)) * 64 + fq * 8;
                pg[0] = *(const PG8_LAS f32x4*)(hp); pg[1] = *(const PG8_LAS f32x4*)(hp + 4); pv[0] = *(const PG8_LAS f32x4*)(hp + 32); pv[1] = *(const PG8_LAS f32x4*)(hp + 36);
            }
#pragma unroll
            for (int m = 0; m < 4; ++m) {
                const int row = row0 + ai * HALF + m * 16;
                u32x4 w;
#pragma unroll
                for (int n = 0; n < 2; ++n) {
                    const f32x4 bg = *(const PG8_LAS f32x4*)(WB + 4 * n), bv = *(const PG8_LAS f32x4*)(WB + 128 + 4 * n);
                    const f32x4 g0 = *(const PG8_LAS f32x4*)(WB + 256 + 4 * n), w0 = *(const PG8_LAS f32x4*)(WB + 256 + 128 + 4 * n);
                    const f32x4 g1 = *(const PG8_LAS f32x4*)(WB + 512 + 4 * n), w1 = *(const PG8_LAS f32x4*)(WB + 512 + 128 + 4 * n);
                    const f32x4 g2 = *(const PG8_LAS f32x4*)(WB + 768 + 4 * n), w2 = *(const PG8_LAS f32x4*)(WB + 768 + 128 + 4 * n);
                    const f32x4 xg = acc[ai][0][m][n], xv = acc[ai][1][m][n];
                    f32x4 g1s, g2s, v1s, v2s;
#pragma unroll
                    for (int j = 0; j < 4; ++j) {
                        g1s[j] = dpp_ror1(is15 ? pg[n][j] : xg[j]); g2s[j] = dpp_ror2(ge14 ? pg[n][j] : xg[j]);
                        v1s[j] = dpp_ror1(is15 ? pv[n][j] : xv[j]); v2s[j] = dpp_ror2(ge14 ? pv[n][j] : xv[j]);
                    }
                    const f32x4 og = bg + g0 * g2s + g1 * g1s + g2 * xg;
                    const f32x4 ov = bv + w0 * v2s + w1 * v1s + w2 * xv;
                    f32x4 e;
#pragma unroll
                    for (int j = 0; j < 4; ++j) e[j] = __builtin_amdgcn_rcpf(1.0f + __builtin_amdgcn_exp2f(og[j] * -1.4426950408889634f));
                    const f32x4 a = og * e * ov;
                    if (n == 0) { w.x = cvt_pk_bf16(a[0], a[1]); w.y = cvt_pk_bf16(a[2], a[3]); } else { w.z = cvt_pk_bf16(a[0], a[1]); w.w = cvt_pk_bf16(a[2], a[3]); }
                    pg[n] = xg; pv[n] = xv;
                }
                const bool skip = (ai == 0 && wr == 0 && m == 0 && fr < 2 && !seq_start);
                if (!skip) *(u32x4*)(ACT + (size_t)row * FF + u.pn * 128 + cc0) = w;
            }
        }
    }
};

struct EpiKvq {
    bf16_t* KV; bf16_t* Q; bf16_t* QR; float* GATES; const float* rss; const float* rope;
    __device__ __forceinline__ void prefetch(const Unit& u, int ui, PG8_LAS unsigned char* le, int wid, int lane) const { dma_rss(rss, u.pm, ui, le, wid, lane); }
    __device__ __forceinline__ void operator()(f32x4 (&acc)[2][2][4][2], const Unit& u, int ui, int wr, int wc, int fr, int fq, PG8_LAS unsigned char* le) const {
        asm volatile("" : "+v"(fr), "+v"(fq));
        const int pn = u.pn;
        const int row0 = u.pm * BM + wr * 64 + fr;
        const float C2 = 0.125f * 1.4426950408889634f;
#pragma unroll
        for (int ai = 0; ai < 2; ++ai)
#pragma unroll
            for (int m = 0; m < 4; ++m) {
                const int row = row0 + ai * HALF + m * 16;
                const int b = row >> 11, s = row & 2047;
                const float rs = rstd_of(((const PG8_LAS float*)(le + EC_OFF + (ui & 1) * EC_STRIDE))[wr * 64 + fr + ai * HALF + m * 16]);
                f32x4 lo0 = acc[ai][0][m][0] * rs, lo1 = acc[ai][0][m][1] * rs;
                f32x4 hi0 = acc[ai][1][m][0] * rs, hi1 = acc[ai][1][m][1] * rs;
                if (pn == 10) {
                    if (wc == 0) {
                        float* gp = GATES + (size_t)row * 48 + 8 * fq;
#pragma unroll
                        for (int j = 0; j < 4; ++j) { lo0[j] = sigmoidf_(lo0[j]); lo1[j] = sigmoidf_(lo1[j]); hi0[j] = sigmoidf_(hi0[j]); hi1[j] = sigmoidf_(hi1[j]); }
                        *(f32x4*)(gp) = lo0; *(f32x4*)(gp + 4) = lo1;
                        if (fq < 2) { *(f32x4*)(gp + 32) = hi0; *(f32x4*)(gp + 36) = hi1; }
                    }
                    continue;
                }
                const bool isq = pn >= 6;
                const bool dorope = isq || pn == 2 || pn == 4;
                f32x4 rl0 = lo0, rl1 = lo1, rh0 = hi0, rh1 = hi1;
                if (dorope) {
                    const float* rp = rope + ((size_t)s * 32 + 8 * fq) * 2;
                    const f32x4 t0 = *(const f32x4*)(rp), t1 = *(const f32x4*)(rp + 4), t2 = *(const f32x4*)(rp + 8), t3 = *(const f32x4*)(rp + 12);
                    const float cs[8] = {t0[0], t0[2], t1[0], t1[2], t2[0], t2[2], t3[0], t3[2]};
                    const float sn[8] = {t0[1], t0[3], t1[1], t1[3], t2[1], t2[3], t3[1], t3[3]};
#pragma unroll
                    for (int j = 0; j < 4; ++j) {
                        rl0[j] = lo0[j] * cs[j] - hi0[j] * sn[j]; rh0[j] = lo0[j] * sn[j] + hi0[j] * cs[j];
                        rl1[j] = lo1[j] * cs[4 + j] - hi1[j] * sn[4 + j]; rh1[j] = lo1[j] * sn[4 + j] + hi1[j] * cs[4 + j];
                    }
                }
                if (!isq) {
                    bf16_t* p = KV + ((((size_t)pn * 16 + b) * 4 + wc) * 2048 + s) * 64 + 8 * fq;
                    *(u32x4*)(p) = pack8(rl0, rl1); *(u32x4*)(p + 32) = pack8(rh0, rh1);
                } else {
                    const int h = (pn - 6) * 4 + wc;
                    const size_t o = (((size_t)b * 16 + h) * 2048 + s) * 64 + 8 * fq;
                    *(u32x4*)(Q + o) = pack8(lo0 * C2, lo1 * C2); *(u32x4*)(Q + o + 32) = pack8(hi0 * C2, hi1 * C2);
                    *(u32x4*)(QR + o) = pack8(rl0 * C2, rl1 * C2); *(u32x4*)(QR + o + 32) = pack8(rh0 * C2, rh1 * C2);
                }
            }
    }
};

struct EpiCmp {
    float* HP;
    __device__ __forceinline__ void prefetch(const Unit&, int, PG8_LAS unsigned char*, int, int) const {}
    __device__ __forceinline__ void operator()(f32x4 (&acc)[2][2][4][2], const Unit& u, int ui, int wr, int wc, int fr, int fq, PG8_LAS unsigned char* le) const {
        asm volatile("" : "+v"(fr), "+v"(fq));
        const int row0 = u.pm * BM + wr * 64 + fr;
        float* base = HP + (size_t)u.pn * 16384 * 256;
#pragma unroll
        for (int ai = 0; ai < 2; ++ai)
#pragma unroll
            for (int m = 0; m < 4; ++m) {
                float* rp = base + (size_t)(row0 + ai * HALF + m * 16) * 256 + wc * 32 + 8 * fq;
#pragma unroll
                for (int bj = 0; bj < 2; ++bj) { *(f32x4*)(rp + bj * HALF) = acc[ai][bj][m][0]; *(f32x4*)(rp + bj * HALF + 4) = acc[ai][bj][m][1]; }
            }
    }
};
struct EpiNull {
    __device__ __forceinline__ void prefetch(const Unit&, int, PG8_LAS unsigned char*, int, int) const {}
    __device__ __forceinline__ void operator()(f32x4 (&acc)[2][2][4][2], const Unit& u, int ui, int wr, int wc, int fr, int fq, PG8_LAS unsigned char* le) const {
#pragma unroll
        for (int ai = 0; ai < 2; ++ai)
#pragma unroll
            for (int bj = 0; bj < 2; ++bj)
#pragma unroll
                for (int m = 0; m < 4; ++m) { asm volatile("" :: "v"(acc[ai][bj][m][0]), "v"(acc[ai][bj][m][1])); }
    }
};
}
namespace pro {
typedef unsigned short bf16_t;
typedef unsigned v4u __attribute__((ext_vector_type(4)));
typedef float f32x4 __attribute__((ext_vector_type(4)));
#define LAS3 __attribute__((address_space(3)))
__device__ __forceinline__ unsigned f2bf(float f) { unsigned u = __builtin_bit_cast(unsigned, f); return (u + 0x7fffu + ((u >> 16) & 1u)) >> 16; }
__device__ __forceinline__ unsigned pk2(float lo, float hi) { return f2bf(lo) | (f2bf(hi) << 16); }

struct In {
    const float *x, *norm_mix, *norm_ffn, *gla_w_in, *gla_w_alpha_up, *gla_b_alpha, *gla_norm, *gla_w_o, *kv_norm, *nsa_w_kv, *cmp_pe_k, *cmp_pe_v,
        *cmp_k_w1, *cmp_k_w2, *cmp_v_w1, *cmp_v_w2, *nsa_w_in, *nsa_w_o, *ffn_w_up, *ffn_conv_w, *ffn_conv_b, *ffn_w_down, *norm_final;
};
struct Wts { bf16_t *WGI, *WGO, *WKQ, *WC1, *WC2, *WNO, *WUP, *WDN; float *ROPE, *BIASC; };

__device__ __forceinline__ void transpose_item(const float* W, int ldw, int scol0, int nvalid, const float* gain, bf16_t* WT, int K, int drow0, int k0, LAS3 float* scr, int lane) {
    const int kr = lane >> 3, nc = (lane & 7) * 4;
    f32x4 v[8];
#pragma unroll
    for (int i = 0; i < 8; ++i) { const int kk = 8 * i + kr;
        v[i] = (nc < nvalid) ? *(const f32x4*)(W + (size_t)(k0 + kk) * ldw + scol0 + nc) : (f32x4){0.f, 0.f, 0.f, 0.f};
        if (gain) v[i] = v[i] * gain[k0 + kk]; }
#pragma unroll
    for (int i = 0; i < 8; ++i) { const int kk = 8 * i + kr; LAS3 float* d = scr + kk * 33 + nc; d[0] = v[i].x; d[1] = v[i].y; d[2] = v[i].z; d[3] = v[i].w; }
    asm volatile("s_waitcnt lgkmcnt(0)" ::: "memory");
    const int c = lane & 7;
#pragma unroll
    for (int j = 0; j < 4; ++j) { const int nn = (lane >> 3) + 8 * j; const LAS3 float* s = scr + (8 * c) * 33 + nn;
        v4u o; o.x = pk2(s[0 * 33], s[1 * 33]); o.y = pk2(s[2 * 33], s[3 * 33]); o.z = pk2(s[4 * 33], s[5 * 33]); o.w = pk2(s[6 * 33], s[7 * 33]);
        *(v4u*)(WT + (size_t)(drow0 + nn) * K + k0 + 8 * c) = o; }
    asm volatile("s_waitcnt lgkmcnt(0)" ::: "memory");
}
__device__ __forceinline__ void weff_item(const In& I, bf16_t* WT, int nb, int k0, LAS3 float* scr, int lane) {
    const int n = lane & 31, ng = 32 * nb + n;
    float wa[16];
#pragma unroll
    for (int r = 0; r < 16; ++r) wa[r] = I.gla_w_alpha_up[r * 512 + ng];
#pragma unroll 2
    for (int i = 0; i < 32; ++i) { const int kk = 2 * i + (lane >> 5); const float* wr = I.gla_w_in + (size_t)(k0 + kk) * 3088 + 3072;
        float v = 0.f;
#pragma unroll
        for (int r = 0; r < 16; ++r) v += wr[r] * wa[r];
        scr[kk * 33 + n] = v * I.norm_mix[k0 + kk]; }
    asm volatile("s_waitcnt lgkmcnt(0)" ::: "memory");
    const int c = lane & 7;
#pragma unroll
    for (int j = 0; j < 4; ++j) { const int nn = (lane >> 3) + 8 * j; const LAS3 float* s = scr + (8 * c) * 33 + nn;
        v4u o; o.x = pk2(s[0 * 33], s[1 * 33]); o.y = pk2(s[2 * 33], s[3 * 33]); o.z = pk2(s[4 * 33], s[5 * 33]); o.w = pk2(s[6 * 33], s[7 * 33]);
        *(v4u*)(WT + (size_t)(3072 + 32 * nb + nn) * 1024 + k0 + 8 * c) = o; }
    asm volatile("s_waitcnt lgkmcnt(0)" ::: "memory");
}

__device__ __forceinline__ void prologue(const In& I, const Wts& W, bf16_t* XB, float* RSS0, LAS3 unsigned char* lds, int gw, int NGW, int lane, int wave) {
    LAS3 float* scr = (LAS3 float*)(lds + wave * 16384);
    constexpr int I0 = 16 * 96, I1 = 16 * 16, I2 = 16 * 32, I3 = 16 * 88, I4 = 32 * 8, I6 = 4 * 2, I8 = 16 * 32, I9 = 16 * 176, I11 = 44 * 32;
    constexpr int NIT = I0 + I1 + I2 + I3 + 2 * I4 + 2 * I6 + I8 + 2 * I9 + 2 * I11;
    for (int it = gw; it < NIT; it += NGW) {
        int r = it;
        if (r < I0) { const int kb = r / 96, nb = r % 96; transpose_item(I.gla_w_in, 3088, 32 * nb, 32, I.norm_mix, W.WGI, 1024, 32 * nb, 64 * kb, scr, lane); continue; } r -= I0;
        if (r < I1) { const int kb = r / 16, nb = r % 16; weff_item(I, W.WGI, nb, 64 * kb, scr, lane); continue; } r -= I1;
        if (r < I2) { const int kb = r / 32, nb = r % 32; transpose_item(I.gla_w_o, 1024, 32 * nb, 32, nullptr, W.WGO, 1024, 32 * nb, 64 * kb, scr, lane); continue; } r -= I2;
        if (r < I3) { const int kb = r / 88, nb = r % 88; const int tile = nb >> 3, gi = nb & 7, L0 = (gi & 3) * 64 + (gi >> 2) * 32;
            if (tile < 6) transpose_item(I.nsa_w_kv, 1536, tile * 256 + L0, 32, I.kv_norm, W.WKQ, 1024, 32 * nb, 64 * kb, scr, lane);
            else if (tile < 10) transpose_item(I.nsa_w_in, 1072, (tile - 6) * 256 + L0, 32, I.norm_mix + 1024, W.WKQ, 1024, 32 * nb, 64 * kb, scr, lane);
            else { int nv = 48 - L0; nv = nv < 0 ? 0 : (nv > 32 ? 32 : nv); transpose_item(I.nsa_w_in, 1072, 1024 + (nv > 0 ? L0 : 0), nv, I.norm_mix + 1024, W.WKQ, 1024, 32 * nb, 64 * kb, scr, lane); }
            continue; } r -= I3;
        if (r < 2 * I4) { const int w = r / I4; r %= I4; const int kb = r / 8, nb = r % 8;
            transpose_item(w ? I.cmp_v_w1 : I.cmp_k_w1, 256, 32 * nb, 32, nullptr, W.WC1 + (size_t)w * 256 * 2048, 2048, 32 * nb, 64 * kb, scr, lane); continue; } r -= 2 * I4;
        if (r < 2 * I6) { const int w = r / I6; r %= I6; const int kb = r / 2, nb = r % 2;
            transpose_item(w ? I.cmp_v_w2 : I.cmp_k_w2, 64, 32 * nb, 32, nullptr, W.WC2 + (size_t)w * 64 * 256, 256, 32 * nb, 64 * kb, scr, lane); continue; } r -= 2 * I6;
        if (r < I8) { const int kb = r / 32, nb = r % 32; transpose_item(I.nsa_w_o, 1024, 32 * nb, 32, nullptr, W.WNO, 1024, 32 * nb, 64 * kb, scr, lane); continue; } r -= I8;
        if (r < 2 * I9) { const int l = r / I9; r %= I9; const int kb = r / 176, nb = r % 176; const int tile = nb >> 3, gi = nb & 7;
            const int sc = (gi < 4) ? (128 * tile + 32 * gi) : (2816 + 128 * tile + 32 * (gi - 4));
            transpose_item(I.ffn_w_up + (size_t)l * 1024 * 5632, 5632, sc, 32, I.norm_ffn + l * 1024, W.WUP + (size_t)l * 5632 * 1024, 1024, 32 * nb, 64 * kb, scr, lane); continue; } r -= 2 * I9;
        { const int l = r / I11; r %= I11; const int kb = r / 32, nb = r % 32;
            transpose_item(I.ffn_w_down + (size_t)l * 2816 * 1024, 1024, 32 * nb, 32, nullptr, W.WDN + (size_t)l * 1024 * 2816, 2816, 32 * nb, 64 * kb, scr, lane); }
    }
    for (int i = gw * 64 + lane; i < 2048 * 32; i += NGW * 64) {
        const int pos = i >> 5, d = i & 31;
        const float inv = powf(10000.0f, -(float)d / 32.0f);
        const float ang = (float)pos * inv;
        float sn, cs; sincosf(ang, &sn, &cs);
        W.ROPE[2 * i] = cs; W.ROPE[2 * i + 1] = sn;
    }
    for (int it = gw; it < 256; it += NGW) {
        const int w = it >> 7, ng = (it >> 5) & 3, kc = it & 31; const float* pe = (w ? I.cmp_pe_v : I.cmp_pe_k) + 64 * kc; const float* w1 = (w ? I.cmp_v_w1 : I.cmp_k_w1) + (size_t)(64 * kc) * 256 + 64 * ng + lane;
        float s = 0.f;
#pragma unroll 16
        for (int k = 0; k < 64; ++k) s += pe[k] * w1[(size_t)k * 256];
        atomicAdd(W.BIASC + w * 256 + 64 * ng + lane, s);
    }
    for (int m = gw; m < 32768; m += NGW) {
        const f32x4* xr = (const f32x4*)(I.x + (size_t)m * 1024) + lane;
        f32x4 v[4]; float s = 0.f;
#pragma unroll
        for (int j = 0; j < 4; ++j) { v[j] = xr[64 * j]; s += (v[j].x * v[j].x + v[j].y * v[j].y) + (v[j].z * v[j].z + v[j].w * v[j].w); }
#pragma unroll
        for (int off = 1; off < 64; off <<= 1) s += __shfl_xor(s, off);
        if (lane == 0) RSS0[m] = s;
        unsigned long long* o8 = (unsigned long long*)(XB + (size_t)m * 1024) + lane;
#pragma unroll
        for (int j = 0; j < 4; ++j) o8[64 * j] = (unsigned long long)pk2(v[j].x, v[j].y) | ((unsigned long long)pk2(v[j].z, v[j].w) << 32);
    }
}
}
namespace gla {
typedef unsigned short bf16_t;
typedef short bf16x8 __attribute__((ext_vector_type(8)));
typedef short s16x4 __attribute__((ext_vector_type(4)));
typedef float f32x16 __attribute__((ext_vector_type(16)));
typedef float f32x4 __attribute__((ext_vector_type(4)));
typedef unsigned u32x4 __attribute__((ext_vector_type(4)));
typedef unsigned u32x2 __attribute__((ext_vector_type(2)));
#define GLAS __attribute__((address_space(3)))
__device__ __forceinline__ int crow(int r, int hi) { return (r & 3) + 8 * (r >> 2) + 4 * hi; }
__device__ __forceinline__ float bf2f(bf16_t v) { return __builtin_bit_cast(float, (unsigned)v << 16); }
__device__ __forceinline__ unsigned cvtpk(float lo, float hi) { typedef float f2 __attribute__((ext_vector_type(2))); typedef __bf16 b2 __attribute__((ext_vector_type(2))); f2 v = {lo, hi}; b2 b = __builtin_convertvector(v, b2); return __builtin_bit_cast(unsigned, b); }
__device__ __forceinline__ bf16_t f2bf1(float f) { return (bf16_t)(cvtpk(f, 0.f) & 0xffffu); }
__device__ __forceinline__ s16x4 vtr(const GLAS unsigned char* p) { typedef short v4i16_t __attribute__((ext_vector_type(4))); return __builtin_bit_cast(s16x4, __builtin_amdgcn_ds_read_tr16_b64_v4i16((GLAS v4i16_t*)p)); }
__device__ __forceinline__ bf16x8 ld2x64(const GLAS unsigned char* p0, const GLAS unsigned char* p1) {
    const s16x4 a = *(const GLAS s16x4*)p0, b = *(const GLAS s16x4*)p1; return (bf16x8){a[0], a[1], a[2], a[3], b[0], b[1], b[2], b[3]};
}
constexpr int QEP = 264, KDP = 136, VP = 576, OLP = 260;
constexpr int L_QE = 0, L_KE = 16896, L_KDT = 33792, L_ATT = 51200, L_V = 59904, L_BL = 96768, L_QT = 97280, L_END = 99328;

template <bool STATE_ONLY>
__device__ __forceinline__ void gla_unit(int b, int h, int seg, const bf16_t* Qg, const bf16_t* Kg, const bf16_t* VO, bf16_t* Oout, const bf16_t* Rg, const float* Gg, const float* gnorm, float* SLOC, float* DSEG, GLAS unsigned char* lds, int tid0) {
    int tid_ = tid0; asm volatile("" : "+v"(tid_));
    const int tid = tid_, lane = tid & 63, w = __builtin_amdgcn_readfirstlane(tid >> 6), r32 = lane & 31, hi = lane >> 5;
    f32x16 S[4];
#pragma unroll
    for (int i = 0; i < 4; ++i)
#pragma unroll
        for (int r = 0; r < 16; ++r) S[i][r] = 0.f;
    const int kcol = tid & 127, qd = tid >> 7;
    const int bh = b * 4 + h;
    if (!STATE_ONLY && seg >= 1) {
#pragma unroll 1
        for (int s = 0; s < seg; ++s) {
            const float* sl = SLOC + ((size_t)(bh * 3 + s) * 128) * 256 + 32 * w + r32; const float* dd = DSEG + (bh * 3 + s) * 128;
#pragma unroll
            for (int i = 0; i < 4; ++i)
#pragma unroll
                for (int r = 0; r < 16; ++r) { const int k = 32 * i + crow(r, hi); const float d = (s == 0) ? 0.f : dd[k]; S[i][r] = S[i][r] * d + sl[(size_t)k * 256]; }
        }
    }
    float dlog = 0.f;
    GLAS float* BL = (GLAS float*)(lds + L_BL); GLAS float* QT = (GLAS float*)(lds + L_QT);
    GLAS float* OL = (GLAS float*)lds;
    for (int c = seg * 8; c < seg * 8 + 8; ++c) {
        const size_t row0 = (size_t)b * 2048 + c * 64;
        {
            float cs[16]; float run = 0.f;
            const float* gp = Gg + (row0 + 16 * qd) * 512 + h * 128 + kcol;
#pragma unroll
            for (int i = 0; i < 16; ++i) { run += gp[(size_t)i * 512]; cs[i] = run; }
            QT[qd * 128 + kcol] = run;
#pragma unroll
            for (int i = 0; i < 4; ++i) { const int p = tid + 512 * i, rr = p >> 5, ch = p & 31;
                const u32x4 v = *(const u32x4*)(VO + (row0 + rr) * 1024 + h * 256 + ch * 8);
                *(GLAS u32x4*)(lds + L_V + rr * VP + ch * 16) = v; }
            float qv[16], kv[16];
            const bf16_t* qp = Qg + (row0 + 16 * qd) * 512 + h * 128 + kcol; const bf16_t* kp = Kg + (row0 + 16 * qd) * 512 + h * 128 + kcol;
#pragma unroll
            for (int i = 0; i < 16; ++i) { qv[i] = STATE_ONLY ? 0.f : bf2f(qp[(size_t)i * 512]); kv[i] = bf2f(kp[(size_t)i * 512]); }
            __syncthreads();
            float pre = 0.f, tot = 0.f;
#pragma unroll
            for (int q = 0; q < 4; ++q) { const float t = QT[q * 128 + kcol]; tot += t; if (q < qd) pre += t; }
            if (qd == 0) BL[kcol] = __expf(tot);
            dlog += tot;
            float kd[16];
#pragma unroll
            for (int i = 0; i < 16; ++i) { const float bb = pre + cs[i]; const int t = 16 * qd + i;
                if (!STATE_ONLY) { *(GLAS bf16_t*)(lds + L_QE + t * QEP + kcol * 2) = f2bf1(qv[i] * __expf(bb));
                                   *(GLAS bf16_t*)(lds + L_KE + t * QEP + kcol * 2) = f2bf1(kv[i] * __expf(-bb)); }
                kd[i] = kv[i] * __expf(tot - bb); }
#pragma unroll
            for (int i = 0; i < 4; ++i) { u32x2 v; v.x = cvtpk(kd[4 * i], kd[4 * i + 1]); v.y = cvtpk(kd[4 * i + 2], kd[4 * i + 3]);
                *(GLAS u32x2*)(lds + L_KDT + kcol * KDP + (16 * qd + 4 * i) * 2) = v; }
        }
        __syncthreads();
        f32x16 o[2];
#pragma unroll
        for (int r = 0; r < 16; ++r) { o[0][r] = 0.f; o[1][r] = 0.f; }
        if (!STATE_ONLY) {
        if (w < 3) {
            const int ti = (w >= 1) ? 1 : 0, si = (w == 2) ? 1 : 0;
            f32x16 a;
#pragma unroll
            for (int r = 0; r < 16; ++r) a[r] = 0.f;
            const GLAS unsigned char* ap = lds + L_QE + (32 * ti + r32) * QEP + 16 * hi; const GLAS unsigned char* bp = lds + L_KE + (32 * si + r32) * QEP + 16 * hi;
#pragma unroll
            for (int s = 0; s < 8; ++s) { const bf16x8 A = ld2x64(ap + 32 * s, ap + 32 * s + 8), B = ld2x64(bp + 32 * s, bp + 32 * s + 8);
                a = __builtin_amdgcn_mfma_f32_32x32x16_bf16(A, B, a, 0, 0, 0); }
            const int sg = 32 * si + r32;
#pragma unroll
            for (int r = 0; r < 16; ++r) { const int tg = 32 * ti + crow(r, hi); const float v = (sg <= tg) ? a[r] : 0.f;
                *(GLAS bf16_t*)(lds + L_ATT + tg * KDP + sg * 2) = f2bf1(v); }
        } else if (w == 3) {
#pragma unroll
            for (int r = 0; r < 16; ++r) *(GLAS bf16_t*)(lds + L_ATT + crow(r, hi) * KDP + (32 + r32) * 2) = 0;
        }
        {
#pragma unroll
            for (int i = 0; i < 4; ++i)
#pragma unroll
                for (int s = 0; s < 2; ++s) {
                    u32x4 pk; pk.x = cvtpk(S[i][8 * s], S[i][8 * s + 1]); pk.y = cvtpk(S[i][8 * s + 2], S[i][8 * s + 3]); pk.z = cvtpk(S[i][8 * s + 4], S[i][8 * s + 5]); pk.w = cvtpk(S[i][8 * s + 6], S[i][8 * s + 7]);
                    const bf16x8 Bf = __builtin_bit_cast(bf16x8, pk);
#pragma unroll
                    for (int ti = 0; ti < 2; ++ti) { const GLAS unsigned char* ap = lds + L_QE + (32 * ti + r32) * QEP + (32 * i + 16 * s + 4 * hi) * 2;
                        const bf16x8 A = ld2x64(ap, ap + 16); o[ti] = __builtin_amdgcn_mfma_f32_32x32x16_bf16(A, Bf, o[ti], 0, 0, 0); }
                }
        }
        __syncthreads();
        }
        {
            bf16x8 vf[4];
            const int gI = lane >> 4, i16 = lane & 15, q = i16 >> 2, p = i16 & 3;
            const GLAS unsigned char* vb = lds + L_V + (8 * hi + q) * VP + (32 * w + 16 * (gI & 1) + 4 * p) * 2;
#pragma unroll
            for (int ks = 0; ks < 4; ++ks) { const s16x4 lo = vtr(vb + 16 * ks * VP), hh = vtr(vb + (16 * ks + 4) * VP);
                vf[ks] = (bf16x8){lo[0], lo[1], lo[2], lo[3], hh[0], hh[1], hh[2], hh[3]}; }
            if (!STATE_ONLY) {
#pragma unroll
            for (int ti = 0; ti < 2; ++ti)
#pragma unroll
                for (int ks = 0; ks < 4; ++ks) { const GLAS unsigned char* ap = lds + L_ATT + (32 * ti + r32) * KDP + (16 * ks + 8 * hi) * 2;
                    const bf16x8 A = ld2x64(ap, ap + 8); o[ti] = __builtin_amdgcn_mfma_f32_32x32x16_bf16(A, vf[ks], o[ti], 0, 0, 0); }
            }
#pragma unroll
            for (int i = 0; i < 4; ++i) {
#pragma unroll
                for (int r = 0; r < 16; ++r) S[i][r] *= BL[32 * i + crow(r, hi)];
#pragma unroll
                for (int ks = 0; ks < 4; ++ks) { const GLAS unsigned char* ap = lds + L_KDT + (32 * i + r32) * KDP + (16 * ks + 8 * hi) * 2;
                    const bf16x8 A = ld2x64(ap, ap + 8); S[i] = __builtin_amdgcn_mfma_f32_32x32x16_bf16(A, vf[ks], S[i], 0, 0, 0); }
            }
        }
        __syncthreads();
        if (!STATE_ONLY) {
#pragma unroll
        for (int ti = 0; ti < 2; ++ti)
#pragma unroll
            for (int r = 0; r < 16; ++r) OL[(32 * ti + crow(r, hi)) * OLP + 32 * w + r32] = o[ti][r];
        __syncthreads();
        {
            const int t = tid >> 3, seg = tid & 7;
            f32x4 v[8]; float ss = 0.f;
#pragma unroll
            for (int j = 0; j < 8; ++j) { v[j] = *(const GLAS f32x4*)(OL + t * OLP + 32 * seg + 4 * j); ss += (v[j].x * v[j].x + v[j].y * v[j].y) + (v[j].z * v[j].z + v[j].w * v[j].w); }
            ss += dpp_xor1(ss); ss += dpp_xor2(ss); ss += dpp_hmirror(ss);
            const float rs = rsqrtf(ss * (1.0f / 256.0f) + 1e-6f);
            const size_t go = (row0 + t) * 1024 + h * 256 + 32 * seg;
            const float* gn = gnorm + h * 256 + 32 * seg;
#pragma unroll
            for (int j = 0; j < 4; ++j) {
                const u32x4 rr = *(const u32x4*)(Rg + go + 8 * j);
                const f32x4 g0 = *(const f32x4*)(gn + 8 * j), g1 = *(const f32x4*)(gn + 8 * j + 4);
                const f32x4 a = v[2 * j], bq = v[2 * j + 1];
                u32x4 ov;
                ov.x = cvtpk(a.x * rs * g0.x * __builtin_bit_cast(float, rr.x << 16), a.y * rs * g0.y * __builtin_bit_cast(float, rr.x & 0xffff0000u));
                ov.y = cvtpk(a.z * rs * g0.z * __builtin_bit_cast(float, rr.y << 16), a.w * rs * g0.w * __builtin_bit_cast(float, rr.y & 0xffff0000u));
                ov.z = cvtpk(bq.x * rs * g1.x * __builtin_bit_cast(float, rr.z << 16), bq.y * rs * g1.y * __builtin_bit_cast(float, rr.z & 0xffff0000u));
                ov.w = cvtpk(bq.z * rs * g1.z * __builtin_bit_cast(float, rr.w << 16), bq.w * rs * g1.w * __builtin_bit_cast(float, rr.w & 0xffff0000u));
                *(u32x4*)(Oout + go + 8 * j) = ov;
            }
        }
        __syncthreads();
        }
    }
    if (STATE_ONLY) {
        float* sl = SLOC + ((size_t)(bh * 3 + seg) * 128) * 256 + 32 * w + r32;
#pragma unroll
        for (int i = 0; i < 4; ++i)
#pragma unroll
            for (int r = 0; r < 16; ++r) sl[(size_t)(32 * i + crow(r, hi)) * 256] = S[i][r];
        if (qd == 0) DSEG[(bh * 3 + seg) * 128 + kcol] = __expf(dlog);
    }
}
}
namespace nsa {
typedef unsigned short bf16_t;
typedef short bf16x8 __attribute__((ext_vector_type(8)));
typedef short s16x4 __attribute__((ext_vector_type(4)));
typedef float f32x16 __attribute__((ext_vector_type(16)));
typedef float f32x4 __attribute__((ext_vector_type(4)));
typedef unsigned u32x4 __attribute__((ext_vector_type(4)));
#define NLAS __attribute__((address_space(3)))
__device__ __forceinline__ int crow(int r, int hi) { return (r & 3) + 8 * (r >> 2) + 4 * hi; }
__device__ __forceinline__ unsigned cvtpk(float lo, float hi) { typedef float f2 __attribute__((ext_vector_type(2))); typedef __bf16 b2 __attribute__((ext_vector_type(2))); f2 v = {lo, hi}; b2 b = __builtin_convertvector(v, b2); return __builtin_bit_cast(unsigned, b); }
__device__ __forceinline__ s16x4 vtr(const NLAS unsigned char* p) { typedef short v4i16_t __attribute__((ext_vector_type(4))); return __builtin_bit_cast(s16x4, __builtin_amdgcn_ds_read_tr16_b64_v4i16((NLAS v4i16_t*)p)); }

__device__ __forceinline__ float gelu_tanh(float x) { const float y = 0.7978845608028654f * (x + 0.044715f * x * x * x); const float e = __expf(2.0f * y); const float th = 1.0f - 2.0f * __builtin_amdgcn_rcpf(e + 1.0f); return 0.5f * x * (1.0f + th); }
__device__ __forceinline__ void cmp_finalize(const float* HP, const float* BIASC, const bf16_t* WC2, bf16_t* KCVC, int gw, int NGW, int lane) {
    typedef float f4 __attribute__((ext_vector_type(4)));
    const int r = lane & 15, kq = lane >> 4;
    for (int item = gw; item < 1024; item += NGW) {
        const int R0 = item * 16, w = R0 >> 13, row = R0 + r;
        f4 acc[4];
#pragma unroll
        for (int nt = 0; nt < 4; ++nt) acc[nt] = (f4){0.f, 0.f, 0.f, 0.f};
#pragma unroll
        for (int ks = 0; ks < 8; ++ks) {
            const int col = 32 * ks + 8 * kq;
            f32x4 s0 = *(const f32x4*)(BIASC + w * 256 + col), s1 = *(const f32x4*)(BIASC + w * 256 + col + 4);
#pragma unroll
            for (int p = 0; p < 4; ++p) { const float* hp = HP + ((size_t)p * 16384 + row) * 256 + col; s0 = s0 + *(const f32x4*)hp; s1 = s1 + *(const f32x4*)(hp + 4); }
            u32x4 pk; pk.x = cvtpk(gelu_tanh(s0.x), gelu_tanh(s0.y)); pk.y = cvtpk(gelu_tanh(s0.z), gelu_tanh(s0.w)); pk.z = cvtpk(gelu_tanh(s1.x), gelu_tanh(s1.y)); pk.w = cvtpk(gelu_tanh(s1.z), gelu_tanh(s1.w));
            const bf16x8 A = __builtin_bit_cast(bf16x8, pk);
#pragma unroll
            for (int nt = 0; nt < 4; ++nt) { const bf16x8 B = *(const bf16x8*)(WC2 + ((size_t)w * 64 + 16 * nt + r) * 256 + col);
                acc[nt] = __builtin_amdgcn_mfma_f32_16x16x32_bf16(A, B, acc[nt], 0, 0, 0); }
        }
#pragma unroll
        for (int nt = 0; nt < 4; ++nt)
#pragma unroll
            for (int rg = 0; rg < 4; ++rg) { const int orow = R0 + 4 * kq + rg; const float v = ((orow & 127) == 127) ? 0.f : acc[nt][rg];
                KCVC[(size_t)orow * 64 + 16 * nt + r] = (bf16_t)(cvtpk(v, 0.f) & 0xffffu); }
    }
}

constexpr int SLOTB = 16384, NSLOT = 4;
constexpr int L_IMP = NSLOT * SLOTB, L_CAR = L_IMP + 8 * 32 * 33 * 4, L_VAL = L_CAR + 8 * 32 * 33 * 4, L_SELM = L_VAL + 64 * 33 * 4, L_WSF = L_SELM + 256, L_FAC = L_WSF + 8 * 64 * 4, L_AEND = L_FAC + 8 * 32 * 2 * 4;
static_assert(L_AEND <= 131072 + 28672, "attention LDS");
#define NINF (-__builtin_inff())
#define ABAR() asm volatile("s_waitcnt lgkmcnt(0)\n\ts_barrier" ::: "memory")

__device__ __forceinline__ void k_load(bf16x8* kf, const NLAS unsigned char* ks, int r32, int hi) {
    const int sw = (r32 >> 1) & 7;
    const NLAS unsigned char* kb = ks + r32 * 128;
#pragma unroll
    for (int d0 = 0; d0 < 4; ++d0) { const int off = (((2 * d0 + hi) ^ sw) << 4);
        kf[2 * d0] = *(const NLAS bf16x8*)(kb + off); kf[2 * d0 + 1] = *(const NLAS bf16x8*)(kb + 4096 + off); }
}
__device__ __forceinline__ void qk_mma(f32x16& p0, f32x16& p1, const bf16x8* kf, const bf16x8* qf, const f32x16& c) {
#pragma unroll
    for (int d0 = 0; d0 < 4; ++d0) {
        if (d0 == 0) { p0 = __builtin_amdgcn_mfma_f32_32x32x16_bf16(kf[0], qf[0], c, 0, 0, 0); p1 = __builtin_amdgcn_mfma_f32_32x32x16_bf16(kf[1], qf[0], c, 0, 0, 0); }
        else { p0 = __builtin_amdgcn_mfma_f32_32x32x16_bf16(kf[2 * d0], qf[d0], p0, 0, 0, 0); p1 = __builtin_amdgcn_mfma_f32_32x32x16_bf16(kf[2 * d0 + 1], qf[d0], p1, 0, 0, 0); }
    }
}
__device__ __forceinline__ void pack_p(bf16x8* pa, const f32x16& p0, const f32x16& p1) {
    u32x4 w;
    w.x = cvtpk(p0[0], p0[1]); w.y = cvtpk(p0[2], p0[3]); w.z = cvtpk(p0[4], p0[5]); w.w = cvtpk(p0[6], p0[7]); pa[0] = __builtin_bit_cast(bf16x8, w);
    w.x = cvtpk(p0[8], p0[9]); w.y = cvtpk(p0[10], p0[11]); w.z = cvtpk(p0[12], p0[13]); w.w = cvtpk(p0[14], p0[15]); pa[1] = __builtin_bit_cast(bf16x8, w);
    w.x = cvtpk(p1[0], p1[1]); w.y = cvtpk(p1[2], p1[3]); w.z = cvtpk(p1[4], p1[5]); w.w = cvtpk(p1[6], p1[7]); pa[2] = __builtin_bit_cast(bf16x8, w);
    w.x = cvtpk(p1[8], p1[9]); w.y = cvtpk(p1[10], p1[11]); w.z = cvtpk(p1[12], p1[13]); w.w = cvtpk(p1[14], p1[15]); pa[3] = __builtin_bit_cast(bf16x8, w);
}
__device__ __forceinline__ void v_load(bf16x8* vf, const NLAS unsigned char* vs, int lane) {
    const int hi = lane >> 5;
    const NLAS unsigned char* vb = vs + ((lane >> 4) & 1) * 32 + (lane & 3) * 8 + (4 * hi + ((lane & 15) >> 2)) * 64;
#pragma unroll
    for (int d0 = 0; d0 < 2; ++d0)
#pragma unroll
        for (int ks = 0; ks < 4; ++ks) {
            const s16x4 lo = vtr(vb + d0 * 4096 + ks * 1024), hh = vtr(vb + d0 * 4096 + ks * 1024 + 512);
            vf[d0 * 4 + ks] = (bf16x8){lo[0], lo[1], lo[2], lo[3], hh[0], hh[1], hh[2], hh[3]};
        }
}
__device__ __forceinline__ void pv_mma(f32x16* o, const bf16x8* vf, const bf16x8* pa) {
#pragma unroll
    for (int ks = 0; ks < 4; ++ks) {
        o[0] = __builtin_amdgcn_mfma_f32_32x32x16_bf16(pa[ks], vf[ks], o[0], 0, 0, 0);
        o[1] = __builtin_amdgcn_mfma_f32_32x32x16_bf16(pa[ks], vf[4 + ks], o[1], 0, 0, 0);
    }
}
__device__ __forceinline__ float max32(const f32x16& p0, const f32x16& p1) {
    float a = fmaxf(p0[0], p1[0]);
#pragma unroll
    for (int r = 1; r < 16; ++r) a = fmaxf(a, fmaxf(p0[r], p1[r]));
    return a;
}
__device__ __forceinline__ float comb_max(float v) { auto rr = __builtin_amdgcn_permlane32_swap(__float_as_uint(v), __float_as_uint(v), false, false); return fmaxf(__uint_as_float(rr[0]), __uint_as_float(rr[1])); }
__device__ __forceinline__ float comb_sum(float v) { auto rr = __builtin_amdgcn_permlane32_swap(__float_as_uint(v), __float_as_uint(v), false, false); return __uint_as_float(rr[0]) + __uint_as_float(rr[1]); }
__device__ __forceinline__ void mask_le(f32x16& p0, f32x16& p1, int thr, int hi) {
    int t2 = thr - 4 * hi; asm volatile("" : "+v"(t2));
#pragma unroll
    for (int r = 0; r < 16; ++r) { const int kc = (r & 3) + 8 * (r >> 2); if (kc > t2) p0[r] = NINF; if (kc + 32 > t2) p1[r] = NINF; }
}
__device__ __forceinline__ void mask_gt(f32x16& p0, f32x16& p1, int thr, int hi) {
    int t2 = thr - 4 * hi; asm volatile("" : "+v"(t2));
#pragma unroll
    for (int r = 0; r < 16; ++r) { const int kc = (r & 3) + 8 * (r >> 2); if (kc <= t2) p0[r] = NINF; if (kc + 32 <= t2) p1[r] = NINF; }
}

#ifndef SOFT_THR
#define SOFT_THR 8.0f
#endif
struct Soft { float mhat, l; f32x16 o[2]; };
__device__ __forceinline__ void soft_init(Soft& s) { s.mhat = 0.f; s.l = 0.f;
#pragma unroll
    for (int r = 0; r < 16; ++r) { s.o[0][r] = 0.f; s.o[1][r] = 0.f; } }
__device__ __forceinline__ float soft_update(Soft& s, f32x16& p0, f32x16& p1, bool first, NLAS float* wsf, int r32, int hi) {
    const float rm = comb_max(max32(p0, p1));
    const float dl = first ? ((rm > NINF) ? rm : 0.f) : ((rm > SOFT_THR) ? rm : 0.f);
    float f = 1.0f;
    if (__any(dl != 0.f)) {
        s.mhat += dl;
        f = __builtin_amdgcn_exp2f(-dl);
        s.l *= f;
#pragma unroll
        for (int r = 0; r < 16; ++r) { p0[r] -= dl; p1[r] -= dl; }
        if (!first) {
            if (hi == 0) wsf[r32] = f;
            asm volatile("s_waitcnt lgkmcnt(0)" ::: "memory");
#pragma unroll
            for (int r = 0; r < 16; ++r) { const float ff = wsf[crow(r, hi)]; s.o[0][r] *= ff; s.o[1][r] *= ff; }
            asm volatile("s_waitcnt lgkmcnt(0)" ::: "memory");
        }
    }
    float sum = 0.f;
#pragma unroll
    for (int r = 0; r < 16; ++r) { p0[r] = __builtin_amdgcn_exp2f(p0[r]); p1[r] = __builtin_amdgcn_exp2f(p1[r]); sum += p0[r] + p1[r]; }
    s.l += sum;
    return f;
}

struct AttnBufs { unsigned char* ws; };
struct Strm { int u, kind, j; };
__device__ __forceinline__ int unit_qt(int u, int sub) { return 8 * (u >> 1) + ((u & 1) ? (7 - sub) : sub); }
__device__ __forceinline__ void strm_next(Strm& s, int sub) {
    const int qt = unit_qt(s.u, sub);
    if (s.kind == 0) { if (s.j == 0) s.j = 1; else { s.kind = 1; s.j = qt; } }
    else if (s.kind == 1) { if (s.j > 0) --s.j; else { s.kind = 2; s.j = qt; } }
    else { const int jlo = qt >= 8 ? qt - 8 : 0; if (s.j > jlo) --s.j; else { ++s.u; s.kind = 0; s.j = 0; } }
}
__device__ __forceinline__ void dma16(const void* g, NLAS unsigned char* l) { __builtin_amdgcn_global_load_lds((const unsigned*)g, (NLAS unsigned*)l, 16, 0, 0); }

template <int VAR = 0>
__device__ __forceinline__ void attn_block(int bh, int sub, const AttnBufs& T, NLAS unsigned char* lds, int tid0) {
    int tid_ = tid0; asm volatile("" : "+v"(tid_));
    const int tid = tid_, lane = tid & 63, w = __builtin_amdgcn_readfirstlane(tid >> 6), r32 = lane & 31, hi = lane >> 5;
    const int b = bh >> 2, hk = bh & 3, g = w >> 1, hq = hk * 4 + g, qi = 32 * (w & 1) + r32;
    NLAS float* wsf = (NLAS float*)(lds + L_WSF) + w * 64;
    NLAS float* IMP = (NLAS float*)(lds + L_IMP) + w * 32 * 33; NLAS float* CAR = (NLAS float*)(lds + L_CAR) + w * 32 * 33;
    NLAS float* stash = (NLAS float*)(lds + L_IMP + w * 8448) + lane;
    const int krow = 8 * w + (lane >> 3), koff = krow * 64 + (((lane & 7) ^ ((krow >> 1) & 7)) << 3), voff = (16 * (w & 3) + (lane >> 2)) * 64 + (w >> 2) * 32 + (lane & 3) * 8;
    unsigned char* const ws = T.ws;
    constexpr size_t kvs = (size_t)16 * 4 * 2048 * 64;
#define A_KC ((const bf16_t*)(ws + WS_KCVC) + ((size_t)bh * 128) * 64)
#define A_VC ((const bf16_t*)(ws + WS_KCVC) + ((size_t)(64 + bh) * 128) * 64)
#define A_KV ((const bf16_t*)(ws + WS_KV) + (size_t)bh * 2048 * 64)
#define ISSUE(st, slot) do { const bf16_t* kt_; const bf16_t* vt_; \
        if ((st).kind == 0) { kt_ = A_KC + (st).j * 4096; vt_ = A_VC + (st).j * 4096; } \
        else if ((st).kind == 1) { kt_ = A_KV + 2 * kvs + (size_t)(st).j * 4096; vt_ = A_KV + 3 * kvs + (size_t)(st).j * 4096; } \
        else { kt_ = A_KV + 4 * kvs + (size_t)(st).j * 4096; vt_ = A_KV + 5 * kvs + (size_t)(st).j * 4096; } \
        dma16(kt_ + koff, lds + (slot) * SLOTB + w * 1024); dma16(vt_ + voff, lds + (slot) * SLOTB + 8192 + w * 1024); } while (0)
    Strm ist; ist.u = 0; ist.kind = 0; ist.j = 0;
    Strm cst = ist;
    int P = 0;
#pragma unroll 1
    for (int u = 0; u < 8; ++u) { const int qt = unit_qt(u, sub); P += 2 + (qt + 1) + ((qt >= 8 ? 8 : qt) + 1); }
    ISSUE(ist, 0); strm_next(ist, sub); ISSUE(ist, 1); strm_next(ist, sub); ISSUE(ist, 2); strm_next(ist, sub);
    Soft S; soft_init(S);
    bf16x8 qf[4];
    float g_cmp = 0.f, g_sel = 0.f, g_win = 0.f; unsigned selm = 0u; int qt = 0;
#pragma unroll 1
    for (int p = 0; p < P; ++p) {
        const int ahead = P - 1 - p;
        if (ahead >= 2) asm volatile("s_waitcnt vmcnt(4)" ::: "memory"); else if (ahead == 1) asm volatile("s_waitcnt vmcnt(2)" ::: "memory"); else asm volatile("s_waitcnt vmcnt(0)" ::: "memory");
        ABAR();
        if (p + 3 < P) { ISSUE(ist, (p + 3) & 3); strm_next(ist, sub); }
        const NLAS unsigned char* slot = lds + (p & 3) * SLOTB;
        const int kind = cst.kind, j = cst.j;
        if (kind == 0 && j == 0) {
            qt = unit_qt(cst.u, sub);
            const int tok = 64 * qt + qi;
            const float* gp = (const float*)(ws + WS_GATES) + ((size_t)b * 2048 + tok) * 48 + hq;
            g_cmp = gp[0]; g_sel = gp[16]; g_win = gp[32];
            const size_t qoff = (((size_t)b * 16 + hq) * 2048 + tok) * 64 + 8 * hi;
#pragma unroll
            for (int d0 = 0; d0 < 4; ++d0) qf[d0] = *(const bf16x8*)((const bf16_t*)(ws + WS_NQ) + qoff + 16 * d0);
            soft_init(S);
        }
        if ((kind == 1 || kind == 2) && j == qt) soft_init(S);
        const bool first = (kind == 0) ? (j == 0) : (j == qt);
        float cv = -S.mhat;
        if (kind == 1) { if (!((selm >> j) & 1u)) cv = NINF; }
        f32x16 c;
#pragma unroll
        for (int r = 0; r < 16; ++r) c[r] = cv;
        f32x16 p0, p1;
        if (VAR == 1) { p0 = c; p1 = c; asm volatile("" : "+v"(p0), "+v"(p1)); if (VAR == 1) { strm_next(cst, sub); continue; } }
        bf16x8 vf[8];
        {
            bf16x8 kf[8]; k_load(kf, slot, r32, hi);
            qk_mma(p0, p1, kf, qf, c);
        }
        v_load(vf, slot + 8192, lane);
        __builtin_amdgcn_sched_barrier(0);
        if (VAR == 2) { asm volatile("" :: "v"(p0), "v"(p1)); strm_next(cst, sub); continue; }
        if (kind == 0) { const int tok = 64 * qt + qi; const int nmax = (tok >= 31) ? ((tok - 31) >> 4) : -1; mask_le(p0, p1, nmax - 64 * j, hi); }
        else { if (j == qt) mask_le(p0, p1, qi, hi); if (kind == 2 && j == qt - 8) mask_gt(p0, p1, qi, hi); }
        const float f = soft_update(S, p0, p1, first, wsf, r32, hi);
        if (VAR == 3) { asm volatile("" :: "v"(p0), "v"(p1)); strm_next(cst, sub); continue; }
        {
            bf16x8 pa[4]; pack_p(pa, p0, p1);
            pv_mma(S.o, vf, pa);
        }
        if (kind == 0) {
            NLAS float* FAC = (NLAS float*)(lds + L_FAC) + w * 64;
            if (j == 0) {
                if (hi == 0) CAR[r32 * 33] = 0.f;
#pragma unroll
                for (int a = 0; a < 4; ++a) {
                    const int jb = 2 * a + hi;
                    IMP[r32 * 33 + jb] = p0[4 * a] + p0[4 * a + 1] + p0[4 * a + 2] + 0.5f * p0[4 * a + 3]; CAR[r32 * 33 + jb + 1] = 0.5f * p0[4 * a + 3];
                    IMP[r32 * 33 + jb + 8] = p1[4 * a] + p1[4 * a + 1] + p1[4 * a + 2] + 0.5f * p1[4 * a + 3]; CAR[r32 * 33 + jb + 9] = 0.5f * p1[4 * a + 3];
                }
            } else {
                const float l = comb_sum(S.l);
                const float inv = (l > 0.f) ? __builtin_amdgcn_rcpf(l) : 0.f;
                if (hi == 0) { FAC[r32] = f * inv; FAC[32 + r32] = inv; }
#pragma unroll
                for (int a = 0; a < 4; ++a) {
                    const int jb = 2 * a + hi;
                    IMP[r32 * 33 + jb + 16] = p0[4 * a] + p0[4 * a + 1] + p0[4 * a + 2] + 0.5f * p0[4 * a + 3]; CAR[r32 * 33 + jb + 17] = 0.5f * p0[4 * a + 3];
                    IMP[r32 * 33 + jb + 24] = p1[4 * a] + p1[4 * a + 1] + p1[4 * a + 2] + 0.5f * p1[4 * a + 3]; if (jb + 25 < 32) CAR[r32 * 33 + jb + 25] = 0.5f * p1[4 * a + 3];
                }
                ABAR();
                {
                    NLAS float* VAL = (NLAS float*)(lds + L_VAL);
                    const int tq = tid >> 3, sb = tid & 7, wv = tq >> 5, rr = tq & 31;
                    const NLAS float* I0 = (const NLAS float*)(lds + L_IMP); const NLAS float* C0 = (const NLAS float*)(lds + L_CAR);
                    float v[4];
#pragma unroll
                    for (int e = 0; e < 4; ++e) { const int jb = 4 * sb + e; float sc = 0.f;
#pragma unroll
                        for (int gg = 0; gg < 4; ++gg) { const int ww = 2 * gg + wv; const NLAS float* fc = (const NLAS float*)(lds + L_FAC) + ww * 64 + rr;
                            sc += I0[(ww * 32 + rr) * 33 + jb] * fc[jb < 16 ? 0 : 32] + C0[(ww * 32 + rr) * 33 + jb] * fc[jb <= 16 ? 0 : 32]; }
                        if (jb > qt) sc = -1.0f; else if (jb == 0 || jb == qt || jb == qt - 1) sc = 1e4f;
                        v[e] = sc; VAL[tq * 33 + jb] = sc; }
                    ABAR();
                    unsigned bits = 0u;
#pragma unroll
                    for (int e = 0; e < 4; ++e) { const int jb = 4 * sb + e; int rank = 0;
#pragma unroll
                        for (int i = 0; i < 32; ++i) { const float x = VAL[tq * 33 + i]; rank += (x > v[e] || (x == v[e] && i < jb)) ? 1 : 0; }
                        if (rank < 16) bits |= 1u << jb; }
                    bits |= dpp_xor1(bits); bits |= dpp_xor2(bits); bits |= dpp_hmirror(bits);
                    if (sb == 0) ((NLAS unsigned*)(lds + L_SELM))[tq] = bits;
                }
                ABAR();
#ifdef DBG_SELALL
                selm = 0xffffffffu;
#else
                selm = ((const NLAS unsigned*)(lds + L_SELM))[qi];
#endif
                const float fac = g_cmp * inv;
                if (hi == 0) wsf[r32] = fac;
                asm volatile("s_waitcnt lgkmcnt(0)" ::: "memory");
#pragma unroll
                for (int r = 0; r < 16; ++r) { const float ff = wsf[crow(r, hi)]; stash[r * 64] = S.o[0][r] * ff; stash[(16 + r) * 64] = S.o[1][r] * ff; }
                asm volatile("s_waitcnt lgkmcnt(0)" ::: "memory");
                const size_t qoff = (((size_t)b * 16 + hq) * 2048 + 64 * qt + qi) * 64 + 8 * hi;
#pragma unroll
                for (int d0 = 0; d0 < 4; ++d0) qf[d0] = *(const bf16x8*)((const bf16_t*)(ws + WS_NQR) + qoff + 16 * d0);
            }
        } else {
            const int jend = (kind == 1) ? 0 : (qt >= 8 ? qt - 8 : 0);
            if (j == jend) {
                const float l = comb_sum(S.l);
                const float fac = (kind == 1 ? g_sel : g_win) * __builtin_amdgcn_rcpf(l);
                if (hi == 0) wsf[r32] = fac;
                asm volatile("s_waitcnt lgkmcnt(0)" ::: "memory");
#pragma unroll
                for (int r = 0; r < 16; ++r) { const float ff = wsf[crow(r, hi)]; stash[r * 64] += S.o[0][r] * ff; stash[(16 + r) * 64] += S.o[1][r] * ff; }
                asm volatile("s_waitcnt lgkmcnt(0)" ::: "memory");
                if (kind == 2) {
                    const NLAS float* sw = (const NLAS float*)(lds + L_IMP + w * 8448);
                    bf16_t* ob = (bf16_t*)(ws + WS_OATT) + ((size_t)b * 2048 + 64 * qt + 32 * (w & 1)) * 1024 + hq * 64;
#pragma unroll
                    for (int i = 0; i < 4; ++i) {
                        const int row = 8 * i + (lane >> 3), ch = lane & 7;
                        const int hh_ = (row >> 2) & 1, rr_ = (row & 3) + 4 * (row >> 3), d0 = ch >> 2;
                        const NLAS float* sp = sw + ((d0 * 16 + rr_) * 64 + hh_ * 32 + (ch & 3) * 8);
                        const f32x4 x0 = *(const NLAS f32x4*)sp, x1 = *(const NLAS f32x4*)(sp + 4);
                        u32x4 ov; ov.x = cvtpk(x0.x, x0.y); ov.y = cvtpk(x0.z, x0.w); ov.z = cvtpk(x1.x, x1.y); ov.w = cvtpk(x1.z, x1.w);
                        *(u32x4*)(ob + (size_t)row * 1024 + ch * 8) = ov;
                    }
                }
            }
        }
        strm_next(cst, sub);
    }
    ABAR();
#undef ISSUE
#undef A_KC
#undef A_VC
#undef A_KV
}
}
namespace cg = cooperative_groups;
typedef unsigned short bf16_t;
struct Params { const float* in[23]; float* out; unsigned char* ws; };

constexpr int PARAM_OFF = EPI_OFF + 28672, BARST_OFF = PARAM_OFF + 256;
template <class T> __device__ __forceinline__ T* ldp(PG8_LAS unsigned char* lds, int idx) {
    const PG8_LAS unsigned* p = (const PG8_LAS unsigned*)(lds + PARAM_OFF) + 2 * idx;
    const unsigned lo = __builtin_amdgcn_readfirstlane(p[0]), hi = __builtin_amdgcn_readfirstlane(p[1]);
    typedef __attribute__((address_space(1))) unsigned char gchar_t;
    gchar_t* gp = (gchar_t*)(((unsigned long long)hi << 32) | lo);
    return (T*)(unsigned char*)gp;
}
#define INP(k) ldp<const float>(lds, (k))
#define OUTP() ldp<float>(lds, 23)
#define WSP() ldp<unsigned char>(lds, 24)
__device__ __forceinline__ pro::In load_in(PG8_LAS unsigned char* lds) {
    pro::In I;
    I.x = INP(0); I.norm_mix = INP(1); I.norm_ffn = INP(2); I.gla_w_in = INP(3); I.gla_w_alpha_up = INP(4); I.gla_b_alpha = INP(5); I.gla_norm = INP(6); I.gla_w_o = INP(7);
    I.kv_norm = INP(8); I.nsa_w_kv = INP(9); I.cmp_pe_k = INP(10); I.cmp_pe_v = INP(11); I.cmp_k_w1 = INP(12); I.cmp_k_w2 = INP(13); I.cmp_v_w1 = INP(14); I.cmp_v_w2 = INP(15);
    I.nsa_w_in = INP(16); I.nsa_w_o = INP(17); I.ffn_w_up = INP(18); I.ffn_conv_w = INP(19); I.ffn_conv_b = INP(20); I.ffn_w_down = INP(21); I.norm_final = INP(22);
    return I;
}

__global__ void __launch_bounds__(512, 2) yoco_fwd(Params P) {
    extern __shared__ __attribute__((aligned(16))) unsigned char lds_raw[];
    PG8_LAS unsigned char* lds = (PG8_LAS unsigned char*)lds_raw;
    cg::grid_group grid = cg::this_grid();
    const int G = gridDim.x, bx = blockIdx.x;
    const int wave0 = __builtin_amdgcn_readfirstlane(threadIdx.x >> 6);
#define NOWTID() (wave0 * 64 + lane_id())
    if (threadIdx.x == 0) {
        PG8_LAS unsigned long long* lp = (PG8_LAS unsigned long long*)(lds + PARAM_OFF);
#pragma unroll
        for (int i = 0; i < 23; ++i) lp[i] = (unsigned long long)P.in[i];
        lp[23] = (unsigned long long)P.out; lp[24] = (unsigned long long)P.ws;
    }
    if (threadIdx.x < 2) ((PG8_LAS unsigned*)(lds + BARST_OFF))[threadIdx.x] = 0u;
    __syncthreads();
    (void)xcd_barrier_post((unsigned*)(P.ws + WS_BAR), (volatile LAS unsigned*)(lds + BARST_OFF), (int)threadIdx.x);
#define GSYNC() do { XcdBarrier b_; b_.bar = (unsigned*)(WSP() + WS_BAR); b_.x = xb_xcc_id(); b_.st = (volatile LAS unsigned*)(lds + BARST_OFF); xcd_barrier(b_, NOWTID()); } while (0)
#define PH_COMMON int tid_ = NOWTID(); asm volatile("" : "+v"(tid_)); const int tid = tid_, lane = tid & 63, wave = __builtin_amdgcn_readfirstlane(tid >> 6); const int gw = bx * 8 + wave, NGW = G * 8; (void)lane; (void)gw; (void)NGW; unsigned char* ws = WSP(); (void)ws;

#ifndef SKIP_PRO
    { PH_COMMON
        pro::In I = load_in(lds); pro::Wts W;
        W.WGI = (bf16_t*)(ws + WS_WGI); W.WGO = (bf16_t*)(ws + WS_WGO); W.WKQ = (bf16_t*)(ws + WS_WKQ); W.WC1 = (bf16_t*)(ws + WS_WC1); W.WC2 = (bf16_t*)(ws + WS_WC2);
        W.WNO = (bf16_t*)(ws + WS_WNO); W.WUP = (bf16_t*)(ws + WS_WUP); W.WDN = (bf16_t*)(ws + WS_WDN); W.ROPE = (float*)(ws + WS_ROPE); W.BIASC = (float*)(ws + WS_BIASC);
#ifdef REP_PRO
        pro::prologue(I, W, (bf16_t*)(ws + WS_XB), (float*)(ws + WS_RSS), lds, gw, NGW, lane, wave); __syncthreads();
#endif
        pro::prologue(I, W, (bf16_t*)(ws + WS_XB), (float*)(ws + WS_RSS), lds, gw, NGW, lane, wave); }
#endif
    grid.sync();

#ifdef REP_SYNC
#pragma unroll 1
    for (int r = 0; r < REP_SYNC; ++r) GSYNC();
#endif
#ifndef SKIP_P1
    { unsigned char* ws = WSP();
        pg8::Gemm g = pg8::make_gemm((const bf16_t*)(ws + WS_XB), (const bf16_t*)(ws + WS_WGI), M_TOK, 3584, 1024, 1024, 1024);
        pg8::StaticOrder S; S.init(M_TOK, 3584, G, bx);
        epi::EpiGlaIn E{(bf16_t*)(ws + WS_GQ), (bf16_t*)(ws + WS_GK), (bf16_t*)(ws + WS_GV), (bf16_t*)(ws + WS_GR), (float*)(ws + WS_GG), (const float*)(ws + WS_RSS), INP(5)};
#ifdef REP_P1
        pg8::gemm_phase(lds, lds + EPI_OFF, g, S, E, NOWTID());
#endif
        pg8::gemm_phase(lds, lds + EPI_OFF, g, S, E, NOWTID());
    }
#endif
    GSYNC();
#ifndef SKIP_GLA
    { unsigned char* ws = WSP();
        float* SLOC = (float*)(ws + WS_BIG + 260 * MiB); float* DSEG = (float*)(ws + WS_BIG + 290 * MiB);
        if ((bx & 3) < 3) gla::gla_unit<true>(bx >> 4, (bx >> 2) & 3, bx & 3, (const bf16_t*)(ws + WS_GQ), (const bf16_t*)(ws + WS_GK), (const bf16_t*)(ws + WS_GV), (bf16_t*)(ws + WS_GV), (const bf16_t*)(ws + WS_GR), (const float*)(ws + WS_GG), INP(6), SLOC, DSEG, lds, NOWTID());
    }
    GSYNC();
    { unsigned char* ws = WSP();
        float* SLOC = (float*)(ws + WS_BIG + 260 * MiB); float* DSEG = (float*)(ws + WS_BIG + 290 * MiB);
        gla::gla_unit<false>(bx >> 4, (bx >> 2) & 3, bx & 3, (const bf16_t*)(ws + WS_GQ), (const bf16_t*)(ws + WS_GK), (const bf16_t*)(ws + WS_GV), (bf16_t*)(ws + WS_GV), (const bf16_t*)(ws + WS_GR), (const float*)(ws + WS_GG), INP(6), SLOC, DSEG, lds, NOWTID());
    }
#endif
    GSYNC();
#ifndef SKIP_P3
    { unsigned char* ws = WSP();
        pg8::Gemm g = pg8::make_gemm((const bf16_t*)(ws + WS_GV), (const bf16_t*)(ws + WS_WGO), M_TOK, 1024, 1024, 1024, 1024);
        pg8::StaticOrder S; S.init(M_TOK, 1024, G, bx);
        epi::EpiRes E{INP(0), OUTP(), (bf16_t*)(ws + WS_XB), (float*)(ws + WS_RSS) + 1 * M_TOK};
        pg8::gemm_phase(lds, lds + EPI_OFF, g, S, E, NOWTID());
    }
#endif
    GSYNC();
#pragma unroll 1
    for (int layer = 0; layer < 2; ++layer) {
        if (layer == 1) {
#ifndef SKIP_P7
            { unsigned char* ws = WSP();
                pg8::Gemm g = pg8::make_gemm((const bf16_t*)(ws + WS_XB), (const bf16_t*)(ws + WS_WKQ), M_TOK, 2816, 1024, 1024, 1024);
                pg8::StaticOrder S; S.init(M_TOK, 2816, G, bx);
                epi::EpiKvq E{(bf16_t*)(ws + WS_KV), (bf16_t*)(ws + WS_NQ), (bf16_t*)(ws + WS_NQR), (float*)(ws + WS_GATES), (const float*)(ws + WS_RSS) + 2 * M_TOK, (const float*)(ws + WS_ROPE)};
#ifdef REP_P7
                pg8::gemm_phase(lds, lds + EPI_OFF, g, S, E, NOWTID());
#endif
                pg8::gemm_phase(lds, lds + EPI_OFF, g, S, E, NOWTID());
            }
#endif
            GSYNC();
#ifndef SKIP_P8
            { unsigned char* ws = WSP();
                pg8::Gemm g = pg8::make_gemm((const bf16_t*)(ws + WS_KV), (const bf16_t*)(ws + WS_WC1), 16384, 1024, 512, 1024, 2048);
                g.a_pn = 512 * 2; g.b_pn = 512 * 2; g.b_hi = (size_t)256 * 2048 * 2; g.b_split = 32;
                pg8::StaticOrder S; S.init(16384, 1024, G, bx);
                epi::EpiCmp E{(float*)(ws + WS_HP)};
                pg8::gemm_phase(lds, lds + EPI_OFF, g, S, E, NOWTID());
            }
#endif
            GSYNC();
#ifndef SKIP_P9
            { PH_COMMON nsa::cmp_finalize((const float*)(ws + WS_HP), (const float*)(ws + WS_BIASC), (const bf16_t*)(ws + WS_WC2), (bf16_t*)(ws + WS_KCVC), gw, NGW, lane); }
#endif
            GSYNC();
#ifndef SKIP_ATTN
            { unsigned char* ws = WSP();
                nsa::AttnBufs T{ws};
#ifdef REP_ATTN
                nsa::attn_block<REP_ATTN>(bx >> 2, bx & 3, T, lds, NOWTID());
#endif
                nsa::attn_block(bx >> 2, bx & 3, T, lds, NOWTID());
            }
#endif
            GSYNC();
#ifndef SKIP_P11
            { unsigned char* ws = WSP(); float* out = OUTP();
                pg8::Gemm g = pg8::make_gemm((const bf16_t*)(ws + WS_OATT), (const bf16_t*)(ws + WS_WNO), M_TOK, 1024, 1024, 1024, 1024);
                pg8::StaticOrder S; S.init(M_TOK, 1024, G, bx);
                epi::EpiRes E{out, out, (bf16_t*)(ws + WS_XB), (float*)(ws + WS_RSS) + 3 * M_TOK};
                pg8::gemm_phase(lds, lds + EPI_OFF, g, S, E, NOWTID());
            }
#endif
            GSYNC();
        }
#ifndef SKIP_UP
        { unsigned char* ws = WSP();
            const float* rss_in = (const float*)(ws + WS_RSS) + (layer == 0 ? 1 : 3) * M_TOK;
            const float* cw = INP(19) + (size_t)layer * 3 * 5632; const float* cb = INP(20) + (size_t)layer * 5632;
            pg8::Gemm g = pg8::make_gemm((const bf16_t*)(ws + WS_XB), (const bf16_t*)(ws + WS_WUP) + (size_t)layer * 5632 * 1024, M_TOK, 5632, 1024, 1024, 1024);
            pg8::StaticOrder S; S.init(M_TOK, 5632, G, bx);
            epi::EpiFfnUp E{(bf16_t*)(ws + WS_ACT), (float*)(ws + WS_HALO), rss_in, cw, cb};
#ifdef REP_UP
            pg8::gemm_phase(lds, lds + EPI_OFF, g, S, E, NOWTID());
#endif
#ifdef REP_UPNULL
            { epi::EpiNull EN; pg8::gemm_phase(lds, lds + EPI_OFF, g, S, EN, NOWTID()); }
#endif
            pg8::gemm_phase(lds, lds + EPI_OFF, g, S, E, NOWTID());
        }
#endif
        GSYNC();
#ifndef SKIP_FIX
        { PH_COMMON
            const float* cw = INP(19) + (size_t)layer * 3 * 5632; const float* cb = INP(20) + (size_t)layer * 5632;
            const float* HALO = (const float*)(ws + WS_HALO); bf16_t* ACT = (bf16_t*)(ws + WS_ACT);
            for (int i = bx * 512 + tid; i < 128 * 2 * 2816; i += G * 512) {
                const int f = i % 2816, pr = i / 2816, r = pr & 1, pm = pr >> 1;
                if ((pm & 7) == 0) continue;
                const int pn = f >> 7, cc = f & 127;
                const float* hc = HALO + ((size_t)(pm * 22 + pn) * 4) * 256; const float* hp = HALO + ((size_t)((pm - 1) * 22 + pn) * 4) * 256;
                float ug, ug1, ug2, uv, uv1, uv2;
                if (r == 0) { ug = hc[cc]; ug1 = hp[3 * 256 + cc]; ug2 = hp[2 * 256 + cc]; uv = hc[128 + cc]; uv1 = hp[3 * 256 + 128 + cc]; uv2 = hp[2 * 256 + 128 + cc]; }
                else { ug = hc[256 + cc]; ug1 = hc[cc]; ug2 = hp[3 * 256 + cc]; uv = hc[256 + 128 + cc]; uv1 = hc[128 + cc]; uv2 = hp[3 * 256 + 128 + cc]; }
                const float og = cb[f] + cw[f] * ug2 + cw[5632 + f] * ug1 + cw[2 * 5632 + f] * ug;
                const float ov = cb[2816 + f] + cw[2816 + f] * uv2 + cw[5632 + 2816 + f] * uv1 + cw[2 * 5632 + 2816 + f] * uv;
                const float a = og * __builtin_amdgcn_rcpf(1.0f + __expf(-og)) * ov;
                ACT[(size_t)(pm * 256 + r) * 2816 + f] = (bf16_t)(pg8::cvt_pk_bf16(a, 0.f) & 0xffffu);
            }
        }
#endif
        GSYNC();
#ifndef SKIP_DOWN
        { unsigned char* ws = WSP(); float* out = OUTP();
            float* rss_out = (float*)(ws + WS_RSS) + (layer == 0 ? 2 : 4) * M_TOK;
            pg8::Gemm g = pg8::make_gemm((const bf16_t*)(ws + WS_ACT), (const bf16_t*)(ws + WS_WDN) + (size_t)layer * 1024 * 2816, M_TOK, 1024, 2816, 2816, 2816);
            pg8::StaticOrder S; S.init(M_TOK, 1024, G, bx);
            epi::EpiRes E{out, out, (bf16_t*)(ws + WS_XB), rss_out};
            pg8::gemm_phase(lds, lds + EPI_OFF, g, S, E, NOWTID());
        }
#endif
        GSYNC();
    }
    { PH_COMMON
        const float* rss = (const float*)(ws + WS_RSS) + 4 * M_TOK; float* out = OUTP(); const float* norm_final = INP(22);
        for (int m = gw; m < M_TOK; m += NGW) {
            const float rs = rsqrtf(rss[m] * (1.0f / 1024.0f) + 1e-6f);
            pro::f32x4* xr = (pro::f32x4*)(out + (size_t)m * 1024) + lane; const pro::f32x4* gr = (const pro::f32x4*)norm_final + lane;
#pragma unroll
            for (int j = 0; j < 4; ++j) { const pro::f32x4 v = xr[64 * j], gg = gr[64 * j]; xr[64 * j] = v * rs * gg; }
        }
    }
}

extern "C" void kernel_launch(void* const* d_in, const int* in_sizes, int n_in, void* d_out, int out_size, void* d_ws, size_t ws_size, hipStream_t stream) {
    static int grid = 0;
    if (grid == 0) {
        if (n_in != 23 || ws_size < WS_END) { fprintf(stderr, "kernel_launch: unexpected n_in %d or ws_size %zu (< %zu)\n", n_in, ws_size, (size_t)WS_END); grid = -1; return; }
        int dev = 0, cus = 0, per_cu = 0;
        (void)hipGetDevice(&dev);
        (void)hipDeviceGetAttribute(&cus, hipDeviceAttributeMultiprocessorCount, dev);
        (void)hipFuncSetAttribute((const void*)yoco_fwd, hipFuncAttributeMaxDynamicSharedMemorySize, LDS_BYTES);
        (void)hipOccupancyMaxActiveBlocksPerMultiprocessor(&per_cu, (const void*)yoco_fwd, 512, LDS_BYTES);
        if (per_cu < 1) { fprintf(stderr, "kernel_launch: occupancy query reports %d blocks per CU\n", per_cu); grid = -1; return; }
        grid = cus;
        if (grid > 256) grid = 256;
        grid &= ~7;
    }
    if (grid <= 0) return;
    (void)hipMemsetAsync((char*)d_ws + WS_RSS, 0, 1 * MiB, stream);
    Params p{};
    for (int i = 0; i < 23; ++i) p.in[i] = (const float*)d_in[i];
    p.out = (float*)d_out; p.ws = (unsigned char*)d_ws;
    void* args[] = {&p};
    hipError_t e = hipLaunchCooperativeKernel((void*)yoco_fwd, dim3(grid), dim3(512), args, LDS_BYTES, stream);
    if (e != hipSuccess) fprintf(stderr, "cooperative launch failed: %s (grid %d)\n", hipGetErrorString(e), grid);
}
```

```cpp
#include <hip/hip_runtime.h>
#include <hip/hip_cooperative_groups.h>
#include <cstdio>
#include <cstdint>
constexpr size_t MiB = 1u << 20;
constexpr int M_TOK = 32768;
constexpr size_t WS_RSS = 0;
constexpr size_t WS_BAR = 768 * 1024;
constexpr size_t WS_ROPE = 1 * MiB, WS_BIASC = 800 * 1024;
constexpr size_t WS_WGI = 2 * MiB, WS_WGO = 9 * MiB, WS_WKQ = 11 * MiB, WS_WC1 = 17 * MiB, WS_WC2 = 19 * MiB, WS_WNO = 20 * MiB, WS_WUP = 22 * MiB, WS_WDN = 44 * MiB;
constexpr size_t WS_XB = 56 * MiB;
constexpr size_t WS_BIG = 120 * MiB;
constexpr size_t WS_GQ = WS_BIG, WS_GK = WS_BIG + 32 * MiB, WS_GV = WS_BIG + 64 * MiB, WS_GR = WS_BIG + 128 * MiB, WS_GG = WS_BIG + 192 * MiB;
constexpr size_t WS_ACT = WS_BIG, WS_HALO = WS_BIG + 176 * MiB;
constexpr size_t WS_KV = WS_BIG, WS_NQ = WS_BIG + 96 * MiB, WS_NQR = WS_BIG + 160 * MiB, WS_GATES = WS_BIG + 224 * MiB, WS_HP = WS_BIG + 230 * MiB, WS_KCVC = WS_BIG + 294 * MiB, WS_OATT = WS_BIG + 296 * MiB;
constexpr size_t WS_END = WS_BIG + 376 * MiB;
constexpr int LDS_BYTES = 160 * 1024, EPI_OFF = 131072;


#define LAS __attribute__((address_space(3)))
#define XB_TMO      128
#define XB_XCNT(j)  (256  + 64 * (j))
#define XB_XSUB(j)  (1280 + 64 * (j))
#define XB_XGEN(j)  (2304 + 64 * (j))
#define XB_TOP      3328
#define XB_TOPGEN   3392
#define XCD_BAR_WORDS 3456
#define XB_SPIN_CAP (1u << 18)

__device__ __forceinline__ unsigned xb_ld(unsigned* p)              { return __hip_atomic_load(p, __ATOMIC_RELAXED, __HIP_MEMORY_SCOPE_AGENT); }
__device__ __forceinline__ unsigned xb_add(unsigned* p, unsigned v) { return __hip_atomic_fetch_add(p, v, __ATOMIC_RELAXED, __HIP_MEMORY_SCOPE_AGENT); }
__device__ __forceinline__ unsigned xb_xcc_id() { return (unsigned)__builtin_amdgcn_s_getreg((3 << 11) | 20) & 0xFu; }
#define XB_SPIN(cond, bar) do { unsigned _sp = 0; while (cond) { __builtin_amdgcn_s_sleep(1); \
    if ((++_sp & 255u) == 0u) { if (xb_ld(&(bar)[XB_TMO])) break; if (_sp > XB_SPIN_CAP) { atomicAdd(&(bar)[XB_TMO], 1u); break; } } } } while (0)

struct XcdBarrier {
    unsigned* bar; unsigned x;
    volatile LAS unsigned* st;
};

__device__ __forceinline__ XcdBarrier xcd_barrier_post(unsigned* bar, volatile LAS unsigned* st, int tid) {
    XcdBarrier b; b.bar = bar; b.x = xb_xcc_id(); b.st = st;
    if (tid == 0) (void)xb_add(&bar[XB_XCNT(b.x)], 1u);
    return b;
}
__device__ __forceinline__ void xcd_barrier_complete(unsigned* bar, unsigned x, unsigned& nloc, unsigned& nx) {
    const unsigned G = gridDim.x * gridDim.y * gridDim.z;
    unsigned sum, cnt, mine, sp = 0u;
    for (;;) {
        sum = 0u; cnt = 0u; mine = 0u;
#pragma unroll
        for (unsigned j = 0; j < 16; ++j) { const unsigned c = xb_ld(&bar[XB_XCNT(j)]); sum += c; cnt += (c > 0u) ? 1u : 0u; mine = (j == x) ? c : mine; }
        if (sum == G) break;
        __builtin_amdgcn_s_sleep(1);
        if ((++sp & 255u) == 0u) { if (xb_ld(&bar[XB_TMO])) break; if (sp > XB_SPIN_CAP) { atomicAdd(&bar[XB_TMO], 1u); break; } }
    }
    nloc = mine > 0u ? mine : 1u; nx = cnt > 0u ? cnt : 1u;
}

__device__ __forceinline__ void xcd_barrier(const XcdBarrier& b, int tid) {
    asm volatile("s_waitcnt vmcnt(0)" ::: "memory");
    __syncthreads();
    if (tid == 0) {
        unsigned* bar = b.bar;
        __builtin_amdgcn_s_waitcnt(0);
        unsigned nloc = b.st[0], nx = b.st[1];
        if (nloc == 0u) { xcd_barrier_complete(bar, b.x, nloc, nx); b.st[0] = nloc; b.st[1] = nx; }
        const unsigned old = xb_add(&bar[XB_XSUB(b.x)], 1u);
        const unsigned gen = old / nloc;
        if (old + 1u == (gen + 1u) * nloc) {
            __builtin_amdgcn_fence(__ATOMIC_RELEASE, "agent");
            asm volatile("s_waitcnt vmcnt(0)" ::: "memory");
            const unsigned og = xb_add(&bar[XB_TOP], 1u);
            const unsigned tg = og / nx;
            if (og + 1u == (tg + 1u) * nx) xb_add(&bar[XB_TOPGEN], 1u);
            else XB_SPIN(xb_ld(&bar[XB_TOPGEN]) == tg, bar);
            __builtin_amdgcn_fence(__ATOMIC_ACQUIRE, "agent");
            xb_add(&bar[XB_XGEN(b.x)], 1u);
            asm volatile("s_waitcnt vmcnt(0)" ::: "memory");
        } else {
            XB_SPIN(xb_ld(&bar[XB_XGEN(b.x)]) == gen, bar);
            __builtin_amdgcn_fence(__ATOMIC_ACQUIRE, "agent");
            asm volatile("s_waitcnt vmcnt(0)" ::: "memory");
        }
    }
    __syncthreads();
}

__device__ __forceinline__ int lane_id() { return (int)__builtin_amdgcn_mbcnt_hi(~0u, __builtin_amdgcn_mbcnt_lo(~0u, 0u)); }
template <class T> __device__ __forceinline__ T dpp_xor1(T x) { return __builtin_bit_cast(T, __builtin_amdgcn_mov_dpp(__builtin_bit_cast(int, x), 0xB1, 0xf, 0xf, true)); }
template <class T> __device__ __forceinline__ T dpp_xor2(T x) { return __builtin_bit_cast(T, __builtin_amdgcn_mov_dpp(__builtin_bit_cast(int, x), 0x4E, 0xf, 0xf, true)); }
template <class T> __device__ __forceinline__ T dpp_hmirror(T x) { return __builtin_bit_cast(T, __builtin_amdgcn_mov_dpp(__builtin_bit_cast(int, x), 0x141, 0xf, 0xf, true)); }
template <class T> __device__ __forceinline__ T swz_xor16(T x) { return __builtin_bit_cast(T, __builtin_amdgcn_ds_swizzle(__builtin_bit_cast(int, x), 0x401F)); }
namespace pg8 {
#define PG8_LAS __attribute__((address_space(3)))
typedef unsigned short bf16_t;
typedef short bf16x8 __attribute__((ext_vector_type(8)));
typedef float f32x4 __attribute__((ext_vector_type(4)));
typedef float f32x2 __attribute__((ext_vector_type(2)));
typedef unsigned u32x4 __attribute__((ext_vector_type(4)));
typedef unsigned u32x2 __attribute__((ext_vector_type(2)));
constexpr int BM = 256, BK = 64, HALF = 128, HTB = HALF * BK * 2, STAGE_BYTES = 8 * HTB, NXCD = 8, WGM = 8;

__host__ __device__ __forceinline__ int lds_byte(int r, int c) { const int st = (r >> 4) * 2 + (c >> 5), rr = r & 15, cc = c & 31, ob = rr * 64 + cc * 2; return st * 1024 + (ob ^ (((ob >> 9) & 1) << 5)); }
__host__ __device__ __forceinline__ void stage_rc(int b, int& R, int& C) { const int st = b / 1024, sb = b % 1024, swz = sb ^ (((sb >> 9) & 1) << 5); R = (st >> 1) * 16 + swz / 64; C = (st & 1) * 32 + (swz % 64) / 2; }
__host__ __device__ __forceinline__ int perm32(int rho) { const int n = rho >> 4, i = rho & 15; return 8 * (i >> 2) + 4 * n + (i & 3); }

struct Unit { int pm, pn; };
struct Gemm { const bf16_t* A; const bf16_t* Bt; int M, N, K; int lda, ldb; size_t a_pm, a_pn, b_pn, b_hi; int b_split; };
__device__ __forceinline__ Gemm make_gemm(const bf16_t* A, const bf16_t* Bt, int M, int N, int K, int lda, int ldb) {
    Gemm g; g.A = A; g.Bt = Bt; g.M = M; g.N = N; g.K = K; g.lda = lda; g.ldb = ldb;
    g.a_pm = (size_t)BM * lda * 2; g.a_pn = 0; g.b_pn = (size_t)BM * ldb * 2; g.b_hi = 0; g.b_split = 0x7fffffff; return g;
}

struct StaticOrder {
    int nM, nN, nwg, G, c;
    __device__ void init(int M, int N, int G_, int c_) { nM = M / BM; nN = N / BM; nwg = nM * nN; G = G_; c = c_; }
    __device__ bool next(int i, Unit& u) const {
        const long L = (long)i * G + c; if (L >= nwg) return false;
        int wgid = (int)L; { const int q = nwg / NXCD, r = nwg % NXCD, xcd = wgid % NXCD, off = wgid / NXCD; wgid = (xcd < r ? xcd * (q + 1) : r * (q + 1) + (xcd - r) * q) + off; }
        const int nig = WGM * nN, gid = wgid / nig, fm = gid * WGM, gsz = (nM - fm) < WGM ? (nM - fm) : WGM;
        u.pm = fm + ((wgid % nig) % gsz); u.pn = (wgid % nig) / gsz; return true;
    }
};

__device__ __forceinline__ unsigned cvt_pk_bf16(float lo, float hi) {
    typedef __bf16 bf16x2_t __attribute__((ext_vector_type(2)));
    f32x2 v = {lo, hi}; bf16x2_t b = __builtin_convertvector(v, bf16x2_t); return __builtin_bit_cast(unsigned, b);
}

template <class Epi>
__device__ __forceinline__ void gemm_phase(PG8_LAS unsigned char* lds, PG8_LAS unsigned char* lds_epi, const Gemm g, const StaticOrder& S, const Epi& E, int tid0) {
    int tid_ = tid0; asm volatile("" : "+v"(tid_));
    const int tid = tid_, wid = __builtin_amdgcn_readfirstlane(tid >> 6), lane = tid & 63, wr = wid >> 2, wc = wid & 3, fr = lane & 15, fq = lane >> 4;
    const int K = g.K, nt = K / BK;
    unsigned voffA[2], voffB[2];
#pragma unroll
    for (int i = 0; i < 2; ++i) { int R, C; stage_rc(tid * 16 + i * 8192, R, C); const int Rb = (R & ~31) + perm32(R & 31);
        voffA[i] = (unsigned)(R * g.lda + C) * 2u; voffB[i] = (unsigned)(Rb * g.ldb + C) * 2u; }
    const size_t kstep = (size_t)(BK * 2);
    const size_t hstepA = (size_t)HALF * g.lda * 2, hstepB = (size_t)HALF * g.ldb * 2;
    const unsigned ldsw = (unsigned)wid * 1024u;
    const int aoff = lds_byte(wr * 64 + fr, fq * 8), boff = lds_byte(wc * 32 + fr, fq * 8);
#define PG8_SA(b, h) (((b) * 2 + (h)) * HTB)
#define PG8_SB(b, h) ((4 + (b) * 2 + (h)) * HTB)
#define PG8_STAGE(bufoff, gbase, voff) do { _Pragma("unroll") for (int _i = 0; _i < 2; ++_i) \
        __builtin_amdgcn_global_load_lds((const unsigned*)((const char*)(gbase) + (voff)[_i]), (PG8_LAS unsigned*)(lds + (bufoff) + ldsw + _i * 8192), 16, 0, 0); } while (0)
#define PG8_LDA(dst, b, h) do { _Pragma("unroll") for (int m = 0; m < 4; ++m) _Pragma("unroll") for (int k = 0; k < 2; ++k) dst[m][k] = *(const PG8_LAS bf16x8*)(lds + PG8_SA(b, h) + aoff + m * 2048 + k * 1024); } while (0)
#define PG8_LDB(dst, b, h) do { _Pragma("unroll") for (int n = 0; n < 2; ++n) _Pragma("unroll") for (int k = 0; k < 2; ++k) dst[n][k] = *(const PG8_LAS bf16x8*)(lds + PG8_SB(b, h) + boff + n * 2048 + k * 1024); } while (0)
#define PG8_MMA(ai, bj, At, Bt) do { __builtin_amdgcn_s_setprio(1); _Pragma("unroll") for (int m = 0; m < 4; ++m) _Pragma("unroll") for (int n = 0; n < 2; ++n) _Pragma("unroll") for (int k = 0; k < 2; ++k) \
        acc[ai][bj][m][n] = __builtin_amdgcn_mfma_f32_16x16x32_bf16(Bt[n][k], At[m][k], acc[ai][bj][m][n], 0, 0, 0); __builtin_amdgcn_s_setprio(0); } while (0)
#define PG8_WAIT_V(n) asm volatile("s_waitcnt vmcnt(" #n ")" ::: "memory")
#define PG8_WAIT_L(n) asm volatile("s_waitcnt lgkmcnt(" #n ")" ::: "memory")
#define PG8_BAR __builtin_amdgcn_s_barrier()
#define PG8_SCHED __builtin_amdgcn_sched_barrier(0)
    Unit cur, nxt; int ui = 0;
    if (!S.next(0, cur)) return;
    f32x4 acc[2][2][4][2];
#pragma unroll
    for (int a = 0; a < 2; ++a)
#pragma unroll
        for (int b = 0; b < 2; ++b)
#pragma unroll
            for (int m = 0; m < 4; ++m)
#pragma unroll
                for (int n = 0; n < 2; ++n) acc[a][b][m][n] = (f32x4){0.f, 0.f, 0.f, 0.f};
    bf16x8 At[4][2], B0[2][2], B1[2][2];
    const char* cA = (const char*)g.A + (size_t)cur.pm * g.a_pm + (size_t)cur.pn * g.a_pn;
    const char* cB = (const char*)g.Bt + (size_t)cur.pn * g.b_pn + (cur.pm >= g.b_split ? g.b_hi : (size_t)0);
    PG8_STAGE(PG8_SB(0, 0), cB, voffB); PG8_STAGE(PG8_SB(0, 1), cB + hstepB, voffB); PG8_STAGE(PG8_SA(0, 0), cA, voffA); PG8_STAGE(PG8_SA(0, 1), cA + hstepA, voffA);
    if (wr == 1) PG8_BAR;
    PG8_WAIT_V(2); PG8_BAR;
    PG8_STAGE(PG8_SB(1, 0), cB + kstep, voffB); PG8_STAGE(PG8_SA(1, 0), cA + kstep, voffA); PG8_STAGE(PG8_SB(1, 1), cB + hstepB + kstep, voffB);
    PG8_WAIT_V(6); PG8_BAR;
    for (;;) {
        const bool has_next = S.next(ui + 1, nxt);
        const char* nA = has_next ? (const char*)g.A + (size_t)nxt.pm * g.a_pm + (size_t)nxt.pn * g.a_pn : cA;
        const char* nB = has_next ? (const char*)g.Bt + (size_t)nxt.pn * g.b_pn + (nxt.pm >= g.b_split ? g.b_hi : (size_t)0) : cB;
        E.prefetch(cur, ui, lds_epi, wid, lane);
        for (int t = 0; t < nt; t += 2) {
            const bool last = (t == nt - 2);
            const char* a1 = cA + (size_t)(t + 1) * kstep;
            const char* a2 = last ? nA : cA + (size_t)(t + 2) * kstep; const char* b2 = last ? nB : cB + (size_t)(t + 2) * kstep;
            const char* a3 = a2 + kstep; const char* b3 = b2 + kstep;
            PG8_LDB(B0, 0, 0); PG8_LDB(B1, 0, 1); PG8_SCHED; PG8_LDA(At, 0, 0); PG8_STAGE(PG8_SA(1, 1), a1 + hstepA, voffA);
            PG8_WAIT_V(8); PG8_WAIT_L(0); PG8_BAR; PG8_MMA(0, 0, At, B0); PG8_MMA(0, 1, At, B1); PG8_BAR; PG8_SCHED;
            PG8_LDA(At, 0, 1); PG8_STAGE(PG8_SB(0, 0), b2, voffB); PG8_STAGE(PG8_SB(0, 1), b2 + hstepB, voffB); PG8_STAGE(PG8_SA(0, 0), a2, voffA);
            PG8_WAIT_V(8); PG8_WAIT_L(0); PG8_BAR; PG8_MMA(1, 0, At, B0); PG8_MMA(1, 1, At, B1); PG8_BAR; PG8_SCHED;
            PG8_LDB(B0, 1, 0); PG8_LDB(B1, 1, 1); PG8_SCHED; PG8_LDA(At, 1, 0); PG8_STAGE(PG8_SA(0, 1), a2 + hstepA, voffA);
            PG8_WAIT_V(8); PG8_WAIT_L(0); PG8_BAR; PG8_MMA(0, 0, At, B0); PG8_MMA(0, 1, At, B1); PG8_BAR; PG8_SCHED;
            PG8_LDA(At, 1, 1); PG8_STAGE(PG8_SB(1, 0), b3, voffB); PG8_STAGE(PG8_SB(1, 1), b3 + hstepB, voffB); PG8_STAGE(PG8_SA(1, 0), a3, voffA);
            PG8_WAIT_V(8); PG8_WAIT_L(0); PG8_BAR; PG8_MMA(1, 0, At, B0); PG8_MMA(1, 1, At, B1); PG8_BAR; PG8_SCHED;
        }
        if (wr == 0) PG8_BAR;
        E(acc, cur, ui, wr, wc, fr, fq, lds_epi);
        if (!has_next) break;
#pragma unroll
        for (int a = 0; a < 2; ++a)
#pragma unroll
            for (int b = 0; b < 2; ++b)
#pragma unroll
                for (int m = 0; m < 4; ++m)
#pragma unroll
                    for (int n = 0; n < 2; ++n) acc[a][b][m][n] = (f32x4){0.f, 0.f, 0.f, 0.f};
        cur = nxt; cA = nA; cB = nB; ++ui;
        if (wr == 1) PG8_BAR;
    }
    PG8_WAIT_V(0);
    PG8_BAR;
#undef PG8_SA
#undef PG8_SB
#undef PG8_STAGE
#undef PG8_LDA
#undef PG8_LDB
#undef PG8_MMA
#undef PG8_WAIT_V
#undef PG8_WAIT_L
#undef PG8_BAR
#undef PG8_SCHED
}
}
namespace epi {
using namespace pg8;
constexpr float EPS = 1e-6f;
__device__ __forceinline__ float rstd_of(float ss) { return rsqrtf(ss * (1.0f / 1024.0f) + EPS); }
__device__ __forceinline__ float sigmoidf_(float x) { return __builtin_amdgcn_rcpf(1.0f + __expf(-x)); }
__device__ __forceinline__ float siluf_(float x) { return x * __builtin_amdgcn_rcpf(1.0f + __expf(-x)); }
__device__ __forceinline__ u32x4 pack8(const f32x4& a, const f32x4& b) { u32x4 w; w.x = cvt_pk_bf16(a[0], a[1]); w.y = cvt_pk_bf16(a[2], a[3]); w.z = cvt_pk_bf16(b[0], b[1]); w.w = cvt_pk_bf16(b[2], b[3]); return w; }

constexpr int EC_OFF = 16384, EC_STRIDE = 6144;
__device__ __forceinline__ void dma16(const void* g, PG8_LAS unsigned char* l) { __builtin_amdgcn_global_load_lds((const unsigned*)g, (PG8_LAS unsigned*)l, 16, 0, 0); }
__device__ __forceinline__ void dma_rss(const float* rss, int pm, int ui, PG8_LAS unsigned char* le, int wid, int lane) {
    if (wid == 0) dma16(rss + pm * BM + 4 * lane, le + EC_OFF + (ui & 1) * EC_STRIDE);
}
struct EpiGlaIn {
    bf16_t* Q; bf16_t* Kk; bf16_t* V; bf16_t* R; float* G; const float* rss; const float* b_alpha;
    __device__ __forceinline__ void prefetch(const Unit& u, int ui, PG8_LAS unsigned char* le, int wid, int lane) const { dma_rss(rss, u.pm, ui, le, wid, lane); }
    __device__ __forceinline__ void operator()(f32x4 (&acc)[2][2][4][2], const Unit& u, int ui, int wr, int wc, int fr, int fq, PG8_LAS unsigned char* le) const {
        asm volatile("" : "+v"(fr), "+v"(fq));
        const int pn = u.pn;
        const int row0 = u.pm * BM + wr * 64 + fr;
        const int ct = wc * 32 + 8 * fq;
#pragma unroll
        for (int ai = 0; ai < 2; ++ai)
#pragma unroll
            for (int m = 0; m < 4; ++m) {
                const int row = row0 + ai * HALF + m * 16;
                const float rs = rstd_of(((const PG8_LAS float*)(le + EC_OFF + (ui & 1) * EC_STRIDE))[wr * 64 + fr + ai * HALF + m * 16]);
#pragma unroll
                for (int bj = 0; bj < 2; ++bj) {
                    f32x4 v0 = acc[ai][bj][m][0] * rs, v1 = acc[ai][bj][m][1] * rs;
                    const int c = bj * HALF + ct;
                    if (pn < 2) { const float sc = 0.08838834764831845f; *(u32x4*)(Q + (size_t)row * 512 + pn * 256 + c) = pack8(v0 * sc, v1 * sc); }
                    else if (pn < 4) { *(u32x4*)(Kk + (size_t)row * 512 + (pn - 2) * 256 + c) = pack8(v0, v1); }
                    else if (pn < 8) { *(u32x4*)(V + (size_t)row * 1024 + (pn - 4) * 256 + c) = pack8(v0, v1); }
                    else if (pn < 12) {
#pragma unroll
                        for (int j = 0; j < 4; ++j) { v0[j] = siluf_(v0[j]); v1[j] = siluf_(v1[j]); }
                        *(u32x4*)(R + (size_t)row * 1024 + (pn - 8) * 256 + c) = pack8(v0, v1); }
                    else {
                        const int gc = (pn - 12) * 256 + c;
                        const f32x4 b0 = *(const f32x4*)(b_alpha + gc), b1 = *(const f32x4*)(b_alpha + gc + 4);
                        f32x4 o0, o1;
#pragma unroll
                        for (int j = 0; j < 4; ++j) {
                            const float z0 = v0[j] + b0[j], z1 = v1[j] + b1[j];
                            o0[j] = (fminf(z0, 0.f) - __logf(1.0f + __expf(-fabsf(z0)))) * 0.0625f;
                            o1[j] = (fminf(z1, 0.f) - __logf(1.0f + __expf(-fabsf(z1)))) * 0.0625f; }
                        *(f32x4*)(G + (size_t)row * 512 + gc) = o0; *(f32x4*)(G + (size_t)row * 512 + gc + 4) = o1; }
                }
            }
    }
};

struct EpiRes {
    const float* xin; float* xout; bf16_t* XB; float* rss;
    __device__ __forceinline__ void prefetch(const Unit&, int, PG8_LAS unsigned char*, int, int) const {}
    __device__ __forceinline__ void operator()(f32x4 (&acc)[2][2][4][2], const Unit& u, int ui, int wr, int wc, int fr, int fq, PG8_LAS unsigned char* le) const {
        asm volatile("" : "+v"(fr), "+v"(fq));
        const int row0 = u.pm * BM + wr * 64 + fr;
        const int col0 = u.pn * BM + wc * 32 + 8 * fq;
#pragma unroll
        for (int ai = 0; ai < 2; ++ai)
#pragma unroll
            for (int m = 0; m < 4; ++m) {
                const int row = row0 + ai * HALF + m * 16;
                float ss = 0.f;
#pragma unroll
                for (int bj = 0; bj < 2; ++bj) {
                    const size_t off = (size_t)row * 1024 + col0 + bj * HALF;
                    const f32x4 x0 = *(const f32x4*)(xin + off), x1 = *(const f32x4*)(xin + off + 4);
                    const f32x4 v0 = x0 + acc[ai][bj][m][0], v1 = x1 + acc[ai][bj][m][1];
                    *(f32x4*)(xout + off) = v0; *(f32x4*)(xout + off + 4) = v1;
                    *(u32x4*)(XB + off) = pack8(v0, v1);
                    ss += (v0[0] * v0[0] + v0[1] * v0[1]) + (v0[2] * v0[2] + v0[3] * v0[3]) + (v1[0] * v1[0] + v1[1] * v1[1]) + (v1[2] * v1[2] + v1[3] * v1[3]);
                }
                ss += swz_xor16(ss); { auto rr_ = __builtin_amdgcn_permlane32_swap(__float_as_uint(ss), __float_as_uint(ss), false, false); ss = __uint_as_float(rr_[0]) + __uint_as_float(rr_[1]); }
                if (fq == 0) atomicAdd(rss + row, ss);
            }
    }
};

__device__ __forceinline__ float dpp_ror1(float x) { return __builtin_bit_cast(float, __builtin_amdgcn_update_dpp(0, __builtin_bit_cast(int, x), 0x121, 0xf, 0xf, false)); }
__device__ __forceinline__ float dpp_ror2(float x) { return __builtin_bit_cast(float, __builtin_amdgcn_update_dpp(0, __builtin_bit_cast(int, x), 0x122, 0xf, 0xf, false)); }
constexpr int FF = 2816;
struct EpiFfnUp {
    bf16_t* ACT; float* HALO; const float* rss; const float* cw; const float* cb;
    __device__ __forceinline__ void prefetch(const Unit& u, int ui, PG8_LAS unsigned char* le, int wid, int lane) const {
        dma_rss(rss, u.pm, ui, le, wid, lane);
        if (wid >= 1 && wid <= 4) { const int k = wid - 1; const float* src = (k == 0 ? cb : cw + (k - 1) * 2 * FF) + u.pn * 128 + ((lane < 32) ? 4 * lane : FF + 4 * (lane - 32));
            dma16(src, le + EC_OFF + (ui & 1) * EC_STRIDE + 1024 + k * 1024); }
    }
    __device__ __forceinline__ void operator()(f32x4 (&acc)[2][2][4][2], const Unit& u, int ui, int wr, int wc, int fr, int fq, PG8_LAS unsigned char* le) const {
        asm volatile("" : "+v"(fr), "+v"(fq));
        const int row0 = u.pm * BM + wr * 64 + fr;
        const PG8_LAS float* EC = (const PG8_LAS float*)(le + EC_OFF + (ui & 1) * EC_STRIDE);
#pragma unroll
        for (int ai = 0; ai < 2; ++ai)
#pragma unroll
            for (int m = 0; m < 4; ++m) {
                const float rs = rstd_of(EC[wr * 64 + fr + ai * HALF + m * 16]);
#pragma unroll
                for (int bj = 0; bj < 2; ++bj) { acc[ai][bj][m][0] = acc[ai][bj][m][0] * rs; acc[ai][bj][m][1] = acc[ai][bj][m][1] * rs; }
            }
        PG8_LAS float* HL = (PG8_LAS float*)le + (ui & 1) * 2048;
        if (fr >= 14) {
#pragma unroll
            for (int ai = 0; ai < 2; ++ai)
#pragma unroll
                for (int bj = 0; bj < 2; ++bj)
#pragma unroll
                    for (int n = 0; n < 2; ++n)
                        *(PG8_LAS f32x4*)(HL + ((((wr * 4 + wc) * 2 + ai) * 2 + (fr - 14)) * 64) + bj * 32 + fq * 8 + n * 4) = acc[ai][bj][3][n];
        }
        {
            float* hb = HALO + ((size_t)(u.pm * 22 + u.pn) * 4) * 256 + wc * 32 + fq * 8;
            if (wr == 0 && fr < 2) {
#pragma unroll
                for (int bj = 0; bj < 2; ++bj)
#pragma unroll
                    for (int n = 0; n < 2; ++n) *(f32x4*)(hb + fr * 256 + bj * HALF + n * 4) = acc[0][bj][0][n];
            }
            if (wr == 1 && fr >= 14) {
#pragma unroll
                for (int bj = 0; bj < 2; ++bj)
#pragma unroll
                    for (int n = 0; n < 2; ++n) *(f32x4*)(hb + (fr - 12) * 256 + bj * HALF + n * 4) = acc[1][bj][3][n];
            }
        }
        asm volatile("s_waitcnt lgkmcnt(0)" ::: "memory"); __builtin_amdgcn_s_barrier(); asm volatile("" ::: "memory");
        const bool seq_start = (u.pm & 7) == 0;
        const int cc0 = wc * 32 + fq * 8;
        const bool is15 = (fr == 15), ge14 = (fr >= 14);
        const PG8_LAS float* WB = EC + 256 + cc0;
#pragma unroll
        for (int ai = 0; ai < 2; ++ai) {
            f32x4 pg[2], pv[2];
            if (ai == 0 && wr == 0) { pg[0] = pg[1] = pv[0] = pv[1] = (f32x4){0.f, 0.f, 0.f, 0.f}; }
            else {
                const int swr = (ai == 1 && wr == 1) ? 0 : (ai == 0 ? 0 : 1), sai = (ai == 1 && wr == 1) ? 1 : 0;
                const PG8_LAS float* hp = HL + (((swr * 4 + wc) * 2 + sai) * 2 + (is15 ? 1 : 0)) * 64 + fq * 8;
                pg[0] = *(const PG8_LAS f32x4*)(hp); pg[1] = *(const PG8_LAS f32x4*)(hp + 4); pv[0] = *(const PG8_LAS f32x4*)(hp + 32); pv[1] = *(const PG8_LAS f32x4*)(hp + 36);
            }
#pragma unroll
            for (int m = 0; m < 4; ++m) {
                const int row = row0 + ai * HALF + m * 16;
                u32x4 w;
#pragma unroll
                for (int n = 0; n < 2; ++n) {
                    const f32x4 bg = *(const PG8_LAS f32x4*)(WB + 4 * n), bv = *(const PG8_LAS f32x4*)(WB + 128 + 4 * n);
                    const f32x4 g0 = *(const PG8_LAS f32x4*)(WB + 256 + 4 * n), w0 = *(const PG8_LAS f32x4*)(WB + 256 + 128 + 4 * n);
                    const f32x4 g1 = *(const PG8_LAS f32x4*)(WB + 512 + 4 * n), w1 = *(const PG8_LAS f32x4*)(WB + 512 + 128 + 4 * n);
                    const f32x4 g2 = *(const PG8_LAS f32x4*)(WB + 768 + 4 * n), w2 = *(const PG8_LAS f32x4*)(WB + 768 + 128 + 4 * n);
                    const f32x4 xg = acc[ai][0][m][n], xv = acc[ai][1][m][n];
                    f32x4 g1s, g2s, v1s, v2s;
#pragma unroll
                    for (int j = 0; j < 4; ++j) {
                        g1s[j] = dpp_ror1(is15 ? pg[n][j] : xg[j]); g2s[j] = dpp_ror2(ge14 ? pg[n][j] : xg[j]);
                        v1s[j] = dpp_ror1(is15 ? pv[n][j] : xv[j]); v2s[j] = dpp_ror2(ge14 ? pv[n][j] : xv[j]);
                    }
                    const f32x4 og = bg + g0 * g2s + g1 * g1s + g2 * xg;
                    const f32x4 ov = bv + w0 * v2s + w1 * v1s + w2 * xv;
                    f32x4 e;
#pragma unroll
                    for (int j = 0; j < 4; ++j) e[j] = __builtin_amdgcn_rcpf(1.0f + __builtin_amdgcn_exp2f(og[j] * -1.4426950408889634f));
                    const f32x4 a = og * e * ov;
                    if (n == 0) { w.x = cvt_pk_bf16(a[0], a[1]); w.y = cvt_pk_bf16(a[2], a[3]); } else { w.z = cvt_pk_bf16(a[0], a[1]); w.w = cvt_pk_bf16(a[2], a[3]); }
                    pg[n] = xg; pv[n] = xv;
                }
                const bool skip = (ai == 0 && wr == 0 && m == 0 && fr < 2 && !seq_start);
                if (!skip) *(u32x4*)(ACT + (size_t)row * FF + u.pn * 128 + cc0) = w;
            }
        }
    }
};

struct EpiKvq {
    bf16_t* KV; bf16_t* Q; bf16_t* QR; float* GATES; const float* rss; const float* rope;
    __device__ __forceinline__ void prefetch(const Unit& u, int ui, PG8_LAS unsigned char* le, int wid, int lane) const { dma_rss(rss, u.pm, ui, le, wid, lane); }
    __device__ __forceinline__ void operator()(f32x4 (&acc)[2][2][4][2], const Unit& u, int ui, int wr, int wc, int fr, int fq, PG8_LAS unsigned char* le) const {
        asm volatile("" : "+v"(fr), "+v"(fq));
        const int pn = u.pn;
        const int row0 = u.pm * BM + wr * 64 + fr;
        const float C2 = 0.125f * 1.4426950408889634f;
#pragma unroll
        for (int ai = 0; ai < 2; ++ai)
#pragma unroll
            for (int m = 0; m < 4; ++m) {
                const int row = row0 + ai * HALF + m * 16;
                const int b = row >> 11, s = row & 2047;
                const float rs = rstd_of(((const PG8_LAS float*)(le + EC_OFF + (ui & 1) * EC_STRIDE))[wr * 64 + fr + ai * HALF + m * 16]);
                f32x4 lo0 = acc[ai][0][m][0] * rs, lo1 = acc[ai][0][m][1] * rs;
                f32x4 hi0 = acc[ai][1][m][0] * rs, hi1 = acc[ai][1][m][1] * rs;
                if (pn == 10) {
                    if (wc == 0) {
                        float* gp = GATES + (size_t)row * 48 + 8 * fq;
#pragma unroll
                        for (int j = 0; j < 4; ++j) { lo0[j] = sigmoidf_(lo0[j]); lo1[j] = sigmoidf_(lo1[j]); hi0[j] = sigmoidf_(hi0[j]); hi1[j] = sigmoidf_(hi1[j]); }
                        *(f32x4*)(gp) = lo0; *(f32x4*)(gp + 4) = lo1;
                        if (fq < 2) { *(f32x4*)(gp + 32) = hi0; *(f32x4*)(gp + 36) = hi1; }
                    }
                    continue;
                }
                const bool isq = pn >= 6;
                const bool dorope = isq || pn == 2 || pn == 4;
                f32x4 rl0 = lo0, rl1 = lo1, rh0 = hi0, rh1 = hi1;
                if (dorope) {
                    const float* rp = rope + ((size_t)s * 32 + 8 * fq) * 2;
                    const f32x4 t0 = *(const f32x4*)(rp), t1 = *(const f32x4*)(rp + 4), t2 = *(const f32x4*)(rp + 8), t3 = *(const f32x4*)(rp + 12);
                    const float cs[8] = {t0[0], t0[2], t1[0], t1[2], t2[0], t2[2], t3[0], t3[2]};
                    const float sn[8] = {t0[1], t0[3], t1[1], t1[3], t2[1], t2[3], t3[1], t3[3]};
#pragma unroll
                    for (int j = 0; j < 4; ++j) {
                        rl0[j] = lo0[j] * cs[j] - hi0[j] * sn[j]; rh0[j] = lo0[j] * sn[j] + hi0[j] * cs[j];
                        rl1[j] = lo1[j] * cs[4 + j] - hi1[j] * sn[4 + j]; rh1[j] = lo1[j] * sn[4 + j] + hi1[j] * cs[4 + j];
                    }
                }
                if (!isq) {
                    bf16_t* p = KV + ((((size_t)pn * 16 + b) * 4 + wc) * 2048 + s) * 64 + 8 * fq;
                    *(u32x4*)(p) = pack8(rl0, rl1); *(u32x4*)(p + 32) = pack8(rh0, rh1);
                } else {
                    const int h = (pn - 6) * 4 + wc;
                    const size_t o = (((size_t)b * 16 + h) * 2048 + s) * 64 + 8 * fq;
                    *(u32x4*)(Q + o) = pack8(lo0 * C2, lo1 * C2); *(u32x4*)(Q + o + 32) = pack8(hi0 * C2, hi1 * C2);
                    *(u32x4*)(QR + o) = pack8(rl0 * C2, rl1 * C2); *(u32x4*)(QR + o + 32) = pack8(rh0 * C2, rh1 * C2);
                }
            }
    }
};

struct EpiCmp {
    float* HP;
    __device__ __forceinline__ void prefetch(const Unit&, int, PG8_LAS unsigned char*, int, int) const {}
    __device__ __forceinline__ void operator()(f32x4 (&acc)[2][2][4][2], const Unit& u, int ui, int wr, int wc, int fr, int fq, PG8_LAS unsigned char* le) const {
        asm volatile("" : "+v"(fr), "+v"(fq));
        const int row0 = u.pm * BM + wr * 64 + fr;
        float* base = HP + (size_t)u.pn * 16384 * 256;
#pragma unroll
        for (int ai = 0; ai < 2; ++ai)
#pragma unroll
            for (int m = 0; m < 4; ++m) {
                float* rp = base + (size_t)(row0 + ai * HALF + m * 16) * 256 + wc * 32 + 8 * fq;
#pragma unroll
                for (int bj = 0; bj < 2; ++bj) { *(f32x4*)(rp + bj * HALF) = acc[ai][bj][m][0]; *(f32x4*)(rp + bj * HALF + 4) = acc[ai][bj][m][1]; }
            }
    }
};
struct EpiNull {
    __device__ __forceinline__ void prefetch(const Unit&, int, PG8_LAS unsigned char*, int, int) const {}
    __device__ __forceinline__ void operator()(f32x4 (&acc)[2][2][4][2], const Unit& u, int ui, int wr, int wc, int fr, int fq, PG8_LAS unsigned char* le) const {
#pragma unroll
        for (int ai = 0; ai < 2; ++ai)
#pragma unroll
            for (int bj = 0; bj < 2; ++bj)
#pragma unroll
                for (int m = 0; m < 4; ++m) { asm volatile("" :: "v"(acc[ai][bj][m][0]), "v"(acc[ai][bj][m][1])); }
    }
};
}
namespace pro {
typedef unsigned short bf16_t;
typedef unsigned v4u __attribute__((ext_vector_type(4)));
typedef float f32x4 __attribute__((ext_vector_type(4)));
#define LAS3 __attribute__((address_space(3)))
__device__ __forceinline__ unsigned f2bf(float f) { unsigned u = __builtin_bit_cast(unsigned, f); return (u + 0x7fffu + ((u >> 16) & 1u)) >> 16; }
__device__ __forceinline__ unsigned pk2(float lo, float hi) { return f2bf(lo) | (f2bf(hi) << 16); }

struct In {
    const float *x, *norm_mix, *norm_ffn, *gla_w_in, *gla_w_alpha_up, *gla_b_alpha, *gla_norm, *gla_w_o, *kv_norm, *nsa_w_kv, *cmp_pe_k, *cmp_pe_v,
        *cmp_k_w1, *cmp_k_w2, *cmp_v_w1, *cmp_v_w2, *nsa_w_in, *nsa_w_o, *ffn_w_up, *ffn_conv_w, *ffn_conv_b, *ffn_w_down, *norm_final;
};
struct Wts { bf16_t *WGI, *WGO, *WKQ, *WC1, *WC2, *WNO, *WUP, *WDN; float *ROPE, *BIASC; };

__device__ __forceinline__ void transpose_item(const float* W, int ldw, int scol0, int nvalid, const float* gain, bf16_t* WT, int K, int drow0, int k0, LAS3 float* scr, int lane) {
    const int kr = lane >> 3, nc = (lane & 7) * 4;
    f32x4 v[8];
#pragma unroll
    for (int i = 0; i < 8; ++i) { const int kk = 8 * i + kr;
        v[i] = (nc < nvalid) ? *(const f32x4*)(W + (size_t)(k0 + kk) * ldw + scol0 + nc) : (f32x4){0.f, 0.f, 0.f, 0.f};
        if (gain) v[i] = v[i] * gain[k0 + kk]; }
#pragma unroll
    for (int i = 0; i < 8; ++i) { const int kk = 8 * i + kr; LAS3 float* d = scr + kk * 33 + nc; d[0] = v[i].x; d[1] = v[i].y; d[2] = v[i].z; d[3] = v[i].w; }
    asm volatile("s_waitcnt lgkmcnt(0)" ::: "memory");
    const int c = lane & 7;
#pragma unroll
    for (int j = 0; j < 4; ++j) { const int nn = (lane >> 3) + 8 * j; const LAS3 float* s = scr + (8 * c) * 33 + nn;
        v4u o; o.x = pk2(s[0 * 33], s[1 * 33]); o.y = pk2(s[2 * 33], s[3 * 33]); o.z = pk2(s[4 * 33], s[5 * 33]); o.w = pk2(s[6 * 33], s[7 * 33]);
        *(v4u*)(WT + (size_t)(drow0 + nn) * K + k0 + 8 * c) = o; }
    asm volatile("s_waitcnt lgkmcnt(0)" ::: "memory");
}
__device__ __forceinline__ void weff_item(const In& I, bf16_t* WT, int nb, int k0, LAS3 float* scr, int lane) {
    const int n = lane & 31, ng = 32 * nb + n;
    float wa[16];
#pragma unroll
    for (int r = 0; r < 16; ++r) wa[r] = I.gla_w_alpha_up[r * 512 + ng];
#pragma unroll 2
    for (int i = 0; i < 32; ++i) { const int kk = 2 * i + (lane >> 5); const float* wr = I.gla_w_in + (size_t)(k0 + kk) * 3088 + 3072;
        float v = 0.f;
#pragma unroll
        for (int r = 0; r < 16; ++r) v += wr[r] * wa[r];
        scr[kk * 33 + n] = v * I.norm_mix[k0 + kk]; }
    asm volatile("s_waitcnt lgkmcnt(0)" ::: "memory");
    const int c = lane & 7;
#pragma unroll
    for (int j = 0; j < 4; ++j) { const int nn = (lane >> 3) + 8 * j; const LAS3 float* s = scr + (8 * c) * 33 + nn;
        v4u o; o.x = pk2(s[0 * 33], s[1 * 33]); o.y = pk2(s[2 * 33], s[3 * 33]); o.z = pk2(s[4 * 33], s[5 * 33]); o.w = pk2(s[6 * 33], s[7 * 33]);
        *(v4u*)(WT + (size_t)(3072 + 32 * nb + nn) * 1024 + k0 + 8 * c) = o; }
    asm volatile("s_waitcnt lgkmcnt(0)" ::: "memory");
}

__device__ __forceinline__ void prologue(const In& I, const Wts& W, bf16_t* XB, float* RSS0, LAS3 unsigned char* lds, int gw, int NGW, int lane, int wave) {
    LAS3 float* scr = (LAS3 float*)(lds + wave * 16384);
    constexpr int I0 = 16 * 96, I1 = 16 * 16, I2 = 16 * 32, I3 = 16 * 88, I4 = 32 * 8, I6 = 4 * 2, I8 = 16 * 32, I9 = 16 * 176, I11 = 44 * 32;
    constexpr int NIT = I0 + I1 + I2 + I3 + 2 * I4 + 2 * I6 + I8 + 2 * I9 + 2 * I11;
    for (int it = gw; it < NIT; it += NGW) {
        int r = it;
        if (r < I0) { const int kb = r / 96, nb = r % 96; transpose_item(I.gla_w_in, 3088, 32 * nb, 32, I.norm_mix, W.WGI, 1024, 32 * nb, 64 * kb, scr, lane); continue; } r -= I0;
        if (r < I1) { const int kb = r / 16, nb = r % 16; weff_item(I, W.WGI, nb, 64 * kb, scr, lane); continue; } r -= I1;
        if (r < I2) { const int kb = r / 32, nb = r % 32; transpose_item(I.gla_w_o, 1024, 32 * nb, 32, nullptr, W.WGO, 1024, 32 * nb, 64 * kb, scr, lane); continue; } r -= I2;
        if (r < I3) { const int kb = r / 88, nb = r % 88; const int tile = nb >> 3, gi = nb & 7, L0 = (gi & 3) * 64 + (gi >> 2) * 32;
            if (tile < 6) transpose_item(I.nsa_w_kv, 1536, tile * 256 + L0, 32, I.kv_norm, W.WKQ, 1024, 32 * nb, 64 * kb, scr, lane);
            else if (tile < 10) transpose_item(I.nsa_w_in, 1072, (tile - 6) * 256 + L0, 32, I.norm_mix + 1024, W.WKQ, 1024, 32 * nb, 64 * kb, scr, lane);
            else { int nv = 48 - L0; nv = nv < 0 ? 0 : (nv > 32 ? 32 : nv); transpose_item(I.nsa_w_in, 1072, 1024 + (nv > 0 ? L0 : 0), nv, I.norm_mix + 1024, W.WKQ, 1024, 32 * nb, 64 * kb, scr, lane); }
            continue; } r -= I3;
        if (r < 2 * I4) { const int w = r / I4; r %= I4; const int kb = r / 8, nb = r % 8;
            transpose_item(w ? I.cmp_v_w1 : I.cmp_k_w1, 256, 32 * nb, 32, nullptr, W.WC1 + (size_t)w * 256 * 2048, 2048, 32 * nb, 64 * kb, scr, lane); continue; } r -= 2 * I4;
        if (r < 2 * I6) { const int w = r / I6; r %= I6; const int kb = r / 2, nb = r % 2;
            transpose_item(w ? I.cmp_v_w2 : I.cmp_k_w2, 64, 32 * nb, 32, nullptr, W.WC2 + (size_t)w * 64 * 256, 256, 32 * nb, 64 * kb, scr, lane); continue; } r -= 2 * I6;
        if (r < I8) { const int kb = r / 32, nb = r % 32; transpose_item(I.nsa_w_o, 1024, 32 * nb, 32, nullptr, W.WNO, 1024, 32 * nb, 64 * kb, scr, lane); continue; } r -= I8;
        if (r < 2 * I9) { const int l = r / I9; r %= I9; const int kb = r / 176, nb = r % 176; const int tile = nb >> 3, gi = nb & 7;
            const int sc = (gi < 4) ? (128 * tile + 32 * gi) : (2816 + 128 * tile + 32 * (gi - 4));
            transpose_item(I.ffn_w_up + (size_t)l * 1024 * 5632, 5632, sc, 32, I.norm_ffn + l * 1024, W.WUP + (size_t)l * 5632 * 1024, 1024, 32 * nb, 64 * kb, scr, lane); continue; } r -= 2 * I9;
        { const int l = r / I11; r %= I11; const int kb = r / 32, nb = r % 32;
            transpose_item(I.ffn_w_down + (size_t)l * 2816 * 1024, 1024, 32 * nb, 32, nullptr, W.WDN + (size_t)l * 1024 * 2816, 2816, 32 * nb, 64 * kb, scr, lane); }
    }
    for (int i = gw * 64 + lane; i < 2048 * 32; i += NGW * 64) {
        const int pos = i >> 5, d = i & 31;
        const float inv = powf(10000.0f, -(float)d / 32.0f);
        const float ang = (float)pos * inv;
        float sn, cs; sincosf(ang, &sn, &cs);
        W.ROPE[2 * i] = cs; W.ROPE[2 * i + 1] = sn;
    }
    for (int it = gw; it < 256; it += NGW) {
        const int w = it >> 7, ng = (it >> 5) & 3, kc = it & 31; const float* pe = (w ? I.cmp_pe_v : I.cmp_pe_k) + 64 * kc; const float* w1 = (w ? I.cmp_v_w1 : I.cmp_k_w1) + (size_t)(64 * kc) * 256 + 64 * ng + lane;
        float s = 0.f;
#pragma unroll 16
        for (int k = 0; k < 64; ++k) s += pe[k] * w1[(size_t)k * 256];
        atomicAdd(W.BIASC + w * 256 + 64 * ng + lane, s);
    }
    for (int m = gw; m < 32768; m += NGW) {
        const f32x4* xr = (const f32x4*)(I.x + (size_t)m * 1024) + lane;
        f32x4 v[4]; float s = 0.f;
#pragma unroll
        for (int j = 0; j < 4; ++j) { v[j] = xr[64 * j]; s += (v[j].x * v[j].x + v[j].y * v[j].y) + (v[j].z * v[j].z + v[j].w * v[j].w); }
#pragma unroll
        for (int off = 1; off < 64; off <<= 1) s += __shfl_xor(s, off);
        if (lane == 0) RSS0[m] = s;
        unsigned long long* o8 = (unsigned long long*)(XB + (size_t)m * 1024) + lane;
#pragma unroll
        for (int j = 0; j < 4; ++j) o8[64 * j] = (unsigned long long)pk2(v[j].x, v[j].y) | ((unsigned long long)pk2(v[j].z, v[j].w) << 32);
    }
}
}
namespace gla {
typedef unsigned short bf16_t;
typedef short bf16x8 __attribute__((ext_vector_type(8)));
typedef short s16x4 __attribute__((ext_vector_type(4)));
typedef float f32x16 __attribute__((ext_vector_type(16)));
typedef float f32x4 __attribute__((ext_vector_type(4)));
typedef unsigned u32x4 __attribute__((ext_vector_type(4)));
typedef unsigned u32x2 __attribute__((ext_vector_type(2)));
#define GLAS __attribute__((address_space(3)))
__device__ __forceinline__ int crow(int r, int hi) { return (r & 3) + 8 * (r >> 2) + 4 * hi; }
__device__ __forceinline__ float bf2f(bf16_t v) { return __builtin_bit_cast(float, (unsigned)v << 16); }
__device__ __forceinline__ unsigned cvtpk(float lo, float hi) { typedef float f2 __attribute__((ext_vector_type(2))); typedef __bf16 b2 __attribute__((ext_vector_type(2))); f2 v = {lo, hi}; b2 b = __builtin_convertvector(v, b2); return __builtin_bit_cast(unsigned, b); }
__device__ __forceinline__ bf16_t f2bf1(float f) { return (bf16_t)(cvtpk(f, 0.f) & 0xffffu); }
__device__ __forceinline__ s16x4 vtr(const GLAS unsigned char* p) { typedef short v4i16_t __attribute__((ext_vector_type(4))); return __builtin_bit_cast(s16x4, __builtin_amdgcn_ds_read_tr16_b64_v4i16((GLAS v4i16_t*)p)); }
__device__ __forceinline__ bf16x8 ld2x64(const GLAS unsigned char* p0, const GLAS unsigned char* p1) {
    const s16x4 a = *(const GLAS s16x4*)p0, b = *(const GLAS s16x4*)p1; return (bf16x8){a[0], a[1], a[2], a[3], b[0], b[1], b[2], b[3]};
}
constexpr int QEP = 264, KDP = 136, VP = 576, OLP = 260;
constexpr int L_QE = 0, L_KE = 16896, L_KDT = 33792, L_ATT = 51200, L_V = 59904, L_BL = 96768, L_QT = 97280, L_END = 99328;

template <bool STATE_ONLY>
__device__ __forceinline__ void gla_unit(int b, int h, int seg, const bf16_t* Qg, const bf16_t* Kg, const bf16_t* VO, bf16_t* Oout, const bf16_t* Rg, const float* Gg, const float* gnorm, float* SLOC, float* DSEG, GLAS unsigned char* lds, int tid0) {
    int tid_ = tid0; asm volatile("" : "+v"(tid_));
    const int tid = tid_, lane = tid & 63, w = __builtin_amdgcn_readfirstlane(tid >> 6), r32 = lane & 31, hi = lane >> 5;
    f32x16 S[4];
#pragma unroll
    for (int i = 0; i < 4; ++i)
#pragma unroll
        for (int r = 0; r < 16; ++r) S[i][r] = 0.f;
    const int kcol = tid & 127, qd = tid >> 7;
    const int bh = b * 4 + h;
    if (!STATE_ONLY && seg >= 1) {
#pragma unroll 1
        for (int s = 0; s < seg; ++s) {
            const float* sl = SLOC + ((size_t)(bh * 3 + s) * 128) * 256 + 32 * w + r32; const float* dd = DSEG + (bh * 3 + s) * 128;
#pragma unroll
            for (int i = 0; i < 4; ++i)
#pragma unroll
                for (int r = 0; r < 16; ++r) { const int k = 32 * i + crow(r, hi); const float d = (s == 0) ? 0.f : dd[k]; S[i][r] = S[i][r] * d + sl[(size_t)k * 256]; }
        }
    }
    float dlog = 0.f;
    GLAS float* BL = (GLAS float*)(lds + L_BL); GLAS float* QT = (GLAS float*)(lds + L_QT);
    GLAS float* OL = (GLAS float*)lds;
    float gq[16]; u32x4 vr[4];
#define GLA_FETCH(cc) do { const size_t r0_ = (size_t)b * 2048 + (cc) * 64; \
        const float* gp_ = Gg + (r0_ + 16 * qd) * 512 + h * 128 + kcol; const bf16_t* qp_ = Qg + (r0_ + 16 * qd) * 512 + h * 128 + kcol; const bf16_t* kp_ = Kg + (r0_ + 16 * qd) * 512 + h * 128 + kcol; \
        _Pragma("unroll") for (int i = 0; i < 16; ++i) { gq[i] = gp_[(size_t)i * 512]; } (void)qp_; (void)kp_; \
        _Pragma("unroll") for (int i = 0; i < 4; ++i) { const int p_ = tid + 512 * i, rr_ = p_ >> 5, ch_ = p_ & 31; vr[i] = *(const u32x4*)(VO + (r0_ + rr_) * 1024 + h * 256 + ch_ * 8); } } while (0)
    GLA_FETCH(seg * 8);
    for (int c = seg * 8; c < seg * 8 + 8; ++c) {
        const size_t row0 = (size_t)b * 2048 + c * 64;
        u32x4 rpre[4];
        if (!STATE_ONLY) { const size_t go_ = (row0 + (tid >> 3)) * 1024 + h * 256 + 32 * (tid & 7);
#pragma unroll
            for (int j = 0; j < 4; ++j) rpre[j] = *(const u32x4*)(Rg + go_ + 8 * j); }
        {
            float cs[16]; float run = 0.f;
#pragma unroll
            for (int i = 0; i < 16; ++i) { run += gq[i]; cs[i] = run; }
            QT[qd * 128 + kcol] = run;
#pragma unroll
            for (int i = 0; i < 4; ++i) { const int p = tid + 512 * i, rr = p >> 5, ch = p & 31;
                *(GLAS u32x4*)(lds + L_V + rr * VP + ch * 16) = vr[i]; }
            float qv[16], kv[16];
            { const bf16_t* qp = Qg + (row0 + 16 * qd) * 512 + h * 128 + kcol; const bf16_t* kp = Kg + (row0 + 16 * qd) * 512 + h * 128 + kcol;
#pragma unroll
              for (int i = 0; i < 16; ++i) { qv[i] = STATE_ONLY ? 0.f : bf2f(qp[(size_t)i * 512]); kv[i] = bf2f(kp[(size_t)i * 512]); } }
            if (c + 1 < seg * 8 + 8) GLA_FETCH(c + 1);
            __syncthreads();
            float pre = 0.f, tot = 0.f;
#pragma unroll
            for (int q = 0; q < 4; ++q) { const float t = QT[q * 128 + kcol]; tot += t; if (q < qd) pre += t; }
            if (qd == 0) BL[kcol] = __expf(tot);
            dlog += tot;
            float kd[16];
#pragma unroll
            for (int i = 0; i < 16; ++i) { const float bb = pre + cs[i]; const int t = 16 * qd + i;
                if (!STATE_ONLY) { *(GLAS bf16_t*)(lds + L_QE + t * QEP + kcol * 2) = f2bf1(qv[i] * __expf(bb));
                                   *(GLAS bf16_t*)(lds + L_KE + t * QEP + kcol * 2) = f2bf1(kv[i] * __expf(-bb)); }
                kd[i] = kv[i] * __expf(tot - bb); }
#pragma unroll
            for (int i = 0; i < 4; ++i) { u32x2 v; v.x = cvtpk(kd[4 * i], kd[4 * i + 1]); v.y = cvtpk(kd[4 * i + 2], kd[4 * i + 3]);
                *(GLAS u32x2*)(lds + L_KDT + kcol * KDP + (16 * qd + 4 * i) * 2) = v; }
        }
        __syncthreads();
        f32x16 o[2];
#pragma unroll
        for (int r = 0; r < 16; ++r) { o[0][r] = 0.f; o[1][r] = 0.f; }
        if (!STATE_ONLY) {
        if (w < 3) {
            const int ti = (w >= 1) ? 1 : 0, si = (w == 2) ? 1 : 0;
            f32x16 a;
#pragma unroll
            for (int r = 0; r < 16; ++r) a[r] = 0.f;
            const GLAS unsigned char* ap = lds + L_QE + (32 * ti + r32) * QEP + 16 * hi; const GLAS unsigned char* bp = lds + L_KE + (32 * si + r32) * QEP + 16 * hi;
#pragma unroll
            for (int s = 0; s < 8; ++s) { const bf16x8 A = ld2x64(ap + 32 * s, ap + 32 * s + 8), B = ld2x64(bp + 32 * s, bp + 32 * s + 8);
                a = __builtin_amdgcn_mfma_f32_32x32x16_bf16(A, B, a, 0, 0, 0); }
            const int sg = 32 * si + r32;
#pragma unroll
            for (int r = 0; r < 16; ++r) { const int tg = 32 * ti + crow(r, hi); const float v = (sg <= tg) ? a[r] : 0.f;
                *(GLAS bf16_t*)(lds + L_ATT + tg * KDP + sg * 2) = f2bf1(v); }
        } else if (w == 3) {
#pragma unroll
            for (int r = 0; r < 16; ++r) *(GLAS bf16_t*)(lds + L_ATT + crow(r, hi) * KDP + (32 + r32) * 2) = 0;
        }
        {
#pragma unroll
            for (int i = 0; i < 4; ++i)
#pragma unroll
                for (int s = 0; s < 2; ++s) {
                    u32x4 pk; pk.x = cvtpk(S[i][8 * s], S[i][8 * s + 1]); pk.y = cvtpk(S[i][8 * s + 2], S[i][8 * s + 3]); pk.z = cvtpk(S[i][8 * s + 4], S[i][8 * s + 5]); pk.w = cvtpk(S[i][8 * s + 6], S[i][8 * s + 7]);
                    const bf16x8 Bf = __builtin_bit_cast(bf16x8, pk);
#pragma unroll
                    for (int ti = 0; ti < 2; ++ti) { const GLAS unsigned char* ap = lds + L_QE + (32 * ti + r32) * QEP + (32 * i + 16 * s + 4 * hi) * 2;
                        const bf16x8 A = ld2x64(ap, ap + 16); o[ti] = __builtin_amdgcn_mfma_f32_32x32x16_bf16(A, Bf, o[ti], 0, 0, 0); }
                }
        }
        __syncthreads();
        }
        {
            bf16x8 vf[4];
            const int gI = lane >> 4, i16 = lane & 15, q = i16 >> 2, p = i16 & 3;
            const GLAS unsigned char* vb = lds + L_V + (8 * hi + q) * VP + (32 * w + 16 * (gI & 1) + 4 * p) * 2;
#pragma unroll
            for (int ks = 0; ks < 4; ++ks) { const s16x4 lo = vtr(vb + 16 * ks * VP), hh = vtr(vb + (16 * ks + 4) * VP);
                vf[ks] = (bf16x8){lo[0], lo[1], lo[2], lo[3], hh[0], hh[1], hh[2], hh[3]}; }
            if (!STATE_ONLY) {
#pragma unroll
            for (int ti = 0; ti < 2; ++ti)
#pragma unroll
                for (int ks = 0; ks < 4; ++ks) { const GLAS unsigned char* ap = lds + L_ATT + (32 * ti + r32) * KDP + (16 * ks + 8 * hi) * 2;
                    const bf16x8 A = ld2x64(ap, ap + 8); o[ti] = __builtin_amdgcn_mfma_f32_32x32x16_bf16(A, vf[ks], o[ti], 0, 0, 0); }
            }
#pragma unroll
            for (int i = 0; i < 4; ++i) {
#pragma unroll
                for (int r = 0; r < 16; ++r) S[i][r] *= BL[32 * i + crow(r, hi)];
#pragma unroll
                for (int ks = 0; ks < 4; ++ks) { const GLAS unsigned char* ap = lds + L_KDT + (32 * i + r32) * KDP + (16 * ks + 8 * hi) * 2;
                    const bf16x8 A = ld2x64(ap, ap + 8); S[i] = __builtin_amdgcn_mfma_f32_32x32x16_bf16(A, vf[ks], S[i], 0, 0, 0); }
            }
        }
        __syncthreads();
        if (!STATE_ONLY) {
#pragma unroll
        for (int ti = 0; ti < 2; ++ti)
#pragma unroll
            for (int r = 0; r < 16; ++r) OL[(32 * ti + crow(r, hi)) * OLP + 32 * w + r32] = o[ti][r];
        __syncthreads();
        {
            const int t = tid >> 3, seg = tid & 7;
            f32x4 v[8]; float ss = 0.f;
#pragma unroll
            for (int j = 0; j < 8; ++j) { v[j] = *(const GLAS f32x4*)(OL + t * OLP + 32 * seg + 4 * j); ss += (v[j].x * v[j].x + v[j].y * v[j].y) + (v[j].z * v[j].z + v[j].w * v[j].w); }
            ss += dpp_xor1(ss); ss += dpp_xor2(ss); ss += dpp_hmirror(ss);
            const float rs = rsqrtf(ss * (1.0f / 256.0f) + 1e-6f);
            const size_t go = (row0 + t) * 1024 + h * 256 + 32 * seg;
            const float* gn = gnorm + h * 256 + 32 * seg;
#pragma unroll
            for (int j = 0; j < 4; ++j) {
                const u32x4 rr = rpre[j];
                const f32x4 g0 = *(const f32x4*)(gn + 8 * j), g1 = *(const f32x4*)(gn + 8 * j + 4);
                const f32x4 a = v[2 * j], bq = v[2 * j + 1];
                u32x4 ov;
                ov.x = cvtpk(a.x * rs * g0.x * __builtin_bit_cast(float, rr.x << 16), a.y * rs * g0.y * __builtin_bit_cast(float, rr.x & 0xffff0000u));
                ov.y = cvtpk(a.z * rs * g0.z * __builtin_bit_cast(float, rr.y << 16), a.w * rs * g0.w * __builtin_bit_cast(float, rr.y & 0xffff0000u));
                ov.z = cvtpk(bq.x * rs * g1.x * __builtin_bit_cast(float, rr.z << 16), bq.y * rs * g1.y * __builtin_bit_cast(float, rr.z & 0xffff0000u));
                ov.w = cvtpk(bq.z * rs * g1.z * __builtin_bit_cast(float, rr.w << 16), bq.w * rs * g1.w * __builtin_bit_cast(float, rr.w & 0xffff0000u));
                *(u32x4*)(Oout + go + 8 * j) = ov;
            }
        }
        __syncthreads();
        }
    }
    if (STATE_ONLY) {
        float* sl = SLOC + ((size_t)(bh * 3 + seg) * 128) * 256 + 32 * w + r32;
#pragma unroll
        for (int i = 0; i < 4; ++i)
#pragma unroll
            for (int r = 0; r < 16; ++r) sl[(size_t)(32 * i + crow(r, hi)) * 256] = S[i][r];
        if (qd == 0) DSEG[(bh * 3 + seg) * 128 + kcol] = __expf(dlog);
    }
#undef GLA_FETCH
}
}
namespace nsa {
typedef unsigned short bf16_t;
typedef short bf16x8 __attribute__((ext_vector_type(8)));
typedef short s16x4 __attribute__((ext_vector_type(4)));
typedef float f32x16 __attribute__((ext_vector_type(16)));
typedef float f32x4 __attribute__((ext_vector_type(4)));
typedef unsigned u32x4 __attribute__((ext_vector_type(4)));
#define NLAS __attribute__((address_space(3)))
__device__ __forceinline__ int crow(int r, int hi) { return (r & 3) + 8 * (r >> 2) + 4 * hi; }
__device__ __forceinline__ unsigned cvtpk(float lo, float hi) { typedef float f2 __attribute__((ext_vector_type(2))); typedef __bf16 b2 __attribute__((ext_vector_type(2))); f2 v = {lo, hi}; b2 b = __builtin_convertvector(v, b2); return __builtin_bit_cast(unsigned, b); }
__device__ __forceinline__ s16x4 vtr(const NLAS unsigned char* p) { typedef short v4i16_t __attribute__((ext_vector_type(4))); return __builtin_bit_cast(s16x4, __builtin_amdgcn_ds_read_tr16_b64_v4i16((NLAS v4i16_t*)p)); }

__device__ __forceinline__ float gelu_tanh(float x) { const float y = 0.7978845608028654f * (x + 0.044715f * x * x * x); const float e = __expf(2.0f * y); const float th = 1.0f - 2.0f * __builtin_amdgcn_rcpf(e + 1.0f); return 0.5f * x * (1.0f + th); }
__device__ __forceinline__ void cmp_finalize(const float* HP, const float* BIASC, const bf16_t* WC2, bf16_t* KCVC, int gw, int NGW, int lane) {
    typedef float f4 __attribute__((ext_vector_type(4)));
    const int r = lane & 15, kq = lane >> 4;
    for (int item = gw; item < 1024; item += NGW) {
        const int R0 = item * 16, w = R0 >> 13, row = R0 + r;
        f4 acc[4];
#pragma unroll
        for (int nt = 0; nt < 4; ++nt) acc[nt] = (f4){0.f, 0.f, 0.f, 0.f};
#pragma unroll
        for (int ks = 0; ks < 8; ++ks) {
            const int col = 32 * ks + 8 * kq;
            f32x4 s0 = *(const f32x4*)(BIASC + w * 256 + col), s1 = *(const f32x4*)(BIASC + w * 256 + col + 4);
#pragma unroll
            for (int p = 0; p < 4; ++p) { const float* hp = HP + ((size_t)p * 16384 + row) * 256 + col; s0 = s0 + *(const f32x4*)hp; s1 = s1 + *(const f32x4*)(hp + 4); }
            u32x4 pk; pk.x = cvtpk(gelu_tanh(s0.x), gelu_tanh(s0.y)); pk.y = cvtpk(gelu_tanh(s0.z), gelu_tanh(s0.w)); pk.z = cvtpk(gelu_tanh(s1.x), gelu_tanh(s1.y)); pk.w = cvtpk(gelu_tanh(s1.z), gelu_tanh(s1.w));
            const bf16x8 A = __builtin_bit_cast(bf16x8, pk);
#pragma unroll
            for (int nt = 0; nt < 4; ++nt) { const bf16x8 B = *(const bf16x8*)(WC2 + ((size_t)w * 64 + 16 * nt + r) * 256 + col);
                acc[nt] = __builtin_amdgcn_mfma_f32_16x16x32_bf16(A, B, acc[nt], 0, 0, 0); }
        }
#pragma unroll
        for (int nt = 0; nt < 4; ++nt)
#pragma unroll
            for (int rg = 0; rg < 4; ++rg) { const int orow = R0 + 4 * kq + rg; const float v = ((orow & 127) == 127) ? 0.f : acc[nt][rg];
                KCVC[(size_t)orow * 64 + 16 * nt + r] = (bf16_t)(cvtpk(v, 0.f) & 0xffffu); }
    }
}

constexpr int SLOTB = 16384, NSLOT = 4;
constexpr int L_IMP = NSLOT * SLOTB, L_CAR = L_IMP + 8 * 32 * 33 * 4, L_VAL = L_CAR + 8 * 32 * 33 * 4, L_SELM = L_VAL + 64 * 33 * 4, L_WSF = L_SELM + 256, L_FAC = L_WSF + 8 * 64 * 4, L_AEND = L_FAC + 8 * 32 * 2 * 4;
static_assert(L_AEND <= 131072 + 28672, "attention LDS");
#define NINF (-__builtin_inff())
#define ABAR() asm volatile("s_waitcnt lgkmcnt(0)\n\ts_barrier" ::: "memory")

__device__ __forceinline__ void k_load(bf16x8* kf, const NLAS unsigned char* ks, int r32, int hi) {
    const int sw = (r32 >> 1) & 7;
    const unsigned kb = (unsigned)(size_t)(ks + r32 * 128);
    const unsigned a0 = kb + (((0 + hi) ^ sw) << 4), a1 = kb + (((2 + hi) ^ sw) << 4), a2 = kb + (((4 + hi) ^ sw) << 4), a3 = kb + (((6 + hi) ^ sw) << 4);
    asm volatile("ds_read_b128 %0, %8\n\tds_read_b128 %1, %8 offset:4096\n\tds_read_b128 %2, %9\n\tds_read_b128 %3, %9 offset:4096\n\t"
                 "ds_read_b128 %4, %10\n\tds_read_b128 %5, %10 offset:4096\n\tds_read_b128 %6, %11\n\tds_read_b128 %7, %11 offset:4096\n\ts_waitcnt lgkmcnt(0)"
                 : "=&v"(kf[0]), "=&v"(kf[1]), "=&v"(kf[2]), "=&v"(kf[3]), "=&v"(kf[4]), "=&v"(kf[5]), "=&v"(kf[6]), "=&v"(kf[7])
                 : "v"(a0), "v"(a1), "v"(a2), "v"(a3) : "memory");
    __builtin_amdgcn_sched_barrier(0);
}
__device__ __forceinline__ void qk_mma(f32x16& p0, f32x16& p1, const bf16x8* kf, const bf16x8* qf, const f32x16& c) {
#pragma unroll
    for (int d0 = 0; d0 < 4; ++d0) {
        if (d0 == 0) { p0 = __builtin_amdgcn_mfma_f32_32x32x16_bf16(kf[0], qf[0], c, 0, 0, 0); p1 = __builtin_amdgcn_mfma_f32_32x32x16_bf16(kf[1], qf[0], c, 0, 0, 0); }
        else { p0 = __builtin_amdgcn_mfma_f32_32x32x16_bf16(kf[2 * d0], qf[d0], p0, 0, 0, 0); p1 = __builtin_amdgcn_mfma_f32_32x32x16_bf16(kf[2 * d0 + 1], qf[d0], p1, 0, 0, 0); }
    }
}
__device__ __forceinline__ void pack_p(bf16x8* pa, const f32x16& p0, const f32x16& p1) {
    u32x4 w;
    w.x = cvtpk(p0[0], p0[1]); w.y = cvtpk(p0[2], p0[3]); w.z = cvtpk(p0[4], p0[5]); w.w = cvtpk(p0[6], p0[7]); pa[0] = __builtin_bit_cast(bf16x8, w);
    w.x = cvtpk(p0[8], p0[9]); w.y = cvtpk(p0[10], p0[11]); w.z = cvtpk(p0[12], p0[13]); w.w = cvtpk(p0[14], p0[15]); pa[1] = __builtin_bit_cast(bf16x8, w);
    w.x = cvtpk(p1[0], p1[1]); w.y = cvtpk(p1[2], p1[3]); w.z = cvtpk(p1[4], p1[5]); w.w = cvtpk(p1[6], p1[7]); pa[2] = __builtin_bit_cast(bf16x8, w);
    w.x = cvtpk(p1[8], p1[9]); w.y = cvtpk(p1[10], p1[11]); w.z = cvtpk(p1[12], p1[13]); w.w = cvtpk(p1[14], p1[15]); pa[3] = __builtin_bit_cast(bf16x8, w);
}
__device__ __forceinline__ void v_load(bf16x8* vf, const NLAS unsigned char* vs, int lane) {
    const int hi = lane >> 5;
    const unsigned vb = (unsigned)(size_t)(vs + ((lane >> 4) & 1) * 32 + (lane & 3) * 8 + (4 * hi + ((lane & 15) >> 2)) * 64);
    s16x4 t[16];
    asm volatile("ds_read_b64_tr_b16 %0, %16\n\tds_read_b64_tr_b16 %1, %16 offset:512\n\tds_read_b64_tr_b16 %2, %16 offset:1024\n\tds_read_b64_tr_b16 %3, %16 offset:1536\n\t"
                 "ds_read_b64_tr_b16 %4, %16 offset:2048\n\tds_read_b64_tr_b16 %5, %16 offset:2560\n\tds_read_b64_tr_b16 %6, %16 offset:3072\n\tds_read_b64_tr_b16 %7, %16 offset:3584\n\t"
                 "ds_read_b64_tr_b16 %8, %16 offset:4096\n\tds_read_b64_tr_b16 %9, %16 offset:4608\n\tds_read_b64_tr_b16 %10, %16 offset:5120\n\tds_read_b64_tr_b16 %11, %16 offset:5632\n\t"
                 "ds_read_b64_tr_b16 %12, %16 offset:6144\n\tds_read_b64_tr_b16 %13, %16 offset:6656\n\tds_read_b64_tr_b16 %14, %16 offset:7168\n\tds_read_b64_tr_b16 %15, %16 offset:7680\n\ts_waitcnt lgkmcnt(0)"
                 : "=&v"(t[0]), "=&v"(t[1]), "=&v"(t[2]), "=&v"(t[3]), "=&v"(t[4]), "=&v"(t[5]), "=&v"(t[6]), "=&v"(t[7]),
                   "=&v"(t[8]), "=&v"(t[9]), "=&v"(t[10]), "=&v"(t[11]), "=&v"(t[12]), "=&v"(t[13]), "=&v"(t[14]), "=&v"(t[15])
                 : "v"(vb) : "memory");
    __builtin_amdgcn_sched_barrier(0);
#pragma unroll
    for (int i = 0; i < 8; ++i) vf[i] = (bf16x8){t[2 * i][0], t[2 * i][1], t[2 * i][2], t[2 * i][3], t[2 * i + 1][0], t[2 * i + 1][1], t[2 * i + 1][2], t[2 * i + 1][3]};
}
__device__ __forceinline__ void pv_mma(f32x16* o, const bf16x8* vf, const bf16x8* pa) {
#pragma unroll
    for (int ks = 0; ks < 4; ++ks) {
        o[0] = __builtin_amdgcn_mfma_f32_32x32x16_bf16(pa[ks], vf[ks], o[0], 0, 0, 0);
        o[1] = __builtin_amdgcn_mfma_f32_32x32x16_bf16(pa[ks], vf[4 + ks], o[1], 0, 0, 0);
    }
}
__device__ __forceinline__ float max32(const f32x16& p0, const f32x16& p1) {
    float a = fmaxf(p0[0], p1[0]);
#pragma unroll
    for (int r = 1; r < 16; ++r) a = fmaxf(a, fmaxf(p0[r], p1[r]));
    return a;
}
__device__ __forceinline__ float comb_max(float v) { auto rr = __builtin_amdgcn_permlane32_swap(__float_as_uint(v), __float_as_uint(v), false, false); return fmaxf(__uint_as_float(rr[0]), __uint_as_float(rr[1])); }
__device__ __forceinline__ float comb_sum(float v) { auto rr = __builtin_amdgcn_permlane32_swap(__float_as_uint(v), __float_as_uint(v), false, false); return __uint_as_float(rr[0]) + __uint_as_float(rr[1]); }
__device__ __forceinline__ void mask_le(f32x16& p0, f32x16& p1, int thr, int hi) {
    int t2 = thr - 4 * hi; asm volatile("" : "+v"(t2));
#pragma unroll
    for (int r = 0; r < 16; ++r) { const int kc = (r & 3) + 8 * (r >> 2); if (kc > t2) p0[r] = NINF; if (kc + 32 > t2) p1[r] = NINF; }
}
__device__ __forceinline__ void mask_gt(f32x16& p0, f32x16& p1, int thr, int hi) {
    int t2 = thr - 4 * hi; asm volatile("" : "+v"(t2));
#pragma unroll
    for (int r = 0; r < 16; ++r) { const int kc = (r & 3) + 8 * (r >> 2); if (kc <= t2) p0[r] = NINF; if (kc + 32 <= t2) p1[r] = NINF; }
}

#ifndef SOFT_THR
#define SOFT_THR 8.0f
#endif
struct Soft { float mhat, l; f32x16 o[2]; };
__device__ __forceinline__ void soft_init(Soft& s) { s.mhat = 0.f; s.l = 0.f;
#pragma unroll
    for (int r = 0; r < 16; ++r) { s.o[0][r] = 0.f; s.o[1][r] = 0.f; } }
__device__ __forceinline__ float soft_update(Soft& s, f32x16& p0, f32x16& p1, bool first, NLAS float* wsf, int r32, int hi) {
    const float rm = comb_max(max32(p0, p1));
    const float dl = first ? ((rm > NINF) ? rm : 0.f) : ((rm > SOFT_THR) ? rm : 0.f);
    float f = 1.0f;
    if (__any(dl != 0.f)) {
        s.mhat += dl;
        f = __builtin_amdgcn_exp2f(-dl);
        s.l *= f;
#pragma unroll
        for (int r = 0; r < 16; ++r) { p0[r] -= dl; p1[r] -= dl; }
        if (!first) {
            if (hi == 0) wsf[r32] = f;
            asm volatile("s_waitcnt lgkmcnt(0)" ::: "memory");
#pragma unroll
            for (int r = 0; r < 16; ++r) { const float ff = wsf[crow(r, hi)]; s.o[0][r] *= ff; s.o[1][r] *= ff; }
            asm volatile("s_waitcnt lgkmcnt(0)" ::: "memory");
        }
    }
    float sum = 0.f;
#pragma unroll
    for (int r = 0; r < 16; ++r) { p0[r] = __builtin_amdgcn_exp2f(p0[r]); p1[r] = __builtin_amdgcn_exp2f(p1[r]); sum += p0[r] + p1[r]; }
    s.l += sum;
    return f;
}

struct AttnBufs { unsigned char* ws; };
struct Strm { int u, kind, j; };
__device__ __forceinline__ int unit_qt(int u, int sub) { return 8 * (u >> 1) + ((u & 1) ? (7 - sub) : sub); }
__device__ __forceinline__ void strm_next(Strm& s, int sub) {
    const int qt = unit_qt(s.u, sub);
    if (s.kind == 0) { if (s.j == 0) s.j = 1; else { s.kind = 1; s.j = qt; } }
    else if (s.kind == 1) { if (s.j > 0) --s.j; else { s.kind = 2; s.j = qt; } }
    else { const int jlo = qt >= 8 ? qt - 8 : 0; if (s.j > jlo) --s.j; else { ++s.u; s.kind = 0; s.j = 0; } }
}
__device__ __forceinline__ void dma16(const void* g, NLAS unsigned char* l) {
    unsigned keep; const unsigned dst = (unsigned)__builtin_amdgcn_readfirstlane((int)(unsigned)(size_t)l);
    asm volatile("s_mov_b32 %0, m0\n\ts_mov_b32 m0, %2\n\ts_nop 0\n\tglobal_load_lds_dwordx4 %1, off\n\ts_mov_b32 m0, %0" : "=&s"(keep) : "v"(g), "s"(dst) : "memory");
}


template <int VAR = 0>
__device__ __forceinline__ void attn_block(int bh, int sub, const AttnBufs& T, NLAS unsigned char* lds, int tid0) {
    int tid_ = tid0; asm volatile("" : "+v"(tid_));
    const int tid = tid_, lane = tid & 63, w = __builtin_amdgcn_readfirstlane(tid >> 6), r32 = lane & 31, hi = lane >> 5;
    const int b = bh >> 2, hk = bh & 3, g = w >> 1, hq = hk * 4 + g, qi = 32 * (w & 1) + r32;
    NLAS float* wsf = (NLAS float*)(lds + L_WSF) + w * 64;
    NLAS float* IMP = (NLAS float*)(lds + L_IMP) + w * 32 * 33; NLAS float* CAR = (NLAS float*)(lds + L_CAR) + w * 32 * 33;
    NLAS float* stash = (NLAS float*)(lds + L_IMP + w * 8448) + lane;
    const int krow = 8 * w + (lane >> 3), koff = krow * 64 + (((lane & 7) ^ ((krow >> 1) & 7)) << 3), voff = (16 * (w & 3) + (lane >> 2)) * 64 + (w >> 2) * 32 + (lane & 3) * 8;
    unsigned char* const ws = T.ws;
    constexpr size_t kvs = (size_t)16 * 4 * 2048 * 64;
#define A_KC ((const bf16_t*)(ws + WS_KCVC) + ((size_t)bh * 128) * 64)
#define A_VC ((const bf16_t*)(ws + WS_KCVC) + ((size_t)(64 + bh) * 128) * 64)
#define A_KV ((const bf16_t*)(ws + WS_KV) + (size_t)bh * 2048 * 64)
#define ISSUE(st, slot) do { const bf16_t* kt_; const bf16_t* vt_; \
        if ((st).kind == 0) { kt_ = A_KC + (st).j * 4096; vt_ = A_VC + (st).j * 4096; } \
        else if ((st).kind == 1) { kt_ = A_KV + 2 * kvs + (size_t)(st).j * 4096; vt_ = A_KV + 3 * kvs + (size_t)(st).j * 4096; } \
        else { kt_ = A_KV + 4 * kvs + (size_t)(st).j * 4096; vt_ = A_KV + 5 * kvs + (size_t)(st).j * 4096; } \
        dma16(kt_ + koff, lds + (slot) * SLOTB + w * 1024); dma16(vt_ + voff, lds + (slot) * SLOTB + 8192 + w * 1024); } while (0)
    Strm ist; ist.u = 0; ist.kind = 0; ist.j = 0;
    Strm cst = ist;
    int P = 0;
#pragma unroll 1
    for (int u = 0; u < 8; ++u) { const int qt = unit_qt(u, sub); P += 2 + (qt + 1) + ((qt >= 8 ? 8 : qt) + 1); }
    ISSUE(ist, 0); strm_next(ist, sub); ISSUE(ist, 1); strm_next(ist, sub); ISSUE(ist, 2); strm_next(ist, sub);
    Soft S; soft_init(S);
    bf16x8 qf[4];
    float g_cmp = 0.f, g_sel = 0.f, g_win = 0.f; unsigned selm = 0u; int qt = 0;
#pragma unroll 1
    for (int p = 0; p < P; ++p) {
        const int ahead = P - 1 - p;
        if (ahead >= 2) asm volatile("s_waitcnt vmcnt(4)" ::: "memory"); else if (ahead == 1) asm volatile("s_waitcnt vmcnt(2)" ::: "memory"); else asm volatile("s_waitcnt vmcnt(0)" ::: "memory");
        ABAR();
        if (p + 3 < P) { ISSUE(ist, (p + 3) & 3); strm_next(ist, sub); }
        const NLAS unsigned char* slot = lds + (p & 3) * SLOTB;
        const int kind = cst.kind, j = cst.j;
        if (kind == 0 && j == 0) {
            qt = unit_qt(cst.u, sub);
            const int tok = 64 * qt + qi;
            const float* gp = (const float*)(ws + WS_GATES) + ((size_t)b * 2048 + tok) * 48 + hq;
            g_cmp = gp[0]; g_sel = gp[16]; g_win = gp[32];
            const size_t qoff = (((size_t)b * 16 + hq) * 2048 + tok) * 64 + 8 * hi;
#pragma unroll
            for (int d0 = 0; d0 < 4; ++d0) qf[d0] = *(const bf16x8*)((const bf16_t*)(ws + WS_NQ) + qoff + 16 * d0);
            soft_init(S);
        }
        if ((kind == 1 || kind == 2) && j == qt) soft_init(S);
        const bool first = (kind == 0) ? (j == 0) : (j == qt);
        float cv = -S.mhat;
        if (kind == 1) { if (!((selm >> j) & 1u)) cv = NINF; }
        f32x16 c;
#pragma unroll
        for (int r = 0; r < 16; ++r) c[r] = cv;
        f32x16 p0, p1;
        if (VAR == 1) { p0 = c; p1 = c; asm volatile("" : "+v"(p0), "+v"(p1)); if (VAR == 1) { strm_next(cst, sub); continue; } }
        bf16x8 vf[8];
        {
            bf16x8 kf[8]; k_load(kf, slot, r32, hi);
            qk_mma(p0, p1, kf, qf, c);
        }
        v_load(vf, slot + 8192, lane);
        __builtin_amdgcn_sched_barrier(0);
        if (VAR == 2) { asm volatile("" :: "v"(p0), "v"(p1)); strm_next(cst, sub); continue; }
        if (kind == 0) { const int tok = 64 * qt + qi; const int nmax = (tok >= 31) ? ((tok - 31) >> 4) : -1; mask_le(p0, p1, nmax - 64 * j, hi); }
        else { if (j == qt) mask_le(p0, p1, qi, hi); if (kind == 2 && j == qt - 8) mask_gt(p0, p1, qi, hi); }
        const float f = soft_update(S, p0, p1, first, wsf, r32, hi);
        if (VAR == 3) { asm volatile("" :: "v"(p0), "v"(p1)); strm_next(cst, sub); continue; }
        {
            bf16x8 pa[4]; pack_p(pa, p0, p1);
            pv_mma(S.o, vf, pa);
        }
        if (kind == 0) {
            NLAS float* FAC = (NLAS float*)(lds + L_FAC) + w * 64;
            if (j == 0) {
                if (hi == 0) CAR[r32 * 33] = 0.f;
#pragma unroll
                for (int a = 0; a < 4; ++a) {
                    const int jb = 2 * a + hi;
                    IMP[r32 * 33 + jb] = p0[4 * a] + p0[4 * a + 1] + p0[4 * a + 2] + 0.5f * p0[4 * a + 3]; CAR[r32 * 33 + jb + 1] = 0.5f * p0[4 * a + 3];
                    IMP[r32 * 33 + jb + 8] = p1[4 * a] + p1[4 * a + 1] + p1[4 * a + 2] + 0.5f * p1[4 * a + 3]; CAR[r32 * 33 + jb + 9] = 0.5f * p1[4 * a + 3];
                }
            } else {
                const float l = comb_sum(S.l);
                const float inv = (l > 0.f) ? __builtin_amdgcn_rcpf(l) : 0.f;
                if (hi == 0) { FAC[r32] = f * inv; FAC[32 + r32] = inv; }
#pragma unroll
                for (int a = 0; a < 4; ++a) {
                    const int jb = 2 * a + hi;
                    IMP[r32 * 33 + jb + 16] = p0[4 * a] + p0[4 * a + 1] + p0[4 * a + 2] + 0.5f * p0[4 * a + 3]; CAR[r32 * 33 + jb + 17] = 0.5f * p0[4 * a + 3];
                    IMP[r32 * 33 + jb + 24] = p1[4 * a] + p1[4 * a + 1] + p1[4 * a + 2] + 0.5f * p1[4 * a + 3]; if (jb + 25 < 32) CAR[r32 * 33 + jb + 25] = 0.5f * p1[4 * a + 3];
                }
                ABAR();
                {
                    NLAS float* VAL = (NLAS float*)(lds + L_VAL);
                    const int tq = tid >> 3, sb = tid & 7, wv = tq >> 5, rr = tq & 31;
                    const NLAS float* I0 = (const NLAS float*)(lds + L_IMP); const NLAS float* C0 = (const NLAS float*)(lds + L_CAR);
                    float v[4];
#pragma unroll
                    for (int e = 0; e < 4; ++e) { const int jb = 4 * sb + e; float sc = 0.f;
#pragma unroll
                        for (int gg = 0; gg < 4; ++gg) { const int ww = 2 * gg + wv; const NLAS float* fc = (const NLAS float*)(lds + L_FAC) + ww * 64 + rr;
                            sc += I0[(ww * 32 + rr) * 33 + jb] * fc[jb < 16 ? 0 : 32] + C0[(ww * 32 + rr) * 33 + jb] * fc[jb <= 16 ? 0 : 32]; }
                        if (jb > qt) sc = -1.0f; else if (jb == 0 || jb == qt || jb == qt - 1) sc = 1e4f;
                        v[e] = sc; VAL[tq * 33 + jb] = sc; }
                    ABAR();
                    unsigned bits = 0u;
#pragma unroll
                    for (int e = 0; e < 4; ++e) { const int jb = 4 * sb + e; int rank = 0;
#pragma unroll
                        for (int i = 0; i < 32; ++i) { const float x = VAL[tq * 33 + i]; rank += (x > v[e] || (x == v[e] && i < jb)) ? 1 : 0; }
                        if (rank < 16) bits |= 1u << jb; }
                    bits |= dpp_xor1(bits); bits |= dpp_xor2(bits); bits |= dpp_hmirror(bits);
                    if (sb == 0) ((NLAS unsigned*)(lds + L_SELM))[tq] = bits;
                }
                ABAR();
#ifdef DBG_SELALL
                selm = 0xffffffffu;
#else
                selm = ((const NLAS unsigned*)(lds + L_SELM))[qi];
#endif
                const float fac = g_cmp * inv;
                if (hi == 0) wsf[r32] = fac;
                asm volatile("s_waitcnt lgkmcnt(0)" ::: "memory");
#pragma unroll
                for (int r = 0; r < 16; ++r) { const float ff = wsf[crow(r, hi)]; stash[r * 64] = S.o[0][r] * ff; stash[(16 + r) * 64] = S.o[1][r] * ff; }
                asm volatile("s_waitcnt lgkmcnt(0)" ::: "memory");
                const size_t qoff = (((size_t)b * 16 + hq) * 2048 + 64 * qt + qi) * 64 + 8 * hi;
#pragma unroll
                for (int d0 = 0; d0 < 4; ++d0) qf[d0] = *(const bf16x8*)((const bf16_t*)(ws + WS_NQR) + qoff + 16 * d0);
            }
        } else {
            const int jend = (kind == 1) ? 0 : (qt >= 8 ? qt - 8 : 0);
            if (j == jend) {
                const float l = comb_sum(S.l);
                const float fac = (kind == 1 ? g_sel : g_win) * __builtin_amdgcn_rcpf(l);
                if (hi == 0) wsf[r32] = fac;
                asm volatile("s_waitcnt lgkmcnt(0)" ::: "memory");
#pragma unroll
                for (int r = 0; r < 16; ++r) { const float ff = wsf[crow(r, hi)]; stash[r * 64] += S.o[0][r] * ff; stash[(16 + r) * 64] += S.o[1][r] * ff; }
                asm volatile("s_waitcnt lgkmcnt(0)" ::: "memory");
                if (kind == 2) {
                    const NLAS float* sw = (const NLAS float*)(lds + L_IMP + w * 8448);
                    bf16_t* ob = (bf16_t*)(ws + WS_OATT) + ((size_t)b * 2048 + 64 * qt + 32 * (w & 1)) * 1024 + hq * 64;
#pragma unroll
                    for (int i = 0; i < 4; ++i) {
                        const int row = 8 * i + (lane >> 3), ch = lane & 7;
                        const int hh_ = (row >> 2) & 1, rr_ = (row & 3) + 4 * (row >> 3), d0 = ch >> 2;
                        const NLAS float* sp = sw + ((d0 * 16 + rr_) * 64 + hh_ * 32 + (ch & 3) * 8);
                        const f32x4 x0 = *(const NLAS f32x4*)sp, x1 = *(const NLAS f32x4*)(sp + 4);
                        u32x4 ov; ov.x = cvtpk(x0.x, x0.y); ov.y = cvtpk(x0.z, x0.w); ov.z = cvtpk(x1.x, x1.y); ov.w = cvtpk(x1.z, x1.w);
                        *(u32x4*)(ob + (size_t)row * 1024 + ch * 8) = ov;
                    }
                }
            }
        }
        strm_next(cst, sub);
    }
    ABAR();
#undef ISSUE
#undef A_KC
#undef A_VC
#undef A_KV
}
}
namespace cg = cooperative_groups;
typedef unsigned short bf16_t;
struct Params { const float* in[23]; float* out; unsigned char* ws; };

constexpr int PARAM_OFF = EPI_OFF + 28672, BARST_OFF = PARAM_OFF + 256;
template <class T> __device__ __forceinline__ T* ldp(PG8_LAS unsigned char* lds, int idx) {
    const PG8_LAS unsigned* p = (const PG8_LAS unsigned*)(lds + PARAM_OFF) + 2 * idx;
    const unsigned lo = __builtin_amdgcn_readfirstlane(p[0]), hi = __builtin_amdgcn_readfirstlane(p[1]);
    typedef __attribute__((address_space(1))) unsigned char gchar_t;
    gchar_t* gp = (gchar_t*)(((unsigned long long)hi << 32) | lo);
    return (T*)(unsigned char*)gp;
}
#define INP(k) ldp<const float>(lds, (k))
#define OUTP() ldp<float>(lds, 23)
#define WSP() ldp<unsigned char>(lds, 24)
__device__ __forceinline__ pro::In load_in(PG8_LAS unsigned char* lds) {
    pro::In I;
    I.x = INP(0); I.norm_mix = INP(1); I.norm_ffn = INP(2); I.gla_w_in = INP(3); I.gla_w_alpha_up = INP(4); I.gla_b_alpha = INP(5); I.gla_norm = INP(6); I.gla_w_o = INP(7);
    I.kv_norm = INP(8); I.nsa_w_kv = INP(9); I.cmp_pe_k = INP(10); I.cmp_pe_v = INP(11); I.cmp_k_w1 = INP(12); I.cmp_k_w2 = INP(13); I.cmp_v_w1 = INP(14); I.cmp_v_w2 = INP(15);
    I.nsa_w_in = INP(16); I.nsa_w_o = INP(17); I.ffn_w_up = INP(18); I.ffn_conv_w = INP(19); I.ffn_conv_b = INP(20); I.ffn_w_down = INP(21); I.norm_final = INP(22);
    return I;
}

__global__ void __launch_bounds__(512, 2) yoco_fwd(Params P) {
    extern __shared__ __attribute__((aligned(16))) unsigned char lds_raw[];
    PG8_LAS unsigned char* lds = (PG8_LAS unsigned char*)lds_raw;
    cg::grid_group grid = cg::this_grid();
    const int G = gridDim.x, bx = blockIdx.x;
    const int wave0 = __builtin_amdgcn_readfirstlane(threadIdx.x >> 6);
#define NOWTID() (wave0 * 64 + lane_id())
    if (threadIdx.x == 0) {
        PG8_LAS unsigned long long* lp = (PG8_LAS unsigned long long*)(lds + PARAM_OFF);
#pragma unroll
        for (int i = 0; i < 23; ++i) lp[i] = (unsigned long long)P.in[i];
        lp[23] = (unsigned long long)P.out; lp[24] = (unsigned long long)P.ws;
    }
    if (threadIdx.x < 2) ((PG8_LAS unsigned*)(lds + BARST_OFF))[threadIdx.x] = 0u;
    __syncthreads();
    (void)xcd_barrier_post((unsigned*)(P.ws + WS_BAR), (volatile LAS unsigned*)(lds + BARST_OFF), (int)threadIdx.x);
#define GSYNC() do { XcdBarrier b_; b_.bar = (unsigned*)(WSP() + WS_BAR); b_.x = xb_xcc_id(); b_.st = (volatile LAS unsigned*)(lds + BARST_OFF); xcd_barrier(b_, NOWTID()); } while (0)
#define PH_COMMON int tid_ = NOWTID(); asm volatile("" : "+v"(tid_)); const int tid = tid_, lane = tid & 63, wave = __builtin_amdgcn_readfirstlane(tid >> 6); const int gw = bx * 8 + wave, NGW = G * 8; (void)lane; (void)gw; (void)NGW; unsigned char* ws = WSP(); (void)ws;

#ifndef SKIP_PRO
    { PH_COMMON
        pro::In I = load_in(lds); pro::Wts W;
        W.WGI = (bf16_t*)(ws + WS_WGI); W.WGO = (bf16_t*)(ws + WS_WGO); W.WKQ = (bf16_t*)(ws + WS_WKQ); W.WC1 = (bf16_t*)(ws + WS_WC1); W.WC2 = (bf16_t*)(ws + WS_WC2);
        W.WNO = (bf16_t*)(ws + WS_WNO); W.WUP = (bf16_t*)(ws + WS_WUP); W.WDN = (bf16_t*)(ws + WS_WDN); W.ROPE = (float*)(ws + WS_ROPE); W.BIASC = (float*)(ws + WS_BIASC);
#ifdef REP_PRO
        pro::prologue(I, W, (bf16_t*)(ws + WS_XB), (float*)(ws + WS_RSS), lds, gw, NGW, lane, wave); __syncthreads();
#endif
        pro::prologue(I, W, (bf16_t*)(ws + WS_XB), (float*)(ws + WS_RSS), lds, gw, NGW, lane, wave); }
#endif
    grid.sync();

#ifdef REP_SYNC
#pragma unroll 1
    for (int r = 0; r < REP_SYNC; ++r) GSYNC();
#endif
#ifndef SKIP_P1
    { unsigned char* ws = WSP();
        pg8::Gemm g = pg8::make_gemm((const bf16_t*)(ws + WS_XB), (const bf16_t*)(ws + WS_WGI), M_TOK, 3584, 1024, 1024, 1024);
        pg8::StaticOrder S; S.init(M_TOK, 3584, G, bx);
        epi::EpiGlaIn E{(bf16_t*)(ws + WS_GQ), (bf16_t*)(ws + WS_GK), (bf16_t*)(ws + WS_GV), (bf16_t*)(ws + WS_GR), (float*)(ws + WS_GG), (const float*)(ws + WS_RSS), INP(5)};
#ifdef REP_P1
        pg8::gemm_phase(lds, lds + EPI_OFF, g, S, E, NOWTID());
#endif
        pg8::gemm_phase(lds, lds + EPI_OFF, g, S, E, NOWTID());
    }
#endif
    GSYNC();
#ifndef SKIP_GLA
    { unsigned char* ws = WSP();
        float* SLOC = (float*)(ws + WS_BIG + 260 * MiB); float* DSEG = (float*)(ws + WS_BIG + 290 * MiB);
#ifdef REP_GLAA
        if ((bx & 3) < 3) gla::gla_unit<true>(bx >> 4, (bx >> 2) & 3, bx & 3, (const bf16_t*)(ws + WS_GQ), (const bf16_t*)(ws + WS_GK), (const bf16_t*)(ws + WS_GV), (bf16_t*)(ws + WS_GV), (const bf16_t*)(ws + WS_GR), (const float*)(ws + WS_GG), INP(6), SLOC, DSEG, lds, NOWTID());
#endif
        if ((bx & 3) < 3) gla::gla_unit<true>(bx >> 4, (bx >> 2) & 3, bx & 3, (const bf16_t*)(ws + WS_GQ), (const bf16_t*)(ws + WS_GK), (const bf16_t*)(ws + WS_GV), (bf16_t*)(ws + WS_GV), (const bf16_t*)(ws + WS_GR), (const float*)(ws + WS_GG), INP(6), SLOC, DSEG, lds, NOWTID());
    }
    GSYNC();
    { unsigned char* ws = WSP();
        float* SLOC = (float*)(ws + WS_BIG + 260 * MiB); float* DSEG = (float*)(ws + WS_BIG + 290 * MiB);
#ifdef REP_GLAB
        gla::gla_unit<false>(bx >> 4, (bx >> 2) & 3, bx & 3, (const bf16_t*)(ws + WS_GQ), (const bf16_t*)(ws + WS_GK), (const bf16_t*)(ws + WS_GV), (bf16_t*)(ws + WS_BIG + 300 * MiB), (const bf16_t*)(ws + WS_GR), (const float*)(ws + WS_GG), INP(6), SLOC, DSEG, lds, NOWTID());
#endif
        gla::gla_unit<false>(bx >> 4, (bx >> 2) & 3, bx & 3, (const bf16_t*)(ws + WS_GQ), (const bf16_t*)(ws + WS_GK), (const bf16_t*)(ws + WS_GV), (bf16_t*)(ws + WS_GV), (const bf16_t*)(ws + WS_GR), (const float*)(ws + WS_GG), INP(6), SLOC, DSEG, lds, NOWTID());
    }
#endif
    GSYNC();
#ifndef SKIP_P3
    { unsigned char* ws = WSP();
        pg8::Gemm g = pg8::make_gemm((const bf16_t*)(ws + WS_GV), (const bf16_t*)(ws + WS_WGO), M_TOK, 1024, 1024, 1024, 1024);
        pg8::StaticOrder S; S.init(M_TOK, 1024, G, bx);
        epi::EpiRes E{INP(0), OUTP(), (bf16_t*)(ws + WS_XB), (float*)(ws + WS_RSS) + 1 * M_TOK};
        pg8::gemm_phase(lds, lds + EPI_OFF, g, S, E, NOWTID());
    }
#endif
    GSYNC();
#pragma unroll 1
    for (int layer = 0; layer < 2; ++layer) {
        if (layer == 1) {
#ifndef SKIP_P7
            { unsigned char* ws = WSP();
                pg8::Gemm g = pg8::make_gemm((const bf16_t*)(ws + WS_XB), (const bf16_t*)(ws + WS_WKQ), M_TOK, 2816, 1024, 1024, 1024);
                pg8::StaticOrder S; S.init(M_TOK, 2816, G, bx);
                epi::EpiKvq E{(bf16_t*)(ws + WS_KV), (bf16_t*)(ws + WS_NQ), (bf16_t*)(ws + WS_NQR), (float*)(ws + WS_GATES), (const float*)(ws + WS_RSS) + 2 * M_TOK, (const float*)(ws + WS_ROPE)};
#ifdef REP_P7
                pg8::gemm_phase(lds, lds + EPI_OFF, g, S, E, NOWTID());
#endif
                pg8::gemm_phase(lds, lds + EPI_OFF, g, S, E, NOWTID());
            }
#endif
            GSYNC();
#ifndef SKIP_P8
            { unsigned char* ws = WSP();
                pg8::Gemm g = pg8::make_gemm((const bf16_t*)(ws + WS_KV), (const bf16_t*)(ws + WS_WC1), 16384, 1024, 512, 1024, 2048);
                g.a_pn = 512 * 2; g.b_pn = 512 * 2; g.b_hi = (size_t)256 * 2048 * 2; g.b_split = 32;
                pg8::StaticOrder S; S.init(16384, 1024, G, bx);
                epi::EpiCmp E{(float*)(ws + WS_HP)};
                pg8::gemm_phase(lds, lds + EPI_OFF, g, S, E, NOWTID());
            }
#endif
            GSYNC();
#ifndef SKIP_P9
            { PH_COMMON nsa::cmp_finalize((const float*)(ws + WS_HP), (const float*)(ws + WS_BIASC), (const bf16_t*)(ws + WS_WC2), (bf16_t*)(ws + WS_KCVC), gw, NGW, lane); }
#endif
            GSYNC();
#ifndef SKIP_ATTN
            { unsigned char* ws = WSP();
                nsa::AttnBufs T{ws};
#ifdef REP_ATTN
                nsa::attn_block<REP_ATTN>(bx >> 2, bx & 3, T, lds, NOWTID());
#endif
                nsa::attn_block(bx >> 2, bx & 3, T, lds, NOWTID());
            }
#endif
            GSYNC();
#ifndef SKIP_P11
            { unsigned char* ws = WSP(); float* out = OUTP();
                pg8::Gemm g = pg8::make_gemm((const bf16_t*)(ws + WS_OATT), (const bf16_t*)(ws + WS_WNO), M_TOK, 1024, 1024, 1024, 1024);
                pg8::StaticOrder S; S.init(M_TOK, 1024, G, bx);
                epi::EpiRes E{out, out, (bf16_t*)(ws + WS_XB), (float*)(ws + WS_RSS) + 3 * M_TOK};
                pg8::gemm_phase(lds, lds + EPI_OFF, g, S, E, NOWTID());
            }
#endif
            GSYNC();
        }
#ifndef SKIP_UP
        { unsigned char* ws = WSP();
            const float* rss_in = (const float*)(ws + WS_RSS) + (layer == 0 ? 1 : 3) * M_TOK;
            const float* cw = INP(19) + (size_t)layer * 3 * 5632; const float* cb = INP(20) + (size_t)layer * 5632;
            pg8::Gemm g = pg8::make_gemm((const bf16_t*)(ws + WS_XB), (const bf16_t*)(ws + WS_WUP) + (size_t)layer * 5632 * 1024, M_TOK, 5632, 1024, 1024, 1024);
            pg8::StaticOrder S; S.init(M_TOK, 5632, G, bx);
            epi::EpiFfnUp E{(bf16_t*)(ws + WS_ACT), (float*)(ws + WS_HALO), rss_in, cw, cb};
#ifdef REP_UP
            pg8::gemm_phase(lds, lds + EPI_OFF, g, S, E, NOWTID());
#endif
#ifdef REP_UPNULL
            { epi::EpiNull EN; pg8::gemm_phase(lds, lds + EPI_OFF, g, S, EN, NOWTID()); }
#endif
            pg8::gemm_phase(lds, lds + EPI_OFF, g, S, E, NOWTID());
        }
#endif
        GSYNC();
#ifndef SKIP_FIX
        { PH_COMMON
            const float* cw = INP(19) + (size_t)layer * 3 * 5632; const float* cb = INP(20) + (size_t)layer * 5632;
            const float* HALO = (const float*)(ws + WS_HALO); bf16_t* ACT = (bf16_t*)(ws + WS_ACT);
            for (int i = bx * 512 + tid; i < 128 * 2 * 2816; i += G * 512) {
                const int f = i % 2816, pr = i / 2816, r = pr & 1, pm = pr >> 1;
                if ((pm & 7) == 0) continue;
                const int pn = f >> 7, cc = f & 127;
                const float* hc = HALO + ((size_t)(pm * 22 + pn) * 4) * 256; const float* hp = HALO + ((size_t)((pm - 1) * 22 + pn) * 4) * 256;
                float ug, ug1, ug2, uv, uv1, uv2;
                if (r == 0) { ug = hc[cc]; ug1 = hp[3 * 256 + cc]; ug2 = hp[2 * 256 + cc]; uv = hc[128 + cc]; uv1 = hp[3 * 256 + 128 + cc]; uv2 = hp[2 * 256 + 128 + cc]; }
                else { ug = hc[256 + cc]; ug1 = hc[cc]; ug2 = hp[3 * 256 + cc]; uv = hc[256 + 128 + cc]; uv1 = hc[128 + cc]; uv2 = hp[3 * 256 + 128 + cc]; }
                const float og = cb[f] + cw[f] * ug2 + cw[5632 + f] * ug1 + cw[2 * 5632 + f] * ug;
                const float ov = cb[2816 + f] + cw[2816 + f] * uv2 + cw[5632 + 2816 + f] * uv1 + cw[2 * 5632 + 2816 + f] * uv;
                const float a = og * __builtin_amdgcn_rcpf(1.0f + __expf(-og)) * ov;
                ACT[(size_t)(pm * 256 + r) * 2816 + f] = (bf16_t)(pg8::cvt_pk_bf16(a, 0.f) & 0xffffu);
            }
        }
#endif
        GSYNC();
#ifndef SKIP_DOWN
        { unsigned char* ws = WSP(); float* out = OUTP();
            float* rss_out = (float*)(ws + WS_RSS) + (layer == 0 ? 2 : 4) * M_TOK;
            pg8::Gemm g = pg8::make_gemm((const bf16_t*)(ws + WS_ACT), (const bf16_t*)(ws + WS_WDN) + (size_t)layer * 1024 * 2816, M_TOK, 1024, 2816, 2816, 2816);
            pg8::StaticOrder S; S.init(M_TOK, 1024, G, bx);
            epi::EpiRes E{out, out, (bf16_t*)(ws + WS_XB), rss_out};
            pg8::gemm_phase(lds, lds + EPI_OFF, g, S, E, NOWTID());
        }
#endif
        GSYNC();
    }
    { PH_COMMON
        const float* rss = (const float*)(ws + WS_RSS) + 4 * M_TOK; float* out = OUTP(); const float* norm_final = INP(22);
        for (int m = gw; m < M_TOK; m += NGW) {
            const float rs = rsqrtf(rss[m] * (1.0f / 1024.0f) + 1e-6f);
            pro::f32x4* xr = (pro::f32x4*)(out + (size_t)m * 1024) + lane; const pro::f32x4* gr = (const pro::f32x4*)norm_final + lane;
#pragma unroll
            for (int j = 0; j < 4; ++j) { const pro::f32x4 v = xr[64 * j], gg = gr[64 * j]; xr[64 * j] = v * rs * gg; }
        }
    }
}

extern "C" void kernel_launch(void* const* d_in, const int* in_sizes, int n_in, void* d_out, int out_size, void* d_ws, size_t ws_size, hipStream_t stream) {
    static int grid = 0;
    if (grid == 0) {
        if (n_in != 23 || ws_size < WS_END) { fprintf(stderr, "kernel_launch: unexpected n_in %d or ws_size %zu (< %zu)\n", n_in, ws_size, (size_t)WS_END); grid = -1; return; }
        int dev = 0, cus = 0, per_cu = 0;
        (void)hipGetDevice(&dev);
        (void)hipDeviceGetAttribute(&cus, hipDeviceAttributeMultiprocessorCount, dev);
        (void)hipFuncSetAttribute((const void*)yoco_fwd, hipFuncAttributeMaxDynamicSharedMemorySize, LDS_BYTES);
        (void)hipOccupancyMaxActiveBlocksPerMultiprocessor(&per_cu, (const void*)yoco_fwd, 512, LDS_BYTES);
        if (per_cu < 1) { fprintf(stderr, "kernel_launch: occupancy query reports %d blocks per CU\n", per_cu); grid = -1; return; }
        grid = cus;
        if (grid > 256) grid = 256;
        grid &= ~7;
    }
    if (grid <= 0) return;
    (void)hipMemsetAsync((char*)d_ws + WS_RSS, 0, 1 * MiB, stream);
    Params p{};
    for (int i = 0; i < 23; ++i) p.in[i] = (const float*)d_in[i];
    p.out = (float*)d_out; p.ws = (unsigned char*)d_ws;
    void* args[] = {&p};
    hipError_t e = hipLaunchCooperativeKernel((void*)yoco_fwd, dim3(grid), dim3(512), args, LDS_BYTES, stream);
    if (e != hipSuccess) fprintf(stderr, "cooperative launch failed: %s (grid %d)\n", hipGetErrorString(e), grid);
}
```

```cpp
#include <hip/hip_runtime.h>
#include <hip/hip_cooperative_groups.h>
#include <cstdio>
#include <cstdint>
constexpr size_t MiB = 1u << 20;
constexpr int M_TOK = 32768;
constexpr size_t WS_RSS = 0;
constexpr size_t WS_BAR = 768 * 1024;
constexpr size_t WS_ROPE = 1 * MiB, WS_BIASC = 800 * 1024;
constexpr size_t WS_WGI = 2 * MiB, WS_WGO = 9 * MiB, WS_WKQ = 11 * MiB, WS_WC1 = 17 * MiB, WS_WC2 = 19 * MiB, WS_WNO = 20 * MiB, WS_WUP = 22 * MiB, WS_WDN = 44 * MiB;
constexpr size_t WS_XB = 56 * MiB;
constexpr size_t WS_BIG = 120 * MiB;
constexpr size_t WS_GQ = WS_BIG, WS_GK = WS_BIG + 32 * MiB, WS_GV = WS_BIG + 64 * MiB, WS_GR = WS_BIG + 128 * MiB, WS_GG = WS_BIG + 192 * MiB;
constexpr size_t WS_ACT = WS_BIG, WS_HALO = WS_BIG + 176 * MiB;
constexpr size_t WS_KV = WS_BIG, WS_NQ = WS_BIG + 96 * MiB, WS_NQR = WS_BIG + 160 * MiB, WS_GATES = WS_BIG + 224 * MiB, WS_HP = WS_BIG + 230 * MiB, WS_KCVC = WS_BIG + 294 * MiB, WS_OATT = WS_BIG + 296 * MiB;
constexpr size_t WS_END = WS_BIG + 376 * MiB;
constexpr int LDS_BYTES = 160 * 1024, EPI_OFF = 131072;


#define LAS __attribute__((address_space(3)))
#define XB_TMO      128
#define XB_XCNT(j)  (256  + 64 * (j))
#define XB_XSUB(j)  (1280 + 64 * (j))
#define XB_XGEN(j)  (2304 + 64 * (j))
#define XB_TOP      3328
#define XB_TOPGEN   3392
#define XCD_BAR_WORDS 3456
#define XB_SPIN_CAP (1u << 18)

__device__ __forceinline__ unsigned xb_ld(unsigned* p)              { return __hip_atomic_load(p, __ATOMIC_RELAXED, __HIP_MEMORY_SCOPE_AGENT); }
__device__ __forceinline__ unsigned xb_add(unsigned* p, unsigned v) { return __hip_atomic_fetch_add(p, v, __ATOMIC_RELAXED, __HIP_MEMORY_SCOPE_AGENT); }
__device__ __forceinline__ unsigned xb_xcc_id() { return (unsigned)__builtin_amdgcn_s_getreg((3 << 11) | 20) & 0xFu; }
#define XB_SPIN(cond, bar) do { unsigned _sp = 0; while (cond) { __builtin_amdgcn_s_sleep(1); \
    if ((++_sp & 255u) == 0u) { if (xb_ld(&(bar)[XB_TMO])) break; if (_sp > XB_SPIN_CAP) { atomicAdd(&(bar)[XB_TMO], 1u); break; } } } } while (0)

struct XcdBarrier {
    unsigned* bar; unsigned x;
    volatile LAS unsigned* st;
};

__device__ __forceinline__ XcdBarrier xcd_barrier_post(unsigned* bar, volatile LAS unsigned* st, int tid) {
    XcdBarrier b; b.bar = bar; b.x = xb_xcc_id(); b.st = st;
    if (tid == 0) (void)xb_add(&bar[XB_XCNT(b.x)], 1u);
    return b;
}
__device__ __forceinline__ void xcd_barrier_complete(unsigned* bar, unsigned x, unsigned& nloc, unsigned& nx) {
    const unsigned G = gridDim.x * gridDim.y * gridDim.z;
    unsigned sum, cnt, mine, sp = 0u;
    for (;;) {
        sum = 0u; cnt = 0u; mine = 0u;
#pragma unroll
        for (unsigned j = 0; j < 16; ++j) { const unsigned c = xb_ld(&bar[XB_XCNT(j)]); sum += c; cnt += (c > 0u) ? 1u : 0u; mine = (j == x) ? c : mine; }
        if (sum == G) break;
        __builtin_amdgcn_s_sleep(1);
        if ((++sp & 255u) == 0u) { if (xb_ld(&bar[XB_TMO])) break; if (sp > XB_SPIN_CAP) { atomicAdd(&bar[XB_TMO], 1u); break; } }
    }
    nloc = mine > 0u ? mine : 1u; nx = cnt > 0u ? cnt : 1u;
}

__device__ __forceinline__ void xcd_barrier(const XcdBarrier& b, int tid) {
    asm volatile("s_waitcnt vmcnt(0)" ::: "memory");
    __syncthreads();
    if (tid == 0) {
        unsigned* bar = b.bar;
        __builtin_amdgcn_s_waitcnt(0);
        unsigned nloc = b.st[0], nx = b.st[1];
        if (nloc == 0u) { xcd_barrier_complete(bar, b.x, nloc, nx); b.st[0] = nloc; b.st[1] = nx; }
        const unsigned old = xb_add(&bar[XB_XSUB(b.x)], 1u);
        const unsigned gen = old / nloc;
        if (old + 1u == (gen + 1u) * nloc) {
            __builtin_amdgcn_fence(__ATOMIC_RELEASE, "agent");
            asm volatile("s_waitcnt vmcnt(0)" ::: "memory");
            const unsigned og = xb_add(&bar[XB_TOP], 1u);
            const unsigned tg = og / nx;
            if (og + 1u == (tg + 1u) * nx) xb_add(&bar[XB_TOPGEN], 1u);
            else XB_SPIN(xb_ld(&bar[XB_TOPGEN]) == tg, bar);
            __builtin_amdgcn_fence(__ATOMIC_ACQUIRE, "agent");
            xb_add(&bar[XB_XGEN(b.x)], 1u);
            asm volatile("s_waitcnt vmcnt(0)" ::: "memory");
        } else {
            XB_SPIN(xb_ld(&bar[XB_XGEN(b.x)]) == gen, bar);
            __builtin_amdgcn_fence(__ATOMIC_ACQUIRE, "agent");
            asm volatile("s_waitcnt vmcnt(0)" ::: "memory");
        }
    }
    __syncthreads();
}

__device__ __forceinline__ int lane_id() { return (int)__builtin_amdgcn_mbcnt_hi(~0u, __builtin_amdgcn_mbcnt_lo(~0u, 0u)); }
template <class T> __device__ __forceinline__ T dpp_xor1(T x) { return __builtin_bit_cast(T, __builtin_amdgcn_mov_dpp(__builtin_bit_cast(int, x), 0xB1, 0xf, 0xf, true)); }
template <class T> __device__ __forceinline__ T dpp_xor2(T x) { return __builtin_bit_cast(T, __builtin_amdgcn_mov_dpp(__builtin_bit_cast(int, x), 0x4E, 0xf, 0xf, true)); }
template <class T> __device__ __forceinline__ T dpp_hmirror(T x) { return __builtin_bit_cast(T, __builtin_amdgcn_mov_dpp(__builtin_bit_cast(int, x), 0x141, 0xf, 0xf, true)); }
template <class T> __device__ __forceinline__ T swz_xor16(T x) { return __builtin_bit_cast(T, __builtin_amdgcn_ds_swizzle(__builtin_bit_cast(int, x), 0x401F)); }
namespace pg8 {
#define PG8_LAS __attribute__((address_space(3)))
typedef unsigned short bf16_t;
typedef short bf16x8 __attribute__((ext_vector_type(8)));
typedef float f32x4 __attribute__((ext_vector_type(4)));
typedef float f32x2 __attribute__((ext_vector_type(2)));
typedef unsigned u32x4 __attribute__((ext_vector_type(4)));
typedef unsigned u32x2 __attribute__((ext_vector_type(2)));
constexpr int BM = 256, BK = 64, HALF = 128, HTB = HALF * BK * 2, STAGE_BYTES = 8 * HTB, NXCD = 8, WGM = 8;

__host__ __device__ __forceinline__ int lds_byte(int r, int c) { const int st = (r >> 4) * 2 + (c >> 5), rr = r & 15, cc = c & 31, ob = rr * 64 + cc * 2; return st * 1024 + (ob ^ (((ob >> 9) & 1) << 5)); }
__host__ __device__ __forceinline__ void stage_rc(int b, int& R, int& C) { const int st = b / 1024, sb = b % 1024, swz = sb ^ (((sb >> 9) & 1) << 5); R = (st >> 1) * 16 + swz / 64; C = (st & 1) * 32 + (swz % 64) / 2; }
__host__ __device__ __forceinline__ int perm32(int rho) { const int n = rho >> 4, i = rho & 15; return 8 * (i >> 2) + 4 * n + (i & 3); }

struct Unit { int pm, pn; };
struct Gemm { const bf16_t* A; const bf16_t* Bt; int M, N, K; int lda, ldb; size_t a_pm, a_pn, b_pn, b_hi; int b_split; };
__device__ __forceinline__ Gemm make_gemm(const bf16_t* A, const bf16_t* Bt, int M, int N, int K, int lda, int ldb) {
    Gemm g; g.A = A; g.Bt = Bt; g.M = M; g.N = N; g.K = K; g.lda = lda; g.ldb = ldb;
    g.a_pm = (size_t)BM * lda * 2; g.a_pn = 0; g.b_pn = (size_t)BM * ldb * 2; g.b_hi = 0; g.b_split = 0x7fffffff; return g;
}

struct StaticOrder {
    int nM, nN, nwg, G, c;
    __device__ void init(int M, int N, int G_, int c_) { nM = M / BM; nN = N / BM; nwg = nM * nN; G = G_; c = c_; }
    __device__ bool next(int i, Unit& u) const {
        const long L = (long)i * G + c; if (L >= nwg) return false;
        int wgid = (int)L; { const int q = nwg / NXCD, r = nwg % NXCD, xcd = wgid % NXCD, off = wgid / NXCD; wgid = (xcd < r ? xcd * (q + 1) : r * (q + 1) + (xcd - r) * q) + off; }
        const int nig = WGM * nN, gid = wgid / nig, fm = gid * WGM, gsz = (nM - fm) < WGM ? (nM - fm) : WGM;
        u.pm = fm + ((wgid % nig) % gsz); u.pn = (wgid % nig) / gsz; return true;
    }
};

__device__ __forceinline__ unsigned cvt_pk_bf16(float lo, float hi) {
    typedef __bf16 bf16x2_t __attribute__((ext_vector_type(2)));
    f32x2 v = {lo, hi}; bf16x2_t b = __builtin_convertvector(v, bf16x2_t); return __builtin_bit_cast(unsigned, b);
}

template <class Epi>
__device__ __forceinline__ void gemm_phase(PG8_LAS unsigned char* lds, PG8_LAS unsigned char* lds_epi, const Gemm g, const StaticOrder& S, const Epi& E, int tid0) {
    int tid_ = tid0; asm volatile("" : "+v"(tid_));
    const int tid = tid_, wid = __builtin_amdgcn_readfirstlane(tid >> 6), lane = tid & 63, wr = wid >> 2, wc = wid & 3, fr = lane & 15, fq = lane >> 4;
    const int K = g.K, nt = K / BK;
    unsigned voffA[2], voffB[2];
#pragma unroll
    for (int i = 0; i < 2; ++i) { int R, C; stage_rc(tid * 16 + i * 8192, R, C); const int Rb = (R & ~31) + perm32(R & 31);
        voffA[i] = (unsigned)(R * g.lda + C) * 2u; voffB[i] = (unsigned)(Rb * g.ldb + C) * 2u; }
    const size_t kstep = (size_t)(BK * 2);
    const size_t hstepA = (size_t)HALF * g.lda * 2, hstepB = (size_t)HALF * g.ldb * 2;
    const unsigned ldsw = (unsigned)wid * 1024u;
    const int aoff = lds_byte(wr * 64 + fr, fq * 8), boff = lds_byte(wc * 32 + fr, fq * 8);
#define PG8_SA(b, h) (((b) * 2 + (h)) * HTB)
#define PG8_SB(b, h) ((4 + (b) * 2 + (h)) * HTB)
#define PG8_STAGE(bufoff, gbase, voff) do { _Pragma("unroll") for (int _i = 0; _i < 2; ++_i) \
        __builtin_amdgcn_global_load_lds((const unsigned*)((const char*)(gbase) + (voff)[_i]), (PG8_LAS unsigned*)(lds + (bufoff) + ldsw + _i * 8192), 16, 0, 0); } while (0)
#define PG8_LDA(dst, b, h) do { _Pragma("unroll") for (int m = 0; m < 4; ++m) _Pragma("unroll") for (int k = 0; k < 2; ++k) dst[m][k] = *(const PG8_LAS bf16x8*)(lds + PG8_SA(b, h) + aoff + m * 2048 + k * 1024); } while (0)
#define PG8_LDB(dst, b, h) do { _Pragma("unroll") for (int n = 0; n < 2; ++n) _Pragma("unroll") for (int k = 0; k < 2; ++k) dst[n][k] = *(const PG8_LAS bf16x8*)(lds + PG8_SB(b, h) + boff + n * 2048 + k * 1024); } while (0)
#define PG8_MMA(ai, bj, At, Bt) do { __builtin_amdgcn_s_setprio(1); _Pragma("unroll") for (int m = 0; m < 4; ++m) _Pragma("unroll") for (int n = 0; n < 2; ++n) _Pragma("unroll") for (int k = 0; k < 2; ++k) \
        acc[ai][bj][m][n] = __builtin_amdgcn_mfma_f32_16x16x32_bf16(Bt[n][k], At[m][k], acc[ai][bj][m][n], 0, 0, 0); __builtin_amdgcn_s_setprio(0); } while (0)
#define PG8_WAIT_V(n) asm volatile("s_waitcnt vmcnt(" #n ")" ::: "memory")
#define PG8_WAIT_L(n) asm volatile("s_waitcnt lgkmcnt(" #n ")" ::: "memory")
#define PG8_BAR __builtin_amdgcn_s_barrier()
#define PG8_SCHED __builtin_amdgcn_sched_barrier(0)
    Unit cur, nxt; int ui = 0;
    if (!S.next(0, cur)) return;
    f32x4 acc[2][2][4][2];
#pragma unroll
    for (int a = 0; a < 2; ++a)
#pragma unroll
        for (int b = 0; b < 2; ++b)
#pragma unroll
            for (int m = 0; m < 4; ++m)
#pragma unroll
                for (int n = 0; n < 2; ++n) acc[a][b][m][n] = (f32x4){0.f, 0.f, 0.f, 0.f};
    bf16x8 At[4][2], B0[2][2], B1[2][2];
    const char* cA = (const char*)g.A + (size_t)cur.pm * g.a_pm + (size_t)cur.pn * g.a_pn;
    const char* cB = (const char*)g.Bt + (size_t)cur.pn * g.b_pn + (cur.pm >= g.b_split ? g.b_hi : (size_t)0);
    PG8_STAGE(PG8_SB(0, 0), cB, voffB); PG8_STAGE(PG8_SB(0, 1), cB + hstepB, voffB); PG8_STAGE(PG8_SA(0, 0), cA, voffA); PG8_STAGE(PG8_SA(0, 1), cA + hstepA, voffA);
    if (wr == 1) PG8_BAR;
    PG8_WAIT_V(2); PG8_BAR;
    PG8_STAGE(PG8_SB(1, 0), cB + kstep, voffB); PG8_STAGE(PG8_SA(1, 0), cA + kstep, voffA); PG8_STAGE(PG8_SB(1, 1), cB + hstepB + kstep, voffB);
    PG8_WAIT_V(6); PG8_BAR;
    for (;;) {
        const bool has_next = S.next(ui + 1, nxt);
        const char* nA = has_next ? (const char*)g.A + (size_t)nxt.pm * g.a_pm + (size_t)nxt.pn * g.a_pn : cA;
        const char* nB = has_next ? (const char*)g.Bt + (size_t)nxt.pn * g.b_pn + (nxt.pm >= g.b_split ? g.b_hi : (size_t)0) : cB;
        E.prefetch(cur, ui, lds_epi, wid, lane);
        for (int t = 0; t < nt; t += 2) {
            const bool last = (t == nt - 2);
            const char* a1 = cA + (size_t)(t + 1) * kstep;
            const char* a2 = last ? nA : cA + (size_t)(t + 2) * kstep; const char* b2 = last ? nB : cB + (size_t)(t + 2) * kstep;
            const char* a3 = a2 + kstep; const char* b3 = b2 + kstep;
            PG8_LDB(B0, 0, 0); PG8_LDB(B1, 0, 1); PG8_SCHED; PG8_LDA(At, 0, 0); PG8_STAGE(PG8_SA(1, 1), a1 + hstepA, voffA);
            PG8_WAIT_V(8); PG8_WAIT_L(0); PG8_BAR; PG8_MMA(0, 0, At, B0); PG8_MMA(0, 1, At, B1); PG8_BAR; PG8_SCHED;
            PG8_LDA(At, 0, 1); PG8_STAGE(PG8_SB(0, 0), b2, voffB); PG8_STAGE(PG8_SB(0, 1), b2 + hstepB, voffB); PG8_STAGE(PG8_SA(0, 0), a2, voffA);
            PG8_WAIT_V(8); PG8_WAIT_L(0); PG8_BAR; PG8_MMA(1, 0, At, B0); PG8_MMA(1, 1, At, B1); PG8_BAR; PG8_SCHED;
            PG8_LDB(B0, 1, 0); PG8_LDB(B1, 1, 1); PG8_SCHED; PG8_LDA(At, 1, 0); PG8_STAGE(PG8_SA(0, 1), a2 + hstepA, voffA);
            PG8_WAIT_V(8); PG8_WAIT_L(0); PG8_BAR; PG8_MMA(0, 0, At, B0); PG8_MMA(0, 1, At, B1); PG8_BAR; PG8_SCHED;
            PG8_LDA(At, 1, 1); PG8_STAGE(PG8_SB(1, 0), b3, voffB); PG8_STAGE(PG8_SB(1, 1), b3 + hstepB, voffB); PG8_STAGE(PG8_SA(1, 0), a3, voffA);
            PG8_WAIT_V(8); PG8_WAIT_L(0); PG8_BAR; PG8_MMA(1, 0, At, B0); PG8_MMA(1, 1, At, B1); PG8_BAR; PG8_SCHED;
        }
        if (wr == 0) PG8_BAR;
        E(acc, cur, ui, wr, wc, fr, fq, lds_epi);
        if (!has_next) break;
#pragma unroll
        for (int a = 0; a < 2; ++a)
#pragma unroll
            for (int b = 0; b < 2; ++b)
#pragma unroll
                for (int m = 0; m < 4; ++m)
#pragma unroll
                    for (int n = 0; n < 2; ++n) acc[a][b][m][n] = (f32x4){0.f, 0.f, 0.f, 0.f};
        cur = nxt; cA = nA; cB = nB; ++ui;
        if (wr == 1) PG8_BAR;
    }
    PG8_WAIT_V(0);
    PG8_BAR;
#undef PG8_SA
#undef PG8_SB
#undef PG8_STAGE
#undef PG8_LDA
#undef PG8_LDB
#undef PG8_MMA
#undef PG8_WAIT_V
#undef PG8_WAIT_L
#undef PG8_BAR
#undef PG8_SCHED
}
}
namespace epi {
using namespace pg8;
constexpr float EPS = 1e-6f;
__device__ __forceinline__ float rstd_of(float ss) { return rsqrtf(ss * (1.0f / 1024.0f) + EPS); }
__device__ __forceinline__ float sigmoidf_(float x) { return __builtin_amdgcn_rcpf(1.0f + __expf(-x)); }
__device__ __forceinline__ float siluf_(float x) { return x * __builtin_amdgcn_rcpf(1.0f + __expf(-x)); }
__device__ __forceinline__ u32x4 pack8(const f32x4& a, const f32x4& b) { u32x4 w; w.x = cvt_pk_bf16(a[0], a[1]); w.y = cvt_pk_bf16(a[2], a[3]); w.z = cvt_pk_bf16(b[0], b[1]); w.w = cvt_pk_bf16(b[2], b[3]); return w; }

constexpr int EC_OFF = 16384, EC_STRIDE = 6144;
__device__ __forceinline__ void dma16(const void* g, PG8_LAS unsigned char* l) { __builtin_amdgcn_global_load_lds((const unsigned*)g, (PG8_LAS unsigned*)l, 16, 0, 0); }
__device__ __forceinline__ void dma_rss(const float* rss, int pm, int ui, PG8_LAS unsigned char* le, int wid, int lane) {
    if (wid == 0) dma16(rss + pm * BM + 4 * lane, le + EC_OFF + (ui & 1) * EC_STRIDE);
}
struct EpiGlaIn {
    bf16_t* Q; bf16_t* Kk; bf16_t* V; bf16_t* R; float* G; const float* rss; const float* b_alpha;
    __device__ __forceinline__ void prefetch(const Unit& u, int ui, PG8_LAS unsigned char* le, int wid, int lane) const { dma_rss(rss, u.pm, ui, le, wid, lane); }
    __device__ __forceinline__ void operator()(f32x4 (&acc)[2][2][4][2], const Unit& u, int ui, int wr, int wc, int fr, int fq, PG8_LAS unsigned char* le) const {
        asm volatile("" : "+v"(fr), "+v"(fq));
        const int pn = u.pn;
        const int row0 = u.pm * BM + wr * 64 + fr;
        const int ct = wc * 32 + 8 * fq;
#pragma unroll
        for (int ai = 0; ai < 2; ++ai)
#pragma unroll
            for (int m = 0; m < 4; ++m) {
                const int row = row0 + ai * HALF + m * 16;
                const float rs = rstd_of(((const PG8_LAS float*)(le + EC_OFF + (ui & 1) * EC_STRIDE))[wr * 64 + fr + ai * HALF + m * 16]);
#pragma unroll
                for (int bj = 0; bj < 2; ++bj) {
                    f32x4 v0 = acc[ai][bj][m][0] * rs, v1 = acc[ai][bj][m][1] * rs;
                    const int c = bj * HALF + ct;
                    if (pn < 2) { const float sc = 0.08838834764831845f; *(u32x4*)(Q + (size_t)row * 512 + pn * 256 + c) = pack8(v0 * sc, v1 * sc); }
                    else if (pn < 4) { *(u32x4*)(Kk + (size_t)row * 512 + (pn - 2) * 256 + c) = pack8(v0, v1); }
                    else if (pn < 8) { *(u32x4*)(V + (size_t)row * 1024 + (pn - 4) * 256 + c) = pack8(v0, v1); }
                    else if (pn < 12) {
#pragma unroll
                        for (int j = 0; j < 4; ++j) { v0[j] = siluf_(v0[j]); v1[j] = siluf_(v1[j]); }
                        *(u32x4*)(R + (size_t)row * 1024 + (pn - 8) * 256 + c) = pack8(v0, v1); }
                    else {
                        const int gc = (pn - 12) * 256 + c;
                        const f32x4 b0 = *(const f32x4*)(b_alpha + gc), b1 = *(const f32x4*)(b_alpha + gc + 4);
                        f32x4 o0, o1;
#pragma unroll
                        for (int j = 0; j < 4; ++j) {
                            const float z0 = v0[j] + b0[j], z1 = v1[j] + b1[j];
                            o0[j] = (fminf(z0, 0.f) - __logf(1.0f + __expf(-fabsf(z0)))) * 0.0625f;
                            o1[j] = (fminf(z1, 0.f) - __logf(1.0f + __expf(-fabsf(z1)))) * 0.0625f; }
                        *(f32x4*)(G + (size_t)row * 512 + gc) = o0; *(f32x4*)(G + (size_t)row * 512 + gc + 4) = o1; }
                }
            }
    }
};

struct EpiRes {
    const float* xin; float* xout; bf16_t* XB; float* rss;
    __device__ __forceinline__ void prefetch(const Unit&, int, PG8_LAS unsigned char*, int, int) const {}
    __device__ __forceinline__ void operator()(f32x4 (&acc)[2][2][4][2], const Unit& u, int ui, int wr, int wc, int fr, int fq, PG8_LAS unsigned char* le) const {
        asm volatile("" : "+v"(fr), "+v"(fq));
        const int row0 = u.pm * BM + wr * 64 + fr;
        const int col0 = u.pn * BM + wc * 32 + 8 * fq;
#pragma unroll
        for (int ai = 0; ai < 2; ++ai)
#pragma unroll
            for (int m = 0; m < 4; ++m) {
                const int row = row0 + ai * HALF + m * 16;
                float ss = 0.f;
#pragma unroll
                for (int bj = 0; bj < 2; ++bj) {
                    const size_t off = (size_t)row * 1024 + col0 + bj * HALF;
                    const f32x4 x0 = *(const f32x4*)(xin + off), x1 = *(const f32x4*)(xin + off + 4);
                    const f32x4 v0 = x0 + acc[ai][bj][m][0], v1 = x1 + acc[ai][bj][m][1];
                    *(f32x4*)(xout + off) = v0; *(f32x4*)(xout + off + 4) = v1;
                    *(u32x4*)(XB + off) = pack8(v0, v1);
                    ss += (v0[0] * v0[0] + v0[1] * v0[1]) + (v0[2] * v0[2] + v0[3] * v0[3]) + (v1[0] * v1[0] + v1[1] * v1[1]) + (v1[2] * v1[2] + v1[3] * v1[3]);
                }
                ss += swz_xor16(ss); { auto rr_ = __builtin_amdgcn_permlane32_swap(__float_as_uint(ss), __float_as_uint(ss), false, false); ss = __uint_as_float(rr_[0]) + __uint_as_float(rr_[1]); }
                if (fq == 0) atomicAdd(rss + row, ss);
            }
    }
};

__device__ __forceinline__ float dpp_ror1(float x) { return __builtin_bit_cast(float, __builtin_amdgcn_mov_dpp(__builtin_bit_cast(int, x), 0x121, 0xf, 0xf, true)); }
__device__ __forceinline__ float dpp_ror2(float x) { return __builtin_bit_cast(float, __builtin_amdgcn_mov_dpp(__builtin_bit_cast(int, x), 0x122, 0xf, 0xf, true)); }
constexpr int FF = 2816;
struct EpiFfnUp {
    bf16_t* ACT; float* HALO; const float* rss; const float* cw; const float* cb;
    __device__ __forceinline__ void prefetch(const Unit& u, int ui, PG8_LAS unsigned char* le, int wid, int lane) const {
        dma_rss(rss, u.pm, ui, le, wid, lane);
        if (wid >= 1 && wid <= 4) { const int k = wid - 1; const float* src = (k == 0 ? cb : cw + (k - 1) * 2 * FF) + u.pn * 128 + ((lane < 32) ? 4 * lane : FF + 4 * (lane - 32));
            dma16(src, le + EC_OFF + (ui & 1) * EC_STRIDE + 1024 + k * 1024); }
    }
    __device__ __forceinline__ void operator()(f32x4 (&acc)[2][2][4][2], const Unit& u, int ui, int wr, int wc, int fr, int fq, PG8_LAS unsigned char* le) const {
        asm volatile("" : "+v"(fr), "+v"(fq));
        const int row0 = u.pm * BM + wr * 64 + fr;
        const PG8_LAS float* EC = (const PG8_LAS float*)(le + EC_OFF + (ui & 1) * EC_STRIDE);
#pragma unroll
        for (int ai = 0; ai < 2; ++ai)
#pragma unroll
            for (int m = 0; m < 4; ++m) {
                const float rs = rstd_of(EC[wr * 64 + fr + ai * HALF + m * 16]);
#pragma unroll
                for (int bj = 0; bj < 2; ++bj) { acc[ai][bj][m][0] = acc[ai][bj][m][0] * rs; acc[ai][bj][m][1] = acc[ai][bj][m][1] * rs; }
            }
        PG8_LAS float* HL = (PG8_LAS float*)le + (ui & 1) * 2048;
        if (fr >= 14) {
#pragma unroll
            for (int ai = 0; ai < 2; ++ai)
#pragma unroll
                for (int bj = 0; bj < 2; ++bj)
#pragma unroll
                    for (int n = 0; n < 2; ++n)
                        *(PG8_LAS f32x4*)(HL + ((((wr * 4 + wc) * 2 + ai) * 2 + (fr - 14)) * 64) + bj * 32 + fq * 8 + n * 4) = acc[ai][bj][3][n];
        }
        {
            float* hb = HALO + ((size_t)(u.pm * 22 + u.pn) * 4) * 256 + wc * 32 + fq * 8;
            if (wr == 0 && fr < 2) {
#pragma unroll
                for (int bj = 0; bj < 2; ++bj)
#pragma unroll
                    for (int n = 0; n < 2; ++n) *(f32x4*)(hb + fr * 256 + bj * HALF + n * 4) = acc[0][bj][0][n];
            }
            if (wr == 1 && fr >= 14) {
#pragma unroll
                for (int bj = 0; bj < 2; ++bj)
#pragma unroll
                    for (int n = 0; n < 2; ++n) *(f32x4*)(hb + (fr - 12) * 256 + bj * HALF + n * 4) = acc[1][bj][3][n];
            }
        }
        asm volatile("s_waitcnt lgkmcnt(0)" ::: "memory"); __builtin_amdgcn_s_barrier(); asm volatile("" ::: "memory");
        const bool seq_start = (u.pm & 7) == 0;
        const int cc0 = wc * 32 + fq * 8;
        const bool is15 = (fr == 15), ge14 = (fr >= 14);
        const PG8_LAS float* WB = EC + 256 + cc0;
#pragma unroll
        for (int ai = 0; ai < 2; ++ai) {
            f32x4 pg[2], pv[2];
            if (ai == 0 && wr == 0) { pg[0] = pg[1] = pv[0] = pv[1] = (f32x4){0.f, 0.f, 0.f, 0.f}; }
            else {
                const int swr = (ai == 1 && wr == 1) ? 0 : (ai == 0 ? 0 : 1), sai = (ai == 1 && wr == 1) ? 1 : 0;
                const PG8_LAS float* hp = HL + (((swr * 4 + wc) * 2 + sai) * 2 + (is15 ? 1 : 0)) * 64 + fq * 8;
                pg[0] = *(const PG8_LAS f32x4*)(hp); pg[1] = *(const PG8_LAS f32x4*)(hp + 4); pv[0] = *(const PG8_LAS f32x4*)(hp + 32); pv[1] = *(const PG8_LAS f32x4*)(hp + 36);
            }
#pragma unroll
            for (int m = 0; m < 4; ++m) {
                const int row = row0 + ai * HALF + m * 16;
                u32x4 w;
#pragma unroll
                for (int n = 0; n < 2; ++n) {
                    const f32x4 bg = *(const PG8_LAS f32x4*)(WB + 4 * n), bv = *(const PG8_LAS f32x4*)(WB + 128 + 4 * n);
                    const f32x4 g0 = *(const PG8_LAS f32x4*)(WB + 256 + 4 * n), w0 = *(const PG8_LAS f32x4*)(WB + 256 + 128 + 4 * n);
                    const f32x4 g1 = *(const PG8_LAS f32x4*)(WB + 512 + 4 * n), w1 = *(const PG8_LAS f32x4*)(WB + 512 + 128 + 4 * n);
                    const f32x4 g2 = *(const PG8_LAS f32x4*)(WB + 768 + 4 * n), w2 = *(const PG8_LAS f32x4*)(WB + 768 + 128 + 4 * n);
                    const f32x4 xg = acc[ai][0][m][n], xv = acc[ai][1][m][n];
                    f32x4 g1s, g2s, v1s, v2s;
#pragma unroll
                    for (int j = 0; j < 4; ++j) {
                        g1s[j] = dpp_ror1(is15 ? pg[n][j] : xg[j]); g2s[j] = dpp_ror2(ge14 ? pg[n][j] : xg[j]);
                        v1s[j] = dpp_ror1(is15 ? pv[n][j] : xv[j]); v2s[j] = dpp_ror2(ge14 ? pv[n][j] : xv[j]);
                    }
                    const f32x4 og = bg + g0 * g2s + g1 * g1s + g2 * xg;
                    const f32x4 ov = bv + w0 * v2s + w1 * v1s + w2 * xv;
                    f32x4 e;
#pragma unroll
                    for (int j = 0; j < 4; ++j) e[j] = __builtin_amdgcn_rcpf(1.0f + __builtin_amdgcn_exp2f(og[j] * -1.4426950408889634f));
                    const f32x4 a = og * e * ov;
                    if (n == 0) { w.x = cvt_pk_bf16(a[0], a[1]); w.y = cvt_pk_bf16(a[2], a[3]); } else { w.z = cvt_pk_bf16(a[0], a[1]); w.w = cvt_pk_bf16(a[2], a[3]); }
                    pg[n] = xg; pv[n] = xv;
                }
                const bool skip = (ai == 0 && wr == 0 && m == 0 && fr < 2 && !seq_start);
                if (!skip) *(u32x4*)(ACT + (size_t)row * FF + u.pn * 128 + cc0) = w;
            }
        }
    }
};

struct EpiKvq {
    bf16_t* KV; bf16_t* Q; bf16_t* QR; float* GATES; const float* rss; const float* rope;
    __device__ __forceinline__ void prefetch(const Unit& u, int ui, PG8_LAS unsigned char* le, int wid, int lane) const { dma_rss(rss, u.pm, ui, le, wid, lane); }
    __device__ __forceinline__ void operator()(f32x4 (&acc)[2][2][4][2], const Unit& u, int ui, int wr, int wc, int fr, int fq, PG8_LAS unsigned char* le) const {
        asm volatile("" : "+v"(fr), "+v"(fq));
        const int pn = u.pn;
        const int row0 = u.pm * BM + wr * 64 + fr;
        const float C2 = 0.125f * 1.4426950408889634f;
#pragma unroll
        for (int ai = 0; ai < 2; ++ai)
#pragma unroll
            for (int m = 0; m < 4; ++m) {
                const int row = row0 + ai * HALF + m * 16;
                const int b = row >> 11, s = row & 2047;
                const float rs = rstd_of(((const PG8_LAS float*)(le + EC_OFF + (ui & 1) * EC_STRIDE))[wr * 64 + fr + ai * HALF + m * 16]);
                f32x4 lo0 = acc[ai][0][m][0] * rs, lo1 = acc[ai][0][m][1] * rs;
                f32x4 hi0 = acc[ai][1][m][0] * rs, hi1 = acc[ai][1][m][1] * rs;
                if (pn == 10) {
                    if (wc == 0) {
                        float* gp = GATES + (size_t)row * 48 + 8 * fq;
#pragma unroll
                        for (int j = 0; j < 4; ++j) { lo0[j] = sigmoidf_(lo0[j]); lo1[j] = sigmoidf_(lo1[j]); hi0[j] = sigmoidf_(hi0[j]); hi1[j] = sigmoidf_(hi1[j]); }
                        *(f32x4*)(gp) = lo0; *(f32x4*)(gp + 4) = lo1;
                        if (fq < 2) { *(f32x4*)(gp + 32) = hi0; *(f32x4*)(gp + 36) = hi1; }
                    }
                    continue;
                }
                const bool isq = pn >= 6;
                const bool dorope = isq || pn == 2 || pn == 4;
                f32x4 rl0 = lo0, rl1 = lo1, rh0 = hi0, rh1 = hi1;
                if (dorope) {
                    const float* rp = rope + ((size_t)s * 32 + 8 * fq) * 2;
                    const f32x4 t0 = *(const f32x4*)(rp), t1 = *(const f32x4*)(rp + 4), t2 = *(const f32x4*)(rp + 8), t3 = *(const f32x4*)(rp + 12);
                    const float cs[8] = {t0[0], t0[2], t1[0], t1[2], t2[0], t2[2], t3[0], t3[2]};
                    const float sn[8] = {t0[1], t0[3], t1[1], t1[3], t2[1], t2[3], t3[1], t3[3]};
#pragma unroll
                    for (int j = 0; j < 4; ++j) {
                        rl0[j] = lo0[j] * cs[j] - hi0[j] * sn[j]; rh0[j] = lo0[j] * sn[j] + hi0[j] * cs[j];
                        rl1[j] = lo1[j] * cs[4 + j] - hi1[j] * sn[4 + j]; rh1[j] = lo1[j] * sn[4 + j] + hi1[j] * cs[4 + j];
                    }
                }
                if (!isq) {
                    bf16_t* p = KV + ((((size_t)pn * 16 + b) * 4 + wc) * 2048 + s) * 64 + 8 * fq;
                    *(u32x4*)(p) = pack8(rl0, rl1); *(u32x4*)(p + 32) = pack8(rh0, rh1);
                } else {
                    const int h = (pn - 6) * 4 + wc;
                    const size_t o = (((size_t)b * 16 + h) * 2048 + s) * 64 + 8 * fq;
                    *(u32x4*)(Q + o) = pack8(lo0 * C2, lo1 * C2); *(u32x4*)(Q + o + 32) = pack8(hi0 * C2, hi1 * C2);
                    *(u32x4*)(QR + o) = pack8(rl0 * C2, rl1 * C2); *(u32x4*)(QR + o + 32) = pack8(rh0 * C2, rh1 * C2);
                }
            }
    }
};

struct EpiCmp {
    float* HP;
    __device__ __forceinline__ void prefetch(const Unit&, int, PG8_LAS unsigned char*, int, int) const {}
    __device__ __forceinline__ void operator()(f32x4 (&acc)[2][2][4][2], const Unit& u, int ui, int wr, int wc, int fr, int fq, PG8_LAS unsigned char* le) const {
        asm volatile("" : "+v"(fr), "+v"(fq));
        const int row0 = u.pm * BM + wr * 64 + fr;
        float* base = HP + (size_t)u.pn * 16384 * 256;
#pragma unroll
        for (int ai = 0; ai < 2; ++ai)
#pragma unroll
            for (int m = 0; m < 4; ++m) {
                float* rp = base + (size_t)(row0 + ai * HALF + m * 16) * 256 + wc * 32 + 8 * fq;
#pragma unroll
                for (int bj = 0; bj < 2; ++bj) { *(f32x4*)(rp + bj * HALF) = acc[ai][bj][m][0]; *(f32x4*)(rp + bj * HALF + 4) = acc[ai][bj][m][1]; }
            }
    }
};
struct EpiNull {
    __device__ __forceinline__ void prefetch(const Unit&, int, PG8_LAS unsigned char*, int, int) const {}
    __device__ __forceinline__ void operator()(f32x4 (&acc)[2][2][4][2], const Unit& u, int ui, int wr, int wc, int fr, int fq, PG8_LAS unsigned char* le) const {
#pragma unroll
        for (int ai = 0; ai < 2; ++ai)
#pragma unroll
            for (int bj = 0; bj < 2; ++bj)
#pragma unroll
                for (int m = 0; m < 4; ++m) { asm volatile("" :: "v"(acc[ai][bj][m][0]), "v"(acc[ai][bj][m][1])); }
    }
};
}
namespace pro {
typedef unsigned short bf16_t;
typedef unsigned v4u __attribute__((ext_vector_type(4)));
typedef float f32x4 __attribute__((ext_vector_type(4)));
#define LAS3 __attribute__((address_space(3)))
__device__ __forceinline__ unsigned f2bf(float f) { unsigned u = __builtin_bit_cast(unsigned, f); return (u + 0x7fffu + ((u >> 16) & 1u)) >> 16; }
__device__ __forceinline__ unsigned pk2(float lo, float hi) { return f2bf(lo) | (f2bf(hi) << 16); }

struct In {
    const float *x, *norm_mix, *norm_ffn, *gla_w_in, *gla_w_alpha_up, *gla_b_alpha, *gla_norm, *gla_w_o, *kv_norm, *nsa_w_kv, *cmp_pe_k, *cmp_pe_v,
        *cmp_k_w1, *cmp_k_w2, *cmp_v_w1, *cmp_v_w2, *nsa_w_in, *nsa_w_o, *ffn_w_up, *ffn_conv_w, *ffn_conv_b, *ffn_w_down, *norm_final;
};
struct Wts { bf16_t *WGI, *WGO, *WKQ, *WC1, *WC2, *WNO, *WUP, *WDN; float *ROPE, *BIASC; };

__device__ __forceinline__ void transpose_item(const float* W, int ldw, int scol0, int nvalid, const float* gain, bf16_t* WT, int K, int drow0, int k0, LAS3 float* scr, int lane) {
    const int kr = lane >> 3, nc = (lane & 7) * 4;
    f32x4 v[8];
#pragma unroll
    for (int i = 0; i < 8; ++i) { const int kk = 8 * i + kr;
        v[i] = (nc < nvalid) ? *(const f32x4*)(W + (size_t)(k0 + kk) * ldw + scol0 + nc) : (f32x4){0.f, 0.f, 0.f, 0.f};
        if (gain) v[i] = v[i] * gain[k0 + kk]; }
#pragma unroll
    for (int i = 0; i < 8; ++i) { const int kk = 8 * i + kr; LAS3 float* d = scr + kk * 33 + nc; d[0] = v[i].x; d[1] = v[i].y; d[2] = v[i].z; d[3] = v[i].w; }
    asm volatile("s_waitcnt lgkmcnt(0)" ::: "memory");
    const int c = lane & 7;
#pragma unroll
    for (int j = 0; j < 4; ++j) { const int nn = (lane >> 3) + 8 * j; const LAS3 float* s = scr + (8 * c) * 33 + nn;
        v4u o; o.x = pk2(s[0 * 33], s[1 * 33]); o.y = pk2(s[2 * 33], s[3 * 33]); o.z = pk2(s[4 * 33], s[5 * 33]); o.w = pk2(s[6 * 33], s[7 * 33]);
        *(v4u*)(WT + (size_t)(drow0 + nn) * K + k0 + 8 * c) = o; }
    asm volatile("s_waitcnt lgkmcnt(0)" ::: "memory");
}
__device__ __forceinline__ void weff_item(const In& I, bf16_t* WT, int nb, int k0, LAS3 float* scr, int lane) {
    const int n = lane & 31, ng = 32 * nb + n;
    float wa[16];
#pragma unroll
    for (int r = 0; r < 16; ++r) wa[r] = I.gla_w_alpha_up[r * 512 + ng];
#pragma unroll 2
    for (int i = 0; i < 32; ++i) { const int kk = 2 * i + (lane >> 5); const float* wr = I.gla_w_in + (size_t)(k0 + kk) * 3088 + 3072;
        float v = 0.f;
#pragma unroll
        for (int r = 0; r < 16; ++r) v += wr[r] * wa[r];
        scr[kk * 33 + n] = v * I.norm_mix[k0 + kk]; }
    asm volatile("s_waitcnt lgkmcnt(0)" ::: "memory");
    const int c = lane & 7;
#pragma unroll
    for (int j = 0; j < 4; ++j) { const int nn = (lane >> 3) + 8 * j; const LAS3 float* s = scr + (8 * c) * 33 + nn;
        v4u o; o.x = pk2(s[0 * 33], s[1 * 33]); o.y = pk2(s[2 * 33], s[3 * 33]); o.z = pk2(s[4 * 33], s[5 * 33]); o.w = pk2(s[6 * 33], s[7 * 33]);
        *(v4u*)(WT + (size_t)(3072 + 32 * nb + nn) * 1024 + k0 + 8 * c) = o; }
    asm volatile("s_waitcnt lgkmcnt(0)" ::: "memory");
}

__device__ __forceinline__ void prologue(const In& I, const Wts& W, bf16_t* XB, float* RSS0, LAS3 unsigned char* lds, int gw, int NGW, int lane, int wave) {
    LAS3 float* scr = (LAS3 float*)(lds + wave * 16384);
    constexpr int I0 = 16 * 96, I1 = 16 * 16, I2 = 16 * 32, I3 = 16 * 88, I4 = 32 * 8, I6 = 4 * 2, I8 = 16 * 32, I9 = 16 * 176, I11 = 44 * 32;
    constexpr int NIT = I0 + I1 + I2 + I3 + 2 * I4 + 2 * I6 + I8 + 2 * I9 + 2 * I11;
    for (int it = gw; it < NIT; it += NGW) {
        int r = it;
        if (r < I0) { const int kb = r / 96, nb = r % 96; transpose_item(I.gla_w_in, 3088, 32 * nb, 32, I.norm_mix, W.WGI, 1024, 32 * nb, 64 * kb, scr, lane); continue; } r -= I0;
        if (r < I1) { const int kb = r / 16, nb = r % 16; weff_item(I, W.WGI, nb, 64 * kb, scr, lane); continue; } r -= I1;
        if (r < I2) { const int kb = r / 32, nb = r % 32; transpose_item(I.gla_w_o, 1024, 32 * nb, 32, nullptr, W.WGO, 1024, 32 * nb, 64 * kb, scr, lane); continue; } r -= I2;
        if (r < I3) { const int kb = r / 88, nb = r % 88; const int tile = nb >> 3, gi = nb & 7, L0 = (gi & 3) * 64 + (gi >> 2) * 32;
            if (tile < 6) transpose_item(I.nsa_w_kv, 1536, tile * 256 + L0, 32, I.kv_norm, W.WKQ, 1024, 32 * nb, 64 * kb, scr, lane);
            else if (tile < 10) transpose_item(I.nsa_w_in, 1072, (tile - 6) * 256 + L0, 32, I.norm_mix + 1024, W.WKQ, 1024, 32 * nb, 64 * kb, scr, lane);
            else { int nv = 48 - L0; nv = nv < 0 ? 0 : (nv > 32 ? 32 : nv); transpose_item(I.nsa_w_in, 1072, 1024 + (nv > 0 ? L0 : 0), nv, I.norm_mix + 1024, W.WKQ, 1024, 32 * nb, 64 * kb, scr, lane); }
            continue; } r -= I3;
        if (r < 2 * I4) { const int w = r / I4; r %= I4; const int kb = r / 8, nb = r % 8;
            transpose_item(w ? I.cmp_v_w1 : I.cmp_k_w1, 256, 32 * nb, 32, nullptr, W.WC1 + (size_t)w * 256 * 2048, 2048, 32 * nb, 64 * kb, scr, lane); continue; } r -= 2 * I4;
        if (r < 2 * I6) { const int w = r / I6; r %= I6; const int kb = r / 2, nb = r % 2;
            transpose_item(w ? I.cmp_v_w2 : I.cmp_k_w2, 64, 32 * nb, 32, nullptr, W.WC2 + (size_t)w * 64 * 256, 256, 32 * nb, 64 * kb, scr, lane); continue; } r -= 2 * I6;
        if (r < I8) { const int kb = r / 32, nb = r % 32; transpose_item(I.nsa_w_o, 1024, 32 * nb, 32, nullptr, W.WNO, 1024, 32 * nb, 64 * kb, scr, lane); continue; } r -= I8;
        if (r < 2 * I9) { const int l = r / I9; r %= I9; const int kb = r / 176, nb = r % 176; const int tile = nb >> 3, gi = nb & 7;
            const int sc = (gi < 4) ? (128 * tile + 32 * gi) : (2816 + 128 * tile + 32 * (gi - 4));
            transpose_item(I.ffn_w_up + (size_t)l * 1024 * 5632, 5632, sc, 32, I.norm_ffn + l * 1024, W.WUP + (size_t)l * 5632 * 1024, 1024, 32 * nb, 64 * kb, scr, lane); continue; } r -= 2 * I9;
        { const int l = r / I11; r %= I11; const int kb = r / 32, nb = r % 32;
            transpose_item(I.ffn_w_down + (size_t)l * 2816 * 1024, 1024, 32 * nb, 32, nullptr, W.WDN + (size_t)l * 1024 * 2816, 2816, 32 * nb, 64 * kb, scr, lane); }
    }
    for (int i = gw * 64 + lane; i < 2048 * 32; i += NGW * 64) {
        const int pos = i >> 5, d = i & 31;
        const float inv = powf(10000.0f, -(float)d / 32.0f);
        const float ang = (float)pos * inv;
        float sn, cs; sincosf(ang, &sn, &cs);
        W.ROPE[2 * i] = cs; W.ROPE[2 * i + 1] = sn;
    }
    for (int it = gw; it < 256; it += NGW) {
        const int w = it >> 7, ng = (it >> 5) & 3, kc = it & 31; const float* pe = (w ? I.cmp_pe_v : I.cmp_pe_k) + 64 * kc; const float* w1 = (w ? I.cmp_v_w1 : I.cmp_k_w1) + (size_t)(64 * kc) * 256 + 64 * ng + lane;
        float s = 0.f;
#pragma unroll 16
        for (int k = 0; k < 64; ++k) s += pe[k] * w1[(size_t)k * 256];
        atomicAdd(W.BIASC + w * 256 + 64 * ng + lane, s);
    }
    for (int m = gw; m < 32768; m += NGW) {
        const f32x4* xr = (const f32x4*)(I.x + (size_t)m * 1024) + lane;
        f32x4 v[4]; float s = 0.f;
#pragma unroll
        for (int j = 0; j < 4; ++j) { v[j] = xr[64 * j]; s += (v[j].x * v[j].x + v[j].y * v[j].y) + (v[j].z * v[j].z + v[j].w * v[j].w); }
#pragma unroll
        for (int off = 1; off < 64; off <<= 1) s += __shfl_xor(s, off);
        if (lane == 0) RSS0[m] = s;
        unsigned long long* o8 = (unsigned long long*)(XB + (size_t)m * 1024) + lane;
#pragma unroll
        for (int j = 0; j < 4; ++j) o8[64 * j] = (unsigned long long)pk2(v[j].x, v[j].y) | ((unsigned long long)pk2(v[j].z, v[j].w) << 32);
    }
}
}
namespace gla {
typedef unsigned short bf16_t;
typedef short bf16x8 __attribute__((ext_vector_type(8)));
typedef short s16x4 __attribute__((ext_vector_type(4)));
typedef float f32x16 __attribute__((ext_vector_type(16)));
typedef float f32x4 __attribute__((ext_vector_type(4)));
typedef unsigned u32x4 __attribute__((ext_vector_type(4)));
typedef unsigned u32x2 __attribute__((ext_vector_type(2)));
#define GLAS __attribute__((address_space(3)))
__device__ __forceinline__ int crow(int r, int hi) { return (r & 3) + 8 * (r >> 2) + 4 * hi; }
__device__ __forceinline__ float bf2f(bf16_t v) { return __builtin_bit_cast(float, (unsigned)v << 16); }
__device__ __forceinline__ unsigned cvtpk(float lo, float hi) { typedef float f2 __attribute__((ext_vector_type(2))); typedef __bf16 b2 __attribute__((ext_vector_type(2))); f2 v = {lo, hi}; b2 b = __builtin_convertvector(v, b2); return __builtin_bit_cast(unsigned, b); }
__device__ __forceinline__ bf16_t f2bf1(float f) { return (bf16_t)(cvtpk(f, 0.f) & 0xffffu); }
__device__ __forceinline__ s16x4 vtr(const GLAS unsigned char* p) { typedef short v4i16_t __attribute__((ext_vector_type(4))); return __builtin_bit_cast(s16x4, __builtin_amdgcn_ds_read_tr16_b64_v4i16((GLAS v4i16_t*)p)); }
__device__ __forceinline__ bf16x8 ld2x64(const GLAS unsigned char* p0, const GLAS unsigned char* p1) {
    const s16x4 a = *(const GLAS s16x4*)p0, b = *(const GLAS s16x4*)p1; return (bf16x8){a[0], a[1], a[2], a[3], b[0], b[1], b[2], b[3]};
}
constexpr int QEP = 264, KDP = 136, VP = 576, OLP = 260;
constexpr int L_QE = 0, L_KE = 16896, L_KDT = 33792, L_ATT = 51200, L_V = 59904, L_BL = 96768, L_QT = 97280, L_END = 99328;

template <bool STATE_ONLY>
__device__ __forceinline__ void gla_unit(int b, int h, int seg, const bf16_t* Qg, const bf16_t* Kg, const bf16_t* VO, bf16_t* Oout, const bf16_t* Rg, const float* Gg, const float* gnorm, float* SLOC, float* DSEG, GLAS unsigned char* lds, int tid0) {
    int tid_ = tid0; asm volatile("" : "+v"(tid_));
    const int tid = tid_, lane = tid & 63, w = __builtin_amdgcn_readfirstlane(tid >> 6), r32 = lane & 31, hi = lane >> 5;
    f32x16 S[4];
#pragma unroll
    for (int i = 0; i < 4; ++i)
#pragma unroll
        for (int r = 0; r < 16; ++r) S[i][r] = 0.f;
    const int kcol = tid & 127, qd = tid >> 7;
    const int bh = b * 4 + h;
    if (!STATE_ONLY && seg >= 1) {
#pragma unroll 1
        for (int s = 0; s < seg; ++s) {
            const float* sl = SLOC + ((size_t)(bh * 3 + s) * 128) * 256 + 32 * w + r32; const float* dd = DSEG + (bh * 3 + s) * 128;
#pragma unroll
            for (int i = 0; i < 4; ++i)
#pragma unroll
                for (int r = 0; r < 16; ++r) { const int k = 32 * i + crow(r, hi); const float d = (s == 0) ? 0.f : dd[k]; S[i][r] = S[i][r] * d + sl[(size_t)k * 256]; }
        }
    }
    float dlog = 0.f;
    GLAS float* BL = (GLAS float*)(lds + L_BL); GLAS float* QT = (GLAS float*)(lds + L_QT);
    GLAS float* OL = (GLAS float*)lds;
    float gq[16]; u32x4 vr[4];
#define GLA_FETCH(cc) do { const size_t r0_ = (size_t)b * 2048 + (cc) * 64; \
        const float* gp_ = Gg + (r0_ + 16 * qd) * 512 + h * 128 + kcol; const bf16_t* qp_ = Qg + (r0_ + 16 * qd) * 512 + h * 128 + kcol; const bf16_t* kp_ = Kg + (r0_ + 16 * qd) * 512 + h * 128 + kcol; \
        _Pragma("unroll") for (int i = 0; i < 16; ++i) { gq[i] = gp_[(size_t)i * 512]; } (void)qp_; (void)kp_; \
        _Pragma("unroll") for (int i = 0; i < 4; ++i) { const int p_ = tid + 512 * i, rr_ = p_ >> 5, ch_ = p_ & 31; vr[i] = *(const u32x4*)(VO + (r0_ + rr_) * 1024 + h * 256 + ch_ * 8); } } while (0)
    GLA_FETCH(seg * 8);
    for (int c = seg * 8; c < seg * 8 + 8; ++c) {
        const size_t row0 = (size_t)b * 2048 + c * 64;
        u32x4 rpre[4];
        if (!STATE_ONLY) { const size_t go_ = (row0 + (tid >> 3)) * 1024 + h * 256 + 32 * (tid & 7);
#pragma unroll
            for (int j = 0; j < 4; ++j) rpre[j] = *(const u32x4*)(Rg + go_ + 8 * j); }
        {
            float cs[16]; float run = 0.f;
#pragma unroll
            for (int i = 0; i < 16; ++i) { run += gq[i]; cs[i] = run; }
            QT[qd * 128 + kcol] = run;
#pragma unroll
            for (int i = 0; i < 4; ++i) { const int p = tid + 512 * i, rr = p >> 5, ch = p & 31;
                *(GLAS u32x4*)(lds + L_V + rr * VP + ch * 16) = vr[i]; }
            float qv[16], kv[16];
            { const bf16_t* qp = Qg + (row0 + 16 * qd) * 512 + h * 128 + kcol; const bf16_t* kp = Kg + (row0 + 16 * qd) * 512 + h * 128 + kcol;
#pragma unroll
              for (int i = 0; i < 16; ++i) { qv[i] = STATE_ONLY ? 0.f : bf2f(qp[(size_t)i * 512]); kv[i] = bf2f(kp[(size_t)i * 512]); } }
            if (c + 1 < seg * 8 + 8) GLA_FETCH(c + 1);
            __syncthreads();
            float pre = 0.f, tot = 0.f;
#pragma unroll
            for (int q = 0; q < 4; ++q) { const float t = QT[q * 128 + kcol]; tot += t; if (q < qd) pre += t; }
            if (qd == 0) BL[kcol] = __expf(tot);
            dlog += tot;
            float kd[16];
#pragma unroll
            for (int i = 0; i < 16; ++i) { const float bb = pre + cs[i]; const int t = 16 * qd + i;
                if (!STATE_ONLY) { *(GLAS bf16_t*)(lds + L_QE + t * QEP + kcol * 2) = f2bf1(qv[i] * __expf(bb));
                                   *(GLAS bf16_t*)(lds + L_KE + t * QEP + kcol * 2) = f2bf1(kv[i] * __expf(-bb)); }
                kd[i] = kv[i] * __expf(tot - bb); }
#pragma unroll
            for (int i = 0; i < 4; ++i) { u32x2 v; v.x = cvtpk(kd[4 * i], kd[4 * i + 1]); v.y = cvtpk(kd[4 * i + 2], kd[4 * i + 3]);
                *(GLAS u32x2*)(lds + L_KDT + kcol * KDP + (16 * qd + 4 * i) * 2) = v; }
        }
        __syncthreads();
        f32x16 o[2];
#pragma unroll
        for (int r = 0; r < 16; ++r) { o[0][r] = 0.f; o[1][r] = 0.f; }
        if (!STATE_ONLY) {
        if (w < 3) {
            const int ti = (w >= 1) ? 1 : 0, si = (w == 2) ? 1 : 0;
            f32x16 a;
#pragma unroll
            for (int r = 0; r < 16; ++r) a[r] = 0.f;
            const GLAS unsigned char* ap = lds + L_QE + (32 * ti + r32) * QEP + 16 * hi; const GLAS unsigned char* bp = lds + L_KE + (32 * si + r32) * QEP + 16 * hi;
#pragma unroll
            for (int s = 0; s < 8; ++s) { const bf16x8 A = ld2x64(ap + 32 * s, ap + 32 * s + 8), B = ld2x64(bp + 32 * s, bp + 32 * s + 8);
                a = __builtin_amdgcn_mfma_f32_32x32x16_bf16(A, B, a, 0, 0, 0); }
            const int sg = 32 * si + r32;
#pragma unroll
            for (int r = 0; r < 16; ++r) { const int tg = 32 * ti + crow(r, hi); const float v = (sg <= tg) ? a[r] : 0.f;
                *(GLAS bf16_t*)(lds + L_ATT + tg * KDP + sg * 2) = f2bf1(v); }
        } else if (w == 3) {
#pragma unroll
            for (int r = 0; r < 16; ++r) *(GLAS bf16_t*)(lds + L_ATT + crow(r, hi) * KDP + (32 + r32) * 2) = 0;
        }
        {
#pragma unroll
            for (int i = 0; i < 4; ++i)
#pragma unroll
                for (int s = 0; s < 2; ++s) {
                    u32x4 pk; pk.x = cvtpk(S[i][8 * s], S[i][8 * s + 1]); pk.y = cvtpk(S[i][8 * s + 2], S[i][8 * s + 3]); pk.z = cvtpk(S[i][8 * s + 4], S[i][8 * s + 5]); pk.w = cvtpk(S[i][8 * s + 6], S[i][8 * s + 7]);
                    const bf16x8 Bf = __builtin_bit_cast(bf16x8, pk);
#pragma unroll
                    for (int ti = 0; ti < 2; ++ti) { const GLAS unsigned char* ap = lds + L_QE + (32 * ti + r32) * QEP + (32 * i + 16 * s + 4 * hi) * 2;
                        const bf16x8 A = ld2x64(ap, ap + 16); o[ti] = __builtin_amdgcn_mfma_f32_32x32x16_bf16(A, Bf, o[ti], 0, 0, 0); }
                }
        }
        __syncthreads();
        }
        {
            bf16x8 vf[4];
            const int gI = lane >> 4, i16 = lane & 15, q = i16 >> 2, p = i16 & 3;
            const GLAS unsigned char* vb = lds + L_V + (8 * hi + q) * VP + (32 * w + 16 * (gI & 1) + 4 * p) * 2;
#pragma unroll
            for (int ks = 0; ks < 4; ++ks) { const s16x4 lo = vtr(vb + 16 * ks * VP), hh = vtr(vb + (16 * ks + 4) * VP);
                vf[ks] = (bf16x8){lo[0], lo[1], lo[2], lo[3], hh[0], hh[1], hh[2], hh[3]}; }
            if (!STATE_ONLY) {
#pragma unroll
            for (int ti = 0; ti < 2; ++ti)
#pragma unroll
                for (int ks = 0; ks < 4; ++ks) { const GLAS unsigned char* ap = lds + L_ATT + (32 * ti + r32) * KDP + (16 * ks + 8 * hi) * 2;
                    const bf16x8 A = ld2x64(ap, ap + 8); o[ti] = __builtin_amdgcn_mfma_f32_32x32x16_bf16(A, vf[ks], o[ti], 0, 0, 0); }
            }
#pragma unroll
            for (int i = 0; i < 4; ++i) {
#pragma unroll
                for (int r = 0; r < 16; ++r) S[i][r] *= BL[32 * i + crow(r, hi)];
#pragma unroll
                for (int ks = 0; ks < 4; ++ks) { const GLAS unsigned char* ap = lds + L_KDT + (32 * i + r32) * KDP + (16 * ks + 8 * hi) * 2;
                    const bf16x8 A = ld2x64(ap, ap + 8); S[i] = __builtin_amdgcn_mfma_f32_32x32x16_bf16(A, vf[ks], S[i], 0, 0, 0); }
            }
        }
        __syncthreads();
        if (!STATE_ONLY) {
#pragma unroll
        for (int ti = 0; ti < 2; ++ti)
#pragma unroll
            for (int r = 0; r < 16; ++r) OL[(32 * ti + crow(r, hi)) * OLP + 32 * w + r32] = o[ti][r];
        __syncthreads();
        {
            const int t = tid >> 3, seg = tid & 7;
            f32x4 v[8]; float ss = 0.f;
#pragma unroll
            for (int j = 0; j < 8; ++j) { v[j] = *(const GLAS f32x4*)(OL + t * OLP + 32 * seg + 4 * j); ss += (v[j].x * v[j].x + v[j].y * v[j].y) + (v[j].z * v[j].z + v[j].w * v[j].w); }
            ss += dpp_xor1(ss); ss += dpp_xor2(ss); ss += dpp_hmirror(ss);
            const float rs = rsqrtf(ss * (1.0f / 256.0f) + 1e-6f);
            const size_t go = (row0 + t) * 1024 + h * 256 + 32 * seg;
            const float* gn = gnorm + h * 256 + 32 * seg;
#pragma unroll
            for (int j = 0; j < 4; ++j) {
                const u32x4 rr = rpre[j];
                const f32x4 g0 = *(const f32x4*)(gn + 8 * j), g1 = *(const f32x4*)(gn + 8 * j + 4);
                const f32x4 a = v[2 * j], bq = v[2 * j + 1];
                u32x4 ov;
                ov.x = cvtpk(a.x * rs * g0.x * __builtin_bit_cast(float, rr.x << 16), a.y * rs * g0.y * __builtin_bit_cast(float, rr.x & 0xffff0000u));
                ov.y = cvtpk(a.z * rs * g0.z * __builtin_bit_cast(float, rr.y << 16), a.w * rs * g0.w * __builtin_bit_cast(float, rr.y & 0xffff0000u));
                ov.z = cvtpk(bq.x * rs * g1.x * __builtin_bit_cast(float, rr.z << 16), bq.y * rs * g1.y * __builtin_bit_cast(float, rr.z & 0xffff0000u));
                ov.w = cvtpk(bq.z * rs * g1.z * __builtin_bit_cast(float, rr.w << 16), bq.w * rs * g1.w * __builtin_bit_cast(float, rr.w & 0xffff0000u));
                *(u32x4*)(Oout + go + 8 * j) = ov;
            }
        }
        __syncthreads();
        }
    }
    if (STATE_ONLY) {
        float* sl = SLOC + ((size_t)(bh * 3 + seg) * 128) * 256 + 32 * w + r32;
#pragma unroll
        for (int i = 0; i < 4; ++i)
#pragma unroll
            for (int r = 0; r < 16; ++r) sl[(size_t)(32 * i + crow(r, hi)) * 256] = S[i][r];
        if (qd == 0) DSEG[(bh * 3 + seg) * 128 + kcol] = __expf(dlog);
    }
#undef GLA_FETCH
}
}
namespace nsa {
typedef unsigned short bf16_t;
typedef short bf16x8 __attribute__((ext_vector_type(8)));
typedef short s16x4 __attribute__((ext_vector_type(4)));
typedef float f32x16 __attribute__((ext_vector_type(16)));
typedef float f32x4 __attribute__((ext_vector_type(4)));
typedef unsigned u32x4 __attribute__((ext_vector_type(4)));
#define NLAS __attribute__((address_space(3)))
__device__ __forceinline__ int crow(int r, int hi) { return (r & 3) + 8 * (r >> 2) + 4 * hi; }
__device__ __forceinline__ unsigned cvtpk(float lo, float hi) { typedef float f2 __attribute__((ext_vector_type(2))); typedef __bf16 b2 __attribute__((ext_vector_type(2))); f2 v = {lo, hi}; b2 b = __builtin_convertvector(v, b2); return __builtin_bit_cast(unsigned, b); }
__device__ __forceinline__ s16x4 vtr(const NLAS unsigned char* p) { typedef short v4i16_t __attribute__((ext_vector_type(4))); return __builtin_bit_cast(s16x4, __builtin_amdgcn_ds_read_tr16_b64_v4i16((NLAS v4i16_t*)p)); }

__device__ __forceinline__ float gelu_tanh(float x) { const float y = 0.7978845608028654f * (x + 0.044715f * x * x * x); const float e = __expf(2.0f * y); const float th = 1.0f - 2.0f * __builtin_amdgcn_rcpf(e + 1.0f); return 0.5f * x * (1.0f + th); }
__device__ __forceinline__ void cmp_finalize(const float* HP, const float* BIASC, const bf16_t* WC2, bf16_t* KCVC, int gw, int NGW, int lane) {
    typedef float f4 __attribute__((ext_vector_type(4)));
    const int r = lane & 15, kq = lane >> 4;
    for (int item = gw; item < 1024; item += NGW) {
        const int R0 = item * 16, w = R0 >> 13, row = R0 + r;
        f4 acc[4];
#pragma unroll
        for (int nt = 0; nt < 4; ++nt) acc[nt] = (f4){0.f, 0.f, 0.f, 0.f};
#pragma unroll
        for (int ks = 0; ks < 8; ++ks) {
            const int col = 32 * ks + 8 * kq;
            f32x4 s0 = *(const f32x4*)(BIASC + w * 256 + col), s1 = *(const f32x4*)(BIASC + w * 256 + col + 4);
#pragma unroll
            for (int p = 0; p < 4; ++p) { const float* hp = HP + ((size_t)p * 16384 + row) * 256 + col; s0 = s0 + *(const f32x4*)hp; s1 = s1 + *(const f32x4*)(hp + 4); }
            u32x4 pk; pk.x = cvtpk(gelu_tanh(s0.x), gelu_tanh(s0.y)); pk.y = cvtpk(gelu_tanh(s0.z), gelu_tanh(s0.w)); pk.z = cvtpk(gelu_tanh(s1.x), gelu_tanh(s1.y)); pk.w = cvtpk(gelu_tanh(s1.z), gelu_tanh(s1.w));
            const bf16x8 A = __builtin_bit_cast(bf16x8, pk);
#pragma unroll
            for (int nt = 0; nt < 4; ++nt) { const bf16x8 B = *(const bf16x8*)(WC2 + ((size_t)w * 64 + 16 * nt + r) * 256 + col);
                acc[nt] = __builtin_amdgcn_mfma_f32_16x16x32_bf16(A, B, acc[nt], 0, 0, 0); }
        }
#pragma unroll
        for (int nt = 0; nt < 4; ++nt)
#pragma unroll
            for (int rg = 0; rg < 4; ++rg) { const int orow = R0 + 4 * kq + rg; const float v = ((orow & 127) == 127) ? 0.f : acc[nt][rg];
                KCVC[(size_t)orow * 64 + 16 * nt + r] = (bf16_t)(cvtpk(v, 0.f) & 0xffffu); }
    }
}

constexpr int SLOTB = 16384, NSLOT = 4;
constexpr int L_IMP = NSLOT * SLOTB, L_CAR = L_IMP + 8 * 32 * 33 * 4, L_VAL = L_CAR + 8 * 32 * 33 * 4, L_SELM = L_VAL + 64 * 33 * 4, L_WSF = L_SELM + 256, L_FAC = L_WSF + 8 * 64 * 4, L_AEND = L_FAC + 8 * 32 * 2 * 4;
static_assert(L_AEND <= 131072 + 28672, "attention LDS");
#define NINF (-__builtin_inff())
#define ABAR() asm volatile("s_waitcnt lgkmcnt(0)\n\ts_barrier" ::: "memory")

__device__ __forceinline__ void k_load(bf16x8* kf, const NLAS unsigned char* ks, int r32, int hi) {
    const int sw = (r32 >> 1) & 7;
    const unsigned kb = (unsigned)(size_t)(ks + r32 * 128);
    const unsigned a0 = kb + (((0 + hi) ^ sw) << 4), a1 = kb + (((2 + hi) ^ sw) << 4), a2 = kb + (((4 + hi) ^ sw) << 4), a3 = kb + (((6 + hi) ^ sw) << 4);
    asm volatile("ds_read_b128 %0, %8\n\tds_read_b128 %1, %8 offset:4096\n\tds_read_b128 %2, %9\n\tds_read_b128 %3, %9 offset:4096\n\t"
                 "ds_read_b128 %4, %10\n\tds_read_b128 %5, %10 offset:4096\n\tds_read_b128 %6, %11\n\tds_read_b128 %7, %11 offset:4096\n\ts_waitcnt lgkmcnt(0)"
                 : "=&v"(kf[0]), "=&v"(kf[1]), "=&v"(kf[2]), "=&v"(kf[3]), "=&v"(kf[4]), "=&v"(kf[5]), "=&v"(kf[6]), "=&v"(kf[7])
                 : "v"(a0), "v"(a1), "v"(a2), "v"(a3) : "memory");
    __builtin_amdgcn_sched_barrier(0);
}
__device__ __forceinline__ void qk_mma(f32x16& p0, f32x16& p1, const bf16x8* kf, const bf16x8* qf, const f32x16& c) {
#pragma unroll
    for (int d0 = 0; d0 < 4; ++d0) {
        if (d0 == 0) { p0 = __builtin_amdgcn_mfma_f32_32x32x16_bf16(kf[0], qf[0], c, 0, 0, 0); p1 = __builtin_amdgcn_mfma_f32_32x32x16_bf16(kf[1], qf[0], c, 0, 0, 0); }
        else { p0 = __builtin_amdgcn_mfma_f32_32x32x16_bf16(kf[2 * d0], qf[d0], p0, 0, 0, 0); p1 = __builtin_amdgcn_mfma_f32_32x32x16_bf16(kf[2 * d0 + 1], qf[d0], p1, 0, 0, 0); }
    }
}
__device__ __forceinline__ void pack_p(bf16x8* pa, const f32x16& p0, const f32x16& p1) {
    u32x4 w;
    w.x = cvtpk(p0[0], p0[1]); w.y = cvtpk(p0[2], p0[3]); w.z = cvtpk(p0[4], p0[5]); w.w = cvtpk(p0[6], p0[7]); pa[0] = __builtin_bit_cast(bf16x8, w);
    w.x = cvtpk(p0[8], p0[9]); w.y = cvtpk(p0[10], p0[11]); w.z = cvtpk(p0[12], p0[13]); w.w = cvtpk(p0[14], p0[15]); pa[1] = __builtin_bit_cast(bf16x8, w);
    w.x = cvtpk(p1[0], p1[1]); w.y = cvtpk(p1[2], p1[3]); w.z = cvtpk(p1[4], p1[5]); w.w = cvtpk(p1[6], p1[7]); pa[2] = __builtin_bit_cast(bf16x8, w);
    w.x = cvtpk(p1[8], p1[9]); w.y = cvtpk(p1[10], p1[11]); w.z = cvtpk(p1[12], p1[13]); w.w = cvtpk(p1[14], p1[15]); pa[3] = __builtin_bit_cast(bf16x8, w);
}
__device__ __forceinline__ void v_load(bf16x8* vf, const NLAS unsigned char* vs, int lane) {
    const int hi = lane >> 5;
    const unsigned vb = (unsigned)(size_t)(vs + ((lane >> 4) & 1) * 32 + (lane & 3) * 8 + (4 * hi + ((lane & 15) >> 2)) * 64);
    s16x4 t[16];
    asm volatile("ds_read_b64_tr_b16 %0, %16\n\tds_read_b64_tr_b16 %1, %16 offset:512\n\tds_read_b64_tr_b16 %2, %16 offset:1024\n\tds_read_b64_tr_b16 %3, %16 offset:1536\n\t"
                 "ds_read_b64_tr_b16 %4, %16 offset:2048\n\tds_read_b64_tr_b16 %5, %16 offset:2560\n\tds_read_b64_tr_b16 %6, %16 offset:3072\n\tds_read_b64_tr_b16 %7, %16 offset:3584\n\t"
                 "ds_read_b64_tr_b16 %8, %16 offset:4096\n\tds_read_b64_tr_b16 %9, %16 offset:4608\n\tds_read_b64_tr_b16 %10, %16 offset:5120\n\tds_read_b64_tr_b16 %11, %16 offset:5632\n\t"
                 "ds_read_b64_tr_b16 %12, %16 offset:6144\n\tds_read_b64_tr_b16 %13, %16 offset:6656\n\tds_read_b64_tr_b16 %14, %16 offset:7168\n\tds_read_b64_tr_b16 %15, %16 offset:7680\n\ts_waitcnt lgkmcnt(0)"
                 : "=&v"(t[0]), "=&v"(t[1]), "=&v"(t[2]), "=&v"(t[3]), "=&v"(t[4]), "=&v"(t[5]), "=&v"(t[6]), "=&v"(t[7]),
                   "=&v"(t[8]), "=&v"(t[9]), "=&v"(t[10]), "=&v"(t[11]), "=&v"(t[12]), "=&v"(t[13]), "=&v"(t[14]), "=&v"(t[15])
                 : "v"(vb) : "memory");
    __builtin_amdgcn_sched_barrier(0);
#pragma unroll
    for (int i = 0; i < 8; ++i) vf[i] = (bf16x8){t[2 * i][0], t[2 * i][1], t[2 * i][2], t[2 * i][3], t[2 * i + 1][0], t[2 * i + 1][1], t[2 * i + 1][2], t[2 * i + 1][3]};
}
__device__ __forceinline__ void pv_mma(f32x16* o, const bf16x8* vf, const bf16x8* pa) {
#pragma unroll
    for (int ks = 0; ks < 4; ++ks) {
        o[0] = __builtin_amdgcn_mfma_f32_32x32x16_bf16(pa[ks], vf[ks], o[0], 0, 0, 0);
        o[1] = __builtin_amdgcn_mfma_f32_32x32x16_bf16(pa[ks], vf[4 + ks], o[1], 0, 0, 0);
    }
}
__device__ __forceinline__ float max32(const f32x16& p0, const f32x16& p1) {
    float a = fmaxf(p0[0], p1[0]);
#pragma unroll
    for (int r = 1; r < 16; ++r) a = fmaxf(a, fmaxf(p0[r], p1[r]));
    return a;
}
__device__ __forceinline__ float comb_max(float v) { auto rr = __builtin_amdgcn_permlane32_swap(__float_as_uint(v), __float_as_uint(v), false, false); return fmaxf(__uint_as_float(rr[0]), __uint_as_float(rr[1])); }
__device__ __forceinline__ float comb_sum(float v) { auto rr = __builtin_amdgcn_permlane32_swap(__float_as_uint(v), __float_as_uint(v), false, false); return __uint_as_float(rr[0]) + __uint_as_float(rr[1]); }
__device__ __forceinline__ void mask_le(f32x16& p0, f32x16& p1, int thr, int hi) {
    int t2 = thr - 4 * hi; asm volatile("" : "+v"(t2));
#pragma unroll
    for (int r = 0; r < 16; ++r) { const int kc = (r & 3) + 8 * (r >> 2); if (kc > t2) p0[r] = NINF; if (kc + 32 > t2) p1[r] = NINF; }
}
__device__ __forceinline__ void mask_gt(f32x16& p0, f32x16& p1, int thr, int hi) {
    int t2 = thr - 4 * hi; asm volatile("" : "+v"(t2));
#pragma unroll
    for (int r = 0; r < 16; ++r) { const int kc = (r & 3) + 8 * (r >> 2); if (kc <= t2) p0[r] = NINF; if (kc + 32 <= t2) p1[r] = NINF; }
}

#ifndef SOFT_THR
#define SOFT_THR 8.0f
#endif
struct Soft { float mhat, l; f32x16 o[2]; };
__device__ __forceinline__ void soft_init(Soft& s) { s.mhat = 0.f; s.l = 0.f;
#pragma unroll
    for (int r = 0; r < 16; ++r) { s.o[0][r] = 0.f; s.o[1][r] = 0.f; } }
__device__ __forceinline__ float soft_update(Soft& s, f32x16& p0, f32x16& p1, bool first, NLAS float* wsf, int r32, int hi) {
    const float rm = comb_max(max32(p0, p1));
    const float dl = first ? ((rm > NINF) ? rm : 0.f) : ((rm > SOFT_THR) ? rm : 0.f);
    float f = 1.0f;
    if (__any(dl != 0.f)) {
        s.mhat += dl;
        f = __builtin_amdgcn_exp2f(-dl);
        s.l *= f;
#pragma unroll
        for (int r = 0; r < 16; ++r) { p0[r] -= dl; p1[r] -= dl; }
        if (!first) {
            if (hi == 0) wsf[r32] = f;
            asm volatile("s_waitcnt lgkmcnt(0)" ::: "memory");
#pragma unroll
            for (int r = 0; r < 16; ++r) { const float ff = wsf[crow(r, hi)]; s.o[0][r] *= ff; s.o[1][r] *= ff; }
            asm volatile("s_waitcnt lgkmcnt(0)" ::: "memory");
        }
    }
    float sum = 0.f;
#pragma unroll
    for (int r = 0; r < 16; ++r) { p0[r] = __builtin_amdgcn_exp2f(p0[r]); p1[r] = __builtin_amdgcn_exp2f(p1[r]); sum += p0[r] + p1[r]; }
    s.l += sum;
    return f;
}

struct AttnBufs { unsigned char* ws; };
struct Strm { int u, kind, j; };
__device__ __forceinline__ int unit_qt(int u, int sub) { return 8 * (u >> 1) + ((u & 1) ? (7 - sub) : sub); }
__device__ __forceinline__ void strm_next(Strm& s, int sub) {
    const int qt = unit_qt(s.u, sub);
    if (s.kind == 0) { if (s.j == 0) s.j = 1; else { s.kind = 1; s.j = qt; } }
    else if (s.kind == 1) { if (s.j > 0) --s.j; else { s.kind = 2; s.j = qt; } }
    else { const int jlo = qt >= 8 ? qt - 8 : 0; if (s.j > jlo) --s.j; else { ++s.u; s.kind = 0; s.j = 0; } }
}
__device__ __forceinline__ void dma16(const void* g, NLAS unsigned char* l) {
    unsigned keep; const unsigned dst = (unsigned)__builtin_amdgcn_readfirstlane((int)(unsigned)(size_t)l);
    asm volatile("s_mov_b32 %0, m0\n\ts_mov_b32 m0, %2\n\ts_nop 0\n\tglobal_load_lds_dwordx4 %1, off\n\ts_mov_b32 m0, %0" : "=&s"(keep) : "v"(g), "s"(dst) : "memory");
}


template <int VAR = 0>
__device__ __forceinline__ void attn_block(int bh, int sub, const AttnBufs& T, NLAS unsigned char* lds, int tid0) {
    int tid_ = tid0; asm volatile("" : "+v"(tid_));
    const int tid = tid_, lane = tid & 63, w = __builtin_amdgcn_readfirstlane(tid >> 6), r32 = lane & 31, hi = lane >> 5;
    const int b = bh >> 2, hk = bh & 3, g = w >> 1, hq = hk * 4 + g, qi = 32 * (w & 1) + r32;
    NLAS float* wsf = (NLAS float*)(lds + L_WSF) + w * 64;
    NLAS float* IMP = (NLAS float*)(lds + L_IMP) + w * 32 * 33; NLAS float* CAR = (NLAS float*)(lds + L_CAR) + w * 32 * 33;
    NLAS float* stash = (NLAS float*)(lds + L_IMP + w * 8448) + lane;
    const int krow = 8 * w + (lane >> 3), koff = krow * 64 + (((lane & 7) ^ ((krow >> 1) & 7)) << 3), voff = (16 * (w & 3) + (lane >> 2)) * 64 + (w >> 2) * 32 + (lane & 3) * 8;
    unsigned char* const ws = T.ws;
    constexpr size_t kvs = (size_t)16 * 4 * 2048 * 64;
#define A_KC ((const bf16_t*)(ws + WS_KCVC) + ((size_t)bh * 128) * 64)
#define A_VC ((const bf16_t*)(ws + WS_KCVC) + ((size_t)(64 + bh) * 128) * 64)
#define A_KV ((const bf16_t*)(ws + WS_KV) + (size_t)bh * 2048 * 64)
#define ISSUE(st, slot) do { const bf16_t* kt_; const bf16_t* vt_; \
        if ((st).kind == 0) { kt_ = A_KC + (st).j * 4096; vt_ = A_VC + (st).j * 4096; } \
        else if ((st).kind == 1) { kt_ = A_KV + 2 * kvs + (size_t)(st).j * 4096; vt_ = A_KV + 3 * kvs + (size_t)(st).j * 4096; } \
        else { kt_ = A_KV + 4 * kvs + (size_t)(st).j * 4096; vt_ = A_KV + 5 * kvs + (size_t)(st).j * 4096; } \
        dma16(kt_ + koff, lds + (slot) * SLOTB + w * 1024); dma16(vt_ + voff, lds + (slot) * SLOTB + 8192 + w * 1024); } while (0)
    Strm ist; ist.u = 0; ist.kind = 0; ist.j = 0;
    Strm cst = ist;
    int P = 0;
#pragma unroll 1
    for (int u = 0; u < 8; ++u) { const int qt = unit_qt(u, sub); P += 2 + (qt + 1) + ((qt >= 8 ? 8 : qt) + 1); }
    ISSUE(ist, 0); strm_next(ist, sub); ISSUE(ist, 1); strm_next(ist, sub); ISSUE(ist, 2); strm_next(ist, sub);
    Soft S; soft_init(S);
    bf16x8 qf[4];
    float g_cmp = 0.f, g_sel = 0.f, g_win = 0.f; unsigned selm = 0u; int qt = 0;
#pragma unroll 1
    for (int p = 0; p < P; ++p) {
        const int ahead = P - 1 - p;
        if (ahead >= 2) asm volatile("s_waitcnt vmcnt(4)" ::: "memory"); else if (ahead == 1) asm volatile("s_waitcnt vmcnt(2)" ::: "memory"); else asm volatile("s_waitcnt vmcnt(0)" ::: "memory");
        ABAR();
        if (p + 3 < P) { ISSUE(ist, (p + 3) & 3); strm_next(ist, sub); }
        const NLAS unsigned char* slot = lds + (p & 3) * SLOTB;
        const int kind = cst.kind, j = cst.j;
        if (kind == 0 && j == 0) {
            qt = unit_qt(cst.u, sub);
            const int tok = 64 * qt + qi;
            const float* gp = (const float*)(ws + WS_GATES) + ((size_t)b * 2048 + tok) * 48 + hq;
            g_cmp = gp[0]; g_sel = gp[16]; g_win = gp[32];
            const size_t qoff = (((size_t)b * 16 + hq) * 2048 + tok) * 64 + 8 * hi;
#pragma unroll
            for (int d0 = 0; d0 < 4; ++d0) qf[d0] = *(const bf16x8*)((const bf16_t*)(ws + WS_NQ) + qoff + 16 * d0);
            soft_init(S);
        }
        if ((kind == 1 || kind == 2) && j == qt) soft_init(S);
        const bool first = (kind == 0) ? (j == 0) : (j == qt);
        float cv = -S.mhat;
        if (kind == 1) { if (!((selm >> j) & 1u)) cv = NINF; }
        f32x16 c;
#pragma unroll
        for (int r = 0; r < 16; ++r) c[r] = cv;
        f32x16 p0, p1;
        if (VAR == 1) { p0 = c; p1 = c; asm volatile("" : "+v"(p0), "+v"(p1)); if (VAR == 1) { strm_next(cst, sub); continue; } }
        bf16x8 vf[8];
        {
            bf16x8 kf[8]; k_load(kf, slot, r32, hi);
            qk_mma(p0, p1, kf, qf, c);
        }
        v_load(vf, slot + 8192, lane);
        __builtin_amdgcn_sched_barrier(0);
        if (VAR == 2) { asm volatile("" :: "v"(p0), "v"(p1)); strm_next(cst, sub); continue; }
        if (kind == 0) { const int tok = 64 * qt + qi; const int nmax = (tok >= 31) ? ((tok - 31) >> 4) : -1; mask_le(p0, p1, nmax - 64 * j, hi); }
        else { if (j == qt) mask_le(p0, p1, qi, hi); if (kind == 2 && j == qt - 8) mask_gt(p0, p1, qi, hi); }
        const float f = soft_update(S, p0, p1, first, wsf, r32, hi);
        if (VAR == 3) { asm volatile("" :: "v"(p0), "v"(p1)); strm_next(cst, sub); continue; }
        {
            bf16x8 pa[4]; pack_p(pa, p0, p1);
            pv_mma(S.o, vf, pa);
        }
        if (kind == 0) {
            NLAS float* FAC = (NLAS float*)(lds + L_FAC) + w * 64;
            if (j == 0) {
                if (hi == 0) CAR[r32 * 33] = 0.f;
#pragma unroll
                for (int a = 0; a < 4; ++a) {
                    const int jb = 2 * a + hi;
                    IMP[r32 * 33 + jb] = p0[4 * a] + p0[4 * a + 1] + p0[4 * a + 2] + 0.5f * p0[4 * a + 3]; CAR[r32 * 33 + jb + 1] = 0.5f * p0[4 * a + 3];
                    IMP[r32 * 33 + jb + 8] = p1[4 * a] + p1[4 * a + 1] + p1[4 * a + 2] + 0.5f * p1[4 * a + 3]; CAR[r32 * 33 + jb + 9] = 0.5f * p1[4 * a + 3];
                }
            } else {
                const float l = comb_sum(S.l);
                const float inv = (l > 0.f) ? __builtin_amdgcn_rcpf(l) : 0.f;
                if (hi == 0) { FAC[r32] = f * inv; FAC[32 + r32] = inv; }
#pragma unroll
                for (int a = 0; a < 4; ++a) {
                    const int jb = 2 * a + hi;
                    IMP[r32 * 33 + jb + 16] = p0[4 * a] + p0[4 * a + 1] + p0[4 * a + 2] + 0.5f * p0[4 * a + 3]; CAR[r32 * 33 + jb + 17] = 0.5f * p0[4 * a + 3];
                    IMP[r32 * 33 + jb + 24] = p1[4 * a] + p1[4 * a + 1] + p1[4 * a + 2] + 0.5f * p1[4 * a + 3]; if (jb + 25 < 32) CAR[r32 * 33 + jb + 25] = 0.5f * p1[4 * a + 3];
                }
                ABAR();
                {
                    NLAS float* VAL = (NLAS float*)(lds + L_VAL);
                    const int tq = tid >> 3, sb = tid & 7, wv = tq >> 5, rr = tq & 31;
                    const NLAS float* I0 = (const NLAS float*)(lds + L_IMP); const NLAS float* C0 = (const NLAS float*)(lds + L_CAR);
                    float v[4];
#pragma unroll
                    for (int e = 0; e < 4; ++e) { const int jb = 4 * sb + e; float sc = 0.f;
#pragma unroll
                        for (int gg = 0; gg < 4; ++gg) { const int ww = 2 * gg + wv; const NLAS float* fc = (const NLAS float*)(lds + L_FAC) + ww * 64 + rr;
                            sc += I0[(ww * 32 + rr) * 33 + jb] * fc[jb < 16 ? 0 : 32] + C0[(ww * 32 + rr) * 33 + jb] * fc[jb <= 16 ? 0 : 32]; }
                        if (jb > qt) sc = -1.0f; else if (jb == 0 || jb == qt || jb == qt - 1) sc = 1e4f;
                        v[e] = sc; VAL[tq * 33 + jb] = sc; }
                    ABAR();
                    unsigned bits = 0u;
#pragma unroll
                    for (int e = 0; e < 4; ++e) { const int jb = 4 * sb + e; int rank = 0;
#pragma unroll
                        for (int i = 0; i < 32; ++i) { const float x = VAL[tq * 33 + i]; rank += (x > v[e] || (x == v[e] && i < jb)) ? 1 : 0; }
                        if (rank < 16) bits |= 1u << jb; }
                    bits |= dpp_xor1(bits); bits |= dpp_xor2(bits); bits |= dpp_hmirror(bits);
                    if (sb == 0) ((NLAS unsigned*)(lds + L_SELM))[tq] = bits;
                }
                ABAR();
#ifdef DBG_SELALL
                selm = 0xffffffffu;
#else
                selm = ((const NLAS unsigned*)(lds + L_SELM))[qi];
#endif
                const float fac = g_cmp * inv;
                if (hi == 0) wsf[r32] = fac;
                asm volatile("s_waitcnt lgkmcnt(0)" ::: "memory");
#pragma unroll
                for (int r = 0; r < 16; ++r) { const float ff = wsf[crow(r, hi)]; stash[r * 64] = S.o[0][r] * ff; stash[(16 + r) * 64] = S.o[1][r] * ff; }
                asm volatile("s_waitcnt lgkmcnt(0)" ::: "memory");
                const size_t qoff = (((size_t)b * 16 + hq) * 2048 + 64 * qt + qi) * 64 + 8 * hi;
#pragma unroll
                for (int d0 = 0; d0 < 4; ++d0) qf[d0] = *(const bf16x8*)((const bf16_t*)(ws + WS_NQR) + qoff + 16 * d0);
            }
        } else {
            const int jend = (kind == 1) ? 0 : (qt >= 8 ? qt - 8 : 0);
            if (j == jend) {
                const float l = comb_sum(S.l);
                const float fac = (kind == 1 ? g_sel : g_win) * __builtin_amdgcn_rcpf(l);
                if (hi == 0) wsf[r32] = fac;
                asm volatile("s_waitcnt lgkmcnt(0)" ::: "memory");
#pragma unroll
                for (int r = 0; r < 16; ++r) { const float ff = wsf[crow(r, hi)]; stash[r * 64] += S.o[0][r] * ff; stash[(16 + r) * 64] += S.o[1][r] * ff; }
                asm volatile("s_waitcnt lgkmcnt(0)" ::: "memory");
                if (kind == 2) {
                    const NLAS float* sw = (const NLAS float*)(lds + L_IMP + w * 8448);
                    bf16_t* ob = (bf16_t*)(ws + WS_OATT) + ((size_t)b * 2048 + 64 * qt + 32 * (w & 1)) * 1024 + hq * 64;
#pragma unroll
                    for (int i = 0; i < 4; ++i) {
                        const int row = 8 * i + (lane >> 3), ch = lane & 7;
                        const int hh_ = (row >> 2) & 1, rr_ = (row & 3) + 4 * (row >> 3), d0 = ch >> 2;
                        const NLAS float* sp = sw + ((d0 * 16 + rr_) * 64 + hh_ * 32 + (ch & 3) * 8);
                        const f32x4 x0 = *(const NLAS f32x4*)sp, x1 = *(const NLAS f32x4*)(sp + 4);
                        u32x4 ov; ov.x = cvtpk(x0.x, x0.y); ov.y = cvtpk(x0.z, x0.w); ov.z = cvtpk(x1.x, x1.y); ov.w = cvtpk(x1.z, x1.w);
                        *(u32x4*)(ob + (size_t)row * 1024 + ch * 8) = ov;
                    }
                }
            }
        }
        strm_next(cst, sub);
    }
    ABAR();
#undef ISSUE
#undef A_KC
#undef A_VC
#undef A_KV
}
}
namespace cg = cooperative_groups;
typedef unsigned short bf16_t;
struct Params { const float* in[23]; float* out; unsigned char* ws; };

constexpr int PARAM_OFF = EPI_OFF + 28672, BARST_OFF = PARAM_OFF + 256;
template <class T> __device__ __forceinline__ T* ldp(PG8_LAS unsigned char* lds, int idx) {
    const PG8_LAS unsigned* p = (const PG8_LAS unsigned*)(lds + PARAM_OFF) + 2 * idx;
    const unsigned lo = __builtin_amdgcn_readfirstlane(p[0]), hi = __builtin_amdgcn_readfirstlane(p[1]);
    typedef __attribute__((address_space(1))) unsigned char gchar_t;
    gchar_t* gp = (gchar_t*)(((unsigned long long)hi << 32) | lo);
    return (T*)(unsigned char*)gp;
}
#define INP(k) ldp<const float>(lds, (k))
#define OUTP() ldp<float>(lds, 23)
#define WSP() ldp<unsigned char>(lds, 24)
__device__ __forceinline__ pro::In load_in(PG8_LAS unsigned char* lds) {
    pro::In I;
    I.x = INP(0); I.norm_mix = INP(1); I.norm_ffn = INP(2); I.gla_w_in = INP(3); I.gla_w_alpha_up = INP(4); I.gla_b_alpha = INP(5); I.gla_norm = INP(6); I.gla_w_o = INP(7);
    I.kv_norm = INP(8); I.nsa_w_kv = INP(9); I.cmp_pe_k = INP(10); I.cmp_pe_v = INP(11); I.cmp_k_w1 = INP(12); I.cmp_k_w2 = INP(13); I.cmp_v_w1 = INP(14); I.cmp_v_w2 = INP(15);
    I.nsa_w_in = INP(16); I.nsa_w_o = INP(17); I.ffn_w_up = INP(18); I.ffn_conv_w = INP(19); I.ffn_conv_b = INP(20); I.ffn_w_down = INP(21); I.norm_final = INP(22);
    return I;
}

__global__ void __launch_bounds__(512, 2) yoco_fwd(Params P) {
    extern __shared__ __attribute__((aligned(16))) unsigned char lds_raw[];
    PG8_LAS unsigned char* lds = (PG8_LAS unsigned char*)lds_raw;
    cg::grid_group grid = cg::this_grid();
    const int G = gridDim.x, bx = blockIdx.x;
    const int wave0 = __builtin_amdgcn_readfirstlane(threadIdx.x >> 6);
#define NOWTID() (wave0 * 64 + lane_id())
    if (threadIdx.x == 0) {
        PG8_LAS unsigned long long* lp = (PG8_LAS unsigned long long*)(lds + PARAM_OFF);
#pragma unroll
        for (int i = 0; i < 23; ++i) lp[i] = (unsigned long long)P.in[i];
        lp[23] = (unsigned long long)P.out; lp[24] = (unsigned long long)P.ws;
    }
    if (threadIdx.x < 2) ((PG8_LAS unsigned*)(lds + BARST_OFF))[threadIdx.x] = 0u;
    __syncthreads();
    (void)xcd_barrier_post((unsigned*)(P.ws + WS_BAR), (volatile LAS unsigned*)(lds + BARST_OFF), (int)threadIdx.x);
#define GSYNC() do { XcdBarrier b_; b_.bar = (unsigned*)(WSP() + WS_BAR); b_.x = xb_xcc_id(); b_.st = (volatile LAS unsigned*)(lds + BARST_OFF); xcd_barrier(b_, NOWTID()); } while (0)
#define PH_COMMON int tid_ = NOWTID(); asm volatile("" : "+v"(tid_)); const int tid = tid_, lane = tid & 63, wave = __builtin_amdgcn_readfirstlane(tid >> 6); const int gw = bx * 8 + wave, NGW = G * 8; (void)lane; (void)gw; (void)NGW; unsigned char* ws = WSP(); (void)ws;

#ifndef SKIP_PRO
    { PH_COMMON
        pro::In I = load_in(lds); pro::Wts W;
        W.WGI = (bf16_t*)(ws + WS_WGI); W.WGO = (bf16_t*)(ws + WS_WGO); W.WKQ = (bf16_t*)(ws + WS_WKQ); W.WC1 = (bf16_t*)(ws + WS_WC1); W.WC2 = (bf16_t*)(ws + WS_WC2);
        W.WNO = (bf16_t*)(ws + WS_WNO); W.WUP = (bf16_t*)(ws + WS_WUP); W.WDN = (bf16_t*)(ws + WS_WDN); W.ROPE = (float*)(ws + WS_ROPE); W.BIASC = (float*)(ws + WS_BIASC);
#ifdef REP_PRO
        pro::prologue(I, W, (bf16_t*)(ws + WS_XB), (float*)(ws + WS_RSS), lds, gw, NGW, lane, wave); __syncthreads();
#endif
        pro::prologue(I, W, (bf16_t*)(ws + WS_XB), (float*)(ws + WS_RSS), lds, gw, NGW, lane, wave); }
#endif
    grid.sync();

#ifdef REP_SYNC
#pragma unroll 1
    for (int r = 0; r < REP_SYNC; ++r) GSYNC();
#endif
#ifndef SKIP_P1
    { unsigned char* ws = WSP();
        pg8::Gemm g = pg8::make_gemm((const bf16_t*)(ws + WS_XB), (const bf16_t*)(ws + WS_WGI), M_TOK, 3584, 1024, 1024, 1024);
        pg8::StaticOrder S; S.init(M_TOK, 3584, G, bx);
        epi::EpiGlaIn E{(bf16_t*)(ws + WS_GQ), (bf16_t*)(ws + WS_GK), (bf16_t*)(ws + WS_GV), (bf16_t*)(ws + WS_GR), (float*)(ws + WS_GG), (const float*)(ws + WS_RSS), INP(5)};
#ifdef REP_P1
        pg8::gemm_phase(lds, lds + EPI_OFF, g, S, E, NOWTID());
#endif
        pg8::gemm_phase(lds, lds + EPI_OFF, g, S, E, NOWTID());
    }
#endif
    GSYNC();
#ifndef SKIP_GLA
    { unsigned char* ws = WSP();
        float* SLOC = (float*)(ws + WS_BIG + 260 * MiB); float* DSEG = (float*)(ws + WS_BIG + 290 * MiB);
#ifdef REP_GLAA
        if ((bx & 3) < 3) gla::gla_unit<true>(bx >> 4, (bx >> 2) & 3, bx & 3, (const bf16_t*)(ws + WS_GQ), (const bf16_t*)(ws + WS_GK), (const bf16_t*)(ws + WS_GV), (bf16_t*)(ws + WS_GV), (const bf16_t*)(ws + WS_GR), (const float*)(ws + WS_GG), INP(6), SLOC, DSEG, lds, NOWTID());
#endif
        if ((bx & 3) < 3) gla::gla_unit<true>(bx >> 4, (bx >> 2) & 3, bx & 3, (const bf16_t*)(ws + WS_GQ), (const bf16_t*)(ws + WS_GK), (const bf16_t*)(ws + WS_GV), (bf16_t*)(ws + WS_GV), (const bf16_t*)(ws + WS_GR), (const float*)(ws + WS_GG), INP(6), SLOC, DSEG, lds, NOWTID());
    }
    GSYNC();
    { unsigned char* ws = WSP();
        float* SLOC = (float*)(ws + WS_BIG + 260 * MiB); float* DSEG = (float*)(ws + WS_BIG + 290 * MiB);
#ifdef REP_GLAB
        gla::gla_unit<false>(bx >> 4, (bx >> 2) & 3, bx & 3, (const bf16_t*)(ws + WS_GQ), (const bf16_t*)(ws + WS_GK), (const bf16_t*)(ws + WS_GV), (bf16_t*)(ws + WS_BIG + 300 * MiB), (const bf16_t*)(ws + WS_GR), (const float*)(ws + WS_GG), INP(6), SLOC, DSEG, lds, NOWTID());
#endif
        gla::gla_unit<false>(bx >> 4, (bx >> 2) & 3, bx & 3, (const bf16_t*)(ws + WS_GQ), (const bf16_t*)(ws + WS_GK), (const bf16_t*)(ws + WS_GV), (bf16_t*)(ws + WS_GV), (const bf16_t*)(ws + WS_GR), (const float*)(ws + WS_GG), INP(6), SLOC, DSEG, lds, NOWTID());
    }
#endif
    GSYNC();
#ifndef SKIP_P3
    { unsigned char* ws = WSP();
        pg8::Gemm g = pg8::make_gemm((const bf16_t*)(ws + WS_GV), (const bf16_t*)(ws + WS_WGO), M_TOK, 1024, 1024, 1024, 1024);
        pg8::StaticOrder S; S.init(M_TOK, 1024, G, bx);
        epi::EpiRes E{INP(0), OUTP(), (bf16_t*)(ws + WS_XB), (float*)(ws + WS_RSS) + 1 * M_TOK};
        pg8::gemm_phase(lds, lds + EPI_OFF, g, S, E, NOWTID());
    }
#endif
    GSYNC();
#pragma unroll 1
    for (int layer = 0; layer < 2; ++layer) {
        if (layer == 1) {
#ifndef SKIP_P7
            { unsigned char* ws = WSP();
                pg8::Gemm g = pg8::make_gemm((const bf16_t*)(ws + WS_XB), (const bf16_t*)(ws + WS_WKQ), M_TOK, 2816, 1024, 1024, 1024);
                pg8::StaticOrder S; S.init(M_TOK, 2816, G, bx);
                epi::EpiKvq E{(bf16_t*)(ws + WS_KV), (bf16_t*)(ws + WS_NQ), (bf16_t*)(ws + WS_NQR), (float*)(ws + WS_GATES), (const float*)(ws + WS_RSS) + 2 * M_TOK, (const float*)(ws + WS_ROPE)};
#ifdef REP_P7
                pg8::gemm_phase(lds, lds + EPI_OFF, g, S, E, NOWTID());
#endif
                pg8::gemm_phase(lds, lds + EPI_OFF, g, S, E, NOWTID());
            }
#endif
            GSYNC();
#ifndef SKIP_P8
            { unsigned char* ws = WSP();
                pg8::Gemm g = pg8::make_gemm((const bf16_t*)(ws + WS_KV), (const bf16_t*)(ws + WS_WC1), 16384, 1024, 512, 1024, 2048);
                g.a_pn = 512 * 2; g.b_pn = 512 * 2; g.b_hi = (size_t)256 * 2048 * 2; g.b_split = 32;
                pg8::StaticOrder S; S.init(16384, 1024, G, bx);
                epi::EpiCmp E{(float*)(ws + WS_HP)};
#ifdef REP_P8
                pg8::gemm_phase(lds, lds + EPI_OFF, g, S, E, NOWTID());
#endif
                pg8::gemm_phase(lds, lds + EPI_OFF, g, S, E, NOWTID());
            }
#endif
            GSYNC();
#ifndef SKIP_P9
#ifdef REP_P9
            { PH_COMMON nsa::cmp_finalize((const float*)(ws + WS_HP), (const float*)(ws + WS_BIASC), (const bf16_t*)(ws + WS_WC2), (bf16_t*)(ws + WS_KCVC), gw, NGW, lane); }
#endif
            { PH_COMMON nsa::cmp_finalize((const float*)(ws + WS_HP), (const float*)(ws + WS_BIASC), (const bf16_t*)(ws + WS_WC2), (bf16_t*)(ws + WS_KCVC), gw, NGW, lane); }
#endif
            GSYNC();
#ifndef SKIP_ATTN
            { unsigned char* ws = WSP();
                nsa::AttnBufs T{ws};
#ifdef REP_ATTN
                nsa::attn_block<REP_ATTN>(bx >> 2, bx & 3, T, lds, NOWTID());
#endif
                nsa::attn_block(bx >> 2, bx & 3, T, lds, NOWTID());
            }
#endif
            GSYNC();
#ifndef SKIP_P11
            { unsigned char* ws = WSP(); float* out = OUTP();
                pg8::Gemm g = pg8::make_gemm((const bf16_t*)(ws + WS_OATT), (const bf16_t*)(ws + WS_WNO), M_TOK, 1024, 1024, 1024, 1024);
                pg8::StaticOrder S; S.init(M_TOK, 1024, G, bx);
                epi::EpiRes E{out, out, (bf16_t*)(ws + WS_XB), (float*)(ws + WS_RSS) + 3 * M_TOK};
                pg8::gemm_phase(lds, lds + EPI_OFF, g, S, E, NOWTID());
            }
#endif
            GSYNC();
        }
#ifndef SKIP_UP
        { unsigned char* ws = WSP();
            const float* rss_in = (const float*)(ws + WS_RSS) + (layer == 0 ? 1 : 3) * M_TOK;
            const float* cw = INP(19) + (size_t)layer * 3 * 5632; const float* cb = INP(20) + (size_t)layer * 5632;
            pg8::Gemm g = pg8::make_gemm((const bf16_t*)(ws + WS_XB), (const bf16_t*)(ws + WS_WUP) + (size_t)layer * 5632 * 1024, M_TOK, 5632, 1024, 1024, 1024);
            pg8::StaticOrder S; S.init(M_TOK, 5632, G, bx);
            epi::EpiFfnUp E{(bf16_t*)(ws + WS_ACT), (float*)(ws + WS_HALO), rss_in, cw, cb};
#ifdef REP_UP
            pg8::gemm_phase(lds, lds + EPI_OFF, g, S, E, NOWTID());
#endif
#ifdef REP_UPNULL
            { epi::EpiNull EN; pg8::gemm_phase(lds, lds + EPI_OFF, g, S, EN, NOWTID()); }
#endif
            pg8::gemm_phase(lds, lds + EPI_OFF, g, S, E, NOWTID());
        }
#endif
        GSYNC();
#ifndef SKIP_FIX
        { PH_COMMON
            const float* cw = INP(19) + (size_t)layer * 3 * 5632; const float* cb = INP(20) + (size_t)layer * 5632;
            const float* HALO = (const float*)(ws + WS_HALO); bf16_t* ACT = (bf16_t*)(ws + WS_ACT);
#ifdef REP_FIX
            for (int rep_ = 0; rep_ < 2; ++rep_)
#endif
            for (int i = bx * 512 + tid; i < 128 * 2 * 2816; i += G * 512) {
                const int f = i % 2816, pr = i / 2816, r = pr & 1, pm = pr >> 1;
                if ((pm & 7) == 0) continue;
                const int pn = f >> 7, cc = f & 127;
                const float* hc = HALO + ((size_t)(pm * 22 + pn) * 4) * 256; const float* hp = HALO + ((size_t)((pm - 1) * 22 + pn) * 4) * 256;
                float ug, ug1, ug2, uv, uv1, uv2;
                if (r == 0) { ug = hc[cc]; ug1 = hp[3 * 256 + cc]; ug2 = hp[2 * 256 + cc]; uv = hc[128 + cc]; uv1 = hp[3 * 256 + 128 + cc]; uv2 = hp[2 * 256 + 128 + cc]; }
                else { ug = hc[256 + cc]; ug1 = hc[cc]; ug2 = hp[3 * 256 + cc]; uv = hc[256 + 128 + cc]; uv1 = hc[128 + cc]; uv2 = hp[3 * 256 + 128 + cc]; }
                const float og = cb[f] + cw[f] * ug2 + cw[5632 + f] * ug1 + cw[2 * 5632 + f] * ug;
                const float ov = cb[2816 + f] + cw[2816 + f] * uv2 + cw[5632 + 2816 + f] * uv1 + cw[2 * 5632 + 2816 + f] * uv;
                const float a = og * __builtin_amdgcn_rcpf(1.0f + __expf(-og)) * ov;
                ACT[(size_t)(pm * 256 + r) * 2816 + f] = (bf16_t)(pg8::cvt_pk_bf16(a, 0.f) & 0xffffu);
            }
        }
#endif
        GSYNC();
#ifndef SKIP_DOWN
        { unsigned char* ws = WSP(); float* out = OUTP();
            float* rss_out = (float*)(ws + WS_RSS) + (layer == 0 ? 2 : 4) * M_TOK;
            pg8::Gemm g = pg8::make_gemm((const bf16_t*)(ws + WS_ACT), (const bf16_t*)(ws + WS_WDN) + (size_t)layer * 1024 * 2816, M_TOK, 1024, 2816, 2816, 2816);
            pg8::StaticOrder S; S.init(M_TOK, 1024, G, bx);
            epi::EpiRes E{out, out, (bf16_t*)(ws + WS_XB), rss_out};
            pg8::gemm_phase(lds, lds + EPI_OFF, g, S, E, NOWTID());
        }
#endif
        GSYNC();
    }
    { PH_COMMON
        const float* rss = (const float*)(ws + WS_RSS) + 4 * M_TOK; float* out = OUTP(); const float* norm_final = INP(22);
        for (int m = gw; m < M_TOK; m += NGW) {
            const float rs = rsqrtf(rss[m] * (1.0f / 1024.0f) + 1e-6f);
            pro::f32x4* xr = (pro::f32x4*)(out + (size_t)m * 1024) + lane; const pro::f32x4* gr = (const pro::f32x4*)norm_final + lane;
#pragma unroll
            for (int j = 0; j < 4; ++j) { const pro::f32x4 v = xr[64 * j], gg = gr[64 * j]; xr[64 * j] = v * rs * gg; }
        }
    }
}

extern "C" void kernel_launch(void* const* d_in, const int* in_sizes, int n_in, void* d_out, int out_size, void* d_ws, size_t ws_size, hipStream_t stream) {
    static int grid = 0;
    if (grid == 0) {
        if (n_in != 23 || ws_size < WS_END) { fprintf(stderr, "kernel_launch: unexpected n_in %d or ws_size %zu (< %zu)\n", n_in, ws_size, (size_t)WS_END); grid = -1; return; }
        int dev = 0, cus = 0, per_cu = 0;
        (void)hipGetDevice(&dev);
        (void)hipDeviceGetAttribute(&cus, hipDeviceAttributeMultiprocessorCount, dev);
        (void)hipFuncSetAttribute((const void*)yoco_fwd, hipFuncAttributeMaxDynamicSharedMemorySize, LDS_BYTES);
        (void)hipOccupancyMaxActiveBlocksPerMultiprocessor(&per_cu, (const void*)yoco_fwd, 512, LDS_BYTES);
        if (per_cu < 1) { fprintf(stderr, "kernel_launch: occupancy query reports %d blocks per CU\n", per_cu); grid = -1; return; }
        grid = cus;
        if (grid > 256) grid = 256;
        grid &= ~7;
    }
    if (grid <= 0) return;
    (void)hipMemsetAsync((char*)d_ws + WS_RSS, 0, 1 * MiB, stream);
    Params p{};
    for (int i = 0; i < 23; ++i) p.in[i] = (const float*)d_in[i];
    p.out = (float*)d_out; p.ws = (unsigned char*)d_ws;
    void* args[] = {&p};
    hipError_t e = hipLaunchCooperativeKernel((void*)yoco_fwd, dim3(grid), dim3(512), args, LDS_BYTES, stream);
    if (e != hipSuccess) fprintf(stderr, "cooperative launch failed: %s (grid %d)\n", hipGetErrorString(e), grid);
}
```

```cpp
#include <hip/hip_runtime.h>
#include <hip/hip_cooperative_groups.h>
#include <cstdio>
#include <cstdint>
constexpr size_t MiB = 1u << 20;
constexpr int M_TOK = 32768;
constexpr size_t WS_RSS = 0;
constexpr size_t WS_BAR = 768 * 1024;
constexpr size_t WS_ROPE = 1 * MiB, WS_BIASC = 800 * 1024;
constexpr size_t WS_WGI = 2 * MiB, WS_WGO = 9 * MiB, WS_WKQ = 11 * MiB, WS_WC1 = 17 * MiB, WS_WC2 = 19 * MiB, WS_WNO = 20 * MiB, WS_WUP = 22 * MiB, WS_WDN = 44 * MiB;
constexpr size_t WS_XB = 56 * MiB;
constexpr size_t WS_BIG = 120 * MiB;
constexpr size_t WS_GQ = WS_BIG, WS_GK = WS_BIG + 32 * MiB, WS_GV = WS_BIG + 64 * MiB, WS_GR = WS_BIG + 128 * MiB, WS_GG = WS_BIG + 192 * MiB;
constexpr size_t WS_ACT = WS_BIG, WS_HALO = WS_BIG + 176 * MiB;
constexpr size_t WS_KV = WS_BIG, WS_NQ = WS_BIG + 96 * MiB, WS_NQR = WS_BIG + 160 * MiB, WS_GATES = WS_BIG + 224 * MiB, WS_HP = WS_BIG + 230 * MiB, WS_KCVC = WS_BIG + 294 * MiB, WS_OATT = WS_BIG + 296 * MiB;
constexpr size_t WS_END = WS_BIG + 376 * MiB;
constexpr int LDS_BYTES = 160 * 1024, EPI_OFF = 131072;


#define LAS __attribute__((address_space(3)))
#define XB_TMO      128
#define XB_XCNT(j)  (256  + 64 * (j))
#define XB_XSUB(j)  (1280 + 64 * (j))
#define XB_XGEN(j)  (2304 + 64 * (j))
#define XB_TOP      3328
#define XB_TOPGEN   3392
#define XCD_BAR_WORDS 3456
#define XB_SPIN_CAP (1u << 18)

__device__ __forceinline__ unsigned xb_ld(unsigned* p)              { return __hip_atomic_load(p, __ATOMIC_RELAXED, __HIP_MEMORY_SCOPE_AGENT); }
__device__ __forceinline__ unsigned xb_add(unsigned* p, unsigned v) { return __hip_atomic_fetch_add(p, v, __ATOMIC_RELAXED, __HIP_MEMORY_SCOPE_AGENT); }
__device__ __forceinline__ unsigned xb_xcc_id() { return (unsigned)__builtin_amdgcn_s_getreg((3 << 11) | 20) & 0xFu; }
#define XB_SPIN(cond, bar) do { unsigned _sp = 0; while (cond) { __builtin_amdgcn_s_sleep(1); \
    if ((++_sp & 255u) == 0u) { if (xb_ld(&(bar)[XB_TMO])) break; if (_sp > XB_SPIN_CAP) { atomicAdd(&(bar)[XB_TMO], 1u); break; } } } } while (0)

struct XcdBarrier {
    unsigned* bar; unsigned x;
    volatile LAS unsigned* st;
};

__device__ __forceinline__ XcdBarrier xcd_barrier_post(unsigned* bar, volatile LAS unsigned* st, int tid) {
    XcdBarrier b; b.bar = bar; b.x = xb_xcc_id(); b.st = st;
    if (tid == 0) (void)xb_add(&bar[XB_XCNT(b.x)], 1u);
    return b;
}
__device__ __forceinline__ void xcd_barrier_complete(unsigned* bar, unsigned x, unsigned& nloc, unsigned& nx) {
    const unsigned G = gridDim.x * gridDim.y * gridDim.z;
    unsigned sum, cnt, mine, sp = 0u;
    for (;;) {
        sum = 0u; cnt = 0u; mine = 0u;
#pragma unroll
        for (unsigned j = 0; j < 16; ++j) { const unsigned c = xb_ld(&bar[XB_XCNT(j)]); sum += c; cnt += (c > 0u) ? 1u : 0u; mine = (j == x) ? c : mine; }
        if (sum == G) break;
        __builtin_amdgcn_s_sleep(1);
        if ((++sp & 255u) == 0u) { if (xb_ld(&bar[XB_TMO])) break; if (sp > XB_SPIN_CAP) { atomicAdd(&bar[XB_TMO], 1u); break; } }
    }
    nloc = mine > 0u ? mine : 1u; nx = cnt > 0u ? cnt : 1u;
}

__device__ __forceinline__ void xcd_barrier(const XcdBarrier& b, int tid) {
    asm volatile("s_waitcnt vmcnt(0)" ::: "memory");
    __syncthreads();
    if (tid == 0) {
        unsigned* bar = b.bar;
        __builtin_amdgcn_s_waitcnt(0);
        unsigned nloc = b.st[0], nx = b.st[1];
        if (nloc == 0u) { xcd_barrier_complete(bar, b.x, nloc, nx); b.st[0] = nloc; b.st[1] = nx; }
        const unsigned old = xb_add(&bar[XB_XSUB(b.x)], 1u);
        const unsigned gen = old / nloc;
        if (old + 1u == (gen + 1u) * nloc) {
            __builtin_amdgcn_fence(__ATOMIC_RELEASE, "agent");
            asm volatile("s_waitcnt vmcnt(0)" ::: "memory");
            const unsigned og = xb_add(&bar[XB_TOP], 1u);
            const unsigned tg = og / nx;
            if (og + 1u == (tg + 1u) * nx) xb_add(&bar[XB_TOPGEN], 1u);
            else XB_SPIN(xb_ld(&bar[XB_TOPGEN]) == tg, bar);
            __builtin_amdgcn_fence(__ATOMIC_ACQUIRE, "agent");
            xb_add(&bar[XB_XGEN(b.x)], 1u);
            asm volatile("s_waitcnt vmcnt(0)" ::: "memory");
        } else {
            XB_SPIN(xb_ld(&bar[XB_XGEN(b.x)]) == gen, bar);
            __builtin_amdgcn_fence(__ATOMIC_ACQUIRE, "agent");
            asm volatile("s_waitcnt vmcnt(0)" ::: "memory");
        }
    }
    __syncthreads();
}

__device__ __forceinline__ int lane_id() { return (int)__builtin_amdgcn_mbcnt_hi(~0u, __builtin_amdgcn_mbcnt_lo(~0u, 0u)); }
template <class T> __device__ __forceinline__ T dpp_xor1(T x) { return __builtin_bit_cast(T, __builtin_amdgcn_mov_dpp(__builtin_bit_cast(int, x), 0xB1, 0xf, 0xf, true)); }
template <class T> __device__ __forceinline__ T dpp_xor2(T x) { return __builtin_bit_cast(T, __builtin_amdgcn_mov_dpp(__builtin_bit_cast(int, x), 0x4E, 0xf, 0xf, true)); }
template <class T> __device__ __forceinline__ T dpp_hmirror(T x) { return __builtin_bit_cast(T, __builtin_amdgcn_mov_dpp(__builtin_bit_cast(int, x), 0x141, 0xf, 0xf, true)); }
template <class T> __device__ __forceinline__ T swz_xor16(T x) { return __builtin_bit_cast(T, __builtin_amdgcn_ds_swizzle(__builtin_bit_cast(int, x), 0x401F)); }
namespace pg8 {
#define PG8_LAS __attribute__((address_space(3)))
typedef unsigned short bf16_t;
typedef short bf16x8 __attribute__((ext_vector_type(8)));
typedef float f32x4 __attribute__((ext_vector_type(4)));
typedef float f32x2 __attribute__((ext_vector_type(2)));
typedef unsigned u32x4 __attribute__((ext_vector_type(4)));
typedef unsigned u32x2 __attribute__((ext_vector_type(2)));
constexpr int BM = 256, BK = 64, HALF = 128, HTB = HALF * BK * 2, STAGE_BYTES = 8 * HTB, NXCD = 8, WGM = 8;

__host__ __device__ __forceinline__ int lds_byte(int r, int c) { const int st = (r >> 4) * 2 + (c >> 5), rr = r & 15, cc = c & 31, ob = rr * 64 + cc * 2; return st * 1024 + (ob ^ (((ob >> 9) & 1) << 5)); }
__host__ __device__ __forceinline__ void stage_rc(int b, int& R, int& C) { const int st = b / 1024, sb = b % 1024, swz = sb ^ (((sb >> 9) & 1) << 5); R = (st >> 1) * 16 + swz / 64; C = (st & 1) * 32 + (swz % 64) / 2; }
__host__ __device__ __forceinline__ int perm32(int rho) { const int n = rho >> 4, i = rho & 15; return 8 * (i >> 2) + 4 * n + (i & 3); }

struct Unit { int pm, pn; };
struct Gemm { const bf16_t* A; const bf16_t* Bt; int M, N, K; int lda, ldb; size_t a_pm, a_pn, b_pn, b_hi; int b_split; };
__device__ __forceinline__ Gemm make_gemm(const bf16_t* A, const bf16_t* Bt, int M, int N, int K, int lda, int ldb) {
    Gemm g; g.A = A; g.Bt = Bt; g.M = M; g.N = N; g.K = K; g.lda = lda; g.ldb = ldb;
    g.a_pm = (size_t)BM * lda * 2; g.a_pn = 0; g.b_pn = (size_t)BM * ldb * 2; g.b_hi = 0; g.b_split = 0x7fffffff; return g;
}

struct StaticOrder {
    int nM, nN, nwg, G, c;
    __device__ void init(int M, int N, int G_, int c_) { nM = M / BM; nN = N / BM; nwg = nM * nN; G = G_; c = c_; }
    __device__ bool next(int i, Unit& u) const {
        const long L = (long)i * G + c; if (L >= nwg) return false;
        int wgid = (int)L; { const int q = nwg / NXCD, r = nwg % NXCD, xcd = wgid % NXCD, off = wgid / NXCD; wgid = (xcd < r ? xcd * (q + 1) : r * (q + 1) + (xcd - r) * q) + off; }
        const int nig = WGM * nN, gid = wgid / nig, fm = gid * WGM, gsz = (nM - fm) < WGM ? (nM - fm) : WGM;
        u.pm = fm + ((wgid % nig) % gsz); u.pn = (wgid % nig) / gsz; return true;
    }
};

__device__ __forceinline__ unsigned cvt_pk_bf16(float lo, float hi) {
    typedef __bf16 bf16x2_t __attribute__((ext_vector_type(2)));
    f32x2 v = {lo, hi}; bf16x2_t b = __builtin_convertvector(v, bf16x2_t); return __builtin_bit_cast(unsigned, b);
}

template <class Epi>
__device__ __forceinline__ void gemm_phase(PG8_LAS unsigned char* lds, PG8_LAS unsigned char* lds_epi, const Gemm g, const StaticOrder& S, const Epi& E, int tid0) {
    int tid_ = tid0; asm volatile("" : "+v"(tid_));
    const int tid = tid_, wid = __builtin_amdgcn_readfirstlane(tid >> 6), lane = tid & 63, wr = wid >> 2, wc = wid & 3, fr = lane & 15, fq = lane >> 4;
    const int K = g.K, nt = K / BK;
    unsigned voffA[2], voffB[2];
#pragma unroll
    for (int i = 0; i < 2; ++i) { int R, C; stage_rc(tid * 16 + i * 8192, R, C); const int Rb = (R & ~31) + perm32(R & 31);
        voffA[i] = (unsigned)(R * g.lda + C) * 2u; voffB[i] = (unsigned)(Rb * g.ldb + C) * 2u; }
    const size_t kstep = (size_t)(BK * 2);
    const size_t hstepA = (size_t)HALF * g.lda * 2, hstepB = (size_t)HALF * g.ldb * 2;
    const unsigned ldsw = (unsigned)wid * 1024u;
    const int aoff = lds_byte(wr * 64 + fr, fq * 8), boff = lds_byte(wc * 32 + fr, fq * 8);
#define PG8_SA(b, h) (((b) * 2 + (h)) * HTB)
#define PG8_SB(b, h) ((4 + (b) * 2 + (h)) * HTB)
#define PG8_STAGE(bufoff, gbase, voff) do { _Pragma("unroll") for (int _i = 0; _i < 2; ++_i) \
        __builtin_amdgcn_global_load_lds((const unsigned*)((const char*)(gbase) + (voff)[_i]), (PG8_LAS unsigned*)(lds + (bufoff) + ldsw + _i * 8192), 16, 0, 0); } while (0)
#define PG8_LDA(dst, b, h) do { _Pragma("unroll") for (int m = 0; m < 4; ++m) _Pragma("unroll") for (int k = 0; k < 2; ++k) dst[m][k] = *(const PG8_LAS bf16x8*)(lds + PG8_SA(b, h) + aoff + m * 2048 + k * 1024); } while (0)
#define PG8_LDB(dst, b, h) do { _Pragma("unroll") for (int n = 0; n < 2; ++n) _Pragma("unroll") for (int k = 0; k < 2; ++k) dst[n][k] = *(const PG8_LAS bf16x8*)(lds + PG8_SB(b, h) + boff + n * 2048 + k * 1024); } while (0)
#define PG8_MMA(ai, bj, At, Bt) do { __builtin_amdgcn_s_setprio(1); _Pragma("unroll") for (int m = 0; m < 4; ++m) _Pragma("unroll") for (int n = 0; n < 2; ++n) _Pragma("unroll") for (int k = 0; k < 2; ++k) \
        acc[ai][bj][m][n] = __builtin_amdgcn_mfma_f32_16x16x32_bf16(Bt[n][k], At[m][k], acc[ai][bj][m][n], 0, 0, 0); __builtin_amdgcn_s_setprio(0); } while (0)
#define PG8_WAIT_V(n) asm volatile("s_waitcnt vmcnt(" #n ")" ::: "memory")
#define PG8_WAIT_L(n) asm volatile("s_waitcnt lgkmcnt(" #n ")" ::: "memory")
#define PG8_BAR __builtin_amdgcn_s_barrier()
#define PG8_SCHED __builtin_amdgcn_sched_barrier(0)
    Unit cur, nxt; int ui = 0;
    if (!S.next(0, cur)) return;
    f32x4 acc[2][2][4][2];
#pragma unroll
    for (int a = 0; a < 2; ++a)
#pragma unroll
        for (int b = 0; b < 2; ++b)
#pragma unroll
            for (int m = 0; m < 4; ++m)
#pragma unroll
                for (int n = 0; n < 2; ++n) acc[a][b][m][n] = (f32x4){0.f, 0.f, 0.f, 0.f};
    bf16x8 At[4][2], B0[2][2], B1[2][2];
    const char* cA = (const char*)g.A + (size_t)cur.pm * g.a_pm + (size_t)cur.pn * g.a_pn;
    const char* cB = (const char*)g.Bt + (size_t)cur.pn * g.b_pn + (cur.pm >= g.b_split ? g.b_hi : (size_t)0);
    PG8_STAGE(PG8_SB(0, 0), cB, voffB); PG8_STAGE(PG8_SB(0, 1), cB + hstepB, voffB); PG8_STAGE(PG8_SA(0, 0), cA, voffA); PG8_STAGE(PG8_SA(0, 1), cA + hstepA, voffA);
    if (wr == 1) PG8_BAR;
    PG8_WAIT_V(2); PG8_BAR;
    PG8_STAGE(PG8_SB(1, 0), cB + kstep, voffB); PG8_STAGE(PG8_SA(1, 0), cA + kstep, voffA); PG8_STAGE(PG8_SB(1, 1), cB + hstepB + kstep, voffB);
    PG8_WAIT_V(6); PG8_BAR;
    for (;;) {
        const bool has_next = S.next(ui + 1, nxt);
        const char* nA = has_next ? (const char*)g.A + (size_t)nxt.pm * g.a_pm + (size_t)nxt.pn * g.a_pn : cA;
        const char* nB = has_next ? (const char*)g.Bt + (size_t)nxt.pn * g.b_pn + (nxt.pm >= g.b_split ? g.b_hi : (size_t)0) : cB;
        E.prefetch(cur, ui, lds_epi, wid, lane);
        for (int t = 0; t < nt; t += 2) {
            const bool last = (t == nt - 2);
            const char* a1 = cA + (size_t)(t + 1) * kstep;
            const char* a2 = last ? nA : cA + (size_t)(t + 2) * kstep; const char* b2 = last ? nB : cB + (size_t)(t + 2) * kstep;
            const char* a3 = a2 + kstep; const char* b3 = b2 + kstep;
            PG8_LDB(B0, 0, 0); PG8_LDB(B1, 0, 1); PG8_SCHED; PG8_LDA(At, 0, 0); PG8_STAGE(PG8_SA(1, 1), a1 + hstepA, voffA);
            PG8_WAIT_V(8); PG8_WAIT_L(0); PG8_BAR; PG8_MMA(0, 0, At, B0); PG8_MMA(0, 1, At, B1); PG8_BAR; PG8_SCHED;
            PG8_LDA(At, 0, 1); PG8_STAGE(PG8_SB(0, 0), b2, voffB); PG8_STAGE(PG8_SB(0, 1), b2 + hstepB, voffB); PG8_STAGE(PG8_SA(0, 0), a2, voffA);
            PG8_WAIT_V(8); PG8_WAIT_L(0); PG8_BAR; PG8_MMA(1, 0, At, B0); PG8_MMA(1, 1, At, B1); PG8_BAR; PG8_SCHED;
            PG8_LDB(B0, 1, 0); PG8_LDB(B1, 1, 1); PG8_SCHED; PG8_LDA(At, 1, 0); PG8_STAGE(PG8_SA(0, 1), a2 + hstepA, voffA);
            PG8_WAIT_V(8); PG8_WAIT_L(0); PG8_BAR; PG8_MMA(0, 0, At, B0); PG8_MMA(0, 1, At, B1); PG8_BAR; PG8_SCHED;
            PG8_LDA(At, 1, 1); PG8_STAGE(PG8_SB(1, 0), b3, voffB); PG8_STAGE(PG8_SB(1, 1), b3 + hstepB, voffB); PG8_STAGE(PG8_SA(1, 0), a3, voffA);
            PG8_WAIT_V(8); PG8_WAIT_L(0); PG8_BAR; PG8_MMA(1, 0, At, B0); PG8_MMA(1, 1, At, B1); PG8_BAR; PG8_SCHED;
        }
        if (wr == 0) PG8_BAR;
        E(acc, cur, ui, wr, wc, fr, fq, lds_epi);
        if (!has_next) break;
#pragma unroll
        for (int a = 0; a < 2; ++a)
#pragma unroll
            for (int b = 0; b < 2; ++b)
#pragma unroll
                for (int m = 0; m < 4; ++m)
#pragma unroll
                    for (int n = 0; n < 2; ++n) acc[a][b][m][n] = (f32x4){0.f, 0.f, 0.f, 0.f};
        cur = nxt; cA = nA; cB = nB; ++ui;
        if (wr == 1) PG8_BAR;
    }
    PG8_WAIT_V(0);
    PG8_BAR;
#undef PG8_SA
#undef PG8_SB
#undef PG8_STAGE
#undef PG8_LDA
#undef PG8_LDB
#undef PG8_MMA
#undef PG8_WAIT_V
#undef PG8_WAIT_L
#undef PG8_BAR
#undef PG8_SCHED
}
}
namespace epi {
using namespace pg8;
constexpr float EPS = 1e-6f;
__device__ __forceinline__ float rstd_of(float ss) { return rsqrtf(ss * (1.0f / 1024.0f) + EPS); }
__device__ __forceinline__ float sigmoidf_(float x) { return __builtin_amdgcn_rcpf(1.0f + __expf(-x)); }
__device__ __forceinline__ float siluf_(float x) { return x * __builtin_amdgcn_rcpf(1.0f + __expf(-x)); }
__device__ __forceinline__ u32x4 pack8(const f32x4& a, const f32x4& b) { u32x4 w; w.x = cvt_pk_bf16(a[0], a[1]); w.y = cvt_pk_bf16(a[2], a[3]); w.z = cvt_pk_bf16(b[0], b[1]); w.w = cvt_pk_bf16(b[2], b[3]); return w; }

constexpr int EC_OFF = 16384, EC_STRIDE = 6144;
__device__ __forceinline__ void dma16(const void* g, PG8_LAS unsigned char* l) { __builtin_amdgcn_global_load_lds((const unsigned*)g, (PG8_LAS unsigned*)l, 16, 0, 0); }
__device__ __forceinline__ void dma_rss(const float* rss, int pm, int ui, PG8_LAS unsigned char* le, int wid, int lane) {
    if (wid == 0) dma16(rss + pm * BM + 4 * lane, le + EC_OFF + (ui & 1) * EC_STRIDE);
}
struct EpiGlaIn {
    bf16_t* Q; bf16_t* Kk; bf16_t* V; bf16_t* R; float* G; const float* rss; const float* b_alpha;
    __device__ __forceinline__ void prefetch(const Unit& u, int ui, PG8_LAS unsigned char* le, int wid, int lane) const { dma_rss(rss, u.pm, ui, le, wid, lane); }
    __device__ __forceinline__ void operator()(f32x4 (&acc)[2][2][4][2], const Unit& u, int ui, int wr, int wc, int fr, int fq, PG8_LAS unsigned char* le) const {
        asm volatile("" : "+v"(fr), "+v"(fq));
        const int pn = u.pn;
        const int row0 = u.pm * BM + wr * 64 + fr;
        const int ct = wc * 32 + 8 * fq;
#pragma unroll
        for (int ai = 0; ai < 2; ++ai)
#pragma unroll
            for (int m = 0; m < 4; ++m) {
                const int row = row0 + ai * HALF + m * 16;
                const float rs = rstd_of(((const PG8_LAS float*)(le + EC_OFF + (ui & 1) * EC_STRIDE))[wr * 64 + fr + ai * HALF + m * 16]);
#pragma unroll
                for (int bj = 0; bj < 2; ++bj) {
                    f32x4 v0 = acc[ai][bj][m][0] * rs, v1 = acc[ai][bj][m][1] * rs;
                    const int c = bj * HALF + ct;
                    if (pn < 2) { const float sc = 0.08838834764831845f; *(u32x4*)(Q + (size_t)row * 512 + pn * 256 + c) = pack8(v0 * sc, v1 * sc); }
                    else if (pn < 4) { *(u32x4*)(Kk + (size_t)row * 512 + (pn - 2) * 256 + c) = pack8(v0, v1); }
                    else if (pn < 8) { *(u32x4*)(V + (size_t)row * 1024 + (pn - 4) * 256 + c) = pack8(v0, v1); }
                    else if (pn < 12) {
#pragma unroll
                        for (int j = 0; j < 4; ++j) { v0[j] = siluf_(v0[j]); v1[j] = siluf_(v1[j]); }
                        *(u32x4*)(R + (size_t)row * 1024 + (pn - 8) * 256 + c) = pack8(v0, v1); }
                    else {
                        const int gc = (pn - 12) * 256 + c;
                        const f32x4 b0 = *(const f32x4*)(b_alpha + gc), b1 = *(const f32x4*)(b_alpha + gc + 4);
                        f32x4 o0, o1;
#pragma unroll
                        for (int j = 0; j < 4; ++j) {
                            const float z0 = v0[j] + b0[j], z1 = v1[j] + b1[j];
                            o0[j] = (fminf(z0, 0.f) - __logf(1.0f + __expf(-fabsf(z0)))) * 0.0625f;
                            o1[j] = (fminf(z1, 0.f) - __logf(1.0f + __expf(-fabsf(z1)))) * 0.0625f; }
                        *(f32x4*)(G + (size_t)row * 512 + gc) = o0; *(f32x4*)(G + (size_t)row * 512 + gc + 4) = o1; }
                }
            }
    }
};

struct EpiRes {
    const float* xin; float* xout; bf16_t* XB; float* rss;
    __device__ __forceinline__ void prefetch(const Unit&, int, PG8_LAS unsigned char*, int, int) const {}
    __device__ __forceinline__ void operator()(f32x4 (&acc)[2][2][4][2], const Unit& u, int ui, int wr, int wc, int fr, int fq, PG8_LAS unsigned char* le) const {
        asm volatile("" : "+v"(fr), "+v"(fq));
        const int row0 = u.pm * BM + wr * 64 + fr;
        const int col0 = u.pn * BM + wc * 32 + 8 * fq;
#pragma unroll
        for (int ai = 0; ai < 2; ++ai)
#pragma unroll
            for (int m = 0; m < 4; ++m) {
                const int row = row0 + ai * HALF + m * 16;
                float ss = 0.f;
#pragma unroll
                for (int bj = 0; bj < 2; ++bj) {
                    const size_t off = (size_t)row * 1024 + col0 + bj * HALF;
                    const f32x4 x0 = *(const f32x4*)(xin + off), x1 = *(const f32x4*)(xin + off + 4);
                    const f32x4 v0 = x0 + acc[ai][bj][m][0], v1 = x1 + acc[ai][bj][m][1];
                    *(f32x4*)(xout + off) = v0; *(f32x4*)(xout + off + 4) = v1;
                    *(u32x4*)(XB + off) = pack8(v0, v1);
                    ss += (v0[0] * v0[0] + v0[1] * v0[1]) + (v0[2] * v0[2] + v0[3] * v0[3]) + (v1[0] * v1[0] + v1[1] * v1[1]) + (v1[2] * v1[2] + v1[3] * v1[3]);
                }
                ss += swz_xor16(ss); { auto rr_ = __builtin_amdgcn_permlane32_swap(__float_as_uint(ss), __float_as_uint(ss), false, false); ss = __uint_as_float(rr_[0]) + __uint_as_float(rr_[1]); }
                if (fq == 0) atomicAdd(rss + row, ss);
            }
    }
};

__device__ __forceinline__ float dpp_ror1(float x) { return __builtin_bit_cast(float, __builtin_amdgcn_mov_dpp(__builtin_bit_cast(int, x), 0x121, 0xf, 0xf, true)); }
__device__ __forceinline__ float dpp_ror2(float x) { return __builtin_bit_cast(float, __builtin_amdgcn_mov_dpp(__builtin_bit_cast(int, x), 0x122, 0xf, 0xf, true)); }
constexpr int FF = 2816;
struct EpiFfnUp {
    bf16_t* ACT; float* HALO; const float* rss; const float* cw; const float* cb;
    __device__ __forceinline__ void prefetch(const Unit& u, int ui, PG8_LAS unsigned char* le, int wid, int lane) const {
        dma_rss(rss, u.pm, ui, le, wid, lane);
        if (wid >= 1 && wid <= 4) { const int k = wid - 1; const float* src = (k == 0 ? cb : cw + (k - 1) * 2 * FF) + u.pn * 128 + ((lane < 32) ? 4 * lane : FF + 4 * (lane - 32));
            dma16(src, le + EC_OFF + (ui & 1) * EC_STRIDE + 1024 + k * 1024); }
    }
    __device__ __forceinline__ void operator()(f32x4 (&acc)[2][2][4][2], const Unit& u, int ui, int wr, int wc, int fr, int fq, PG8_LAS unsigned char* le) const {
        asm volatile("" : "+v"(fr), "+v"(fq));
        const int row0 = u.pm * BM + wr * 64 + fr;
        const PG8_LAS float* EC = (const PG8_LAS float*)(le + EC_OFF + (ui & 1) * EC_STRIDE);
#pragma unroll
        for (int ai = 0; ai < 2; ++ai)
#pragma unroll
            for (int m = 0; m < 4; ++m) {
                const float rs = rstd_of(EC[wr * 64 + fr + ai * HALF + m * 16]);
#pragma unroll
                for (int bj = 0; bj < 2; ++bj) { acc[ai][bj][m][0] = acc[ai][bj][m][0] * rs; acc[ai][bj][m][1] = acc[ai][bj][m][1] * rs; }
            }
        PG8_LAS float* HL = (PG8_LAS float*)le + (ui & 1) * 2048;
        if (fr >= 14) {
#pragma unroll
            for (int ai = 0; ai < 2; ++ai)
#pragma unroll
                for (int bj = 0; bj < 2; ++bj)
#pragma unroll
                    for (int n = 0; n < 2; ++n)
                        *(PG8_LAS f32x4*)(HL + ((((wr * 4 + wc) * 2 + ai) * 2 + (fr - 14)) * 64) + bj * 32 + fq * 8 + n * 4) = acc[ai][bj][3][n];
        }
        {
            float* hb = HALO + ((size_t)(u.pm * 22 + u.pn) * 4) * 256 + wc * 32 + fq * 8;
            if (wr == 0 && fr < 2) {
#pragma unroll
                for (int bj = 0; bj < 2; ++bj)
#pragma unroll
                    for (int n = 0; n < 2; ++n) *(f32x4*)(hb + fr * 256 + bj * HALF + n * 4) = acc[0][bj][0][n];
            }
            if (wr == 1 && fr >= 14) {
#pragma unroll
                for (int bj = 0; bj < 2; ++bj)
#pragma unroll
                    for (int n = 0; n < 2; ++n) *(f32x4*)(hb + (fr - 12) * 256 + bj * HALF + n * 4) = acc[1][bj][3][n];
            }
        }
        asm volatile("s_waitcnt lgkmcnt(0)" ::: "memory"); __builtin_amdgcn_s_barrier(); asm volatile("" ::: "memory");
        const bool seq_start = (u.pm & 7) == 0;
        const int cc0 = wc * 32 + fq * 8;
        const bool is15 = (fr == 15), ge14 = (fr >= 14);
        const PG8_LAS float* WB = EC + 256 + cc0;
#pragma unroll
        for (int ai = 0; ai < 2; ++ai) {
            f32x4 pg[2], pv[2];
            if (ai == 0 && wr == 0) { pg[0] = pg[1] = pv[0] = pv[1] = (f32x4){0.f, 0.f, 0.f, 0.f}; }
            else {
                const int swr = (ai == 1 && wr == 1) ? 0 : (ai == 0 ? 0 : 1), sai = (ai == 1 && wr == 1) ? 1 : 0;
                const PG8_LAS float* hp = HL + (((swr * 4 + wc) * 2 + sai) * 2 + (is15 ? 1 : 0)) * 64 + fq * 8;
                pg[0] = *(const PG8_LAS f32x4*)(hp); pg[1] = *(const PG8_LAS f32x4*)(hp + 4); pv[0] = *(const PG8_LAS f32x4*)(hp + 32); pv[1] = *(const PG8_LAS f32x4*)(hp + 36);
            }
#pragma unroll
            for (int m = 0; m < 4; ++m) {
                const int row = row0 + ai * HALF + m * 16;
                u32x4 w;
#pragma unroll
                for (int n = 0; n < 2; ++n) {
                    const f32x4 bg = *(const PG8_LAS f32x4*)(WB + 4 * n), bv = *(const PG8_LAS f32x4*)(WB + 128 + 4 * n);
                    const f32x4 g0 = *(const PG8_LAS f32x4*)(WB + 256 + 4 * n), w0 = *(const PG8_LAS f32x4*)(WB + 256 + 128 + 4 * n);
                    const f32x4 g1 = *(const PG8_LAS f32x4*)(WB + 512 + 4 * n), w1 = *(const PG8_LAS f32x4*)(WB + 512 + 128 + 4 * n);
                    const f32x4 g2 = *(const PG8_LAS f32x4*)(WB + 768 + 4 * n), w2 = *(const PG8_LAS f32x4*)(WB + 768 + 128 + 4 * n);
                    const f32x4 xg = acc[ai][0][m][n], xv = acc[ai][1][m][n];
                    f32x4 g1s, g2s, v1s, v2s;
#pragma unroll
                    for (int j = 0; j < 4; ++j) {
                        g1s[j] = dpp_ror1(is15 ? pg[n][j] : xg[j]); g2s[j] = dpp_ror2(ge14 ? pg[n][j] : xg[j]);
                        v1s[j] = dpp_ror1(is15 ? pv[n][j] : xv[j]); v2s[j] = dpp_ror2(ge14 ? pv[n][j] : xv[j]);
                    }
                    const f32x4 og = bg + g0 * g2s + g1 * g1s + g2 * xg;
                    const f32x4 ov = bv + w0 * v2s + w1 * v1s + w2 * xv;
                    f32x4 e;
#pragma unroll
                    for (int j = 0; j < 4; ++j) e[j] = __builtin_amdgcn_rcpf(1.0f + __builtin_amdgcn_exp2f(og[j] * -1.4426950408889634f));
                    const f32x4 a = og * e * ov;
                    if (n == 0) { w.x = cvt_pk_bf16(a[0], a[1]); w.y = cvt_pk_bf16(a[2], a[3]); } else { w.z = cvt_pk_bf16(a[0], a[1]); w.w = cvt_pk_bf16(a[2], a[3]); }
                    pg[n] = xg; pv[n] = xv;
                }
                const bool skip = (ai == 0 && wr == 0 && m == 0 && fr < 2 && !seq_start);
                if (!skip) *(u32x4*)(ACT + (size_t)row * FF + u.pn * 128 + cc0) = w;
            }
        }
    }
};

struct EpiKvq {
    bf16_t* KV; bf16_t* Q; bf16_t* QR; float* GATES; const float* rss; const float* rope;
    __device__ __forceinline__ void prefetch(const Unit& u, int ui, PG8_LAS unsigned char* le, int wid, int lane) const { dma_rss(rss, u.pm, ui, le, wid, lane); }
    __device__ __forceinline__ void operator()(f32x4 (&acc)[2][2][4][2], const Unit& u, int ui, int wr, int wc, int fr, int fq, PG8_LAS unsigned char* le) const {
        asm volatile("" : "+v"(fr), "+v"(fq));
        const int pn = u.pn;
        const int row0 = u.pm * BM + wr * 64 + fr;
        const float C2 = 0.125f * 1.4426950408889634f;
#pragma unroll
        for (int ai = 0; ai < 2; ++ai)
#pragma unroll
            for (int m = 0; m < 4; ++m) {
                const int row = row0 + ai * HALF + m * 16;
                const int b = row >> 11, s = row & 2047;
                const float rs = rstd_of(((const PG8_LAS float*)(le + EC_OFF + (ui & 1) * EC_STRIDE))[wr * 64 + fr + ai * HALF + m * 16]);
                f32x4 lo0 = acc[ai][0][m][0] * rs, lo1 = acc[ai][0][m][1] * rs;
                f32x4 hi0 = acc[ai][1][m][0] * rs, hi1 = acc[ai][1][m][1] * rs;
                if (pn == 10) {
                    if (wc == 0) {
                        float* gp = GATES + (size_t)row * 48 + 8 * fq;
#pragma unroll
                        for (int j = 0; j < 4; ++j) { lo0[j] = sigmoidf_(lo0[j]); lo1[j] = sigmoidf_(lo1[j]); hi0[j] = sigmoidf_(hi0[j]); hi1[j] = sigmoidf_(hi1[j]); }
                        *(f32x4*)(gp) = lo0; *(f32x4*)(gp + 4) = lo1;
                        if (fq < 2) { *(f32x4*)(gp + 32) = hi0; *(f32x4*)(gp + 36) = hi1; }
                    }
                    continue;
                }
                const bool isq = pn >= 6;
                const bool dorope = isq || pn == 2 || pn == 4;
                f32x4 rl0 = lo0, rl1 = lo1, rh0 = hi0, rh1 = hi1;
                if (dorope) {
                    const float* rp = rope + ((size_t)s * 32 + 8 * fq) * 2;
                    const f32x4 t0 = *(const f32x4*)(rp), t1 = *(const f32x4*)(rp + 4), t2 = *(const f32x4*)(rp + 8), t3 = *(const f32x4*)(rp + 12);
                    const float cs[8] = {t0[0], t0[2], t1[0], t1[2], t2[0], t2[2], t3[0], t3[2]};
                    const float sn[8] = {t0[1], t0[3], t1[1], t1[3], t2[1], t2[3], t3[1], t3[3]};
#pragma unroll
                    for (int j = 0; j < 4; ++j) {
                        rl0[j] = lo0[j] * cs[j] - hi0[j] * sn[j]; rh0[j] = lo0[j] * sn[j] + hi0[j] * cs[j];
                        rl1[j] = lo1[j] * cs[4 + j] - hi1[j] * sn[4 + j]; rh1[j] = lo1[j] * sn[4 + j] + hi1[j] * cs[4 + j];
                    }
                }
                if (!isq) {
                    bf16_t* p = KV + ((((size_t)pn * 16 + b) * 4 + wc) * 2048 + s) * 64 + 8 * fq;
                    *(u32x4*)(p) = pack8(rl0, rl1); *(u32x4*)(p + 32) = pack8(rh0, rh1);
                } else {
                    const int h = (pn - 6) * 4 + wc;
                    const size_t o = (((size_t)b * 16 + h) * 2048 + s) * 64 + 8 * fq;
                    *(u32x4*)(Q + o) = pack8(lo0 * C2, lo1 * C2); *(u32x4*)(Q + o + 32) = pack8(hi0 * C2, hi1 * C2);
                    *(u32x4*)(QR + o) = pack8(rl0 * C2, rl1 * C2); *(u32x4*)(QR + o + 32) = pack8(rh0 * C2, rh1 * C2);
                }
            }
    }
};

struct EpiCmp {
    float* HP;
    __device__ __forceinline__ void prefetch(const Unit&, int, PG8_LAS unsigned char*, int, int) const {}
    __device__ __forceinline__ void operator()(f32x4 (&acc)[2][2][4][2], const Unit& u, int ui, int wr, int wc, int fr, int fq, PG8_LAS unsigned char* le) const {
        asm volatile("" : "+v"(fr), "+v"(fq));
        const int row0 = u.pm * BM + wr * 64 + fr;
        float* base = HP + (size_t)u.pn * 16384 * 256;
#pragma unroll
        for (int ai = 0; ai < 2; ++ai)
#pragma unroll
            for (int m = 0; m < 4; ++m) {
                float* rp = base + (size_t)(row0 + ai * HALF + m * 16) * 256 + wc * 32 + 8 * fq;
#pragma unroll
                for (int bj = 0; bj < 2; ++bj) { *(f32x4*)(rp + bj * HALF) = acc[ai][bj][m][0]; *(f32x4*)(rp + bj * HALF + 4) = acc[ai][bj][m][1]; }
            }
    }
};
struct EpiNull {
    __device__ __forceinline__ void prefetch(const Unit&, int, PG8_LAS unsigned char*, int, int) const {}
    __device__ __forceinline__ void operator()(f32x4 (&acc)[2][2][4][2], const Unit& u, int ui, int wr, int wc, int fr, int fq, PG8_LAS unsigned char* le) const {
#pragma unroll
        for (int ai = 0; ai < 2; ++ai)
#pragma unroll
            for (int bj = 0; bj < 2; ++bj)
#pragma unroll
                for (int m = 0; m < 4; ++m) { asm volatile("" :: "v"(acc[ai][bj][m][0]), "v"(acc[ai][bj][m][1])); }
    }
};
}
namespace pro {
typedef unsigned short bf16_t;
typedef unsigned v4u __attribute__((ext_vector_type(4)));
typedef float f32x4 __attribute__((ext_vector_type(4)));
#define LAS3 __attribute__((address_space(3)))
__device__ __forceinline__ unsigned f2bf(float f) { unsigned u = __builtin_bit_cast(unsigned, f); return (u + 0x7fffu + ((u >> 16) & 1u)) >> 16; }
__device__ __forceinline__ unsigned pk2(float lo, float hi) { return f2bf(lo) | (f2bf(hi) << 16); }

struct In {
    const float *x, *norm_mix, *norm_ffn, *gla_w_in, *gla_w_alpha_up, *gla_b_alpha, *gla_norm, *gla_w_o, *kv_norm, *nsa_w_kv, *cmp_pe_k, *cmp_pe_v,
        *cmp_k_w1, *cmp_k_w2, *cmp_v_w1, *cmp_v_w2, *nsa_w_in, *nsa_w_o, *ffn_w_up, *ffn_conv_w, *ffn_conv_b, *ffn_w_down, *norm_final;
};
struct Wts { bf16_t *WGI, *WGO, *WKQ, *WC1, *WC2, *WNO, *WUP, *WDN; float *ROPE, *BIASC; };

__device__ __forceinline__ void transpose_item(const float* W, int ldw, int scol0, int nvalid, const float* gain, bf16_t* WT, int K, int drow0, int k0, LAS3 float* scr, int lane) {
    const int kr = lane >> 3, nc = (lane & 7) * 4;
    f32x4 v[8];
#pragma unroll
    for (int i = 0; i < 8; ++i) { const int kk = 8 * i + kr;
        v[i] = (nc < nvalid) ? *(const f32x4*)(W + (size_t)(k0 + kk) * ldw + scol0 + nc) : (f32x4){0.f, 0.f, 0.f, 0.f};
        if (gain) v[i] = v[i] * gain[k0 + kk]; }
#pragma unroll
    for (int i = 0; i < 8; ++i) { const int kk = 8 * i + kr; LAS3 float* d = scr + kk * 33 + nc; d[0] = v[i].x; d[1] = v[i].y; d[2] = v[i].z; d[3] = v[i].w; }
    asm volatile("s_waitcnt lgkmcnt(0)" ::: "memory");
    const int c = lane & 7;
#pragma unroll
    for (int j = 0; j < 4; ++j) { const int nn = (lane >> 3) + 8 * j; const LAS3 float* s = scr + (8 * c) * 33 + nn;
        v4u o; o.x = pk2(s[0 * 33], s[1 * 33]); o.y = pk2(s[2 * 33], s[3 * 33]); o.z = pk2(s[4 * 33], s[5 * 33]); o.w = pk2(s[6 * 33], s[7 * 33]);
        *(v4u*)(WT + (size_t)(drow0 + nn) * K + k0 + 8 * c) = o; }
    asm volatile("s_waitcnt lgkmcnt(0)" ::: "memory");
}
__device__ __forceinline__ void weff_item(const In& I, bf16_t* WT, int nb, int k0, LAS3 float* scr, int lane) {
    const int n = lane & 31, ng = 32 * nb + n;
    float wa[16];
#pragma unroll
    for (int r = 0; r < 16; ++r) wa[r] = I.gla_w_alpha_up[r * 512 + ng];
#pragma unroll 2
    for (int i = 0; i < 32; ++i) { const int kk = 2 * i + (lane >> 5); const float* wr = I.gla_w_in + (size_t)(k0 + kk) * 3088 + 3072;
        float v = 0.f;
#pragma unroll
        for (int r = 0; r < 16; ++r) v += wr[r] * wa[r];
        scr[kk * 33 + n] = v * I.norm_mix[k0 + kk]; }
    asm volatile("s_waitcnt lgkmcnt(0)" ::: "memory");
    const int c = lane & 7;
#pragma unroll
    for (int j = 0; j < 4; ++j) { const int nn = (lane >> 3) + 8 * j; const LAS3 float* s = scr + (8 * c) * 33 + nn;
        v4u o; o.x = pk2(s[0 * 33], s[1 * 33]); o.y = pk2(s[2 * 33], s[3 * 33]); o.z = pk2(s[4 * 33], s[5 * 33]); o.w = pk2(s[6 * 33], s[7 * 33]);
        *(v4u*)(WT + (size_t)(3072 + 32 * nb + nn) * 1024 + k0 + 8 * c) = o; }
    asm volatile("s_waitcnt lgkmcnt(0)" ::: "memory");
}

__device__ __forceinline__ void prologue(const In& I, const Wts& W, bf16_t* XB, float* RSS0, LAS3 unsigned char* lds, int gw, int NGW, int lane, int wave) {
    LAS3 float* scr = (LAS3 float*)(lds + wave * 16384);
    constexpr int I0 = 16 * 96, I1 = 16 * 16, I2 = 16 * 32, I3 = 16 * 88, I4 = 32 * 8, I6 = 4 * 2, I8 = 16 * 32, I9 = 16 * 176, I11 = 44 * 32;
    constexpr int NIT = I0 + I1 + I2 + I3 + 2 * I4 + 2 * I6 + I8 + 2 * I9 + 2 * I11;
    for (int it = gw; it < NIT; it += NGW) {
        int r = it;
        if (r < I0) { const int kb = r / 96, nb = r % 96; transpose_item(I.gla_w_in, 3088, 32 * nb, 32, I.norm_mix, W.WGI, 1024, 32 * nb, 64 * kb, scr, lane); continue; } r -= I0;
        if (r < I1) { const int kb = r / 16, nb = r % 16; weff_item(I, W.WGI, nb, 64 * kb, scr, lane); continue; } r -= I1;
        if (r < I2) { const int kb = r / 32, nb = r % 32; transpose_item(I.gla_w_o, 1024, 32 * nb, 32, nullptr, W.WGO, 1024, 32 * nb, 64 * kb, scr, lane); continue; } r -= I2;
        if (r < I3) { const int kb = r / 88, nb = r % 88; const int tile = nb >> 3, gi = nb & 7, L0 = (gi & 3) * 64 + (gi >> 2) * 32;
            if (tile < 6) transpose_item(I.nsa_w_kv, 1536, tile * 256 + L0, 32, I.kv_norm, W.WKQ, 1024, 32 * nb, 64 * kb, scr, lane);
            else if (tile < 10) transpose_item(I.nsa_w_in, 1072, (tile - 6) * 256 + L0, 32, I.norm_mix + 1024, W.WKQ, 1024, 32 * nb, 64 * kb, scr, lane);
            else { int nv = 48 - L0; nv = nv < 0 ? 0 : (nv > 32 ? 32 : nv); transpose_item(I.nsa_w_in, 1072, 1024 + (nv > 0 ? L0 : 0), nv, I.norm_mix + 1024, W.WKQ, 1024, 32 * nb, 64 * kb, scr, lane); }
            continue; } r -= I3;
        if (r < 2 * I4) { const int w = r / I4; r %= I4; const int kb = r / 8, nb = r % 8;
            transpose_item(w ? I.cmp_v_w1 : I.cmp_k_w1, 256, 32 * nb, 32, nullptr, W.WC1 + (size_t)w * 256 * 2048, 2048, 32 * nb, 64 * kb, scr, lane); continue; } r -= 2 * I4;
        if (r < 2 * I6) { const int w = r / I6; r %= I6; const int kb = r / 2, nb = r % 2;
            transpose_item(w ? I.cmp_v_w2 : I.cmp_k_w2, 64, 32 * nb, 32, nullptr, W.WC2 + (size_t)w * 64 * 256, 256, 32 * nb, 64 * kb, scr, lane); continue; } r -= 2 * I6;
        if (r < I8) { const int kb = r / 32, nb = r % 32; transpose_item(I.nsa_w_o, 1024, 32 * nb, 32, nullptr, W.WNO, 1024, 32 * nb, 64 * kb, scr, lane); continue; } r -= I8;
        if (r < 2 * I9) { const int l = r / I9; r %= I9; const int kb = r / 176, nb = r % 176; const int tile = nb >> 3, gi = nb & 7;
            const int sc = (gi < 4) ? (128 * tile + 32 * gi) : (2816 + 128 * tile + 32 * (gi - 4));
            transpose_item(I.ffn_w_up + (size_t)l * 1024 * 5632, 5632, sc, 32, I.norm_ffn + l * 1024, W.WUP + (size_t)l * 5632 * 1024, 1024, 32 * nb, 64 * kb, scr, lane); continue; } r -= 2 * I9;
        { const int l = r / I11; r %= I11; const int kb = r / 32, nb = r % 32;
            transpose_item(I.ffn_w_down + (size_t)l * 2816 * 1024, 1024, 32 * nb, 32, nullptr, W.WDN + (size_t)l * 1024 * 2816, 2816, 32 * nb, 64 * kb, scr, lane); }
    }
    for (int i = gw * 64 + lane; i < 2048 * 32; i += NGW * 64) {
        const int pos = i >> 5, d = i & 31;
        const float inv = powf(10000.0f, -(float)d / 32.0f);
        const float ang = (float)pos * inv;
        float sn, cs; sincosf(ang, &sn, &cs);
        W.ROPE[2 * i] = cs; W.ROPE[2 * i + 1] = sn;
    }
    for (int it = gw; it < 256; it += NGW) {
        const int w = it >> 7, ng = (it >> 5) & 3, kc = it & 31; const float* pe = (w ? I.cmp_pe_v : I.cmp_pe_k) + 64 * kc; const float* w1 = (w ? I.cmp_v_w1 : I.cmp_k_w1) + (size_t)(64 * kc) * 256 + 64 * ng + lane;
        float s = 0.f;
#pragma unroll 16
        for (int k = 0; k < 64; ++k) s += pe[k] * w1[(size_t)k * 256];
        atomicAdd(W.BIASC + w * 256 + 64 * ng + lane, s);
    }
    for (int m = gw; m < 32768; m += NGW) {
        const f32x4* xr = (const f32x4*)(I.x + (size_t)m * 1024) + lane;
        f32x4 v[4]; float s = 0.f;
#pragma unroll
        for (int j = 0; j < 4; ++j) { v[j] = xr[64 * j]; s += (v[j].x * v[j].x + v[j].y * v[j].y) + (v[j].z * v[j].z + v[j].w * v[j].w); }
#pragma unroll
        for (int off = 1; off < 64; off <<= 1) s += __shfl_xor(s, off);
        if (lane == 0) RSS0[m] = s;
        unsigned long long* o8 = (unsigned long long*)(XB + (size_t)m * 1024) + lane;
#pragma unroll
        for (int j = 0; j < 4; ++j) o8[64 * j] = (unsigned long long)pk2(v[j].x, v[j].y) | ((unsigned long long)pk2(v[j].z, v[j].w) << 32);
    }
}
}
namespace gla {
typedef unsigned short bf16_t;
typedef short bf16x8 __attribute__((ext_vector_type(8)));
typedef short s16x4 __attribute__((ext_vector_type(4)));
typedef float f32x16 __attribute__((ext_vector_type(16)));
typedef float f32x4 __attribute__((ext_vector_type(4)));
typedef unsigned u32x4 __attribute__((ext_vector_type(4)));
typedef unsigned u32x2 __attribute__((ext_vector_type(2)));
#define GLAS __attribute__((address_space(3)))
__device__ __forceinline__ int crow(int r, int hi) { return (r & 3) + 8 * (r >> 2) + 4 * hi; }
__device__ __forceinline__ float bf2f(bf16_t v) { return __builtin_bit_cast(float, (unsigned)v << 16); }
__device__ __forceinline__ unsigned cvtpk(float lo, float hi) { typedef float f2 __attribute__((ext_vector_type(2))); typedef __bf16 b2 __attribute__((ext_vector_type(2))); f2 v = {lo, hi}; b2 b = __builtin_convertvector(v, b2); return __builtin_bit_cast(unsigned, b); }
__device__ __forceinline__ bf16_t f2bf1(float f) { return (bf16_t)(cvtpk(f, 0.f) & 0xffffu); }
__device__ __forceinline__ s16x4 vtr(const GLAS unsigned char* p) { typedef short v4i16_t __attribute__((ext_vector_type(4))); return __builtin_bit_cast(s16x4, __builtin_amdgcn_ds_read_tr16_b64_v4i16((GLAS v4i16_t*)p)); }
__device__ __forceinline__ bf16x8 ld2x64(const GLAS unsigned char* p0, const GLAS unsigned char* p1) {
    const s16x4 a = *(const GLAS s16x4*)p0, b = *(const GLAS s16x4*)p1; return (bf16x8){a[0], a[1], a[2], a[3], b[0], b[1], b[2], b[3]};
}
constexpr int QEP = 264, KDP = 136, VP = 576, OLP = 260;
constexpr int L_QE = 0, L_KE = 16896, L_KDT = 33792, L_ATT = 51200, L_V = 59904, L_BL = 96768, L_QT = 97280, L_END = 99328;

template <bool STATE_ONLY>
__device__ __forceinline__ void gla_unit(int b, int h, int seg, const bf16_t* Qg, const bf16_t* Kg, const bf16_t* VO, bf16_t* Oout, const bf16_t* Rg, const float* Gg, const float* gnorm, float* SLOC, float* DSEG, GLAS unsigned char* lds, int tid0) {
    int tid_ = tid0; asm volatile("" : "+v"(tid_));
    const int tid = tid_, lane = tid & 63, w = __builtin_amdgcn_readfirstlane(tid >> 6), r32 = lane & 31, hi = lane >> 5;
    f32x16 S[4];
#pragma unroll
    for (int i = 0; i < 4; ++i)
#pragma unroll
        for (int r = 0; r < 16; ++r) S[i][r] = 0.f;
    const int kcol = tid & 127, qd = tid >> 7;
    const int bh = b * 4 + h;
    if (!STATE_ONLY && seg >= 1) {
#pragma unroll 1
        for (int s = 0; s < seg; ++s) {
            const float* sl = SLOC + ((size_t)(bh * 3 + s) * 128) * 256 + 32 * w + r32; const float* dd = DSEG + (bh * 3 + s) * 128;
#pragma unroll
            for (int i = 0; i < 4; ++i)
#pragma unroll
                for (int r = 0; r < 16; ++r) { const int k = 32 * i + crow(r, hi); const float d = (s == 0) ? 0.f : dd[k]; S[i][r] = S[i][r] * d + sl[(size_t)k * 256]; }
        }
    }
    float dlog = 0.f;
    GLAS float* BL = (GLAS float*)(lds + L_BL); GLAS float* QT = (GLAS float*)(lds + L_QT);
    GLAS float* OL = (GLAS float*)lds;
    float gq[16]; u32x4 vr[4];
#define GLA_FETCH(cc) do { const size_t r0_ = (size_t)b * 2048 + (cc) * 64; \
        const float* gp_ = Gg + (r0_ + 16 * qd) * 512 + h * 128 + kcol; const bf16_t* qp_ = Qg + (r0_ + 16 * qd) * 512 + h * 128 + kcol; const bf16_t* kp_ = Kg + (r0_ + 16 * qd) * 512 + h * 128 + kcol; \
        _Pragma("unroll") for (int i = 0; i < 16; ++i) { gq[i] = gp_[(size_t)i * 512]; } (void)qp_; (void)kp_; \
        _Pragma("unroll") for (int i = 0; i < 4; ++i) { const int p_ = tid + 512 * i, rr_ = p_ >> 5, ch_ = p_ & 31; vr[i] = *(const u32x4*)(VO + (r0_ + rr_) * 1024 + h * 256 + ch_ * 8); } } while (0)
    GLA_FETCH(seg * 8);
    for (int c = seg * 8; c < seg * 8 + 8; ++c) {
        const size_t row0 = (size_t)b * 2048 + c * 64;
        u32x4 rpre[4];
        if (!STATE_ONLY) { const size_t go_ = (row0 + (tid >> 3)) * 1024 + h * 256 + 32 * (tid & 7);
#pragma unroll
            for (int j = 0; j < 4; ++j) rpre[j] = *(const u32x4*)(Rg + go_ + 8 * j); }
        {
            float cs[16]; float run = 0.f;
#pragma unroll
            for (int i = 0; i < 16; ++i) { run += gq[i]; cs[i] = run; }
            QT[qd * 128 + kcol] = run;
#pragma unroll
            for (int i = 0; i < 4; ++i) { const int p = tid + 512 * i, rr = p >> 5, ch = p & 31;
                *(GLAS u32x4*)(lds + L_V + rr * VP + ch * 16) = vr[i]; }
            float qv[16], kv[16];
            { const bf16_t* qp = Qg + (row0 + 16 * qd) * 512 + h * 128 + kcol; const bf16_t* kp = Kg + (row0 + 16 * qd) * 512 + h * 128 + kcol;
#pragma unroll
              for (int i = 0; i < 16; ++i) { qv[i] = STATE_ONLY ? 0.f : bf2f(qp[(size_t)i * 512]); kv[i] = bf2f(kp[(size_t)i * 512]); } }
            if (c + 1 < seg * 8 + 8) GLA_FETCH(c + 1);
            __syncthreads();
            float pre = 0.f, tot = 0.f;
#pragma unroll
            for (int q = 0; q < 4; ++q) { const float t = QT[q * 128 + kcol]; tot += t; if (q < qd) pre += t; }
            if (qd == 0) BL[kcol] = __expf(tot);
            dlog += tot;
            float kd[16];
#pragma unroll
            for (int i = 0; i < 16; ++i) { const float bb = pre + cs[i]; const int t = 16 * qd + i;
                if (!STATE_ONLY) { *(GLAS bf16_t*)(lds + L_QE + t * QEP + kcol * 2) = f2bf1(qv[i] * __expf(bb));
                                   *(GLAS bf16_t*)(lds + L_KE + t * QEP + kcol * 2) = f2bf1(kv[i] * __expf(-bb)); }
                kd[i] = kv[i] * __expf(tot - bb); }
#pragma unroll
            for (int i = 0; i < 4; ++i) { u32x2 v; v.x = cvtpk(kd[4 * i], kd[4 * i + 1]); v.y = cvtpk(kd[4 * i + 2], kd[4 * i + 3]);
                *(GLAS u32x2*)(lds + L_KDT + kcol * KDP + (16 * qd + 4 * i) * 2) = v; }
        }
        __syncthreads();
        f32x16 o[2];
#pragma unroll
        for (int r = 0; r < 16; ++r) { o[0][r] = 0.f; o[1][r] = 0.f; }
        if (!STATE_ONLY) {
        if (w < 3) {
            const int ti = (w >= 1) ? 1 : 0, si = (w == 2) ? 1 : 0;
            f32x16 a;
#pragma unroll
            for (int r = 0; r < 16; ++r) a[r] = 0.f;
            const GLAS unsigned char* ap = lds + L_QE + (32 * ti + r32) * QEP + 16 * hi; const GLAS unsigned char* bp = lds + L_KE + (32 * si + r32) * QEP + 16 * hi;
#pragma unroll
            for (int s = 0; s < 8; ++s) { const bf16x8 A = ld2x64(ap + 32 * s, ap + 32 * s + 8), B = ld2x64(bp + 32 * s, bp + 32 * s + 8);
                a = __builtin_amdgcn_mfma_f32_32x32x16_bf16(A, B, a, 0, 0, 0); }
            const int sg = 32 * si + r32;
#pragma unroll
            for (int r = 0; r < 16; ++r) { const int tg = 32 * ti + crow(r, hi); const float v = (sg <= tg) ? a[r] : 0.f;
                *(GLAS bf16_t*)(lds + L_ATT + tg * KDP + sg * 2) = f2bf1(v); }
        } else if (w == 3) {
#pragma unroll
            for (int r = 0; r < 16; ++r) *(GLAS bf16_t*)(lds + L_ATT + crow(r, hi) * KDP + (32 + r32) * 2) = 0;
        }
        {
#pragma unroll
            for (int i = 0; i < 4; ++i)
#pragma unroll
                for (int s = 0; s < 2; ++s) {
                    u32x4 pk; pk.x = cvtpk(S[i][8 * s], S[i][8 * s + 1]); pk.y = cvtpk(S[i][8 * s + 2], S[i][8 * s + 3]); pk.z = cvtpk(S[i][8 * s + 4], S[i][8 * s + 5]); pk.w = cvtpk(S[i][8 * s + 6], S[i][8 * s + 7]);
                    const bf16x8 Bf = __builtin_bit_cast(bf16x8, pk);
#pragma unroll
                    for (int ti = 0; ti < 2; ++ti) { const GLAS unsigned char* ap = lds + L_QE + (32 * ti + r32) * QEP + (32 * i + 16 * s + 4 * hi) * 2;
                        const bf16x8 A = ld2x64(ap, ap + 16); o[ti] = __builtin_amdgcn_mfma_f32_32x32x16_bf16(A, Bf, o[ti], 0, 0, 0); }
                }
        }
        __syncthreads();
        }
        {
            bf16x8 vf[4];
            const int gI = lane >> 4, i16 = lane & 15, q = i16 >> 2, p = i16 & 3;
            const GLAS unsigned char* vb = lds + L_V + (8 * hi + q) * VP + (32 * w + 16 * (gI & 1) + 4 * p) * 2;
#pragma unroll
            for (int ks = 0; ks < 4; ++ks) { const s16x4 lo = vtr(vb + 16 * ks * VP), hh = vtr(vb + (16 * ks + 4) * VP);
                vf[ks] = (bf16x8){lo[0], lo[1], lo[2], lo[3], hh[0], hh[1], hh[2], hh[3]}; }
            if (!STATE_ONLY) {
#pragma unroll
            for (int ti = 0; ti < 2; ++ti)
#pragma unroll
                for (int ks = 0; ks < 4; ++ks) { const GLAS unsigned char* ap = lds + L_ATT + (32 * ti + r32) * KDP + (16 * ks + 8 * hi) * 2;
                    const bf16x8 A = ld2x64(ap, ap + 8); o[ti] = __builtin_amdgcn_mfma_f32_32x32x16_bf16(A, vf[ks], o[ti], 0, 0, 0); }
            }
#pragma unroll
            for (int i = 0; i < 4; ++i) {
#pragma unroll
                for (int r = 0; r < 16; ++r) S[i][r] *= BL[32 * i + crow(r, hi)];
#pragma unroll
                for (int ks = 0; ks < 4; ++ks) { const GLAS unsigned char* ap = lds + L_KDT + (32 * i + r32) * KDP + (16 * ks + 8 * hi) * 2;
                    const bf16x8 A = ld2x64(ap, ap + 8); S[i] = __builtin_amdgcn_mfma_f32_32x32x16_bf16(A, vf[ks], S[i], 0, 0, 0); }
            }
        }
        __syncthreads();
        if (!STATE_ONLY) {
#pragma unroll
        for (int ti = 0; ti < 2; ++ti)
#pragma unroll
            for (int r = 0; r < 16; ++r) OL[(32 * ti + crow(r, hi)) * OLP + 32 * w + r32] = o[ti][r];
        __syncthreads();
        {
            const int t = tid >> 3, seg = tid & 7;
            f32x4 v[8]; float ss = 0.f;
#pragma unroll
            for (int j = 0; j < 8; ++j) { v[j] = *(const GLAS f32x4*)(OL + t * OLP + 32 * seg + 4 * j); ss += (v[j].x * v[j].x + v[j].y * v[j].y) + (v[j].z * v[j].z + v[j].w * v[j].w); }
            ss += dpp_xor1(ss); ss += dpp_xor2(ss); ss += dpp_hmirror(ss);
            const float rs = rsqrtf(ss * (1.0f / 256.0f) + 1e-6f);
            const size_t go = (row0 + t) * 1024 + h * 256 + 32 * seg;
            const float* gn = gnorm + h * 256 + 32 * seg;
#pragma unroll
            for (int j = 0; j < 4; ++j) {
                const u32x4 rr = rpre[j];
                const f32x4 g0 = *(const f32x4*)(gn + 8 * j), g1 = *(const f32x4*)(gn + 8 * j + 4);
                const f32x4 a = v[2 * j], bq = v[2 * j + 1];
                u32x4 ov;
                ov.x = cvtpk(a.x * rs * g0.x * __builtin_bit_cast(float, rr.x << 16), a.y * rs * g0.y * __builtin_bit_cast(float, rr.x & 0xffff0000u));
                ov.y = cvtpk(a.z * rs * g0.z * __builtin_bit_cast(float, rr.y << 16), a.w * rs * g0.w * __builtin_bit_cast(float, rr.y & 0xffff0000u));
                ov.z = cvtpk(bq.x * rs * g1.x * __builtin_bit_cast(float, rr.z << 16), bq.y * rs * g1.y * __builtin_bit_cast(float, rr.z & 0xffff0000u));
                ov.w = cvtpk(bq.z * rs * g1.z * __builtin_bit_cast(float, rr.w << 16), bq.w * rs * g1.w * __builtin_bit_cast(float, rr.w & 0xffff0000u));
                *(u32x4*)(Oout + go + 8 * j) = ov;
            }
        }
        __syncthreads();
        }
    }
    if (STATE_ONLY) {
        float* sl = SLOC + ((size_t)(bh * 3 + seg) * 128) * 256 + 32 * w + r32;
#pragma unroll
        for (int i = 0; i < 4; ++i)
#pragma unroll
            for (int r = 0; r < 16; ++r) sl[(size_t)(32 * i + crow(r, hi)) * 256] = S[i][r];
        if (qd == 0) DSEG[(bh * 3 + seg) * 128 + kcol] = __expf(dlog);
    }
#undef GLA_FETCH
}
}
namespace nsa {
typedef unsigned short bf16_t;
typedef short bf16x8 __attribute__((ext_vector_type(8)));
typedef short s16x4 __attribute__((ext_vector_type(4)));
typedef float f32x16 __attribute__((ext_vector_type(16)));
typedef float f32x4 __attribute__((ext_vector_type(4)));
typedef unsigned u32x4 __attribute__((ext_vector_type(4)));
#define NLAS __attribute__((address_space(3)))
__device__ __forceinline__ int crow(int r, int hi) { return (r & 3) + 8 * (r >> 2) + 4 * hi; }
__device__ __forceinline__ unsigned cvtpk(float lo, float hi) { typedef float f2 __attribute__((ext_vector_type(2))); typedef __bf16 b2 __attribute__((ext_vector_type(2))); f2 v = {lo, hi}; b2 b = __builtin_convertvector(v, b2); return __builtin_bit_cast(unsigned, b); }
__device__ __forceinline__ s16x4 vtr(const NLAS unsigned char* p) { typedef short v4i16_t __attribute__((ext_vector_type(4))); return __builtin_bit_cast(s16x4, __builtin_amdgcn_ds_read_tr16_b64_v4i16((NLAS v4i16_t*)p)); }

__device__ __forceinline__ float gelu_tanh(float x) { const float y = 0.7978845608028654f * (x + 0.044715f * x * x * x); const float e = __expf(2.0f * y); const float th = 1.0f - 2.0f * __builtin_amdgcn_rcpf(e + 1.0f); return 0.5f * x * (1.0f + th); }
__device__ __forceinline__ void cmp_finalize(const float* HP, const float* BIASC, const bf16_t* WC2, bf16_t* KCVC, int gw, int NGW, int lane) {
    typedef float f4 __attribute__((ext_vector_type(4)));
    const int r = lane & 15, kq = lane >> 4;
    for (int item = gw; item < 1024; item += NGW) {
        const int R0 = item * 16, w = R0 >> 13, row = R0 + r;
        f4 acc[4];
#pragma unroll
        for (int nt = 0; nt < 4; ++nt) acc[nt] = (f4){0.f, 0.f, 0.f, 0.f};
#pragma unroll
        for (int ks = 0; ks < 8; ++ks) {
            const int col = 32 * ks + 8 * kq;
            f32x4 s0 = *(const f32x4*)(BIASC + w * 256 + col), s1 = *(const f32x4*)(BIASC + w * 256 + col + 4);
#pragma unroll
            for (int p = 0; p < 4; ++p) { const float* hp = HP + ((size_t)p * 16384 + row) * 256 + col; s0 = s0 + *(const f32x4*)hp; s1 = s1 + *(const f32x4*)(hp + 4); }
            u32x4 pk; pk.x = cvtpk(gelu_tanh(s0.x), gelu_tanh(s0.y)); pk.y = cvtpk(gelu_tanh(s0.z), gelu_tanh(s0.w)); pk.z = cvtpk(gelu_tanh(s1.x), gelu_tanh(s1.y)); pk.w = cvtpk(gelu_tanh(s1.z), gelu_tanh(s1.w));
            const bf16x8 A = __builtin_bit_cast(bf16x8, pk);
#pragma unroll
            for (int nt = 0; nt < 4; ++nt) { const bf16x8 B = *(const bf16x8*)(WC2 + ((size_t)w * 64 + 16 * nt + r) * 256 + col);
                acc[nt] = __builtin_amdgcn_mfma_f32_16x16x32_bf16(A, B, acc[nt], 0, 0, 0); }
        }
#pragma unroll
        for (int nt = 0; nt < 4; ++nt)
#pragma unroll
            for (int rg = 0; rg < 4; ++rg) { const int orow = R0 + 4 * kq + rg; const float v = ((orow & 127) == 127) ? 0.f : acc[nt][rg];
                KCVC[(size_t)orow * 64 + 16 * nt + r] = (bf16_t)(cvtpk(v, 0.f) & 0xffffu); }
    }
}

constexpr int SLOTB = 16384, NSLOT = 4;
constexpr int L_IMP = NSLOT * SLOTB, L_CAR = L_IMP + 8 * 32 * 33 * 4, L_VAL = L_CAR + 8 * 32 * 33 * 4, L_SELM = L_VAL + 64 * 33 * 4, L_WSF = L_SELM + 256, L_FAC = L_WSF + 8 * 64 * 4, L_AEND = L_FAC + 8 * 32 * 2 * 4;
static_assert(L_AEND <= 131072 + 28672, "attention LDS");
#define NINF (-__builtin_inff())
#define ABAR() asm volatile("s_waitcnt lgkmcnt(0)\n\ts_barrier" ::: "memory")

__device__ __forceinline__ void k_load(bf16x8* kf, const NLAS unsigned char* ks, int r32, int hi) {
    const int sw = (r32 >> 1) & 7;
    const unsigned kb = (unsigned)(size_t)(ks + r32 * 128);
    const unsigned a0 = kb + (((0 + hi) ^ sw) << 4), a1 = kb + (((2 + hi) ^ sw) << 4), a2 = kb + (((4 + hi) ^ sw) << 4), a3 = kb + (((6 + hi) ^ sw) << 4);
    asm volatile("ds_read_b128 %0, %8\n\tds_read_b128 %1, %8 offset:4096\n\tds_read_b128 %2, %9\n\tds_read_b128 %3, %9 offset:4096\n\t"
                 "ds_read_b128 %4, %10\n\tds_read_b128 %5, %10 offset:4096\n\tds_read_b128 %6, %11\n\tds_read_b128 %7, %11 offset:4096\n\ts_waitcnt lgkmcnt(0)"
                 : "=&v"(kf[0]), "=&v"(kf[1]), "=&v"(kf[2]), "=&v"(kf[3]), "=&v"(kf[4]), "=&v"(kf[5]), "=&v"(kf[6]), "=&v"(kf[7])
                 : "v"(a0), "v"(a1), "v"(a2), "v"(a3) : "memory");
    __builtin_amdgcn_sched_barrier(0);
}
__device__ __forceinline__ void qk_mma(f32x16& p0, f32x16& p1, const bf16x8* kf, const bf16x8* qf, const f32x16& c) {
#pragma unroll
    for (int d0 = 0; d0 < 4; ++d0) {
        if (d0 == 0) { p0 = __builtin_amdgcn_mfma_f32_32x32x16_bf16(kf[0], qf[0], c, 0, 0, 0); p1 = __builtin_amdgcn_mfma_f32_32x32x16_bf16(kf[1], qf[0], c, 0, 0, 0); }
        else { p0 = __builtin_amdgcn_mfma_f32_32x32x16_bf16(kf[2 * d0], qf[d0], p0, 0, 0, 0); p1 = __builtin_amdgcn_mfma_f32_32x32x16_bf16(kf[2 * d0 + 1], qf[d0], p1, 0, 0, 0); }
    }
}
__device__ __forceinline__ void pack_p(bf16x8* pa, const f32x16& p0, const f32x16& p1) {
    u32x4 w;
    w.x = cvtpk(p0[0], p0[1]); w.y = cvtpk(p0[2], p0[3]); w.z = cvtpk(p0[4], p0[5]); w.w = cvtpk(p0[6], p0[7]); pa[0] = __builtin_bit_cast(bf16x8, w);
    w.x = cvtpk(p0[8], p0[9]); w.y = cvtpk(p0[10], p0[11]); w.z = cvtpk(p0[12], p0[13]); w.w = cvtpk(p0[14], p0[15]); pa[1] = __builtin_bit_cast(bf16x8, w);
    w.x = cvtpk(p1[0], p1[1]); w.y = cvtpk(p1[2], p1[3]); w.z = cvtpk(p1[4], p1[5]); w.w = cvtpk(p1[6], p1[7]); pa[2] = __builtin_bit_cast(bf16x8, w);
    w.x = cvtpk(p1[8], p1[9]); w.y = cvtpk(p1[10], p1[11]); w.z = cvtpk(p1[12], p1[13]); w.w = cvtpk(p1[14], p1[15]); pa[3] = __builtin_bit_cast(bf16x8, w);
}
__device__ __forceinline__ void v_load(bf16x8* vf, const NLAS unsigned char* vs, int lane) {
    const int hi = lane >> 5;
    const NLAS unsigned char* vb = vs + ((lane >> 4) & 1) * 32 + (lane & 3) * 8 + (4 * hi + ((lane & 15) >> 2)) * 64;
#pragma unroll
    for (int d0 = 0; d0 < 2; ++d0)
#pragma unroll
        for (int ks = 0; ks < 4; ++ks) {
            const s16x4 lo = vtr(vb + d0 * 4096 + ks * 1024), hh = vtr(vb + d0 * 4096 + ks * 1024 + 512);
            vf[d0 * 4 + ks] = (bf16x8){lo[0], lo[1], lo[2], lo[3], hh[0], hh[1], hh[2], hh[3]};
        }
}
__device__ __forceinline__ void pv_mma(f32x16* o, const bf16x8* vf, const bf16x8* pa) {
#pragma unroll
    for (int ks = 0; ks < 4; ++ks) {
        o[0] = __builtin_amdgcn_mfma_f32_32x32x16_bf16(pa[ks], vf[ks], o[0], 0, 0, 0);
        o[1] = __builtin_amdgcn_mfma_f32_32x32x16_bf16(pa[ks], vf[4 + ks], o[1], 0, 0, 0);
    }
}
__device__ __forceinline__ float max32(const f32x16& p0, const f32x16& p1) {
    float a = fmaxf(p0[0], p1[0]);
#pragma unroll
    for (int r = 1; r < 16; ++r) a = fmaxf(a, fmaxf(p0[r], p1[r]));
    return a;
}
__device__ __forceinline__ float comb_max(float v) { auto rr = __builtin_amdgcn_permlane32_swap(__float_as_uint(v), __float_as_uint(v), false, false); return fmaxf(__uint_as_float(rr[0]), __uint_as_float(rr[1])); }
__device__ __forceinline__ float comb_sum(float v) { auto rr = __builtin_amdgcn_permlane32_swap(__float_as_uint(v), __float_as_uint(v), false, false); return __uint_as_float(rr[0]) + __uint_as_float(rr[1]); }
__device__ __forceinline__ void mask_le(f32x16& p0, f32x16& p1, int thr, int hi) {
    int t2 = thr - 4 * hi; asm volatile("" : "+v"(t2));
#pragma unroll
    for (int r = 0; r < 16; ++r) { const int kc = (r & 3) + 8 * (r >> 2); if (kc > t2) p0[r] = NINF; if (kc + 32 > t2) p1[r] = NINF; }
}
__device__ __forceinline__ void mask_gt(f32x16& p0, f32x16& p1, int thr, int hi) {
    int t2 = thr - 4 * hi; asm volatile("" : "+v"(t2));
#pragma unroll
    for (int r = 0; r < 16; ++r) { const int kc = (r & 3) + 8 * (r >> 2); if (kc <= t2) p0[r] = NINF; if (kc + 32 <= t2) p1[r] = NINF; }
}

#ifndef SOFT_THR
#define SOFT_THR 8.0f
#endif
struct Soft { float mhat, l; f32x16 o[2]; };
__device__ __forceinline__ void soft_init(Soft& s) { s.mhat = 0.f; s.l = 0.f;
#pragma unroll
    for (int r = 0; r < 16; ++r) { s.o[0][r] = 0.f; s.o[1][r] = 0.f; } }
__device__ __forceinline__ float soft_update(Soft& s, f32x16& p0, f32x16& p1, bool first, NLAS float* wsf, int r32, int hi) {
    const float rm = comb_max(max32(p0, p1));
    const float dl = first ? ((rm > NINF) ? rm : 0.f) : ((rm > SOFT_THR) ? rm : 0.f);
    float f = 1.0f;
    if (__any(dl != 0.f)) {
        s.mhat += dl;
        f = __builtin_amdgcn_exp2f(-dl);
        s.l *= f;
#pragma unroll
        for (int r = 0; r < 16; ++r) { p0[r] -= dl; p1[r] -= dl; }
        if (!first) {
            if (hi == 0) wsf[r32] = f;
            asm volatile("s_waitcnt lgkmcnt(0)" ::: "memory");
#pragma unroll
            for (int r = 0; r < 16; ++r) { const float ff = wsf[crow(r, hi)]; s.o[0][r] *= ff; s.o[1][r] *= ff; }
            asm volatile("s_waitcnt lgkmcnt(0)" ::: "memory");
        }
    }
    float sum = 0.f;
#pragma unroll
    for (int r = 0; r < 16; ++r) { p0[r] = __builtin_amdgcn_exp2f(p0[r]); p1[r] = __builtin_amdgcn_exp2f(p1[r]); sum += p0[r] + p1[r]; }
    s.l += sum;
    return f;
}

struct AttnBufs { unsigned char* ws; };
struct Strm { int u, kind, j; };
__device__ __forceinline__ int unit_qt(int u, int sub) { return 8 * (u >> 1) + ((u & 1) ? (7 - sub) : sub); }
__device__ __forceinline__ void strm_next(Strm& s, int sub) {
    const int qt = unit_qt(s.u, sub);
    if (s.kind == 0) { if (s.j == 0) s.j = 1; else { s.kind = 1; s.j = qt; } }
    else if (s.kind == 1) { if (s.j > 0) --s.j; else { s.kind = 2; s.j = qt; } }
    else { const int jlo = qt >= 8 ? qt - 8 : 0; if (s.j > jlo) --s.j; else { ++s.u; s.kind = 0; s.j = 0; } }
}
__device__ __forceinline__ void dma16(const void* g, NLAS unsigned char* l) {
    unsigned keep; const unsigned dst = (unsigned)__builtin_amdgcn_readfirstlane((int)(unsigned)(size_t)l);
    asm volatile("s_mov_b32 %0, m0\n\ts_mov_b32 m0, %2\n\ts_nop 0\n\tglobal_load_lds_dwordx4 %1, off\n\ts_mov_b32 m0, %0" : "=&s"(keep) : "v"(g), "s"(dst) : "memory");
}


template <int VAR = 0>
__device__ __forceinline__ void attn_block(int bh, int sub, const AttnBufs& T, NLAS unsigned char* lds, int tid0) {
    int tid_ = tid0; asm volatile("" : "+v"(tid_));
    const int tid = tid_, lane = tid & 63, w = __builtin_amdgcn_readfirstlane(tid >> 6), r32 = lane & 31, hi = lane >> 5;
    const int b = bh >> 2, hk = bh & 3, g = w >> 1, hq = hk * 4 + g, qi = 32 * (w & 1) + r32;
    NLAS float* wsf = (NLAS float*)(lds + L_WSF) + w * 64;
    NLAS float* IMP = (NLAS float*)(lds + L_IMP) + w * 32 * 33; NLAS float* CAR = (NLAS float*)(lds + L_CAR) + w * 32 * 33;
    NLAS float* stash = (NLAS float*)(lds + L_IMP + w * 8448) + lane;
    const int krow = 8 * w + (lane >> 3), koff = krow * 64 + (((lane & 7) ^ ((krow >> 1) & 7)) << 3), voff = (16 * (w & 3) + (lane >> 2)) * 64 + (w >> 2) * 32 + (lane & 3) * 8;
    unsigned char* const ws = T.ws;
    constexpr size_t kvs = (size_t)16 * 4 * 2048 * 64;
#define A_KC ((const bf16_t*)(ws + WS_KCVC) + ((size_t)bh * 128) * 64)
#define A_VC ((const bf16_t*)(ws + WS_KCVC) + ((size_t)(64 + bh) * 128) * 64)
#define A_KV ((const bf16_t*)(ws + WS_KV) + (size_t)bh * 2048 * 64)
#define ISSUE(st, slot) do { const bf16_t* kt_; const bf16_t* vt_; \
        if ((st).kind == 0) { kt_ = A_KC + (st).j * 4096; vt_ = A_VC + (st).j * 4096; } \
        else if ((st).kind == 1) { kt_ = A_KV + 2 * kvs + (size_t)(st).j * 4096; vt_ = A_KV + 3 * kvs + (size_t)(st).j * 4096; } \
        else { kt_ = A_KV + 4 * kvs + (size_t)(st).j * 4096; vt_ = A_KV + 5 * kvs + (size_t)(st).j * 4096; } \
        if (VAR != 5) { dma16(kt_ + koff, lds + (slot) * SLOTB + w * 1024); dma16(vt_ + voff, lds + (slot) * SLOTB + 8192 + w * 1024); } } while (0)
    Strm ist; ist.u = 0; ist.kind = 0; ist.j = 0;
    Strm cst = ist;
    int P = 0;
#pragma unroll 1
    for (int u = 0; u < 8; ++u) { const int qt = unit_qt(u, sub); P += 2 + (qt + 1) + ((qt >= 8 ? 8 : qt) + 1); }
    ISSUE(ist, 0); strm_next(ist, sub); ISSUE(ist, 1); strm_next(ist, sub); ISSUE(ist, 2); strm_next(ist, sub);
    Soft S; soft_init(S);
    bf16x8 qf[4];
    float g_cmp = 0.f, g_sel = 0.f, g_win = 0.f; unsigned selm = 0u; int qt = 0;
#pragma unroll 1
    for (int p = 0; p < P; ++p) {
        const int ahead = P - 1 - p;
        if (ahead >= 2) asm volatile("s_waitcnt vmcnt(4)" ::: "memory"); else if (ahead == 1) asm volatile("s_waitcnt vmcnt(2)" ::: "memory"); else asm volatile("s_waitcnt vmcnt(0)" ::: "memory");
        ABAR();
        if (p + 3 < P) { ISSUE(ist, (p + 3) & 3); strm_next(ist, sub); }
        const NLAS unsigned char* slot = lds + (p & 3) * SLOTB;
        const int kind = cst.kind, j = cst.j;
        if (kind == 0 && j == 0) {
            qt = unit_qt(cst.u, sub);
            const int tok = 64 * qt + qi;
            const float* gp = (const float*)(ws + WS_GATES) + ((size_t)b * 2048 + tok) * 48 + hq;
            g_cmp = gp[0]; g_sel = gp[16]; g_win = gp[32];
            const size_t qoff = (((size_t)b * 16 + hq) * 2048 + tok) * 64 + 8 * hi;
#pragma unroll
            for (int d0 = 0; d0 < 4; ++d0) qf[d0] = *(const bf16x8*)((const bf16_t*)(ws + WS_NQ) + qoff + 16 * d0);
            soft_init(S);
        }
        if ((kind == 1 || kind == 2) && j == qt) soft_init(S);
        const bool first = (kind == 0) ? (j == 0) : (j == qt);
        float cv = -S.mhat;
        if (kind == 1) { if (!((selm >> j) & 1u)) cv = NINF; }
        f32x16 c;
#pragma unroll
        for (int r = 0; r < 16; ++r) c[r] = cv;
        f32x16 p0, p1;
        if (VAR == 1 || VAR == 5) { p0 = c; p1 = c; asm volatile("" : "+v"(p0), "+v"(p1)); strm_next(cst, sub); continue; }
        bf16x8 vf[8];
        {
            bf16x8 kf[8];
            if (VAR == 6) { _Pragma("unroll") for (int i = 0; i < 8; ++i) { kf[i] = qf[i & 3]; vf[i] = qf[i & 3]; } asm volatile("" : "+v"(kf[0]), "+v"(kf[1]), "+v"(kf[2]), "+v"(kf[3]), "+v"(kf[4]), "+v"(kf[5]), "+v"(kf[6]), "+v"(kf[7])); }
            else k_load(kf, slot, r32, hi);
            qk_mma(p0, p1, kf, qf, c);
        }
        if (VAR != 6) v_load(vf, slot + 8192, lane);
        __builtin_amdgcn_sched_barrier(0);
        if (VAR == 2) { asm volatile("" :: "v"(p0), "v"(p1)); strm_next(cst, sub); continue; }
        if (kind == 0) { const int tok = 64 * qt + qi; const int nmax = (tok >= 31) ? ((tok - 31) >> 4) : -1; mask_le(p0, p1, nmax - 64 * j, hi); }
        else { if (j == qt) mask_le(p0, p1, qi, hi); if (kind == 2 && j == qt - 8) mask_gt(p0, p1, qi, hi); }
        const float f = soft_update(S, p0, p1, first, wsf, r32, hi);
        if (VAR == 3) { asm volatile("" :: "v"(p0), "v"(p1)); strm_next(cst, sub); continue; }
        {
            bf16x8 pa[4]; pack_p(pa, p0, p1);
            pv_mma(S.o, vf, pa);
        }
        if (kind == 0) {
            NLAS float* FAC = (NLAS float*)(lds + L_FAC) + w * 64;
            if (j == 0) {
                if (hi == 0) CAR[r32 * 33] = 0.f;
#pragma unroll
                for (int a = 0; a < 4; ++a) {
                    const int jb = 2 * a + hi;
                    IMP[r32 * 33 + jb] = p0[4 * a] + p0[4 * a + 1] + p0[4 * a + 2] + 0.5f * p0[4 * a + 3]; CAR[r32 * 33 + jb + 1] = 0.5f * p0[4 * a + 3];
                    IMP[r32 * 33 + jb + 8] = p1[4 * a] + p1[4 * a + 1] + p1[4 * a + 2] + 0.5f * p1[4 * a + 3]; CAR[r32 * 33 + jb + 9] = 0.5f * p1[4 * a + 3];
                }
            } else {
                const float l = comb_sum(S.l);
                const float inv = (l > 0.f) ? __builtin_amdgcn_rcpf(l) : 0.f;
                if (hi == 0) { FAC[r32] = f * inv; FAC[32 + r32] = inv; }
#pragma unroll
                for (int a = 0; a < 4; ++a) {
                    const int jb = 2 * a + hi;
                    IMP[r32 * 33 + jb + 16] = p0[4 * a] + p0[4 * a + 1] + p0[4 * a + 2] + 0.5f * p0[4 * a + 3]; CAR[r32 * 33 + jb + 17] = 0.5f * p0[4 * a + 3];
                    IMP[r32 * 33 + jb + 24] = p1[4 * a] + p1[4 * a + 1] + p1[4 * a + 2] + 0.5f * p1[4 * a + 3]; if (jb + 25 < 32) CAR[r32 * 33 + jb + 25] = 0.5f * p1[4 * a + 3];
                }
                ABAR();
                {
                    NLAS float* VAL = (NLAS float*)(lds + L_VAL);
                    const int tq = tid >> 3, sb = tid & 7, wv = tq >> 5, rr = tq & 31;
                    const NLAS float* I0 = (const NLAS float*)(lds + L_IMP); const NLAS float* C0 = (const NLAS float*)(lds + L_CAR);
                    float v[4];
#pragma unroll
                    for (int e = 0; e < 4; ++e) { const int jb = 4 * sb + e; float sc = 0.f;
#pragma unroll
                        for (int gg = 0; gg < 4; ++gg) { const int ww = 2 * gg + wv; const NLAS float* fc = (const NLAS float*)(lds + L_FAC) + ww * 64 + rr;
                            sc += I0[(ww * 32 + rr) * 33 + jb] * fc[jb < 16 ? 0 : 32] + C0[(ww * 32 + rr) * 33 + jb] * fc[jb <= 16 ? 0 : 32]; }
                        if (jb > qt) sc = -1.0f; else if (jb == 0 || jb == qt || jb == qt - 1) sc = 1e4f;
                        v[e] = sc; VAL[tq * 33 + jb] = sc; }
                    ABAR();
                    unsigned bits = 0u;
#pragma unroll
                    for (int e = 0; e < 4; ++e) { const int jb = 4 * sb + e; int rank = 0;
#pragma unroll
                        for (int i = 0; i < 32; ++i) { const float x = VAL[tq * 33 + i]; rank += (x > v[e] || (x == v[e] && i < jb)) ? 1 : 0; }
                        if (rank < 16) bits |= 1u << jb; }
                    bits |= dpp_xor1(bits); bits |= dpp_xor2(bits); bits |= dpp_hmirror(bits);
                    if (sb == 0) ((NLAS unsigned*)(lds + L_SELM))[tq] = bits;
                }
                ABAR();
#ifdef DBG_SELALL
                selm = 0xffffffffu;
#else
                selm = ((const NLAS unsigned*)(lds + L_SELM))[qi];
#endif
                const float fac = g_cmp * inv;
                if (hi == 0) wsf[r32] = fac;
                asm volatile("s_waitcnt lgkmcnt(0)" ::: "memory");
#pragma unroll
                for (int r = 0; r < 16; ++r) { const float ff = wsf[crow(r, hi)]; stash[r * 64] = S.o[0][r] * ff; stash[(16 + r) * 64] = S.o[1][r] * ff; }
                asm volatile("s_waitcnt lgkmcnt(0)" ::: "memory");
                const size_t qoff = (((size_t)b * 16 + hq) * 2048 + 64 * qt + qi) * 64 + 8 * hi;
#pragma unroll
                for (int d0 = 0; d0 < 4; ++d0) qf[d0] = *(const bf16x8*)((const bf16_t*)(ws + WS_NQR) + qoff + 16 * d0);
            }
        } else {
            const int jend = (kind == 1) ? 0 : (qt >= 8 ? qt - 8 : 0);
            if (j == jend) {
                const float l = comb_sum(S.l);
                const float fac = (kind == 1 ? g_sel : g_win) * __builtin_amdgcn_rcpf(l);
                if (hi == 0) wsf[r32] = fac;
                asm volatile("s_waitcnt lgkmcnt(0)" ::: "memory");
#pragma unroll
                for (int r = 0; r < 16; ++r) { const float ff = wsf[crow(r, hi)]; stash[r * 64] += S.o[0][r] * ff; stash[(16 + r) * 64] += S.o[1][r] * ff; }
                asm volatile("s_waitcnt lgkmcnt(0)" ::: "memory");
                if (kind == 2) {
                    const NLAS float* sw = (const NLAS float*)(lds + L_IMP + w * 8448);
                    bf16_t* ob = (bf16_t*)(ws + WS_OATT) + ((size_t)b * 2048 + 64 * qt + 32 * (w & 1)) * 1024 + hq * 64;
#pragma unroll
                    for (int i = 0; i < 4; ++i) {
                        const int row = 8 * i + (lane >> 3), ch = lane & 7;
                        const int hh_ = (row >> 2) & 1, rr_ = (row & 3) + 4 * (row >> 3), d0 = ch >> 2;
                        const NLAS float* sp = sw + ((d0 * 16 + rr_) * 64 + hh_ * 32 + (ch & 3) * 8);
                        const f32x4 x0 = *(const NLAS f32x4*)sp, x1 = *(const NLAS f32x4*)(sp + 4);
                        u32x4 ov; ov.x = cvtpk(x0.x, x0.y); ov.y = cvtpk(x0.z, x0.w); ov.z = cvtpk(x1.x, x1.y); ov.w = cvtpk(x1.z, x1.w);
                        *(u32x4*)(ob + (size_t)row * 1024 + ch * 8) = ov;
                    }
                }
            }
        }
        strm_next(cst, sub);
    }
    ABAR();
#undef ISSUE
#undef A_KC
#undef A_VC
#undef A_KV
}
}
namespace cg = cooperative_groups;
typedef unsigned short bf16_t;
struct Params { const float* in[23]; float* out; unsigned char* ws; };

constexpr int PARAM_OFF = EPI_OFF + 28672, BARST_OFF = PARAM_OFF + 256;
template <class T> __device__ __forceinline__ T* ldp(PG8_LAS unsigned char* lds, int idx) {
    const PG8_LAS unsigned* p = (const PG8_LAS unsigned*)(lds + PARAM_OFF) + 2 * idx;
    const unsigned lo = __builtin_amdgcn_readfirstlane(p[0]), hi = __builtin_amdgcn_readfirstlane(p[1]);
    typedef __attribute__((address_space(1))) unsigned char gchar_t;
    gchar_t* gp = (gchar_t*)(((unsigned long long)hi << 32) | lo);
    return (T*)(unsigned char*)gp;
}
#define INP(k) ldp<const float>(lds, (k))
#define OUTP() ldp<float>(lds, 23)
#define WSP() ldp<unsigned char>(lds, 24)
__device__ __forceinline__ pro::In load_in(PG8_LAS unsigned char* lds) {
    pro::In I;
    I.x = INP(0); I.norm_mix = INP(1); I.norm_ffn = INP(2); I.gla_w_in = INP(3); I.gla_w_alpha_up = INP(4); I.gla_b_alpha = INP(5); I.gla_norm = INP(6); I.gla_w_o = INP(7);
    I.kv_norm = INP(8); I.nsa_w_kv = INP(9); I.cmp_pe_k = INP(10); I.cmp_pe_v = INP(11); I.cmp_k_w1 = INP(12); I.cmp_k_w2 = INP(13); I.cmp_v_w1 = INP(14); I.cmp_v_w2 = INP(15);
    I.nsa_w_in = INP(16); I.nsa_w_o = INP(17); I.ffn_w_up = INP(18); I.ffn_conv_w = INP(19); I.ffn_conv_b = INP(20); I.ffn_w_down = INP(21); I.norm_final = INP(22);
    return I;
}

__global__ void __launch_bounds__(512, 2) yoco_fwd(Params P) {
    extern __shared__ __attribute__((aligned(16))) unsigned char lds_raw[];
    PG8_LAS unsigned char* lds = (PG8_LAS unsigned char*)lds_raw;
    cg::grid_group grid = cg::this_grid();
    const int G = gridDim.x, bx = blockIdx.x;
    const int wave0 = __builtin_amdgcn_readfirstlane(threadIdx.x >> 6);
#define NOWTID() (wave0 * 64 + lane_id())
    if (threadIdx.x == 0) {
        PG8_LAS unsigned long long* lp = (PG8_LAS unsigned long long*)(lds + PARAM_OFF);
#pragma unroll
        for (int i = 0; i < 23; ++i) lp[i] = (unsigned long long)P.in[i];
        lp[23] = (unsigned long long)P.out; lp[24] = (unsigned long long)P.ws;
    }
    if (threadIdx.x < 2) ((PG8_LAS unsigned*)(lds + BARST_OFF))[threadIdx.x] = 0u;
    __syncthreads();
    (void)xcd_barrier_post((unsigned*)(P.ws + WS_BAR), (volatile LAS unsigned*)(lds + BARST_OFF), (int)threadIdx.x);
#define GSYNC() do { XcdBarrier b_; b_.bar = (unsigned*)(WSP() + WS_BAR); b_.x = xb_xcc_id(); b_.st = (volatile LAS unsigned*)(lds + BARST_OFF); xcd_barrier(b_, NOWTID()); } while (0)
#define PH_COMMON int tid_ = NOWTID(); asm volatile("" : "+v"(tid_)); const int tid = tid_, lane = tid & 63, wave = __builtin_amdgcn_readfirstlane(tid >> 6); const int gw = bx * 8 + wave, NGW = G * 8; (void)lane; (void)gw; (void)NGW; unsigned char* ws = WSP(); (void)ws;

#ifndef SKIP_PRO
    { PH_COMMON
        pro::In I = load_in(lds); pro::Wts W;
        W.WGI = (bf16_t*)(ws + WS_WGI); W.WGO = (bf16_t*)(ws + WS_WGO); W.WKQ = (bf16_t*)(ws + WS_WKQ); W.WC1 = (bf16_t*)(ws + WS_WC1); W.WC2 = (bf16_t*)(ws + WS_WC2);
        W.WNO = (bf16_t*)(ws + WS_WNO); W.WUP = (bf16_t*)(ws + WS_WUP); W.WDN = (bf16_t*)(ws + WS_WDN); W.ROPE = (float*)(ws + WS_ROPE); W.BIASC = (float*)(ws + WS_BIASC);
#ifdef REP_PRO
        pro::prologue(I, W, (bf16_t*)(ws + WS_XB), (float*)(ws + WS_RSS), lds, gw, NGW, lane, wave); __syncthreads();
#endif
        pro::prologue(I, W, (bf16_t*)(ws + WS_XB), (float*)(ws + WS_RSS), lds, gw, NGW, lane, wave); }
#endif
    grid.sync();

#ifdef REP_SYNC
#pragma unroll 1
    for (int r = 0; r < REP_SYNC; ++r) GSYNC();
#endif
#ifndef SKIP_P1
    { unsigned char* ws = WSP();
        pg8::Gemm g = pg8::make_gemm((const bf16_t*)(ws + WS_XB), (const bf16_t*)(ws + WS_WGI), M_TOK, 3584, 1024, 1024, 1024);
        pg8::StaticOrder S; S.init(M_TOK, 3584, G, bx);
        epi::EpiGlaIn E{(bf16_t*)(ws + WS_GQ), (bf16_t*)(ws + WS_GK), (bf16_t*)(ws + WS_GV), (bf16_t*)(ws + WS_GR), (float*)(ws + WS_GG), (const float*)(ws + WS_RSS), INP(5)};
#ifdef REP_P1
        pg8::gemm_phase(lds, lds + EPI_OFF, g, S, E, NOWTID());
#endif
        pg8::gemm_phase(lds, lds + EPI_OFF, g, S, E, NOWTID());
    }
#endif
    GSYNC();
#ifndef SKIP_GLA
    { unsigned char* ws = WSP();
        float* SLOC = (float*)(ws + WS_BIG + 260 * MiB); float* DSEG = (float*)(ws + WS_BIG + 290 * MiB);
#ifdef REP_GLAA
        if ((bx & 3) < 3) gla::gla_unit<true>(bx >> 4, (bx >> 2) & 3, bx & 3, (const bf16_t*)(ws + WS_GQ), (const bf16_t*)(ws + WS_GK), (const bf16_t*)(ws + WS_GV), (bf16_t*)(ws + WS_GV), (const bf16_t*)(ws + WS_GR), (const float*)(ws + WS_GG), INP(6), SLOC, DSEG, lds, NOWTID());
#endif
        if ((bx & 3) < 3) gla::gla_unit<true>(bx >> 4, (bx >> 2) & 3, bx & 3, (const bf16_t*)(ws + WS_GQ), (const bf16_t*)(ws + WS_GK), (const bf16_t*)(ws + WS_GV), (bf16_t*)(ws + WS_GV), (const bf16_t*)(ws + WS_GR), (const float*)(ws + WS_GG), INP(6), SLOC, DSEG, lds, NOWTID());
    }
    GSYNC();
    { unsigned char* ws = WSP();
        float* SLOC = (float*)(ws + WS_BIG + 260 * MiB); float* DSEG = (float*)(ws + WS_BIG + 290 * MiB);
#ifdef REP_GLAB
        gla::gla_unit<false>(bx >> 4, (bx >> 2) & 3, bx & 3, (const bf16_t*)(ws + WS_GQ), (const bf16_t*)(ws + WS_GK), (const bf16_t*)(ws + WS_GV), (bf16_t*)(ws + WS_BIG + 300 * MiB), (const bf16_t*)(ws + WS_GR), (const float*)(ws + WS_GG), INP(6), SLOC, DSEG, lds, NOWTID());
#endif
        gla::gla_unit<false>(bx >> 4, (bx >> 2) & 3, bx & 3, (const bf16_t*)(ws + WS_GQ), (const bf16_t*)(ws + WS_GK), (const bf16_t*)(ws + WS_GV), (bf16_t*)(ws + WS_GV), (const bf16_t*)(ws + WS_GR), (const float*)(ws + WS_GG), INP(6), SLOC, DSEG, lds, NOWTID());
    }
#endif
    GSYNC();
#ifndef SKIP_P3
    { unsigned char* ws = WSP();
        pg8::Gemm g = pg8::make_gemm((const bf16_t*)(ws + WS_GV), (const bf16_t*)(ws + WS_WGO), M_TOK, 1024, 1024, 1024, 1024);
        pg8::StaticOrder S; S.init(M_TOK, 1024, G, bx);
        epi::EpiRes E{INP(0), OUTP(), (bf16_t*)(ws + WS_XB), (float*)(ws + WS_RSS) + 1 * M_TOK};
        pg8::gemm_phase(lds, lds + EPI_OFF, g, S, E, NOWTID());
    }
#endif
    GSYNC();
#pragma unroll 1
    for (int layer = 0; layer < 2; ++layer) {
        if (layer == 1) {
#ifndef SKIP_P7
            { unsigned char* ws = WSP();
                pg8::Gemm g = pg8::make_gemm((const bf16_t*)(ws + WS_XB), (const bf16_t*)(ws + WS_WKQ), M_TOK, 2816, 1024, 1024, 1024);
                pg8::StaticOrder S; S.init(M_TOK, 2816, G, bx);
                epi::EpiKvq E{(bf16_t*)(ws + WS_KV), (bf16_t*)(ws + WS_NQ), (bf16_t*)(ws + WS_NQR), (float*)(ws + WS_GATES), (const float*)(ws + WS_RSS) + 2 * M_TOK, (const float*)(ws + WS_ROPE)};
#ifdef REP_P7
                pg8::gemm_phase(lds, lds + EPI_OFF, g, S, E, NOWTID());
#endif
                pg8::gemm_phase(lds, lds + EPI_OFF, g, S, E, NOWTID());
            }
#endif
            GSYNC();
#ifndef SKIP_P8
            { unsigned char* ws = WSP();
                pg8::Gemm g = pg8::make_gemm((const bf16_t*)(ws + WS_KV), (const bf16_t*)(ws + WS_WC1), 16384, 1024, 512, 1024, 2048);
                g.a_pn = 512 * 2; g.b_pn = 512 * 2; g.b_hi = (size_t)256 * 2048 * 2; g.b_split = 32;
                pg8::StaticOrder S; S.init(16384, 1024, G, bx);
                epi::EpiCmp E{(float*)(ws + WS_HP)};
#ifdef REP_P8
                pg8::gemm_phase(lds, lds + EPI_OFF, g, S, E, NOWTID());
#endif
                pg8::gemm_phase(lds, lds + EPI_OFF, g, S, E, NOWTID());
            }
#endif
            GSYNC();
#ifndef SKIP_P9
#ifdef REP_P9
            { PH_COMMON nsa::cmp_finalize((const float*)(ws + WS_HP), (const float*)(ws + WS_BIASC), (const bf16_t*)(ws + WS_WC2), (bf16_t*)(ws + WS_KCVC), gw, NGW, lane); }
#endif
            { PH_COMMON nsa::cmp_finalize((const float*)(ws + WS_HP), (const float*)(ws + WS_BIASC), (const bf16_t*)(ws + WS_WC2), (bf16_t*)(ws + WS_KCVC), gw, NGW, lane); }
#endif
            GSYNC();
#ifndef SKIP_ATTN
            { unsigned char* ws = WSP();
                nsa::AttnBufs T{ws};
#ifdef REP_ATTN
                nsa::attn_block<REP_ATTN>(bx >> 2, bx & 3, T, lds, NOWTID());
#endif
                nsa::attn_block(bx >> 2, bx & 3, T, lds, NOWTID());
            }
#endif
            GSYNC();
#ifndef SKIP_P11
            { unsigned char* ws = WSP(); float* out = OUTP();
                pg8::Gemm g = pg8::make_gemm((const bf16_t*)(ws + WS_OATT), (const bf16_t*)(ws + WS_WNO), M_TOK, 1024, 1024, 1024, 1024);
                pg8::StaticOrder S; S.init(M_TOK, 1024, G, bx);
                epi::EpiRes E{out, out, (bf16_t*)(ws + WS_XB), (float*)(ws + WS_RSS) + 3 * M_TOK};
                pg8::gemm_phase(lds, lds + EPI_OFF, g, S, E, NOWTID());
            }
#endif
            GSYNC();
        }
#ifndef SKIP_UP
        { unsigned char* ws = WSP();
            const float* rss_in = (const float*)(ws + WS_RSS) + (layer == 0 ? 1 : 3) * M_TOK;
            const float* cw = INP(19) + (size_t)layer * 3 * 5632; const float* cb = INP(20) + (size_t)layer * 5632;
            pg8::Gemm g = pg8::make_gemm((const bf16_t*)(ws + WS_XB), (const bf16_t*)(ws + WS_WUP) + (size_t)layer * 5632 * 1024, M_TOK, 5632, 1024, 1024, 1024);
            pg8::StaticOrder S; S.init(M_TOK, 5632, G, bx);
            epi::EpiFfnUp E{(bf16_t*)(ws + WS_ACT), (float*)(ws + WS_HALO), rss_in, cw, cb};
#ifdef REP_UP
            pg8::gemm_phase(lds, lds + EPI_OFF, g, S, E, NOWTID());
#endif
#ifdef REP_UPNULL
            { epi::EpiNull EN; pg8::gemm_phase(lds, lds + EPI_OFF, g, S, EN, NOWTID()); }
#endif
            pg8::gemm_phase(lds, lds + EPI_OFF, g, S, E, NOWTID());
        }
#endif
        GSYNC();
#ifndef SKIP_FIX
        { PH_COMMON
            const float* cw = INP(19) + (size_t)layer * 3 * 5632; const float* cb = INP(20) + (size_t)layer * 5632;
            const float* HALO = (const float*)(ws + WS_HALO); bf16_t* ACT = (bf16_t*)(ws + WS_ACT);
#ifdef REP_FIX
            for (int rep_ = 0; rep_ < 2; ++rep_)
#endif
            for (int i = bx * 512 + tid; i < 128 * 2 * 2816; i += G * 512) {
                const int f = i % 2816, pr = i / 2816, r = pr & 1, pm = pr >> 1;
                if ((pm & 7) == 0) continue;
                const int pn = f >> 7, cc = f & 127;
                const float* hc = HALO + ((size_t)(pm * 22 + pn) * 4) * 256; const float* hp = HALO + ((size_t)((pm - 1) * 22 + pn) * 4) * 256;
                float ug, ug1, ug2, uv, uv1, uv2;
                if (r == 0) { ug = hc[cc]; ug1 = hp[3 * 256 + cc]; ug2 = hp[2 * 256 + cc]; uv = hc[128 + cc]; uv1 = hp[3 * 256 + 128 + cc]; uv2 = hp[2 * 256 + 128 + cc]; }
                else { ug = hc[256 + cc]; ug1 = hc[cc]; ug2 = hp[3 * 256 + cc]; uv = hc[256 + 128 + cc]; uv1 = hc[128 + cc]; uv2 = hp[3 * 256 + 128 + cc]; }
                const float og = cb[f] + cw[f] * ug2 + cw[5632 + f] * ug1 + cw[2 * 5632 + f] * ug;
                const float ov = cb[2816 + f] + cw[2816 + f] * uv2 + cw[5632 + 2816 + f] * uv1 + cw[2 * 5632 + 2816 + f] * uv;
                const float a = og * __builtin_amdgcn_rcpf(1.0f + __expf(-og)) * ov;
                ACT[(size_t)(pm * 256 + r) * 2816 + f] = (bf16_t)(pg8::cvt_pk_bf16(a, 0.f) & 0xffffu);
            }
        }
#endif
        GSYNC();
#ifndef SKIP_DOWN
        { unsigned char* ws = WSP(); float* out = OUTP();
            float* rss_out = (float*)(ws + WS_RSS) + (layer == 0 ? 2 : 4) * M_TOK;
            pg8::Gemm g = pg8::make_gemm((const bf16_t*)(ws + WS_ACT), (const bf16_t*)(ws + WS_WDN) + (size_t)layer * 1024 * 2816, M_TOK, 1024, 2816, 2816, 2816);
            pg8::StaticOrder S; S.init(M_TOK, 1024, G, bx);
            epi::EpiRes E{out, out, (bf16_t*)(ws + WS_XB), rss_out};
            pg8::gemm_phase(lds, lds + EPI_OFF, g, S, E, NOWTID());
        }
#endif
        GSYNC();
    }
    { PH_COMMON
        const float* rss = (const float*)(ws + WS_RSS) + 4 * M_TOK; float* out = OUTP(); const float* norm_final = INP(22);
        for (int m = gw; m < M_TOK; m += NGW) {
            const float rs = rsqrtf(rss[m] * (1.0f / 1024.0f) + 1e-6f);
            pro::f32x4* xr = (pro::f32x4*)(out + (size_t)m * 1024) + lane; const pro::f32x4* gr = (const pro::f32x4*)norm_final + lane;
#pragma unroll
            for (int j = 0; j < 4; ++j) { const pro::f32x4 v = xr[64 * j], gg = gr[64 * j]; xr[64 * j] = v * rs * gg; }
        }
    }
}

extern "C" void kernel_launch(void* const* d_in, const int* in_sizes, int n_in, void* d_out, int out_size, void* d_ws, size_t ws_size, hipStream_t stream) {
    static int grid = 0;
    if (grid == 0) {
        if (n_in != 23 || ws_size < WS_END) { fprintf(stderr, "kernel_launch: unexpected n_in %d or ws_size %zu (< %zu)\n", n_in, ws_size, (size_t)WS_END); grid = -1; return; }
        int dev = 0, cus = 0, per_cu = 0;
        (void)hipGetDevice(&dev);
        (void)hipDeviceGetAttribute(&cus, hipDeviceAttributeMultiprocessorCount, dev);
        (void)hipFuncSetAttribute((const void*)yoco_fwd, hipFuncAttributeMaxDynamicSharedMemorySize, LDS_BYTES);
        (void)hipOccupancyMaxActiveBlocksPerMultiprocessor(&per_cu, (const void*)yoco_fwd, 512, LDS_BYTES);
        if (per_cu < 1) { fprintf(stderr, "kernel_launch: occupancy query reports %d blocks per CU\n", per_cu); grid = -1; return; }
        grid = cus;
        if (grid > 256) grid = 256;
        grid &= ~7;
    }
    if (grid <= 0) return;
    (void)hipMemsetAsync((char*)d_ws + WS_RSS, 0, 1 * MiB, stream);
    Params p{};
    for (int i = 0; i < 23; ++i) p.in[i] = (const float*)d_in[i];
    p.out = (float*)d_out; p.ws = (unsigned char*)d_ws;
    void* args[] = {&p};
    hipError_t e = hipLaunchCooperativeKernel((void*)yoco_fwd, dim3(grid), dim3(512), args, LDS_BYTES, stream);
    if (e != hipSuccess) fprintf(stderr, "cooperative launch failed: %s (grid %d)\n", hipGetErrorString(e), grid);
}
```

```cpp
#include <hip/hip_runtime.h>
#include <hip/hip_cooperative_groups.h>
#include <cstdio>
#include <cstdint>
constexpr size_t MiB = 1u << 20;
constexpr int M_TOK = 32768;
constexpr size_t WS_RSS = 0;
constexpr size_t WS_BAR = 768 * 1024;
constexpr size_t WS_XCNT = 832 * 1024;
constexpr size_t WS_ROPE = 1 * MiB, WS_BIASC = 800 * 1024;
constexpr size_t WS_WGI = 2 * MiB, WS_WGO = 9 * MiB, WS_WKQ = 11 * MiB, WS_WC1 = 17 * MiB, WS_WC2 = 19 * MiB, WS_WNO = 20 * MiB, WS_WUP = 22 * MiB, WS_WDN = 44 * MiB;
constexpr size_t WS_XB = 56 * MiB;
constexpr size_t WS_BIG = 120 * MiB;
constexpr size_t WS_GQ = WS_BIG, WS_GK = WS_BIG + 32 * MiB, WS_GV = WS_BIG + 64 * MiB, WS_GR = WS_BIG + 128 * MiB, WS_GG = WS_BIG + 192 * MiB;
constexpr size_t WS_ACT = WS_BIG, WS_HALO = WS_BIG + 176 * MiB;
constexpr size_t WS_KV = WS_BIG, WS_NQ = WS_BIG + 96 * MiB, WS_NQR = WS_BIG + 160 * MiB, WS_GATES = WS_BIG + 224 * MiB, WS_HP = WS_BIG + 230 * MiB, WS_KCVC = WS_BIG + 294 * MiB, WS_OATT = WS_BIG + 296 * MiB;
constexpr size_t WS_XSLOT = WS_BIG + 372 * MiB;
constexpr size_t WS_END = WS_BIG + 376 * MiB;
constexpr int LDS_BYTES = 160 * 1024, EPI_OFF = 131072;


#define LAS __attribute__((address_space(3)))
#define XB_TMO      128
#define XB_XCNT(j)  (256  + 64 * (j))
#define XB_XSUB(j)  (1280 + 64 * (j))
#define XB_XGEN(j)  (2304 + 64 * (j))
#define XB_TOP      3328
#define XB_TOPGEN   3392
#define XCD_BAR_WORDS 3456
#define XB_SPIN_CAP (1u << 18)

__device__ __forceinline__ unsigned xb_ld(unsigned* p)              { return __hip_atomic_load(p, __ATOMIC_RELAXED, __HIP_MEMORY_SCOPE_AGENT); }
__device__ __forceinline__ unsigned xb_add(unsigned* p, unsigned v) { return __hip_atomic_fetch_add(p, v, __ATOMIC_RELAXED, __HIP_MEMORY_SCOPE_AGENT); }
__device__ __forceinline__ unsigned xb_xcc_id() { return (unsigned)__builtin_amdgcn_s_getreg((3 << 11) | 20) & 0xFu; }
#define XB_SPIN(cond, bar) do { unsigned _sp = 0; while (cond) { __builtin_amdgcn_s_sleep(1); \
    if ((++_sp & 255u) == 0u) { if (xb_ld(&(bar)[XB_TMO])) break; if (_sp > XB_SPIN_CAP) { atomicAdd(&(bar)[XB_TMO], 1u); break; } } } } while (0)

struct XcdBarrier {
    unsigned* bar; unsigned x;
    volatile LAS unsigned* st;
};

__device__ __forceinline__ XcdBarrier xcd_barrier_post(unsigned* bar, volatile LAS unsigned* st, int tid) {
    XcdBarrier b; b.bar = bar; b.x = xb_xcc_id(); b.st = st;
    if (tid == 0) (void)xb_add(&bar[XB_XCNT(b.x)], 1u);
    return b;
}
__device__ __forceinline__ void xcd_barrier_complete(unsigned* bar, unsigned x, unsigned& nloc, unsigned& nx) {
    const unsigned G = gridDim.x * gridDim.y * gridDim.z;
    unsigned sum, cnt, mine, sp = 0u;
    for (;;) {
        sum = 0u; cnt = 0u; mine = 0u;
#pragma unroll
        for (unsigned j = 0; j < 16; ++j) { const unsigned c = xb_ld(&bar[XB_XCNT(j)]); sum += c; cnt += (c > 0u) ? 1u : 0u; mine = (j == x) ? c : mine; }
        if (sum == G) break;
        __builtin_amdgcn_s_sleep(1);
        if ((++sp & 255u) == 0u) { if (xb_ld(&bar[XB_TMO])) break; if (sp > XB_SPIN_CAP) { atomicAdd(&bar[XB_TMO], 1u); break; } }
    }
    nloc = mine > 0u ? mine : 1u; nx = cnt > 0u ? cnt : 1u;
}

__device__ __forceinline__ void xcd_barrier(const XcdBarrier& b, int tid) {
    asm volatile("s_waitcnt vmcnt(0)" ::: "memory");
    __syncthreads();
    if (tid == 0) {
        unsigned* bar = b.bar;
        __builtin_amdgcn_s_waitcnt(0);
        unsigned nloc = b.st[0], nx = b.st[1];
        if (nloc == 0u) { xcd_barrier_complete(bar, b.x, nloc, nx); b.st[0] = nloc; b.st[1] = nx; }
        const unsigned old = xb_add(&bar[XB_XSUB(b.x)], 1u);
        const unsigned gen = old / nloc;
        if (old + 1u == (gen + 1u) * nloc) {
            __builtin_amdgcn_fence(__ATOMIC_RELEASE, "agent");
            asm volatile("s_waitcnt vmcnt(0)" ::: "memory");
            const unsigned og = xb_add(&bar[XB_TOP], 1u);
            const unsigned tg = og / nx;
            if (og + 1u == (tg + 1u) * nx) xb_add(&bar[XB_TOPGEN], 1u);
            else XB_SPIN(xb_ld(&bar[XB_TOPGEN]) == tg, bar);
            __builtin_amdgcn_fence(__ATOMIC_ACQUIRE, "agent");
            xb_add(&bar[XB_XGEN(b.x)], 1u);
            asm volatile("s_waitcnt vmcnt(0)" ::: "memory");
        } else {
            XB_SPIN(xb_ld(&bar[XB_XGEN(b.x)]) == gen, bar);
            __builtin_amdgcn_fence(__ATOMIC_ACQUIRE, "agent");
            asm volatile("s_waitcnt vmcnt(0)" ::: "memory");
        }
    }
    __syncthreads();
}

__device__ __forceinline__ int lane_id() { return (int)__builtin_amdgcn_mbcnt_hi(~0u, __builtin_amdgcn_mbcnt_lo(~0u, 0u)); }
__device__ __forceinline__ int lane_id_fresh() { int l; asm volatile("v_mbcnt_lo_u32_b32 %0, -1, 0\n\tv_mbcnt_hi_u32_b32 %0, -1, %0" : "=v"(l)); return l; }
template <class T> __device__ __forceinline__ T dpp_xor1(T x) { return __builtin_bit_cast(T, __builtin_amdgcn_mov_dpp(__builtin_bit_cast(int, x), 0xB1, 0xf, 0xf, true)); }
template <class T> __device__ __forceinline__ T dpp_xor2(T x) { return __builtin_bit_cast(T, __builtin_amdgcn_mov_dpp(__builtin_bit_cast(int, x), 0x4E, 0xf, 0xf, true)); }
template <class T> __device__ __forceinline__ T dpp_hmirror(T x) { return __builtin_bit_cast(T, __builtin_amdgcn_mov_dpp(__builtin_bit_cast(int, x), 0x141, 0xf, 0xf, true)); }
template <class T> __device__ __forceinline__ T swz_xor16(T x) { return __builtin_bit_cast(T, __builtin_amdgcn_ds_swizzle(__builtin_bit_cast(int, x), 0x401F)); }
namespace pg8 {
#define PG8_LAS __attribute__((address_space(3)))
typedef unsigned short bf16_t;
typedef short bf16x8 __attribute__((ext_vector_type(8)));
typedef float f32x4 __attribute__((ext_vector_type(4)));
typedef float f32x2 __attribute__((ext_vector_type(2)));
typedef unsigned u32x4 __attribute__((ext_vector_type(4)));
typedef unsigned u32x2 __attribute__((ext_vector_type(2)));
constexpr int BM = 256, BK = 64, HALF = 128, HTB = HALF * BK * 2, STAGE_BYTES = 8 * HTB, NXCD = 8, WGM = 8;

__host__ __device__ __forceinline__ int lds_byte(int r, int c) { const int st = (r >> 4) * 2 + (c >> 5), rr = r & 15, cc = c & 31, ob = rr * 64 + cc * 2; return st * 1024 + (ob ^ (((ob >> 9) & 1) << 5)); }
__host__ __device__ __forceinline__ void stage_rc(int b, int& R, int& C) { const int st = b / 1024, sb = b % 1024, swz = sb ^ (((sb >> 9) & 1) << 5); R = (st >> 1) * 16 + swz / 64; C = (st & 1) * 32 + (swz % 64) / 2; }
__host__ __device__ __forceinline__ int perm32(int rho) { const int n = rho >> 4, i = rho & 15; return 8 * (i >> 2) + 4 * n + (i & 3); }

struct Unit { int pm, pn; };
struct Gemm { const bf16_t* A; const bf16_t* Bt; int M, N, K; int lda, ldb; size_t a_pm, a_pn, b_pn, b_hi; int b_split; };
__device__ __forceinline__ Gemm make_gemm(const bf16_t* A, const bf16_t* Bt, int M, int N, int K, int lda, int ldb) {
    Gemm g; g.A = A; g.Bt = Bt; g.M = M; g.N = N; g.K = K; g.lda = lda; g.ldb = ldb;
    g.a_pm = (size_t)BM * lda * 2; g.a_pn = 0; g.b_pn = (size_t)BM * ldb * 2; g.b_hi = 0; g.b_split = 0x7fffffff; return g;
}

struct StaticOrder {
    int nM, nN, nwg, G, c;
    __device__ void init(int M, int N, int G_, int c_) { nM = M / BM; nN = N / BM; nwg = nM * nN; G = G_; c = c_; }
    __device__ bool next(int i, Unit& u) const {
        const long L = (long)i * G + c; if (L >= nwg) return false;
        int wgid = (int)L; { const int q = nwg / NXCD, r = nwg % NXCD, xcd = wgid % NXCD, off = wgid / NXCD; wgid = (xcd < r ? xcd * (q + 1) : r * (q + 1) + (xcd - r) * q) + off; }
        const int nig = WGM * nN, gid = wgid / nig, fm = gid * WGM, gsz = (nM - fm) < WGM ? (nM - fm) : WGM;
        u.pm = fm + ((wgid % nig) % gsz); u.pn = (wgid % nig) / gsz; return true;
    }
};

__device__ __forceinline__ unsigned cvt_pk_bf16(float lo, float hi) {
    typedef __bf16 bf16x2_t __attribute__((ext_vector_type(2)));
    f32x2 v = {lo, hi}; bf16x2_t b = __builtin_convertvector(v, bf16x2_t); return __builtin_bit_cast(unsigned, b);
}

template <class Epi>
__device__ __forceinline__ void gemm_phase(PG8_LAS unsigned char* lds, PG8_LAS unsigned char* lds_epi, const Gemm g, const StaticOrder& S, const Epi& E, int tid0) {
    int tid_ = tid0; asm volatile("" : "+v"(tid_));
    const int tid = tid_, wid = __builtin_amdgcn_readfirstlane(tid >> 6), lane = tid & 63, wr = wid >> 2, wc = wid & 3, fr = lane & 15, fq = lane >> 4;
    const int K = g.K, nt = K / BK;
    unsigned voffA[2], voffB[2];
#pragma unroll
    for (int i = 0; i < 2; ++i) { int R, C; stage_rc(tid * 16 + i * 8192, R, C); const int Rb = (R & ~31) + perm32(R & 31);
        voffA[i] = (unsigned)(R * g.lda + C) * 2u; voffB[i] = (unsigned)(Rb * g.ldb + C) * 2u; }
    const size_t kstep = (size_t)(BK * 2);
    const size_t hstepA = (size_t)HALF * g.lda * 2, hstepB = (size_t)HALF * g.ldb * 2;
    const unsigned ldsw = (unsigned)wid * 1024u;
    const int aoff = lds_byte(wr * 64 + fr, fq * 8), boff = lds_byte(wc * 32 + fr, fq * 8);
#define PG8_SA(b, h) (((b) * 2 + (h)) * HTB)
#define PG8_SB(b, h) ((4 + (b) * 2 + (h)) * HTB)
#define PG8_STAGE(bufoff, gbase, voff) do { _Pragma("unroll") for (int _i = 0; _i < 2; ++_i) \
        __builtin_amdgcn_global_load_lds((const unsigned*)((const char*)(gbase) + (voff)[_i]), (PG8_LAS unsigned*)(lds + (bufoff) + ldsw + _i * 8192), 16, 0, 0); } while (0)
#define PG8_LDA(dst, b, h) do { _Pragma("unroll") for (int m = 0; m < 4; ++m) _Pragma("unroll") for (int k = 0; k < 2; ++k) dst[m][k] = *(const PG8_LAS bf16x8*)(lds + PG8_SA(b, h) + aoff + m * 2048 + k * 1024); } while (0)
#define PG8_LDB(dst, b, h) do { _Pragma("unroll") for (int n = 0; n < 2; ++n) _Pragma("unroll") for (int k = 0; k < 2; ++k) dst[n][k] = *(const PG8_LAS bf16x8*)(lds + PG8_SB(b, h) + boff + n * 2048 + k * 1024); } while (0)
#define PG8_MMA(ai, bj, At, Bt) do { __builtin_amdgcn_s_setprio(1); _Pragma("unroll") for (int m = 0; m < 4; ++m) _Pragma("unroll") for (int n = 0; n < 2; ++n) _Pragma("unroll") for (int k = 0; k < 2; ++k) \
        acc[ai][bj][m][n] = __builtin_amdgcn_mfma_f32_16x16x32_bf16(Bt[n][k], At[m][k], acc[ai][bj][m][n], 0, 0, 0); __builtin_amdgcn_s_setprio(0); } while (0)
#define PG8_WAIT_V(n) asm volatile("s_waitcnt vmcnt(" #n ")" ::: "memory")
#define PG8_WAIT_L(n) asm volatile("s_waitcnt lgkmcnt(" #n ")" ::: "memory")
#define PG8_BAR __builtin_amdgcn_s_barrier()
#define PG8_SCHED __builtin_amdgcn_sched_barrier(0)
    Unit cur, nxt; int ui = 0;
    if (!S.next(0, cur)) return;
    f32x4 acc[2][2][4][2];
#pragma unroll
    for (int a = 0; a < 2; ++a)
#pragma unroll
        for (int b = 0; b < 2; ++b)
#pragma unroll
            for (int m = 0; m < 4; ++m)
#pragma unroll
                for (int n = 0; n < 2; ++n) acc[a][b][m][n] = (f32x4){0.f, 0.f, 0.f, 0.f};
    bf16x8 At[4][2], B0[2][2], B1[2][2];
    const char* cA = (const char*)g.A + (size_t)cur.pm * g.a_pm + (size_t)cur.pn * g.a_pn;
    const char* cB = (const char*)g.Bt + (size_t)cur.pn * g.b_pn + (cur.pm >= g.b_split ? g.b_hi : (size_t)0);
    PG8_STAGE(PG8_SB(0, 0), cB, voffB); PG8_STAGE(PG8_SB(0, 1), cB + hstepB, voffB); PG8_STAGE(PG8_SA(0, 0), cA, voffA); PG8_STAGE(PG8_SA(0, 1), cA + hstepA, voffA);
    if (wr == 1) PG8_BAR;
    PG8_WAIT_V(2); PG8_BAR;
    PG8_STAGE(PG8_SB(1, 0), cB + kstep, voffB); PG8_STAGE(PG8_SA(1, 0), cA + kstep, voffA); PG8_STAGE(PG8_SB(1, 1), cB + hstepB + kstep, voffB);
    PG8_WAIT_V(6); PG8_BAR;
    for (;;) {
        const bool has_next = S.next(ui + 1, nxt);
        const char* nA = has_next ? (const char*)g.A + (size_t)nxt.pm * g.a_pm + (size_t)nxt.pn * g.a_pn : cA;
        const char* nB = has_next ? (const char*)g.Bt + (size_t)nxt.pn * g.b_pn + (nxt.pm >= g.b_split ? g.b_hi : (size_t)0) : cB;
        E.prefetch(cur, ui, lds_epi, wid, lane);
        for (int t = 0; t < nt; t += 2) {
            const bool last = (t == nt - 2);
            const char* a1 = cA + (size_t)(t + 1) * kstep;
            const char* a2 = last ? nA : cA + (size_t)(t + 2) * kstep; const char* b2 = last ? nB : cB + (size_t)(t + 2) * kstep;
            const char* a3 = a2 + kstep; const char* b3 = b2 + kstep;
            PG8_LDB(B0, 0, 0); PG8_LDB(B1, 0, 1); PG8_SCHED; PG8_LDA(At, 0, 0); PG8_STAGE(PG8_SA(1, 1), a1 + hstepA, voffA);
            PG8_WAIT_V(8); PG8_WAIT_L(0); PG8_BAR; PG8_MMA(0, 0, At, B0); PG8_MMA(0, 1, At, B1); PG8_BAR; PG8_SCHED;
            PG8_LDA(At, 0, 1); PG8_STAGE(PG8_SB(0, 0), b2, voffB); PG8_STAGE(PG8_SB(0, 1), b2 + hstepB, voffB); PG8_STAGE(PG8_SA(0, 0), a2, voffA);
            PG8_WAIT_V(8); PG8_WAIT_L(0); PG8_BAR; PG8_MMA(1, 0, At, B0); PG8_MMA(1, 1, At, B1); PG8_BAR; PG8_SCHED;
            PG8_LDB(B0, 1, 0); PG8_LDB(B1, 1, 1); PG8_SCHED; PG8_LDA(At, 1, 0); PG8_STAGE(PG8_SA(0, 1), a2 + hstepA, voffA);
            PG8_WAIT_V(8); PG8_WAIT_L(0); PG8_BAR; PG8_MMA(0, 0, At, B0); PG8_MMA(0, 1, At, B1); PG8_BAR; PG8_SCHED;
            PG8_LDA(At, 1, 1); PG8_STAGE(PG8_SB(1, 0), b3, voffB); PG8_STAGE(PG8_SB(1, 1), b3 + hstepB, voffB); PG8_STAGE(PG8_SA(1, 0), a3, voffA);
            PG8_WAIT_V(8); PG8_WAIT_L(0); PG8_BAR; PG8_MMA(1, 0, At, B0); PG8_MMA(1, 1, At, B1); PG8_BAR; PG8_SCHED;
        }
        if (wr == 0) PG8_BAR;
        E(acc, cur, ui, wr, wc, fr, fq, lds_epi);
        if (!has_next) break;
#pragma unroll
        for (int a = 0; a < 2; ++a)
#pragma unroll
            for (int b = 0; b < 2; ++b)
#pragma unroll
                for (int m = 0; m < 4; ++m)
#pragma unroll
                    for (int n = 0; n < 2; ++n) acc[a][b][m][n] = (f32x4){0.f, 0.f, 0.f, 0.f};
        cur = nxt; cA = nA; cB = nB; ++ui;
        if (wr == 1) PG8_BAR;
    }
    PG8_WAIT_V(0);
    PG8_BAR;
#undef PG8_SA
#undef PG8_SB
#undef PG8_STAGE
#undef PG8_LDA
#undef PG8_LDB
#undef PG8_MMA
#undef PG8_WAIT_V
#undef PG8_WAIT_L
#undef PG8_BAR
#undef PG8_SCHED
}
}
namespace epi {
using namespace pg8;
constexpr float EPS = 1e-6f;
__device__ __forceinline__ float rstd_of(float ss) { return rsqrtf(ss * (1.0f / 1024.0f) + EPS); }
__device__ __forceinline__ float sigmoidf_(float x) { return __builtin_amdgcn_rcpf(1.0f + __expf(-x)); }
__device__ __forceinline__ float siluf_(float x) { return x * __builtin_amdgcn_rcpf(1.0f + __expf(-x)); }
__device__ __forceinline__ u32x4 pack8(const f32x4& a, const f32x4& b) { u32x4 w; w.x = cvt_pk_bf16(a[0], a[1]); w.y = cvt_pk_bf16(a[2], a[3]); w.z = cvt_pk_bf16(b[0], b[1]); w.w = cvt_pk_bf16(b[2], b[3]); return w; }

constexpr int EC_OFF = 16384, EC_STRIDE = 6144;
__device__ __forceinline__ void dma16(const void* g, PG8_LAS unsigned char* l) { __builtin_amdgcn_global_load_lds((const unsigned*)g, (PG8_LAS unsigned*)l, 16, 0, 0); }
__device__ __forceinline__ void dma_rss(const float* rss, int pm, int ui, PG8_LAS unsigned char* le, int wid, int lane) {
    if (wid == 0) dma16(rss + pm * BM + 4 * lane, le + EC_OFF + (ui & 1) * EC_STRIDE);
}
struct EpiGlaIn {
    bf16_t* Q; bf16_t* Kk; bf16_t* V; bf16_t* R; float* G; const float* rss; const float* b_alpha;
    __device__ __forceinline__ void prefetch(const Unit& u, int ui, PG8_LAS unsigned char* le, int wid, int lane) const { dma_rss(rss, u.pm, ui, le, wid, lane); }
    template <int CLS>
    __device__ __forceinline__ void tile(f32x4 (&acc)[2][2][4][2], bf16_t* dst, int pitch, float sc, int gcol0, int ui, int wr, int wc, int fr, int fq, int row0, PG8_LAS unsigned char* le) const {
        const int ct = wc * 32 + 8 * fq;
        f32x4 bb[2][2];
        if (CLS == 2) {
#pragma unroll
            for (int bj = 0; bj < 2; ++bj) { bb[bj][0] = *(const f32x4*)(b_alpha + gcol0 + bj * HALF + ct); bb[bj][1] = *(const f32x4*)(b_alpha + gcol0 + bj * HALF + ct + 4); }
        }
#pragma unroll
        for (int ai = 0; ai < 2; ++ai)
#pragma unroll
            for (int m = 0; m < 4; ++m) {
                const int row = row0 + ai * HALF + m * 16;
                const float rs = rstd_of(((const PG8_LAS float*)(le + EC_OFF + (ui & 1) * EC_STRIDE))[wr * 64 + fr + ai * HALF + m * 16]);
#pragma unroll
                for (int bj = 0; bj < 2; ++bj) {
                    f32x4 v0 = acc[ai][bj][m][0] * rs, v1 = acc[ai][bj][m][1] * rs;
                    const int c = bj * HALF + ct;
                    if (CLS == 0) { *(u32x4*)(dst + (size_t)row * pitch + c) = pack8(v0 * sc, v1 * sc); }
                    else if (CLS == 1) {
#pragma unroll
                        for (int j = 0; j < 4; ++j) { v0[j] = siluf_(v0[j]); v1[j] = siluf_(v1[j]); }
                        *(u32x4*)(dst + (size_t)row * pitch + c) = pack8(v0, v1); }
                    else {
                        f32x4 o0, o1;
#pragma unroll
                        for (int j = 0; j < 4; ++j) {
                            const float z0 = v0[j] + bb[bj][0][j], z1 = v1[j] + bb[bj][1][j];
                            o0[j] = (fminf(z0, 0.f) - __logf(1.0f + __expf(-fabsf(z0)))) * 0.0625f;
                            o1[j] = (fminf(z1, 0.f) - __logf(1.0f + __expf(-fabsf(z1)))) * 0.0625f; }
                        float* gp = G + (size_t)row * 512 + gcol0 + c;
                        *(f32x4*)(gp) = o0; *(f32x4*)(gp + 4) = o1; }
                }
            }
    }
    __device__ __forceinline__ void operator()(f32x4 (&acc)[2][2][4][2], const Unit& u, int ui, int wr, int wc, int fr, int fq, PG8_LAS unsigned char* le) const {
        asm volatile("" : "+v"(fr), "+v"(fq));
        const int pn = u.pn;
        const int row0 = u.pm * BM + wr * 64 + fr;
        if (pn < 8) {
            bf16_t* dst; int pitch; float sc = 1.0f;
            if (pn < 2) { dst = Q + pn * 256; pitch = 512; sc = 0.08838834764831845f; } else if (pn < 4) { dst = Kk + (pn - 2) * 256; pitch = 512; } else { dst = V + (pn - 4) * 256; pitch = 1024; }
            tile<0>(acc, dst, pitch, sc, 0, ui, wr, wc, fr, fq, row0, le);
        } else if (pn < 12) tile<1>(acc, R + (pn - 8) * 256, 1024, 1.0f, 0, ui, wr, wc, fr, fq, row0, le);
        else tile<2>(acc, nullptr, 0, 1.0f, (pn - 12) * 256, ui, wr, wc, fr, fq, row0, le);
    }
};

__device__ __forceinline__ void unpack8(const u32x4& w, f32x4& a, f32x4& b) {
    a[0] = __uint_as_float(w.x << 16); a[1] = __uint_as_float(w.x & 0xffff0000u); a[2] = __uint_as_float(w.y << 16); a[3] = __uint_as_float(w.y & 0xffff0000u);
    b[0] = __uint_as_float(w.z << 16); b[1] = __uint_as_float(w.z & 0xffff0000u); b[2] = __uint_as_float(w.w << 16); b[3] = __uint_as_float(w.w & 0xffff0000u);
}
struct EpiRes {
    float* xout; bf16_t* XB; float* rss;
    __device__ __forceinline__ void prefetch(const Unit&, int, PG8_LAS unsigned char*, int, int) const {}
    __device__ __forceinline__ void operator()(f32x4 (&acc)[2][2][4][2], const Unit& u, int ui, int wr, int wc, int fr, int fq, PG8_LAS unsigned char* le) const {
        asm volatile("" : "+v"(fr), "+v"(fq));
        const int row0 = u.pm * BM + wr * 64 + fr;
        const int col0 = u.pn * BM + wc * 32 + 8 * fq;
        u32x4 xb[2][4][2];
#pragma unroll
        for (int ai = 0; ai < 2; ++ai)
#pragma unroll
            for (int m = 0; m < 4; ++m)
#pragma unroll
                for (int bj = 0; bj < 2; ++bj) xb[ai][m][bj] = *(const u32x4*)(XB + (size_t)(row0 + ai * HALF + m * 16) * 1024 + col0 + bj * HALF);
#pragma unroll
        for (int ai = 0; ai < 2; ++ai)
#pragma unroll
            for (int m = 0; m < 4; ++m) {
                const int row = row0 + ai * HALF + m * 16;
                float ss = 0.f;
#pragma unroll
                for (int bj = 0; bj < 2; ++bj) {
                    const size_t off = (size_t)row * 1024 + col0 + bj * HALF;
                    f32x4 x0, x1; unpack8(xb[ai][m][bj], x0, x1);
                    const f32x4 v0 = x0 + acc[ai][bj][m][0], v1 = x1 + acc[ai][bj][m][1];
                    if (xout) { *(f32x4*)(xout + off) = v0; *(f32x4*)(xout + off + 4) = v1; }
                    *(u32x4*)(XB + off) = pack8(v0, v1);
                    ss += (v0[0] * v0[0] + v0[1] * v0[1]) + (v0[2] * v0[2] + v0[3] * v0[3]) + (v1[0] * v1[0] + v1[1] * v1[1]) + (v1[2] * v1[2] + v1[3] * v1[3]);
                }
                ss += swz_xor16(ss); { auto rr_ = __builtin_amdgcn_permlane32_swap(__float_as_uint(ss), __float_as_uint(ss), false, false); ss = __uint_as_float(rr_[0]) + __uint_as_float(rr_[1]); }
                if (fq == 0) atomicAdd(rss + row, ss);
            }
    }
};

__device__ __forceinline__ float dpp_ror1(float x) { return __builtin_bit_cast(float, __builtin_amdgcn_mov_dpp(__builtin_bit_cast(int, x), 0x121, 0xf, 0xf, true)); }
__device__ __forceinline__ float dpp_ror2(float x) { return __builtin_bit_cast(float, __builtin_amdgcn_mov_dpp(__builtin_bit_cast(int, x), 0x122, 0xf, 0xf, true)); }
constexpr int FF = 2816;
struct EpiFfnUp {
    bf16_t* ACT; float* HALO; const float* rss; const float* cw; const float* cb;
    __device__ __forceinline__ void prefetch(const Unit& u, int ui, PG8_LAS unsigned char* le, int wid, int lane) const {
        dma_rss(rss, u.pm, ui, le, wid, lane);
        if (wid >= 1 && wid <= 4) { const int k = wid - 1; const float* src = (k == 0 ? cb : cw + (k - 1) * 2 * FF) + u.pn * 128 + ((lane < 32) ? 4 * lane : FF + 4 * (lane - 32));
            dma16(src, le + EC_OFF + (ui & 1) * EC_STRIDE + 1024 + k * 1024); }
    }
    __device__ __forceinline__ void operator()(f32x4 (&acc)[2][2][4][2], const Unit& u, int ui, int wr, int wc, int fr, int fq, PG8_LAS unsigned char* le) const {
        asm volatile("" : "+v"(fr), "+v"(fq));
        const int row0 = u.pm * BM + wr * 64 + fr;
        const PG8_LAS float* EC = (const PG8_LAS float*)(le + EC_OFF + (ui & 1) * EC_STRIDE);
#pragma unroll
        for (int ai = 0; ai < 2; ++ai)
#pragma unroll
            for (int m = 0; m < 4; ++m) {
                const float rs = rstd_of(EC[wr * 64 + fr + ai * HALF + m * 16]);
#pragma unroll
                for (int bj = 0; bj < 2; ++bj) { acc[ai][bj][m][0] = acc[ai][bj][m][0] * rs; acc[ai][bj][m][1] = acc[ai][bj][m][1] * rs; }
            }
        PG8_LAS float* HL = (PG8_LAS float*)le + (ui & 1) * 2048;
        if (fr >= 14) {
#pragma unroll
            for (int ai = 0; ai < 2; ++ai)
#pragma unroll
                for (int bj = 0; bj < 2; ++bj)
#pragma unroll
                    for (int n = 0; n < 2; ++n)
                        *(PG8_LAS f32x4*)(HL + ((((wr * 4 + wc) * 2 + ai) * 2 + (fr - 14)) * 64) + bj * 32 + fq * 8 + n * 4) = acc[ai][bj][3][n];
        }
        {
            float* hb = HALO + ((size_t)(u.pm * 22 + u.pn) * 4) * 256 + wc * 32 + fq * 8;
            if (wr == 0 && fr < 2) {
#pragma unroll
                for (int bj = 0; bj < 2; ++bj)
#pragma unroll
                    for (int n = 0; n < 2; ++n) *(f32x4*)(hb + fr * 256 + bj * HALF + n * 4) = acc[0][bj][0][n];
            }
            if (wr == 1 && fr >= 14) {
#pragma unroll
                for (int bj = 0; bj < 2; ++bj)
#pragma unroll
                    for (int n = 0; n < 2; ++n) *(f32x4*)(hb + (fr - 12) * 256 + bj * HALF + n * 4) = acc[1][bj][3][n];
            }
        }
        asm volatile("s_waitcnt lgkmcnt(0)" ::: "memory"); __builtin_amdgcn_s_barrier(); asm volatile("" ::: "memory");
        const bool seq_start = (u.pm & 7) == 0;
        const int cc0 = wc * 32 + fq * 8;
        const bool is15 = (fr == 15), ge14 = (fr >= 14);
        const PG8_LAS float* WB = EC + 256 + cc0;
#pragma unroll
        for (int ai = 0; ai < 2; ++ai) {
            f32x4 pg[2], pv[2];
            if (ai == 0 && wr == 0) { pg[0] = pg[1] = pv[0] = pv[1] = (f32x4){0.f, 0.f, 0.f, 0.f}; }
            else {
                const int swr = (ai == 1 && wr == 1) ? 0 : (ai == 0 ? 0 : 1), sai = (ai == 1 && wr == 1) ? 1 : 0;
                const PG8_LAS float* hp = HL + (((swr * 4 + wc) * 2 + sai) * 2 + (is15 ? 1 : 0)) * 64 + fq * 8;
                pg[0] = *(const PG8_LAS f32x4*)(hp); pg[1] = *(const PG8_LAS f32x4*)(hp + 4); pv[0] = *(const PG8_LAS f32x4*)(hp + 32); pv[1] = *(const PG8_LAS f32x4*)(hp + 36);
            }
#pragma unroll
            for (int m = 0; m < 4; ++m) {
                const int row = row0 + ai * HALF + m * 16;
                u32x4 w;
#pragma unroll
                for (int n = 0; n < 2; ++n) {
                    const f32x4 bg = *(const PG8_LAS f32x4*)(WB + 4 * n), bv = *(const PG8_LAS f32x4*)(WB + 128 + 4 * n);
                    const f32x4 g0 = *(const PG8_LAS f32x4*)(WB + 256 + 4 * n), w0 = *(const PG8_LAS f32x4*)(WB + 256 + 128 + 4 * n);
                    const f32x4 g1 = *(const PG8_LAS f32x4*)(WB + 512 + 4 * n), w1 = *(const PG8_LAS f32x4*)(WB + 512 + 128 + 4 * n);
                    const f32x4 g2 = *(const PG8_LAS f32x4*)(WB + 768 + 4 * n), w2 = *(const PG8_LAS f32x4*)(WB + 768 + 128 + 4 * n);
                    const f32x4 xg = acc[ai][0][m][n], xv = acc[ai][1][m][n];
                    f32x4 g1s, g2s, v1s, v2s;
#pragma unroll
                    for (int j = 0; j < 4; ++j) {
                        g1s[j] = dpp_ror1(is15 ? pg[n][j] : xg[j]); g2s[j] = dpp_ror2(ge14 ? pg[n][j] : xg[j]);
                        v1s[j] = dpp_ror1(is15 ? pv[n][j] : xv[j]); v2s[j] = dpp_ror2(ge14 ? pv[n][j] : xv[j]);
                    }
                    const f32x4 og = bg + g0 * g2s + g1 * g1s + g2 * xg;
                    const f32x4 ov = bv + w0 * v2s + w1 * v1s + w2 * xv;
                    f32x4 e;
#pragma unroll
                    for (int j = 0; j < 4; ++j) e[j] = __builtin_amdgcn_rcpf(1.0f + __builtin_amdgcn_exp2f(og[j] * -1.4426950408889634f));
                    const f32x4 a = og * e * ov;
                    if (n == 0) { w.x = cvt_pk_bf16(a[0], a[1]); w.y = cvt_pk_bf16(a[2], a[3]); } else { w.z = cvt_pk_bf16(a[0], a[1]); w.w = cvt_pk_bf16(a[2], a[3]); }
                    pg[n] = xg; pv[n] = xv;
                }
                const bool skip = (ai == 0 && wr == 0 && m == 0 && fr < 2 && !seq_start);
                if (!skip) *(u32x4*)(ACT + (size_t)row * FF + u.pn * 128 + cc0) = w;
            }
        }
    }
};

struct EpiKvq {
    bf16_t* KV; bf16_t* Q; bf16_t* QR; float* GATES; const float* rss; const _Float16* rope;
    __device__ __forceinline__ void prefetch(const Unit& u, int ui, PG8_LAS unsigned char* le, int wid, int lane) const { dma_rss(rss, u.pm, ui, le, wid, lane); }
    template <bool ISQ>
    __device__ __forceinline__ void rope_tile(f32x4 (&acc)[2][2][4][2], int pn, int ui, int wr, int wc, int fr, int fq, int row0, PG8_LAS unsigned char* le) const {
        const float C2 = 0.125f * 1.4426950408889634f;
        u32x4 rc[8][2];
#pragma unroll
        for (int i = 0; i < 8; ++i) { const int row = row0 + (i >> 2) * HALF + (i & 3) * 16; const _Float16* rp = rope + ((size_t)(row & 2047) * 32 + 8 * fq) * 2;
            rc[i][0] = *(const u32x4*)rp; rc[i][1] = *(const u32x4*)(rp + 8); }
#pragma unroll
        for (int i = 0; i < 8; ++i) { const int ai = i >> 2, m = i & 3;
            const int row = row0 + ai * HALF + m * 16;
            const int b = row >> 11, s = row & 2047;
            const float rs = rstd_of(((const PG8_LAS float*)(le + EC_OFF + (ui & 1) * EC_STRIDE))[wr * 64 + fr + ai * HALF + m * 16]);
            const f32x4 lo0 = acc[ai][0][m][0] * rs, lo1 = acc[ai][0][m][1] * rs;
            const f32x4 hi0 = acc[ai][1][m][0] * rs, hi1 = acc[ai][1][m][1] * rs;
            typedef _Float16 h2_t __attribute__((ext_vector_type(2)));
            float cs[8], sn[8];
#pragma unroll
            for (int j = 0; j < 4; ++j) { const unsigned wa_ = rc[i][0][j], wc_ = rc[i][1][j];
                const h2_t a = __builtin_bit_cast(h2_t, wa_), c = __builtin_bit_cast(h2_t, wc_);
                cs[j] = (float)a[0]; sn[j] = (float)a[1]; cs[4 + j] = (float)c[0]; sn[4 + j] = (float)c[1]; }
            f32x4 rl0, rl1, rh0, rh1;
#pragma unroll
            for (int j = 0; j < 4; ++j) {
                rl0[j] = lo0[j] * cs[j] - hi0[j] * sn[j]; rh0[j] = lo0[j] * sn[j] + hi0[j] * cs[j];
                rl1[j] = lo1[j] * cs[4 + j] - hi1[j] * sn[4 + j]; rh1[j] = lo1[j] * sn[4 + j] + hi1[j] * cs[4 + j];
            }
            if (!ISQ) {
                bf16_t* p = KV + ((((size_t)pn * 16 + b) * 4 + wc) * 2048 + s) * 64 + 8 * fq;
                *(u32x4*)(p) = pack8(rl0, rl1); *(u32x4*)(p + 32) = pack8(rh0, rh1);
            } else {
                const int h = (pn - 6) * 4 + wc;
                const size_t o = (((size_t)b * 16 + h) * 2048 + s) * 64 + 8 * fq;
                *(u32x4*)(Q + o) = pack8(lo0 * C2, lo1 * C2); *(u32x4*)(Q + o + 32) = pack8(hi0 * C2, hi1 * C2);
                *(u32x4*)(QR + o) = pack8(rl0 * C2, rl1 * C2); *(u32x4*)(QR + o + 32) = pack8(rh0 * C2, rh1 * C2);
            }
        }
    }
    __device__ __forceinline__ void operator()(f32x4 (&acc)[2][2][4][2], const Unit& u, int ui, int wr, int wc, int fr, int fq, PG8_LAS unsigned char* le) const {
        asm volatile("" : "+v"(fr), "+v"(fq));
        const int pn = u.pn;
        const int row0 = u.pm * BM + wr * 64 + fr;
        if (pn >= 6 && pn < 10) { rope_tile<true>(acc, pn, ui, wr, wc, fr, fq, row0, le); return; }
        if (pn == 2 || pn == 4) { rope_tile<false>(acc, pn, ui, wr, wc, fr, fq, row0, le); return; }
#pragma unroll
        for (int ai = 0; ai < 2; ++ai)
#pragma unroll
            for (int m = 0; m < 4; ++m) {
                const int row = row0 + ai * HALF + m * 16;
                const int b = row >> 11, s = row & 2047;
                const float rs = rstd_of(((const PG8_LAS float*)(le + EC_OFF + (ui & 1) * EC_STRIDE))[wr * 64 + fr + ai * HALF + m * 16]);
                f32x4 lo0 = acc[ai][0][m][0] * rs, lo1 = acc[ai][0][m][1] * rs;
                f32x4 hi0 = acc[ai][1][m][0] * rs, hi1 = acc[ai][1][m][1] * rs;
                if (pn == 10) {
                    if (wc == 0) {
                        float* gp = GATES + (size_t)row * 48 + 8 * fq;
#pragma unroll
                        for (int j = 0; j < 4; ++j) { lo0[j] = sigmoidf_(lo0[j]); lo1[j] = sigmoidf_(lo1[j]); hi0[j] = sigmoidf_(hi0[j]); hi1[j] = sigmoidf_(hi1[j]); }
                        *(f32x4*)(gp) = lo0; *(f32x4*)(gp + 4) = lo1;
                        if (fq < 2) { *(f32x4*)(gp + 32) = hi0; *(f32x4*)(gp + 36) = hi1; }
                    }
                    continue;
                }
                bf16_t* p = KV + ((((size_t)pn * 16 + b) * 4 + wc) * 2048 + s) * 64 + 8 * fq;
                *(u32x4*)(p) = pack8(lo0, lo1); *(u32x4*)(p + 32) = pack8(hi0, hi1);
            }
    }
};

struct EpiCmp {
    float* HP;
    __device__ __forceinline__ void prefetch(const Unit&, int, PG8_LAS unsigned char*, int, int) const {}
    __device__ __forceinline__ void operator()(f32x4 (&acc)[2][2][4][2], const Unit& u, int ui, int wr, int wc, int fr, int fq, PG8_LAS unsigned char* le) const {
        asm volatile("" : "+v"(fr), "+v"(fq));
        const int row0 = u.pm * BM + wr * 64 + fr;
        float* base = HP + (size_t)u.pn * 16384 * 256;
#pragma unroll
        for (int ai = 0; ai < 2; ++ai)
#pragma unroll
            for (int m = 0; m < 4; ++m) {
                float* rp = base + (size_t)(row0 + ai * HALF + m * 16) * 256 + wc * 32 + 8 * fq;
#pragma unroll
                for (int bj = 0; bj < 2; ++bj) { *(f32x4*)(rp + bj * HALF) = acc[ai][bj][m][0]; *(f32x4*)(rp + bj * HALF + 4) = acc[ai][bj][m][1]; }
            }
    }
};

struct EpiResFinal {
    const bf16_t* XB; float* xout; const float* gfin; unsigned* slots; unsigned* cnt;
    __device__ __forceinline__ void prefetch(const Unit&, int, PG8_LAS unsigned char*, int, int) const {}
    __device__ __forceinline__ void operator()(f32x4 (&acc)[2][2][4][2], const Unit& u, int ui, int wr, int wc, int fr, int fq, PG8_LAS unsigned char* le) const {
        asm volatile("" : "+v"(fr), "+v"(fq));
        const int row0 = u.pm * BM + wr * 64 + fr;
        const int col0 = u.pn * BM + wc * 32 + 8 * fq;
        PG8_LAS float* Pt = (PG8_LAS float*)(le + EC_OFF);
        PG8_LAS float* St = (PG8_LAS float*)(le + EC_OFF + 4096);
#pragma unroll
        for (int ai = 0; ai < 2; ++ai)
#pragma unroll
            for (int m = 0; m < 4; ++m) {
                const int row = row0 + ai * HALF + m * 16;
                float ss = 0.f;
#pragma unroll
                for (int bj = 0; bj < 2; ++bj) {
                    const size_t off = (size_t)row * 1024 + col0 + bj * HALF;
                    f32x4 x0, x1; unpack8(*(const u32x4*)(XB + off), x0, x1);
                    const f32x4 v0 = x0 + acc[ai][bj][m][0], v1 = x1 + acc[ai][bj][m][1];
                    acc[ai][bj][m][0] = v0; acc[ai][bj][m][1] = v1;
                    ss += (v0[0] * v0[0] + v0[1] * v0[1]) + (v0[2] * v0[2] + v0[3] * v0[3]) + (v1[0] * v1[0] + v1[1] * v1[1]) + (v1[2] * v1[2] + v1[3] * v1[3]);
                }
                ss += swz_xor16(ss); { auto rr_ = __builtin_amdgcn_permlane32_swap(__float_as_uint(ss), __float_as_uint(ss), false, false); ss = __uint_as_float(rr_[0]) + __uint_as_float(rr_[1]); }
                if (fq == 0) Pt[(ai * HALF + wr * 64 + m * 16 + fr) * 4 + wc] = ss;
            }
        asm volatile("s_waitcnt lgkmcnt(0)" ::: "memory"); __builtin_amdgcn_s_barrier(); asm volatile("" ::: "memory");
        const int wid = wr * 4 + wc, lane = fq * 16 + fr;
        const int prow = wid * 32 + (lane & 31);
        if (lane < 32) {
            const f32x4 p4 = *(const PG8_LAS f32x4*)(Pt + prow * 4);
            const float t = (p4[0] + p4[1]) + (p4[2] + p4[3]);
            __hip_atomic_store(slots + ((size_t)(u.pm * BM + prow) * 4 + u.pn), __float_as_uint(t), __ATOMIC_RELAXED, __HIP_MEMORY_SCOPE_AGENT);
        }
        asm volatile("s_waitcnt vmcnt(0)" ::: "memory");
        if (lane == 0) __hip_atomic_fetch_add(cnt + 64 * u.pm, 1u, __ATOMIC_RELAXED, __HIP_MEMORY_SCOPE_AGENT);
        if (wid == 0) {
            unsigned sp = 0;
            while ((unsigned)__builtin_amdgcn_readfirstlane((int)__hip_atomic_load(cnt + 64 * u.pm, __ATOMIC_RELAXED, __HIP_MEMORY_SCOPE_AGENT)) < 32u) { __builtin_amdgcn_s_sleep(2); if (++sp > (1u << 20)) break; }
            __builtin_amdgcn_fence(__ATOMIC_ACQUIRE, "agent");
        }
        asm volatile("s_waitcnt vmcnt(0) lgkmcnt(0)" ::: "memory"); __builtin_amdgcn_s_barrier(); asm volatile("" ::: "memory");
        if (lane < 32) {
            const unsigned* sl = slots + (size_t)(u.pm * BM + prow) * 4; float t = 0.f;
#pragma unroll
            for (int k = 0; k < 4; ++k) t += __uint_as_float(__hip_atomic_load(sl + k, __ATOMIC_RELAXED, __HIP_MEMORY_SCOPE_AGENT));
            St[prow] = rsqrtf(t * (1.0f / 1024.0f) + EPS);
        }
        asm volatile("s_waitcnt vmcnt(0) lgkmcnt(0)" ::: "memory"); __builtin_amdgcn_s_barrier(); asm volatile("" ::: "memory");
#pragma unroll
        for (int bj = 0; bj < 2; ++bj) {
            const f32x4 g0 = *(const f32x4*)(gfin + col0 + bj * HALF), g1 = *(const f32x4*)(gfin + col0 + bj * HALF + 4);
#pragma unroll
            for (int ai = 0; ai < 2; ++ai)
#pragma unroll
                for (int m = 0; m < 4; ++m) {
                    const float rs = St[ai * HALF + wr * 64 + m * 16 + fr];
                    const size_t off = (size_t)(row0 + ai * HALF + m * 16) * 1024 + col0 + bj * HALF;
                    *(f32x4*)(xout + off) = acc[ai][bj][m][0] * rs * g0; *(f32x4*)(xout + off + 4) = acc[ai][bj][m][1] * rs * g1;
                }
        }
        asm volatile("s_waitcnt lgkmcnt(0)" ::: "memory"); __builtin_amdgcn_s_barrier(); asm volatile("" ::: "memory");
    }
};

struct EpiNull {
    __device__ __forceinline__ void prefetch(const Unit&, int, PG8_LAS unsigned char*, int, int) const {}
    __device__ __forceinline__ void operator()(f32x4 (&acc)[2][2][4][2], const Unit& u, int ui, int wr, int wc, int fr, int fq, PG8_LAS unsigned char* le) const {
#pragma unroll
        for (int ai = 0; ai < 2; ++ai)
#pragma unroll
            for (int bj = 0; bj < 2; ++bj)
#pragma unroll
                for (int m = 0; m < 4; ++m) { asm volatile("" :: "v"(acc[ai][bj][m][0]), "v"(acc[ai][bj][m][1])); }
    }
};
}
namespace pro {
typedef unsigned short bf16_t;
typedef unsigned v4u __attribute__((ext_vector_type(4)));
typedef float f32x4 __attribute__((ext_vector_type(4)));
#define LAS3 __attribute__((address_space(3)))
__device__ __forceinline__ unsigned f2bf(float f) { unsigned u = __builtin_bit_cast(unsigned, f); return (u + 0x7fffu + ((u >> 16) & 1u)) >> 16; }
__device__ __forceinline__ unsigned pk2(float lo, float hi) { return f2bf(lo) | (f2bf(hi) << 16); }

struct In {
    const float *x, *norm_mix, *norm_ffn, *gla_w_in, *gla_w_alpha_up, *gla_b_alpha, *gla_norm, *gla_w_o, *kv_norm, *nsa_w_kv, *cmp_pe_k, *cmp_pe_v,
        *cmp_k_w1, *cmp_k_w2, *cmp_v_w1, *cmp_v_w2, *nsa_w_in, *nsa_w_o, *ffn_w_up, *ffn_conv_w, *ffn_conv_b, *ffn_w_down, *norm_final;
};
struct Wts { bf16_t *WGI, *WGO, *WKQ, *WC1, *WC2, *WNO, *WUP, *WDN; _Float16* ROPE; float* BIASC; };

__device__ __forceinline__ void transpose_item(const float* W, int ldw, int scol0, int nvalid, const float* gain, bf16_t* WT, int K, int drow0, int k0, LAS3 float* scr, int lane) {
    const int kr = lane >> 3, nc = (lane & 7) * 4;
    f32x4 v[8];
#pragma unroll
    for (int i = 0; i < 8; ++i) { const int kk = 8 * i + kr;
        v[i] = (nc < nvalid) ? *(const f32x4*)(W + (size_t)(k0 + kk) * ldw + scol0 + nc) : (f32x4){0.f, 0.f, 0.f, 0.f};
        if (gain) v[i] = v[i] * gain[k0 + kk]; }
#pragma unroll
    for (int i = 0; i < 8; ++i) { const int kk = 8 * i + kr; LAS3 float* d = scr + kk * 33 + nc; d[0] = v[i].x; d[1] = v[i].y; d[2] = v[i].z; d[3] = v[i].w; }
    asm volatile("s_waitcnt lgkmcnt(0)" ::: "memory");
    const int c = lane & 7;
#pragma unroll
    for (int j = 0; j < 4; ++j) { const int nn = (lane >> 3) + 8 * j; const LAS3 float* s = scr + (8 * c) * 33 + nn;
        v4u o; o.x = pk2(s[0 * 33], s[1 * 33]); o.y = pk2(s[2 * 33], s[3 * 33]); o.z = pk2(s[4 * 33], s[5 * 33]); o.w = pk2(s[6 * 33], s[7 * 33]);
        *(v4u*)(WT + (size_t)(drow0 + nn) * K + k0 + 8 * c) = o; }
    asm volatile("s_waitcnt lgkmcnt(0)" ::: "memory");
}
__device__ __forceinline__ void weff_item(const In& I, bf16_t* WT, int nb, int k0, LAS3 float* scr, int lane) {
    const int n = lane & 31, ng = 32 * nb + n;
    float wa[16];
#pragma unroll
    for (int r = 0; r < 16; ++r) wa[r] = I.gla_w_alpha_up[r * 512 + ng];
#pragma unroll 2
    for (int i = 0; i < 32; ++i) { const int kk = 2 * i + (lane >> 5); const float* wr = I.gla_w_in + (size_t)(k0 + kk) * 3088 + 3072;
        float v = 0.f;
#pragma unroll
        for (int r = 0; r < 16; ++r) v += wr[r] * wa[r];
        scr[kk * 33 + n] = v * I.norm_mix[k0 + kk]; }
    asm volatile("s_waitcnt lgkmcnt(0)" ::: "memory");
    const int c = lane & 7;
#pragma unroll
    for (int j = 0; j < 4; ++j) { const int nn = (lane >> 3) + 8 * j; const LAS3 float* s = scr + (8 * c) * 33 + nn;
        v4u o; o.x = pk2(s[0 * 33], s[1 * 33]); o.y = pk2(s[2 * 33], s[3 * 33]); o.z = pk2(s[4 * 33], s[5 * 33]); o.w = pk2(s[6 * 33], s[7 * 33]);
        *(v4u*)(WT + (size_t)(3072 + 32 * nb + nn) * 1024 + k0 + 8 * c) = o; }
    asm volatile("s_waitcnt lgkmcnt(0)" ::: "memory");
}

__device__ __forceinline__ void prologue(const In& I, const Wts& W, bf16_t* XB, float* RSS0, LAS3 unsigned char* lds, int gw, int NGW, int lane, int wave) {
    LAS3 float* scr = (LAS3 float*)(lds + wave * 16384);
    constexpr int I0 = 16 * 96, I1 = 16 * 16, I2 = 16 * 32, I3 = 16 * 88, I4 = 32 * 8, I6 = 4 * 2, I8 = 16 * 32, I9 = 16 * 176, I11 = 44 * 32;
    constexpr int NIT = I0 + I1 + I2 + I3 + 2 * I4 + 2 * I6 + I8 + 2 * I9 + 2 * I11;
    for (int it = gw; it < NIT; it += NGW) {
        int r = it;
        if (r < I0) { const int kb = r / 96, nb = r % 96; transpose_item(I.gla_w_in, 3088, 32 * nb, 32, I.norm_mix, W.WGI, 1024, 32 * nb, 64 * kb, scr, lane); continue; } r -= I0;
        if (r < I1) { const int kb = r / 16, nb = r % 16; weff_item(I, W.WGI, nb, 64 * kb, scr, lane); continue; } r -= I1;
        if (r < I2) { const int kb = r / 32, nb = r % 32; transpose_item(I.gla_w_o, 1024, 32 * nb, 32, I.gla_norm, W.WGO, 1024, 32 * nb, 64 * kb, scr, lane);   continue; } r -= I2;
        if (r < I3) { const int kb = r / 88, nb = r % 88; const int tile = nb >> 3, gi = nb & 7, L0 = (gi & 3) * 64 + (gi >> 2) * 32;
            if (tile < 6) transpose_item(I.nsa_w_kv, 1536, tile * 256 + L0, 32, I.kv_norm, W.WKQ, 1024, 32 * nb, 64 * kb, scr, lane);
            else if (tile < 10) transpose_item(I.nsa_w_in, 1072, (tile - 6) * 256 + L0, 32, I.norm_mix + 1024, W.WKQ, 1024, 32 * nb, 64 * kb, scr, lane);
            else { int nv = 48 - L0; nv = nv < 0 ? 0 : (nv > 32 ? 32 : nv); transpose_item(I.nsa_w_in, 1072, 1024 + (nv > 0 ? L0 : 0), nv, I.norm_mix + 1024, W.WKQ, 1024, 32 * nb, 64 * kb, scr, lane); }
            continue; } r -= I3;
        if (r < 2 * I4) { const int w = r / I4; r %= I4; const int kb = r / 8, nb = r % 8;
            transpose_item(w ? I.cmp_v_w1 : I.cmp_k_w1, 256, 32 * nb, 32, nullptr, W.WC1 + (size_t)w * 256 * 2048, 2048, 32 * nb, 64 * kb, scr, lane); continue; } r -= 2 * I4;
        if (r < 2 * I6) { const int w = r / I6; r %= I6; const int kb = r / 2, nb = r % 2;
            transpose_item(w ? I.cmp_v_w2 : I.cmp_k_w2, 64, 32 * nb, 32, nullptr, W.WC2 + (size_t)w * 64 * 256, 256, 32 * nb, 64 * kb, scr, lane); continue; } r -= 2 * I6;
        if (r < I8) { const int kb = r / 32, nb = r % 32; transpose_item(I.nsa_w_o, 1024, 32 * nb, 32, nullptr, W.WNO, 1024, 32 * nb, 64 * kb, scr, lane); continue; } r -= I8;
        if (r < 2 * I9) { const int l = r / I9; r %= I9; const int kb = r / 176, nb = r % 176; const int tile = nb >> 3, gi = nb & 7;
            const int sc = (gi < 4) ? (128 * tile + 32 * gi) : (2816 + 128 * tile + 32 * (gi - 4));
            transpose_item(I.ffn_w_up + (size_t)l * 1024 * 5632, 5632, sc, 32, I.norm_ffn + l * 1024, W.WUP + (size_t)l * 5632 * 1024, 1024, 32 * nb, 64 * kb, scr, lane); continue; } r -= 2 * I9;
        { const int l = r / I11; r %= I11; const int kb = r / 32, nb = r % 32;
            transpose_item(I.ffn_w_down + (size_t)l * 2816 * 1024, 1024, 32 * nb, 32, nullptr, W.WDN + (size_t)l * 1024 * 2816, 2816, 32 * nb, 64 * kb, scr, lane); }
    }
    for (int i = gw * 64 + lane; i < 2048 * 32; i += NGW * 64) {
        const int pos = i >> 5, d = i & 31;
        const float inv = powf(10000.0f, -(float)d / 32.0f);
        const float ang = (float)pos * inv;
        float sn, cs; sincosf(ang, &sn, &cs);
        typedef _Float16 h2_t __attribute__((ext_vector_type(2))); h2_t cs2; cs2[0] = (_Float16)cs; cs2[1] = (_Float16)sn; *(h2_t*)(W.ROPE + 2 * i) = cs2;
    }
    for (int it = gw; it < 2048; it += NGW) {
        const int w = it >> 10, ng = (it >> 8) & 3, kc = it & 255; const float* pe = (w ? I.cmp_pe_v : I.cmp_pe_k) + 8 * kc; const float* w1 = (w ? I.cmp_v_w1 : I.cmp_k_w1) + (size_t)(8 * kc) * 256 + 64 * ng + lane;
        float s = 0.f;
#pragma unroll
        for (int k = 0; k < 8; ++k) s += pe[k] * w1[(size_t)k * 256];
        atomicAdd(W.BIASC + w * 256 + 64 * ng + lane, s);
    }
    for (int m = gw; m < 32768; m += NGW) {
        const f32x4* xr = (const f32x4*)(I.x + (size_t)m * 1024) + lane;
        f32x4 v[4]; float s = 0.f;
#pragma unroll
        for (int j = 0; j < 4; ++j) { v[j] = xr[64 * j]; s += (v[j].x * v[j].x + v[j].y * v[j].y) + (v[j].z * v[j].z + v[j].w * v[j].w); }
#pragma unroll
        for (int off = 1; off < 64; off <<= 1) s += __shfl_xor(s, off);
        if (lane == 0) RSS0[m] = s;
        unsigned long long* o8 = (unsigned long long*)(XB + (size_t)m * 1024) + lane;
#pragma unroll
        for (int j = 0; j < 4; ++j) o8[64 * j] = (unsigned long long)pk2(v[j].x, v[j].y) | ((unsigned long long)pk2(v[j].z, v[j].w) << 32);
    }
}
}
namespace gla {
typedef unsigned short bf16_t;
typedef short bf16x8 __attribute__((ext_vector_type(8)));
typedef short s16x4 __attribute__((ext_vector_type(4)));
typedef float f32x16 __attribute__((ext_vector_type(16)));
typedef float f32x4 __attribute__((ext_vector_type(4)));
typedef unsigned u32x4 __attribute__((ext_vector_type(4)));
typedef unsigned u32x2 __attribute__((ext_vector_type(2)));
#define GLAS __attribute__((address_space(3)))
__device__ __forceinline__ int crow(int r, int hi) { return (r & 3) + 8 * (r >> 2) + 4 * hi; }
__device__ __forceinline__ float bf2f(bf16_t v) { return __builtin_bit_cast(float, (unsigned)v << 16); }
__device__ __forceinline__ unsigned cvtpk(float lo, float hi) { typedef float f2 __attribute__((ext_vector_type(2))); typedef __bf16 b2 __attribute__((ext_vector_type(2))); f2 v = {lo, hi}; b2 b = __builtin_convertvector(v, b2); return __builtin_bit_cast(unsigned, b); }
__device__ __forceinline__ bf16_t f2bf1(float f) { return (bf16_t)(cvtpk(f, 0.f) & 0xffffu); }
__device__ __forceinline__ s16x4 vtr(const GLAS unsigned char* p) { typedef short v4i16_t __attribute__((ext_vector_type(4))); return __builtin_bit_cast(s16x4, __builtin_amdgcn_ds_read_tr16_b64_v4i16((GLAS v4i16_t*)p)); }
__device__ __forceinline__ bf16x8 ld2x64(const GLAS unsigned char* p0, const GLAS unsigned char* p1) {
    const s16x4 a = *(const GLAS s16x4*)p0, b = *(const GLAS s16x4*)p1; return (bf16x8){a[0], a[1], a[2], a[3], b[0], b[1], b[2], b[3]};
}
constexpr int QEP = 264, KDP = 136, VP = 576, OLP = 260;
constexpr int L_QE = 0, L_KE = 16896, L_KDT = 33792, L_ATT = 51200, L_V = 59904, L_BL = 96768, L_QT = 97280, L_END = 99328;

template <bool STATE_ONLY>
__device__ __forceinline__ void gla_unit(int b, int h, int seg, const bf16_t* Qg, const bf16_t* Kg, const bf16_t* VO, bf16_t* Oout, const bf16_t* Rg, const float* Gg, const float* gnorm, float* SLOC, float* DSEG, GLAS unsigned char* lds, int tid0) {
    int tid_ = tid0; asm volatile("" : "+v"(tid_));
    const int tid = tid_, lane = tid & 63, w = __builtin_amdgcn_readfirstlane(tid >> 6), r32 = lane & 31, hi = lane >> 5;
    f32x16 S[4];
#pragma unroll
    for (int i = 0; i < 4; ++i)
#pragma unroll
        for (int r = 0; r < 16; ++r) S[i][r] = 0.f;
    const int kcol = tid & 127, qd = tid >> 7;
    const int bh = b * 4 + h;
    if (!STATE_ONLY && seg >= 1) {
#pragma unroll 1
        for (int s = 0; s < seg; ++s) {
            const float* sl = SLOC + ((size_t)(bh * 3 + s) * 128) * 256 + 32 * w + r32; const float* dd = DSEG + (bh * 3 + s) * 128;
#pragma unroll
            for (int i = 0; i < 4; ++i)
#pragma unroll
                for (int r = 0; r < 16; ++r) { const int k = 32 * i + crow(r, hi); const float d = (s == 0) ? 0.f : dd[k]; S[i][r] = S[i][r] * d + sl[(size_t)k * 256]; }
        }
    }
    float dlog = 0.f;
#ifdef DBG_GPROF
    unsigned long long gacc_[12] = {0,0,0,0,0,0,0,0,0,0,0,0}; unsigned long long gprev_ = clock64();
#define GSTAMP(k) do { if (!STATE_ONLY) { asm volatile("s_waitcnt lgkmcnt(0)" ::: "memory"); const unsigned long long t_ = clock64(); gacc_[k] += t_ - gprev_; gprev_ = t_; } } while (0)
#else
#define GSTAMP(k) do {} while (0)
#endif
    GLAS float* BL = (GLAS float*)(lds + L_BL); GLAS float* QT = (GLAS float*)(lds + L_QT);
    GLAS float* OL = (GLAS float*)lds;
    float gq[16]; u32x4 vr[4]; bf16_t qr[16], kr[16];
#define GLA_FETCH_GV(cc) do { const size_t r0_ = (size_t)b * 2048 + (cc) * 64; int t2_ = tid; asm volatile("" : "+v"(t2_));   \
        const float* gp_ = Gg + (r0_ + 16 * (t2_ >> 7)) * 512 + h * 128 + (t2_ & 127); \
        _Pragma("unroll") for (int i = 0; i < 16; ++i) { gq[i] = gp_[(size_t)i * 512]; } \
        const bf16_t* vp_ = VO + (r0_ + (t2_ >> 5)) * 1024 + h * 256 + (t2_ & 31) * 8; \
        _Pragma("unroll") for (int i = 0; i < 4; ++i) { vr[i] = *(const u32x4*)(vp_ + (size_t)i * 16 * 1024); } } while (0)
#define GLA_FETCH_QK(cc) do { const size_t r0_ = (size_t)b * 2048 + (cc) * 64; int t2_ = tid; asm volatile("" : "+v"(t2_)); \
        const size_t e0_ = (r0_ + 16 * (t2_ >> 7)) * 512 + h * 128 + (t2_ & 127); const bf16_t* qp_ = Qg + e0_; const bf16_t* kp_ = Kg + e0_; \
        _Pragma("unroll") for (int i = 0; i < 16; ++i) { kr[i] = kp_[(size_t)i * 512]; if (!STATE_ONLY) qr[i] = qp_[(size_t)i * 512]; } } while (0)
    GLA_FETCH_GV(seg * 8); GLA_FETCH_QK(seg * 8);
    for (int c = seg * 8; c < seg * 8 + 8; ++c) {
        const size_t row0 = (size_t)b * 2048 + c * 64;
        u32x4 rpre[4];
        if (!STATE_ONLY) { const size_t go_ = (row0 + (tid >> 3)) * 1024 + h * 256 + 32 * (tid & 7);
#pragma unroll
            for (int j = 0; j < 4; ++j) rpre[j] = *(const u32x4*)(Rg + go_ + 8 * j); }
        {
            float cs[16]; float run = 0.f;
#pragma unroll
            for (int i = 0; i < 16; ++i) { run += gq[i]; cs[i] = run; }
            QT[qd * 128 + kcol] = run;
#pragma unroll
            for (int i = 0; i < 4; ++i) { const int p = tid + 512 * i, rr = p >> 5, ch = p & 31;
                *(GLAS u32x4*)(lds + L_V + rr * VP + ch * 16) = vr[i]; }
            float qv[16], kv[16];
#pragma unroll
            for (int i = 0; i < 16; ++i) { qv[i] = STATE_ONLY ? 0.f : bf2f(qr[i]); kv[i] = bf2f(kr[i]); }
            { const int cn_ = (c + 1 < seg * 8 + 8) ? c + 1 : c; GLA_FETCH_GV(cn_); }
        GSTAMP(0);
            __syncthreads();
        GSTAMP(1);
            float pre = 0.f, tot = 0.f;
#pragma unroll
            for (int q = 0; q < 4; ++q) { const float t = QT[q * 128 + kcol]; tot += t; if (q < qd) pre += t; }
            if (qd == 0) BL[kcol] = __expf(tot);
            dlog += tot;
            float kd[16];
#pragma unroll
            for (int i = 0; i < 16; ++i) { const float bb = pre + cs[i]; const int t = 16 * qd + i;
                if (!STATE_ONLY) { *(GLAS bf16_t*)(lds + L_QE + t * QEP + kcol * 2) = f2bf1(qv[i] * __expf(bb));
                                   *(GLAS bf16_t*)(lds + L_KE + t * QEP + kcol * 2) = f2bf1(kv[i] * __expf(-bb)); }
                kd[i] = kv[i] * __expf(tot - bb); }
#pragma unroll
            for (int i = 0; i < 4; ++i) { u32x2 v; v.x = cvtpk(kd[4 * i], kd[4 * i + 1]); v.y = cvtpk(kd[4 * i + 2], kd[4 * i + 3]);
                *(GLAS u32x2*)(lds + L_KDT + kcol * KDP + (16 * qd + 4 * i) * 2) = v; }
        }
        GSTAMP(2);
        __syncthreads();
        { const int cn_ = (c + 1 < seg * 8 + 8) ? c + 1 : c; GLA_FETCH_QK(cn_); }
        GSTAMP(3);
        f32x16 o[2];
#pragma unroll
        for (int r = 0; r < 16; ++r) { o[0][r] = 0.f; o[1][r] = 0.f; }
        if (!STATE_ONLY) {
        if (w < 3) {
            const int ti = (w >= 1) ? 1 : 0, si = (w == 2) ? 1 : 0;
            f32x16 a;
#pragma unroll
            for (int r = 0; r < 16; ++r) a[r] = 0.f;
            const GLAS unsigned char* ap = lds + L_QE + (32 * ti + r32) * QEP + 16 * hi; const GLAS unsigned char* bp = lds + L_KE + (32 * si + r32) * QEP + 16 * hi;
#pragma unroll
            for (int s = 0; s < 8; ++s) { const bf16x8 A = ld2x64(ap + 32 * s, ap + 32 * s + 8), B = ld2x64(bp + 32 * s, bp + 32 * s + 8);
                a = __builtin_amdgcn_mfma_f32_32x32x16_bf16(A, B, a, 0, 0, 0); }
            int l3_ = lane; asm volatile("" : "+v"(l3_));
            const int r32b = l3_ & 31, hib = l3_ >> 5, sg = 32 * si + r32b;
#pragma unroll
            for (int r = 0; r < 16; ++r) { const int tg = 32 * ti + crow(r, hib); const float v = (sg <= tg) ? a[r] : 0.f;
                *(GLAS bf16_t*)(lds + L_ATT + tg * KDP + sg * 2) = f2bf1(v); }
        } else if (w == 3) {
#pragma unroll
            for (int r = 0; r < 16; ++r) *(GLAS bf16_t*)(lds + L_ATT + crow(r, hi) * KDP + (32 + r32) * 2) = 0;
        }
        {
#pragma unroll
            for (int i = 0; i < 4; ++i)
#pragma unroll
                for (int s = 0; s < 2; ++s) {
                    u32x4 pk; pk.x = cvtpk(S[i][8 * s], S[i][8 * s + 1]); pk.y = cvtpk(S[i][8 * s + 2], S[i][8 * s + 3]); pk.z = cvtpk(S[i][8 * s + 4], S[i][8 * s + 5]); pk.w = cvtpk(S[i][8 * s + 6], S[i][8 * s + 7]);
                    const bf16x8 Bf = __builtin_bit_cast(bf16x8, pk);
#pragma unroll
                    for (int ti = 0; ti < 2; ++ti) { const GLAS unsigned char* ap = lds + L_QE + (32 * ti + r32) * QEP + (32 * i + 16 * s + 4 * hi) * 2;
                        const bf16x8 A = ld2x64(ap, ap + 16); o[ti] = __builtin_amdgcn_mfma_f32_32x32x16_bf16(A, Bf, o[ti], 0, 0, 0); }
                }
        }
        GSTAMP(4);
        __syncthreads();
        GSTAMP(5);
        }
        {
            bf16x8 vf[4];
            const int gI = lane >> 4, i16 = lane & 15, q = i16 >> 2, p = i16 & 3;
            const GLAS unsigned char* vb = lds + L_V + (8 * hi + q) * VP + (32 * w + 16 * (gI & 1) + 4 * p) * 2;
#pragma unroll
            for (int ks = 0; ks < 4; ++ks) { const s16x4 lo = vtr(vb + 16 * ks * VP), hh = vtr(vb + (16 * ks + 4) * VP);
                vf[ks] = (bf16x8){lo[0], lo[1], lo[2], lo[3], hh[0], hh[1], hh[2], hh[3]}; }
            if (!STATE_ONLY) {
#pragma unroll
            for (int ti = 0; ti < 2; ++ti)
#pragma unroll
                for (int ks = 0; ks < 4; ++ks) { const GLAS unsigned char* ap = lds + L_ATT + (32 * ti + r32) * KDP + (16 * ks + 8 * hi) * 2;
                    const bf16x8 A = ld2x64(ap, ap + 8); o[ti] = __builtin_amdgcn_mfma_f32_32x32x16_bf16(A, vf[ks], o[ti], 0, 0, 0); }
            }
#pragma unroll
            for (int i = 0; i < 4; ++i) {
#pragma unroll
                for (int r = 0; r < 16; ++r) S[i][r] *= BL[32 * i + crow(r, hi)];
#pragma unroll
                for (int ks = 0; ks < 4; ++ks) { const GLAS unsigned char* ap = lds + L_KDT + (32 * i + r32) * KDP + (16 * ks + 8 * hi) * 2;
                    const bf16x8 A = ld2x64(ap, ap + 8); S[i] = __builtin_amdgcn_mfma_f32_32x32x16_bf16(A, vf[ks], S[i], 0, 0, 0); }
            }
        }
        GSTAMP(6);
        __syncthreads();
        GSTAMP(7);
        if (!STATE_ONLY) {
#pragma unroll
        for (int ti = 0; ti < 2; ++ti)
#pragma unroll
            for (int r = 0; r < 16; ++r) OL[(32 * ti + crow(r, hi)) * OLP + 32 * w + r32] = o[ti][r];
        GSTAMP(8);
        __syncthreads();
        GSTAMP(9);
        {
            const int t = tid >> 3, seg = tid & 7;
            f32x4 v[8]; float ss = 0.f;
#pragma unroll
            for (int j = 0; j < 8; ++j) { v[j] = *(const GLAS f32x4*)(OL + t * OLP + 32 * seg + 4 * j); ss += (v[j].x * v[j].x + v[j].y * v[j].y) + (v[j].z * v[j].z + v[j].w * v[j].w); }
            ss += dpp_xor1(ss); ss += dpp_xor2(ss); ss += dpp_hmirror(ss);
            const float rs = rsqrtf(ss * (1.0f / 256.0f) + 1e-6f);
            const size_t go = (row0 + t) * 1024 + h * 256 + 32 * seg;
#pragma unroll
            for (int j = 0; j < 4; ++j) {
                const u32x4 rr = rpre[j];
                const f32x4 a = v[2 * j], bq = v[2 * j + 1];
                u32x4 ov;
                ov.x = cvtpk(a.x * rs * __builtin_bit_cast(float, rr.x << 16), a.y * rs * __builtin_bit_cast(float, rr.x & 0xffff0000u));
                ov.y = cvtpk(a.z * rs * __builtin_bit_cast(float, rr.y << 16), a.w * rs * __builtin_bit_cast(float, rr.y & 0xffff0000u));
                ov.z = cvtpk(bq.x * rs * __builtin_bit_cast(float, rr.z << 16), bq.y * rs * __builtin_bit_cast(float, rr.z & 0xffff0000u));
                ov.w = cvtpk(bq.z * rs * __builtin_bit_cast(float, rr.w << 16), bq.w * rs * __builtin_bit_cast(float, rr.w & 0xffff0000u));
                *(u32x4*)(Oout + go + 8 * j) = ov;
            }
        }
        GSTAMP(10);
        __syncthreads();
        GSTAMP(11);
        }
    }
    if (STATE_ONLY) {
        float* sl = SLOC + ((size_t)(bh * 3 + seg) * 128) * 256 + 32 * w + r32;
#pragma unroll
        for (int i = 0; i < 4; ++i)
#pragma unroll
            for (int r = 0; r < 16; ++r) sl[(size_t)(32 * i + crow(r, hi)) * 256] = S[i][r];
        if (qd == 0) DSEG[(bh * 3 + seg) * 128 + kcol] = __expf(dlog);
    }
#ifdef DBG_GPROF
    if (!STATE_ONLY && blockIdx.x == 5 && tid == 0) { unsigned long long* dp = (unsigned long long*)((unsigned char*)SLOC + (size_t)110 * 1048576);
        for (int k = 0; k < 12; ++k) dp[k] = gacc_[k]; }
#endif
#undef GSTAMP
#undef GLA_FETCH_GV
#undef GLA_FETCH_QK
}
}
namespace nsa {
typedef unsigned short bf16_t;
typedef short bf16x8 __attribute__((ext_vector_type(8)));
typedef short s16x4 __attribute__((ext_vector_type(4)));
typedef float f32x16 __attribute__((ext_vector_type(16)));
typedef float f32x4 __attribute__((ext_vector_type(4)));
typedef unsigned u32x4 __attribute__((ext_vector_type(4)));
#define NLAS __attribute__((address_space(3)))
__device__ __forceinline__ int crow(int r, int hi) { return (r & 3) + 8 * (r >> 2) + 4 * hi; }
__device__ __forceinline__ unsigned cvtpk(float lo, float hi) { typedef float f2 __attribute__((ext_vector_type(2))); typedef __bf16 b2 __attribute__((ext_vector_type(2))); f2 v = {lo, hi}; b2 b = __builtin_convertvector(v, b2); return __builtin_bit_cast(unsigned, b); }
__device__ __forceinline__ s16x4 vtr(const NLAS unsigned char* p) { typedef short v4i16_t __attribute__((ext_vector_type(4))); return __builtin_bit_cast(s16x4, __builtin_amdgcn_ds_read_tr16_b64_v4i16((NLAS v4i16_t*)p)); }

__device__ __forceinline__ float gelu_tanh(float x) { const float y = 0.7978845608028654f * (x + 0.044715f * x * x * x); const float e = __expf(2.0f * y); const float th = 1.0f - 2.0f * __builtin_amdgcn_rcpf(e + 1.0f); return 0.5f * x * (1.0f + th); }
__device__ __forceinline__ void cmp_finalize(const float* HP, const float* BIASC, const bf16_t* WC2, bf16_t* KCVC, int gw, int NGW, int lane) {
    typedef float f4 __attribute__((ext_vector_type(4)));
    const int r = lane & 15, kq = lane >> 4;
    for (int item = gw; item < 1024; item += NGW) {
        const int R0 = item * 16, w = R0 >> 13, row = R0 + r;
        f4 acc[4];
#pragma unroll
        for (int nt = 0; nt < 4; ++nt) acc[nt] = (f4){0.f, 0.f, 0.f, 0.f};
#pragma unroll
        for (int ks = 0; ks < 8; ++ks) {
            const int col = 32 * ks + 8 * kq;
            f32x4 s0 = *(const f32x4*)(BIASC + w * 256 + col), s1 = *(const f32x4*)(BIASC + w * 256 + col + 4);
#pragma unroll
            for (int p = 0; p < 4; ++p) { const float* hp = HP + ((size_t)p * 16384 + row) * 256 + col; s0 = s0 + *(const f32x4*)hp; s1 = s1 + *(const f32x4*)(hp + 4); }
            u32x4 pk; pk.x = cvtpk(gelu_tanh(s0.x), gelu_tanh(s0.y)); pk.y = cvtpk(gelu_tanh(s0.z), gelu_tanh(s0.w)); pk.z = cvtpk(gelu_tanh(s1.x), gelu_tanh(s1.y)); pk.w = cvtpk(gelu_tanh(s1.z), gelu_tanh(s1.w));
            const bf16x8 A = __builtin_bit_cast(bf16x8, pk);
#pragma unroll
            for (int nt = 0; nt < 4; ++nt) { const bf16x8 B = *(const bf16x8*)(WC2 + ((size_t)w * 64 + 16 * nt + r) * 256 + col);
                acc[nt] = __builtin_amdgcn_mfma_f32_16x16x32_bf16(A, B, acc[nt], 0, 0, 0); }
        }
#pragma unroll
        for (int nt = 0; nt < 4; ++nt)
#pragma unroll
            for (int rg = 0; rg < 4; ++rg) { const int orow = R0 + 4 * kq + rg; const float v = ((orow & 127) == 127) ? 0.f : acc[nt][rg];
                KCVC[(size_t)orow * 64 + 16 * nt + r] = (bf16_t)(cvtpk(v, 0.f) & 0xffffu); }
    }
}

constexpr int SLOTB = 16384, NSLOT = 4;
constexpr int L_IMP = NSLOT * SLOTB, L_CAR = L_IMP + 8 * 32 * 33 * 4, L_VAL = L_CAR + 8 * 32 * 33 * 4, L_SELM = L_VAL + 64 * 33 * 4, L_WSF = L_SELM + 256, L_FAC = L_WSF + 8 * 64 * 4, L_AEND = L_FAC + 8 * 32 * 2 * 4;
static_assert(L_AEND <= 131072 + 28672, "attention LDS");
#define NINF (-__builtin_inff())
#define ABAR() asm volatile("s_waitcnt lgkmcnt(0)\n\ts_barrier" ::: "memory")

__device__ __forceinline__ void k_issue(bf16x8* kf, const NLAS unsigned char* ks, int r32, int hi) {
    const int sw = (r32 >> 1) & 7;
    const unsigned kb = (unsigned)(size_t)(ks + r32 * 128);
    const unsigned a0 = kb + (((0 + hi) ^ sw) << 4), a1 = kb + (((2 + hi) ^ sw) << 4), a2 = kb + (((4 + hi) ^ sw) << 4), a3 = kb + (((6 + hi) ^ sw) << 4);
    asm volatile("ds_read_b128 %0, %8\n\tds_read_b128 %1, %8 offset:4096\n\tds_read_b128 %2, %9\n\tds_read_b128 %3, %9 offset:4096\n\t"
                 "ds_read_b128 %4, %10\n\tds_read_b128 %5, %10 offset:4096\n\tds_read_b128 %6, %11\n\tds_read_b128 %7, %11 offset:4096"
                 : "=&v"(kf[0]), "=&v"(kf[1]), "=&v"(kf[2]), "=&v"(kf[3]), "=&v"(kf[4]), "=&v"(kf[5]), "=&v"(kf[6]), "=&v"(kf[7])
                 : "v"(a0), "v"(a1), "v"(a2), "v"(a3) : "memory");
}
__device__ __forceinline__ void k_wait(bf16x8* kf) {
    asm volatile("s_waitcnt lgkmcnt(0)" : "+v"(kf[0]), "+v"(kf[1]), "+v"(kf[2]), "+v"(kf[3]), "+v"(kf[4]), "+v"(kf[5]), "+v"(kf[6]), "+v"(kf[7]) :: "memory");
    __builtin_amdgcn_sched_barrier(0);
}
__device__ __forceinline__ void qk_mma(f32x16& p0, f32x16& p1, const bf16x8* kf, const bf16x8* qf, const f32x16& c) {
#pragma unroll
    for (int d0 = 0; d0 < 4; ++d0) {
        if (d0 == 0) { p0 = __builtin_amdgcn_mfma_f32_32x32x16_bf16(kf[0], qf[0], c, 0, 0, 0); p1 = __builtin_amdgcn_mfma_f32_32x32x16_bf16(kf[1], qf[0], c, 0, 0, 0); }
        else { p0 = __builtin_amdgcn_mfma_f32_32x32x16_bf16(kf[2 * d0], qf[d0], p0, 0, 0, 0); p1 = __builtin_amdgcn_mfma_f32_32x32x16_bf16(kf[2 * d0 + 1], qf[d0], p1, 0, 0, 0); }
    }
}
__device__ __forceinline__ void pack_p(bf16x8* pa, const f32x16& p0, const f32x16& p1) {
    u32x4 w;
    w.x = cvtpk(p0[0], p0[1]); w.y = cvtpk(p0[2], p0[3]); w.z = cvtpk(p0[4], p0[5]); w.w = cvtpk(p0[6], p0[7]); pa[0] = __builtin_bit_cast(bf16x8, w);
    w.x = cvtpk(p0[8], p0[9]); w.y = cvtpk(p0[10], p0[11]); w.z = cvtpk(p0[12], p0[13]); w.w = cvtpk(p0[14], p0[15]); pa[1] = __builtin_bit_cast(bf16x8, w);
    w.x = cvtpk(p1[0], p1[1]); w.y = cvtpk(p1[2], p1[3]); w.z = cvtpk(p1[4], p1[5]); w.w = cvtpk(p1[6], p1[7]); pa[2] = __builtin_bit_cast(bf16x8, w);
    w.x = cvtpk(p1[8], p1[9]); w.y = cvtpk(p1[10], p1[11]); w.z = cvtpk(p1[12], p1[13]); w.w = cvtpk(p1[14], p1[15]); pa[3] = __builtin_bit_cast(bf16x8, w);
}
__device__ __forceinline__ void v_load(bf16x8* vf, const NLAS unsigned char* vs, int lane) {
    const int hi = lane >> 5;
    const NLAS unsigned char* vb = vs + ((lane >> 4) & 1) * 32 + (lane & 3) * 8 + (4 * hi + ((lane & 15) >> 2)) * 64;
#pragma unroll
    for (int d0 = 0; d0 < 2; ++d0)
#pragma unroll
        for (int ks = 0; ks < 4; ++ks) {
            const s16x4 lo = vtr(vb + d0 * 4096 + ks * 1024), hh = vtr(vb + d0 * 4096 + ks * 1024 + 512);
            vf[d0 * 4 + ks] = (bf16x8){lo[0], lo[1], lo[2], lo[3], hh[0], hh[1], hh[2], hh[3]};
        }
}
__device__ __forceinline__ void pv_mma(f32x16* o, f32x16& lacc, const bf16x8* vf, const bf16x8* pa) {
    const short one_ = (short)0x3F80; const bf16x8 ones = (bf16x8){one_, one_, one_, one_, one_, one_, one_, one_};
#pragma unroll
    for (int ks = 0; ks < 4; ++ks) {
        o[0] = __builtin_amdgcn_mfma_f32_32x32x16_bf16(pa[ks], vf[ks], o[0], 0, 0, 0);
        o[1] = __builtin_amdgcn_mfma_f32_32x32x16_bf16(pa[ks], vf[4 + ks], o[1], 0, 0, 0);
        lacc = __builtin_amdgcn_mfma_f32_32x32x16_bf16(pa[ks], ones, lacc, 0, 0, 0);
    }
}
__device__ __forceinline__ float max3f(float a, float b, float c) { float r; asm("v_max3_f32 %0, %1, %2, %3" : "=v"(r) : "v"(a), "v"(b), "v"(c)); return r; }
__device__ __forceinline__ float max32(const f32x16& p0, const f32x16& p1) {
    float a = max3f(p0[0], p0[1], p1[0]), b = max3f(p0[2], p0[3], p1[1]); a = max3f(a, p1[2], p1[3]);
#pragma unroll
    for (int r = 4; r < 16; r += 4) { a = max3f(a, p0[r], p0[r + 1]); b = max3f(b, p0[r + 2], p0[r + 3]); a = max3f(a, p1[r], p1[r + 1]); b = max3f(b, p1[r + 2], p1[r + 3]); }
    return max3f(a, b, b);
}
__device__ __forceinline__ float comb_max(float v) { auto rr = __builtin_amdgcn_permlane32_swap(__float_as_uint(v), __float_as_uint(v), false, false); return fmaxf(__uint_as_float(rr[0]), __uint_as_float(rr[1])); }
__device__ __forceinline__ float comb_sum(float v) { auto rr = __builtin_amdgcn_permlane32_swap(__float_as_uint(v), __float_as_uint(v), false, false); return __uint_as_float(rr[0]) + __uint_as_float(rr[1]); }
__device__ __forceinline__ void mask_le(f32x16& p0, f32x16& p1, int thr, int hi) {
    int t2 = thr - 4 * hi; asm volatile("" : "+v"(t2));
#pragma unroll
    for (int r = 0; r < 16; ++r) { const int kc = (r & 3) + 8 * (r >> 2); if (kc > t2) p0[r] = NINF; if (kc + 32 > t2) p1[r] = NINF; }
}
__device__ __forceinline__ void mask_gt(f32x16& p0, f32x16& p1, int thr, int hi) {
    int t2 = thr - 4 * hi; asm volatile("" : "+v"(t2));
#pragma unroll
    for (int r = 0; r < 16; ++r) { const int kc = (r & 3) + 8 * (r >> 2); if (kc <= t2) p0[r] = NINF; if (kc + 32 <= t2) p1[r] = NINF; }
}

#ifndef SOFT_THR
#define SOFT_THR 8.0f
#endif
struct Soft { float mhat; f32x16 lacc; f32x16 o[2]; };
__device__ __forceinline__ void soft_init(Soft& s) { s.mhat = 0.f;
#pragma unroll
    for (int r = 0; r < 16; ++r) { s.lacc[r] = 0.f; s.o[0][r] = 0.f; s.o[1][r] = 0.f; } }
__device__ __forceinline__ float soft_update(Soft& s, f32x16& p0, f32x16& p1, bool first, NLAS float* wsf, int r32, int hi) {
    const float rm = comb_max(max32(p0, p1));
    const float dl = first ? ((rm > NINF) ? rm : 0.f) : ((rm > SOFT_THR) ? rm : 0.f);
    float f = 1.0f;
    if (__any(dl != 0.f)) {
        s.mhat += dl;
        f = __builtin_amdgcn_exp2f(-dl);
#pragma unroll
        for (int r = 0; r < 16; ++r) { p0[r] -= dl; p1[r] -= dl; }
        if (!first) {
            if (hi == 0) wsf[r32] = f;
            asm volatile("s_waitcnt lgkmcnt(0)" ::: "memory");
#pragma unroll
            for (int r = 0; r < 16; ++r) { const float ff = wsf[crow(r, hi)]; s.o[0][r] *= ff; s.o[1][r] *= ff; s.lacc[r] *= ff; }
            asm volatile("s_waitcnt lgkmcnt(0)" ::: "memory");
        }
    }
#pragma unroll
    for (int r = 0; r < 16; ++r) { p0[r] = __builtin_amdgcn_exp2f(p0[r]); p1[r] = __builtin_amdgcn_exp2f(p1[r]); }
    return f;
}

struct AttnBufs { unsigned char* ws; };
struct Strm { int u, kind, j; };
__device__ __forceinline__ int unit_qt(int u, int sub) { return 8 * (u >> 1) + ((u & 1) ? (7 - sub) : sub); }
__device__ __forceinline__ void strm_next(Strm& s, int sub) {
    const int qt = unit_qt(s.u, sub);
    if (s.kind == 0) { if (s.j == 0) s.j = 1; else { s.kind = 1; s.j = qt; } }
    else if (s.kind == 1) { if (s.j > 0) --s.j; else { s.kind = 2; s.j = qt; } }
    else { const int jlo = qt >= 8 ? qt - 8 : 0; if (s.j > jlo) --s.j; else { ++s.u; s.kind = 0; s.j = 0; } }
}
__device__ __forceinline__ void dma16(const void* g, NLAS unsigned char* l) {
    unsigned keep; const unsigned dst = (unsigned)__builtin_amdgcn_readfirstlane((int)(unsigned)(size_t)l);
    asm volatile("s_mov_b32 %0, m0\n\ts_mov_b32 m0, %2\n\ts_nop 0\n\tglobal_load_lds_dwordx4 %1, off\n\ts_mov_b32 m0, %0" : "=&s"(keep) : "v"(g), "s"(dst) : "memory");
}


__device__ __forceinline__ void q_fetch(bf16x8* qf, const bf16_t* qp) {
    asm volatile("global_load_dwordx4 %0, %4, off\n\tglobal_load_dwordx4 %1, %4, off offset:32\n\tglobal_load_dwordx4 %2, %4, off offset:64\n\tglobal_load_dwordx4 %3, %4, off offset:96\n\ts_waitcnt vmcnt(0)"
                 : "=&v"(qf[0]), "=&v"(qf[1]), "=&v"(qf[2]), "=&v"(qf[3]) : "v"(qp) : "memory");
}
__device__ __forceinline__ void qg_fetch(bf16x8* qf, float& g0, float& g1, float& g2, const bf16_t* qp, const float* gp) {
    asm volatile("global_load_dword %4, %8, off\n\tglobal_load_dword %5, %8, off offset:64\n\tglobal_load_dword %6, %8, off offset:128\n\t"
                 "global_load_dwordx4 %0, %7, off\n\tglobal_load_dwordx4 %1, %7, off offset:32\n\tglobal_load_dwordx4 %2, %7, off offset:64\n\tglobal_load_dwordx4 %3, %7, off offset:96\n\ts_waitcnt vmcnt(0)"
                 : "=&v"(qf[0]), "=&v"(qf[1]), "=&v"(qf[2]), "=&v"(qf[3]), "=&v"(g0), "=&v"(g1), "=&v"(g2) : "v"(qp), "v"(gp) : "memory");
}

template <int VAR = 0>
__device__ __forceinline__ void attn_block(int bh, int sub, const AttnBufs& T, NLAS unsigned char* lds, int tid0) {
    int tid_ = tid0; asm volatile("" : "+v"(tid_));
    const int tid = tid_, lane = tid & 63, w = __builtin_amdgcn_readfirstlane(tid >> 6), r32 = lane & 31, hi = lane >> 5;
    const int b = bh >> 2, hk = bh & 3, g = w >> 1, hq = hk * 4 + g, qi = 32 * (w & 1) + r32;
    NLAS float* wsf = (NLAS float*)(lds + L_WSF) + w * 64;
    NLAS float* IMP = (NLAS float*)(lds + L_IMP) + w * 32 * 33; NLAS float* CAR = (NLAS float*)(lds + L_CAR) + w * 32 * 33;
    NLAS float* stash = (NLAS float*)(lds + L_IMP + w * 8448) + lane;
    const int krow = 8 * w + (lane >> 3), koff = krow * 64 + (((lane & 7) ^ ((krow >> 1) & 7)) << 3), voff = (16 * (w & 3) + (lane >> 2)) * 64 + (w >> 2) * 32 + (lane & 3) * 8;
    unsigned char* const ws = T.ws;
    constexpr size_t kvs = (size_t)16 * 4 * 2048 * 64;
#define A_KC ((const bf16_t*)(ws + WS_KCVC) + ((size_t)bh * 128) * 64)
#define A_VC ((const bf16_t*)(ws + WS_KCVC) + ((size_t)(64 + bh) * 128) * 64)
#define A_KV ((const bf16_t*)(ws + WS_KV) + (size_t)bh * 2048 * 64)
    const bf16_t* kp_; const bf16_t* vp_;
#define PTRS(st) do { \
        if ((st).kind == 0) { kp_ = A_KC + (st).j * 4096 + koff; vp_ = A_VC + (st).j * 4096 + voff; } \
        else if ((st).kind == 1) { kp_ = A_KV + 2 * kvs + (size_t)(st).j * 4096 + koff; vp_ = A_KV + 3 * kvs + (size_t)(st).j * 4096 + voff; } \
        else { kp_ = A_KV + 4 * kvs + (size_t)(st).j * 4096 + koff; vp_ = A_KV + 5 * kvs + (size_t)(st).j * 4096 + voff; } } while (0)
#define ISSUE(st, slot) do { dma16(kp_, lds + (slot) * SLOTB + w * 1024); dma16(vp_, lds + (slot) * SLOTB + 8192 + w * 1024); \
        { const int pk_ = (st).kind, pu_ = (st).u; strm_next(st, sub); \
          if ((st).kind == pk_ && (st).u == pu_) { if (pk_ == 0) { kp_ += 4096; vp_ += 4096; } else { kp_ -= 4096; vp_ -= 4096; } } else if ((st).u < 8) PTRS(st); } } while (0)
    Strm ist; ist.u = 0; ist.kind = 0; ist.j = 0;
    Strm cst = ist;
    int P = 0;
#pragma unroll 1
    for (int u = 0; u < 8; ++u) { const int qt = unit_qt(u, sub); P += 2 + (qt + 1) + ((qt >= 8 ? 8 : qt) + 1); }
    PTRS(ist);
    ISSUE(ist, 0); ISSUE(ist, 1);
    Soft S; soft_init(S);
    bf16x8 qf[4];
    float g_cmp = 0.f, g_sel = 0.f, g_win = 0.f; unsigned selm = 0u; int qt = 0;
#ifdef DBG_PROF
    unsigned long long tacc_[7] = {0, 0, 0, 0, 0, 0, 0}; unsigned long long tprev_ = clock64();
#define STAMP(k) do { asm volatile("s_waitcnt lgkmcnt(0)" ::: "memory"); const unsigned long long t_ = clock64(); tacc_[k] += t_ - tprev_; tprev_ = t_; } while (0)
#else
#define STAMP(k) do {} while (0)
#endif
#pragma unroll 1
    for (int p = 0; p < P; ++p) {
        STAMP(0);
        const NLAS unsigned char* slot = lds + (p & 3) * SLOTB;
        bf16x8 kf[8];
        if ((p & 1) == 0) {
            asm volatile("s_waitcnt vmcnt(0)" ::: "memory");
            STAMP(1);
            ABAR();
            STAMP(2);
            k_issue(kf, slot, r32, hi);
            if (p + 2 < P) { ISSUE(ist, (p + 2) & 3); }
            if (p + 3 < P) { ISSUE(ist, (p + 3) & 3); }
        } else k_issue(kf, slot, r32, hi);
        const int kind = cst.kind, j = cst.j;
        if (kind == 0 && j == 0) {
            qt = unit_qt(cst.u, sub);
            const int tok = 64 * qt + qi;
            const float* gp = (const float*)(ws + WS_GATES) + ((size_t)b * 2048 + tok) * 48 + hq;
            const size_t qoff = (((size_t)b * 16 + hq) * 2048 + tok) * 64 + 8 * hi;
            qg_fetch(qf, g_cmp, g_sel, g_win, (const bf16_t*)(ws + WS_NQ) + qoff, gp);
            soft_init(S);
        }
        if ((kind == 1 || kind == 2) && j == qt) soft_init(S);
        const bool first = (kind == 0) ? (j == 0) : (j == qt);
        float cv = -S.mhat;
        if (kind == 1) { if (!((selm >> j) & 1u)) cv = NINF; }
        f32x16 c;
#pragma unroll
        for (int r = 0; r < 16; ++r) c[r] = cv;
        f32x16 p0, p1;
        if (VAR == 1 || VAR == 5) { p0 = c; p1 = c; asm volatile("" : "+v"(p0), "+v"(p1)); strm_next(cst, sub); continue; }
        bf16x8 vf[8];
        {
            k_wait(kf);
            qk_mma(p0, p1, kf, qf, c);
        }
        v_load(vf, slot + 8192, lane);
        __builtin_amdgcn_sched_barrier(0);
        if (VAR == 2) { asm volatile("" :: "v"(p0), "v"(p1)); strm_next(cst, sub); continue; }
        asm volatile("" :: "v"(p0), "v"(p1)); STAMP(3);
        if (kind == 0) { const int tok = 64 * qt + qi; const int nmax = (tok >= 31) ? ((tok - 31) >> 4) : -1; mask_le(p0, p1, nmax - 64 * j, hi); }
        else { if (j == qt) mask_le(p0, p1, qi, hi); if (kind == 2 && j == qt - 8) mask_gt(p0, p1, qi, hi); }
        const float f = soft_update(S, p0, p1, first, wsf, r32, hi);
        asm volatile("" :: "v"(p0), "v"(p1)); STAMP(4);
        if (VAR == 3) { asm volatile("" :: "v"(p0), "v"(p1)); strm_next(cst, sub); continue; }
        {
            bf16x8 pa[4]; pack_p(pa, p0, p1);
            pv_mma(S.o, S.lacc, vf, pa);
        }
        asm volatile("" :: "v"(S.o[0]), "v"(S.o[1])); STAMP(5);
        if (kind == 0) {
            NLAS float* FAC = (NLAS float*)(lds + L_FAC) + w * 64;
            int ll_ = lane; asm volatile("" : "+v"(ll_));
            const int r32 = ll_ & 31, hi = ll_ >> 5, tid = w * 64 + ll_, qi = 32 * (w & 1) + r32;
            NLAS float* IMP = (NLAS float*)(lds + L_IMP) + w * 32 * 33; NLAS float* CAR = (NLAS float*)(lds + L_CAR) + w * 32 * 33;
            NLAS float* wsf = (NLAS float*)(lds + L_WSF) + w * 64;
            NLAS float* stash = (NLAS float*)(lds + L_IMP + w * 8448) + ll_;
            if (j == 0) {
                if (hi == 0) CAR[r32 * 33] = 0.f;
#pragma unroll
                for (int a = 0; a < 4; ++a) {
                    const int jb = 2 * a + hi;
                    IMP[r32 * 33 + jb] = p0[4 * a] + p0[4 * a + 1] + p0[4 * a + 2] + 0.5f * p0[4 * a + 3]; CAR[r32 * 33 + jb + 1] = 0.5f * p0[4 * a + 3];
                    IMP[r32 * 33 + jb + 8] = p1[4 * a] + p1[4 * a + 1] + p1[4 * a + 2] + 0.5f * p1[4 * a + 3]; CAR[r32 * 33 + jb + 9] = 0.5f * p1[4 * a + 3];
                }
            } else {
                if (r32 == 0) {
#pragma unroll
                    for (int r = 0; r < 16; ++r) wsf[crow(r, hi)] = S.lacc[r]; }
                asm volatile("s_waitcnt lgkmcnt(0)" ::: "memory");
                const float l = wsf[r32];
                asm volatile("s_waitcnt lgkmcnt(0)" ::: "memory");
                const float inv = (l > 0.f) ? __builtin_amdgcn_rcpf(l) : 0.f;
                if (hi == 0) { FAC[r32] = f * inv; FAC[32 + r32] = inv; }
#pragma unroll
                for (int a = 0; a < 4; ++a) {
                    const int jb = 2 * a + hi;
                    IMP[r32 * 33 + jb + 16] = p0[4 * a] + p0[4 * a + 1] + p0[4 * a + 2] + 0.5f * p0[4 * a + 3]; CAR[r32 * 33 + jb + 17] = 0.5f * p0[4 * a + 3];
                    IMP[r32 * 33 + jb + 24] = p1[4 * a] + p1[4 * a + 1] + p1[4 * a + 2] + 0.5f * p1[4 * a + 3]; if (jb + 25 < 32) CAR[r32 * 33 + jb + 25] = 0.5f * p1[4 * a + 3];
                }
                ABAR();
                {
                    NLAS float* VAL = (NLAS float*)(lds + L_VAL);
                    const int tq = tid >> 3, sb = tid & 7, wv = tq >> 5, rr = tq & 31;
                    const NLAS float* I0 = (const NLAS float*)(lds + L_IMP); const NLAS float* C0 = (const NLAS float*)(lds + L_CAR);
                    float v[4];
#pragma unroll
                    for (int e = 0; e < 4; ++e) { const int jb = 4 * sb + e; float sc = 0.f;
#pragma unroll
                        for (int gg = 0; gg < 4; ++gg) { const int ww = 2 * gg + wv; const NLAS float* fc = (const NLAS float*)(lds + L_FAC) + ww * 64 + rr;
                            sc += I0[(ww * 32 + rr) * 33 + jb] * fc[jb < 16 ? 0 : 32] + C0[(ww * 32 + rr) * 33 + jb] * fc[jb <= 16 ? 0 : 32]; }
                        if (jb > qt) sc = -1.0f; else if (jb == 0 || jb == qt || jb == qt - 1) sc = 1e4f;
                        v[e] = sc; VAL[tq * 33 + jb] = sc; }
                    asm volatile("s_waitcnt lgkmcnt(0)" ::: "memory");
                    unsigned bits = 0u;
#pragma unroll
                    for (int e = 0; e < 4; ++e) { const int jb = 4 * sb + e; int rank = 0;
#pragma unroll
                        for (int i = 0; i < 32; ++i) { const float x = VAL[tq * 33 + i]; rank += (x > v[e] || (x == v[e] && i < jb)) ? 1 : 0; }
                        if (rank < 16) bits |= 1u << jb; }
                    bits |= dpp_xor1(bits); bits |= dpp_xor2(bits); bits |= dpp_hmirror(bits);
                    if (sb == 0) ((NLAS unsigned*)(lds + L_SELM))[tq] = bits;
                }
                ABAR();
#ifdef DBG_SELALL
                selm = 0xffffffffu;
#else
                selm = ((const NLAS unsigned*)(lds + L_SELM))[qi];
#endif
                const float fac = g_cmp * inv;
                if (hi == 0) wsf[r32] = fac;
                asm volatile("s_waitcnt lgkmcnt(0)" ::: "memory");
#pragma unroll
                for (int r = 0; r < 16; ++r) { const float ff = wsf[crow(r, hi)]; stash[r * 64] = S.o[0][r] * ff; stash[(16 + r) * 64] = S.o[1][r] * ff; }
                asm volatile("s_waitcnt lgkmcnt(0)" ::: "memory");
                const size_t qoff = (((size_t)b * 16 + hq) * 2048 + 64 * qt + qi) * 64 + 8 * hi;
                q_fetch(qf, (const bf16_t*)(ws + WS_NQR) + qoff);
            }
        } else {
            const int jend = (kind == 1) ? 0 : (qt >= 8 ? qt - 8 : 0);
            if (j == jend) {
                int ll_ = lane; asm volatile("" : "+v"(ll_));
                const int r32 = ll_ & 31, hi = ll_ >> 5, lane = ll_;
                NLAS float* wsf = (NLAS float*)(lds + L_WSF) + w * 64;
                NLAS float* stash = (NLAS float*)(lds + L_IMP + w * 8448) + ll_;
                if (hi == 0) wsf[r32] = (kind == 1 ? g_sel : g_win);
                asm volatile("s_waitcnt lgkmcnt(0)" ::: "memory");
#pragma unroll
                for (int r = 0; r < 16; ++r) { const float ff = wsf[crow(r, hi)] * __builtin_amdgcn_rcpf(S.lacc[r]); stash[r * 64] += S.o[0][r] * ff; stash[(16 + r) * 64] += S.o[1][r] * ff; }
                asm volatile("s_waitcnt lgkmcnt(0)" ::: "memory");
                if (kind == 2) {
                    const NLAS float* sw = (const NLAS float*)(lds + L_IMP + w * 8448);
                    bf16_t* ob = (bf16_t*)(ws + WS_OATT) + ((size_t)b * 2048 + 64 * qt + 32 * (w & 1)) * 1024 + hq * 64;
#pragma unroll
                    for (int i = 0; i < 4; ++i) {
                        const int row = 8 * i + (lane >> 3), ch = lane & 7;
                        const int hh_ = (row >> 2) & 1, rr_ = (row & 3) + 4 * (row >> 3), d0 = ch >> 2;
                        const NLAS float* sp = sw + ((d0 * 16 + rr_) * 64 + hh_ * 32 + (ch & 3) * 8);
                        const f32x4 x0 = *(const NLAS f32x4*)sp, x1 = *(const NLAS f32x4*)(sp + 4);
                        u32x4 ov; ov.x = cvtpk(x0.x, x0.y); ov.y = cvtpk(x0.z, x0.w); ov.z = cvtpk(x1.x, x1.y); ov.w = cvtpk(x1.z, x1.w);
                        *(u32x4*)(ob + (size_t)row * 1024 + ch * 8) = ov;
                    }
                    ABAR();
                }
            }
        }
        strm_next(cst, sub);
    }
    ABAR();
#ifdef DBG_PROF
    if (blockIdx.x == 0 && tid == 0) { unsigned long long* dp = (unsigned long long*)(ws + (size_t)500 * 1048576);
        for (int k = 0; k < 7; ++k) dp[k] = tacc_[k]; }
#endif
#undef STAMP
#undef ISSUE
#undef PTRS
#undef A_KC
#undef A_VC
#undef A_KV
}
}
namespace cg = cooperative_groups;
typedef unsigned short bf16_t;
struct Params { const float* in[23]; float* out; unsigned char* ws; };

constexpr int PARAM_OFF = EPI_OFF + 28672, BARST_OFF = PARAM_OFF + 256;
template <class T> __device__ __forceinline__ T* ldp(PG8_LAS unsigned char* lds, int idx) {
    const PG8_LAS unsigned* p = (const PG8_LAS unsigned*)(lds + PARAM_OFF) + 2 * idx;
    const unsigned lo = __builtin_amdgcn_readfirstlane(p[0]), hi = __builtin_amdgcn_readfirstlane(p[1]);
    typedef __attribute__((address_space(1))) unsigned char gchar_t;
    gchar_t* gp = (gchar_t*)(((unsigned long long)hi << 32) | lo);
    return (T*)(unsigned char*)gp;
}
#define INP(k) ldp<const float>(lds, (k))
#define OUTP() ldp<float>(lds, 23)
#define WSP() ldp<unsigned char>(lds, 24)
__device__ __forceinline__ pro::In load_in(PG8_LAS unsigned char* lds) {
    pro::In I;
    I.x = INP(0); I.norm_mix = INP(1); I.norm_ffn = INP(2); I.gla_w_in = INP(3); I.gla_w_alpha_up = INP(4); I.gla_b_alpha = INP(5); I.gla_norm = INP(6); I.gla_w_o = INP(7);
    I.kv_norm = INP(8); I.nsa_w_kv = INP(9); I.cmp_pe_k = INP(10); I.cmp_pe_v = INP(11); I.cmp_k_w1 = INP(12); I.cmp_k_w2 = INP(13); I.cmp_v_w1 = INP(14); I.cmp_v_w2 = INP(15);
    I.nsa_w_in = INP(16); I.nsa_w_o = INP(17); I.ffn_w_up = INP(18); I.ffn_conv_w = INP(19); I.ffn_conv_b = INP(20); I.ffn_w_down = INP(21); I.norm_final = INP(22);
    return I;
}

__global__ void __launch_bounds__(512, 2) yoco_fwd(Params P) {
    extern __shared__ __attribute__((aligned(16))) unsigned char lds_raw[];
    PG8_LAS unsigned char* lds = (PG8_LAS unsigned char*)lds_raw;
    cg::grid_group grid = cg::this_grid();
    const int G = gridDim.x, bx = blockIdx.x;
    const int wave0 = __builtin_amdgcn_readfirstlane(threadIdx.x >> 6);
#define NOWTID() (wave0 * 64 + lane_id_fresh())
    if (threadIdx.x == 0) {
        PG8_LAS unsigned long long* lp = (PG8_LAS unsigned long long*)(lds + PARAM_OFF);
#pragma unroll
        for (int i = 0; i < 23; ++i) lp[i] = (unsigned long long)P.in[i];
        lp[23] = (unsigned long long)P.out; lp[24] = (unsigned long long)P.ws;
    }
    if (threadIdx.x < 2) ((PG8_LAS unsigned*)(lds + BARST_OFF))[threadIdx.x] = 0u;
    __syncthreads();
    (void)xcd_barrier_post((unsigned*)(P.ws + WS_BAR), (volatile LAS unsigned*)(lds + BARST_OFF), (int)threadIdx.x);
#define GSYNC() do { XcdBarrier b_; b_.bar = (unsigned*)(WSP() + WS_BAR); b_.x = xb_xcc_id(); b_.st = (volatile LAS unsigned*)(lds + BARST_OFF); xcd_barrier(b_, NOWTID()); } while (0)
#define PH_COMMON int tid_ = NOWTID(); asm volatile("" : "+v"(tid_)); const int tid = tid_, lane = tid & 63, wave = __builtin_amdgcn_readfirstlane(tid >> 6); const int gw = bx * 8 + wave, NGW = G * 8; (void)lane; (void)gw; (void)NGW; unsigned char* ws = WSP(); (void)ws;

#ifndef SKIP_PRO
    { PH_COMMON
        pro::In I = load_in(lds); pro::Wts W;
        W.WGI = (bf16_t*)(ws + WS_WGI); W.WGO = (bf16_t*)(ws + WS_WGO); W.WKQ = (bf16_t*)(ws + WS_WKQ); W.WC1 = (bf16_t*)(ws + WS_WC1); W.WC2 = (bf16_t*)(ws + WS_WC2);
        W.WNO = (bf16_t*)(ws + WS_WNO); W.WUP = (bf16_t*)(ws + WS_WUP); W.WDN = (bf16_t*)(ws + WS_WDN); W.ROPE = (_Float16*)(ws + WS_ROPE); W.BIASC = (float*)(ws + WS_BIASC);
#ifdef REP_PRO
        pro::prologue(I, W, (bf16_t*)(ws + WS_XB), (float*)(ws + WS_RSS), lds, gw, NGW, lane, wave); __syncthreads();
#endif
        pro::prologue(I, W, (bf16_t*)(ws + WS_XB), (float*)(ws + WS_RSS), lds, gw, NGW, lane, wave); }
#endif
    if (G != 256) grid.sync(); else GSYNC();

#ifdef REP_SYNC
#pragma unroll 1
    for (int r = 0; r < REP_SYNC; ++r) GSYNC();
#endif
#ifndef SKIP_P1
    { unsigned char* ws = WSP();
        pg8::Gemm g = pg8::make_gemm((const bf16_t*)(ws + WS_XB), (const bf16_t*)(ws + WS_WGI), M_TOK, 3584, 1024, 1024, 1024);
        pg8::StaticOrder S; S.init(M_TOK, 3584, G, bx);
        epi::EpiGlaIn E{(bf16_t*)(ws + WS_GQ), (bf16_t*)(ws + WS_GK), (bf16_t*)(ws + WS_GV), (bf16_t*)(ws + WS_GR), (float*)(ws + WS_GG), (const float*)(ws + WS_RSS), INP(5)};
#ifdef REP_P1
        pg8::gemm_phase(lds, lds + EPI_OFF, g, S, E, NOWTID());
#endif
#ifdef REP_P1NULL
        { epi::EpiNull EN; pg8::gemm_phase(lds, lds + EPI_OFF, g, S, EN, NOWTID()); }
#endif
        pg8::gemm_phase(lds, lds + EPI_OFF, g, S, E, NOWTID());
    }
#endif
    GSYNC();
#ifndef SKIP_GLA
    { unsigned char* ws = WSP();
        float* SLOC = (float*)(ws + WS_BIG + 260 * MiB); float* DSEG = (float*)(ws + WS_BIG + 290 * MiB);
#ifdef REP_GLAA
        for (int un = bx; un < 256; un += G) if ((un & 3) < 3) gla::gla_unit<true>(un >> 4, (un >> 2) & 3, un & 3, (const bf16_t*)(ws + WS_GQ), (const bf16_t*)(ws + WS_GK), (const bf16_t*)(ws + WS_GV), (bf16_t*)(ws + WS_GV), (const bf16_t*)(ws + WS_GR), (const float*)(ws + WS_GG), INP(6), SLOC, DSEG, lds, NOWTID());
#endif
        for (int un = bx; un < 256; un += G) if ((un & 3) < 3) gla::gla_unit<true>(un >> 4, (un >> 2) & 3, un & 3, (const bf16_t*)(ws + WS_GQ), (const bf16_t*)(ws + WS_GK), (const bf16_t*)(ws + WS_GV), (bf16_t*)(ws + WS_GV), (const bf16_t*)(ws + WS_GR), (const float*)(ws + WS_GG), INP(6), SLOC, DSEG, lds, NOWTID());
    }
    GSYNC();
    { unsigned char* ws = WSP();
        float* SLOC = (float*)(ws + WS_BIG + 260 * MiB); float* DSEG = (float*)(ws + WS_BIG + 290 * MiB);
#ifdef REP_GLAB
        for (int un = bx; un < 256; un += G) gla::gla_unit<false>(un >> 4, (un >> 2) & 3, un & 3, (const bf16_t*)(ws + WS_GQ), (const bf16_t*)(ws + WS_GK), (const bf16_t*)(ws + WS_GV), (bf16_t*)(ws + WS_BIG + 300 * MiB), (const bf16_t*)(ws + WS_GR), (const float*)(ws + WS_GG), INP(6), SLOC, DSEG, lds, NOWTID());
#endif
        for (int un = bx; un < 256; un += G) gla::gla_unit<false>(un >> 4, (un >> 2) & 3, un & 3, (const bf16_t*)(ws + WS_GQ), (const bf16_t*)(ws + WS_GK), (const bf16_t*)(ws + WS_GV), (bf16_t*)(ws + WS_GV), (const bf16_t*)(ws + WS_GR), (const float*)(ws + WS_GG), INP(6), SLOC, DSEG, lds, NOWTID());
    }
#endif
    GSYNC();
#ifndef SKIP_P3
    { unsigned char* ws = WSP();
        pg8::Gemm g = pg8::make_gemm((const bf16_t*)(ws + WS_GV), (const bf16_t*)(ws + WS_WGO), M_TOK, 1024, 1024, 1024, 1024);
        pg8::StaticOrder S; S.init(M_TOK, 1024, G, bx);
        epi::EpiRes E{nullptr, (bf16_t*)(ws + WS_XB), (float*)(ws + WS_RSS) + 1 * M_TOK};
        pg8::gemm_phase(lds, lds + EPI_OFF, g, S, E, NOWTID());
    }
#endif
    GSYNC();
#pragma unroll 1
    for (int layer = 0; layer < 2; ++layer) {
        if (layer == 1) {
#ifndef SKIP_P7
            { unsigned char* ws = WSP();
                pg8::Gemm g = pg8::make_gemm((const bf16_t*)(ws + WS_XB), (const bf16_t*)(ws + WS_WKQ), M_TOK, 2816, 1024, 1024, 1024);
                pg8::StaticOrder S; S.init(M_TOK, 2816, G, bx);
                epi::EpiKvq E{(bf16_t*)(ws + WS_KV), (bf16_t*)(ws + WS_NQ), (bf16_t*)(ws + WS_NQR), (float*)(ws + WS_GATES), (const float*)(ws + WS_RSS) + 2 * M_TOK, (const _Float16*)(ws + WS_ROPE)};
#ifdef REP_P7
                pg8::gemm_phase(lds, lds + EPI_OFF, g, S, E, NOWTID());
#endif
                pg8::gemm_phase(lds, lds + EPI_OFF, g, S, E, NOWTID());
            }
#endif
            GSYNC();
#ifndef SKIP_P8
            { unsigned char* ws = WSP();
                pg8::Gemm g = pg8::make_gemm((const bf16_t*)(ws + WS_KV), (const bf16_t*)(ws + WS_WC1), 16384, 1024, 512, 1024, 2048);
                g.a_pn = 512 * 2; g.b_pn = 512 * 2; g.b_hi = (size_t)256 * 2048 * 2; g.b_split = 32;
                pg8::StaticOrder S; S.init(16384, 1024, G, bx);
                epi::EpiCmp E{(float*)(ws + WS_HP)};
#ifdef REP_P8
                pg8::gemm_phase(lds, lds + EPI_OFF, g, S, E, NOWTID());
#endif
                pg8::gemm_phase(lds, lds + EPI_OFF, g, S, E, NOWTID());
            }
#endif
            GSYNC();
#ifndef SKIP_P9
#ifdef REP_P9
            { PH_COMMON nsa::cmp_finalize((const float*)(ws + WS_HP), (const float*)(ws + WS_BIASC), (const bf16_t*)(ws + WS_WC2), (bf16_t*)(ws + WS_KCVC), wave * G + bx, NGW, lane); }
#endif
            { PH_COMMON nsa::cmp_finalize((const float*)(ws + WS_HP), (const float*)(ws + WS_BIASC), (const bf16_t*)(ws + WS_WC2), (bf16_t*)(ws + WS_KCVC), wave * G + bx, NGW, lane); }
#endif
            GSYNC();
#ifndef SKIP_ATTN
            { unsigned char* ws = WSP();
                nsa::AttnBufs T{ws};
#ifdef REP_ATTN
                for (int v_ = bx; v_ < 256; v_ += G) nsa::attn_block<REP_ATTN>(v_ >> 2, v_ & 3, T, lds, NOWTID());
#endif
                for (int v_ = bx; v_ < 256; v_ += G) nsa::attn_block(v_ >> 2, v_ & 3, T, lds, NOWTID());
            }
#endif
            GSYNC();
#ifndef SKIP_P11
            { unsigned char* ws = WSP();
                pg8::Gemm g = pg8::make_gemm((const bf16_t*)(ws + WS_OATT), (const bf16_t*)(ws + WS_WNO), M_TOK, 1024, 1024, 1024, 1024);
                pg8::StaticOrder S; S.init(M_TOK, 1024, G, bx);
                epi::EpiRes E{nullptr, (bf16_t*)(ws + WS_XB), (float*)(ws + WS_RSS) + 3 * M_TOK};
                pg8::gemm_phase(lds, lds + EPI_OFF, g, S, E, NOWTID());
            }
#endif
            GSYNC();
        }
#ifndef SKIP_UP
        { unsigned char* ws = WSP();
            const float* rss_in = (const float*)(ws + WS_RSS) + (layer == 0 ? 1 : 3) * M_TOK;
            const float* cw = INP(19) + (size_t)layer * 3 * 5632; const float* cb = INP(20) + (size_t)layer * 5632;
            pg8::Gemm g = pg8::make_gemm((const bf16_t*)(ws + WS_XB), (const bf16_t*)(ws + WS_WUP) + (size_t)layer * 5632 * 1024, M_TOK, 5632, 1024, 1024, 1024);
            pg8::StaticOrder S; S.init(M_TOK, 5632, G, bx);
            epi::EpiFfnUp E{(bf16_t*)(ws + WS_ACT), (float*)(ws + WS_HALO), rss_in, cw, cb};
#ifdef REP_UP
            pg8::gemm_phase(lds, lds + EPI_OFF, g, S, E, NOWTID());
#endif
#ifdef REP_UPNULL
            { epi::EpiNull EN; pg8::gemm_phase(lds, lds + EPI_OFF, g, S, EN, NOWTID()); }
#endif
            pg8::gemm_phase(lds, lds + EPI_OFF, g, S, E, NOWTID());
        }
#endif
        GSYNC();
#ifndef SKIP_FIX
        { PH_COMMON
            const float* cw = INP(19) + (size_t)layer * 3 * 5632; const float* cb = INP(20) + (size_t)layer * 5632;
            const float* HALO = (const float*)(ws + WS_HALO); bf16_t* ACT = (bf16_t*)(ws + WS_ACT);
#ifdef REP_FIX
            for (int rep_ = 0; rep_ < 2; ++rep_)
#endif
            for (int i = bx * 512 + tid; i < 128 * 2 * 704; i += G * 512) {
                const int fg = i % 704, pr = i / 704, r = pr & 1, pm = pr >> 1;
                if ((pm & 7) == 0) continue;
                const int f = 4 * fg, pn = f >> 7, cc = f & 127;
                const float* hc = HALO + ((size_t)(pm * 22 + pn) * 4) * 256 + cc; const float* hp = HALO + ((size_t)((pm - 1) * 22 + pn) * 4) * 256 + cc;
                const float* g0p = r == 0 ? hc : hc + 256; const float* g1p = r == 0 ? hp + 3 * 256 : hc; const float* g2p = r == 0 ? hp + 2 * 256 : hp + 3 * 256;
                const pro::f32x4 ug = *(const pro::f32x4*)g0p, ug1 = *(const pro::f32x4*)g1p, ug2 = *(const pro::f32x4*)g2p;
                const pro::f32x4 uv = *(const pro::f32x4*)(g0p + 128), uv1 = *(const pro::f32x4*)(g1p + 128), uv2 = *(const pro::f32x4*)(g2p + 128);
                const pro::f32x4 bg = *(const pro::f32x4*)(cb + f), wg0 = *(const pro::f32x4*)(cw + f), wg1 = *(const pro::f32x4*)(cw + 5632 + f), wg2 = *(const pro::f32x4*)(cw + 2 * 5632 + f);
                const pro::f32x4 bv = *(const pro::f32x4*)(cb + 2816 + f), wv0 = *(const pro::f32x4*)(cw + 2816 + f), wv1 = *(const pro::f32x4*)(cw + 5632 + 2816 + f), wv2 = *(const pro::f32x4*)(cw + 2 * 5632 + 2816 + f);
                const pro::f32x4 og = bg + wg0 * ug2 + wg1 * ug1 + wg2 * ug;
                const pro::f32x4 ov = bv + wv0 * uv2 + wv1 * uv1 + wv2 * uv;
                float a[4];
#pragma unroll
                for (int j = 0; j < 4; ++j) a[j] = og[j] * __builtin_amdgcn_rcpf(1.0f + __expf(-og[j])) * ov[j];
                pg8::u32x2 w; w.x = pg8::cvt_pk_bf16(a[0], a[1]); w.y = pg8::cvt_pk_bf16(a[2], a[3]);
                *(pg8::u32x2*)(ACT + (size_t)(pm * 256 + r) * 2816 + f) = w;
            }
        }
#endif
        GSYNC();
#ifndef SKIP_DOWN
        { unsigned char* ws = WSP(); float* out = OUTP();
            float* rss_out = (float*)(ws + WS_RSS) + (layer == 0 ? 2 : 4) * M_TOK;
            pg8::Gemm g = pg8::make_gemm((const bf16_t*)(ws + WS_ACT), (const bf16_t*)(ws + WS_WDN) + (size_t)layer * 1024 * 2816, M_TOK, 1024, 2816, 2816, 2816);
            pg8::StaticOrder S; S.init(M_TOK, 1024, G, bx);
            if (layer == 1 && G == 256) {
                epi::EpiResFinal EF{(const bf16_t*)(ws + WS_XB), out, INP(22), (unsigned*)(ws + WS_XSLOT), (unsigned*)(ws + WS_XCNT)};
                pg8::gemm_phase(lds, lds + EPI_OFF, g, S, EF, NOWTID());
            } else {
                epi::EpiRes E{layer == 1 ? out : nullptr, (bf16_t*)(ws + WS_XB), rss_out};
                pg8::gemm_phase(lds, lds + EPI_OFF, g, S, E, NOWTID());
            }
        }
#endif
        if (!(layer == 1 && G == 256)) GSYNC();
    }
    if (G != 256) { PH_COMMON
        const float* rss = (const float*)(ws + WS_RSS) + 4 * M_TOK; float* out = OUTP(); const float* norm_final = INP(22);
        for (int m = gw; m < M_TOK; m += NGW) {
            const float rs = rsqrtf(rss[m] * (1.0f / 1024.0f) + 1e-6f);
            pro::f32x4* xr = (pro::f32x4*)(out + (size_t)m * 1024) + lane; const pro::f32x4* gr = (const pro::f32x4*)norm_final + lane;
#if defined(DBG_GPROF)
            { const unsigned long long* dp = (const unsigned long long*)(ws + WS_BIG + (size_t)370 * 1048576); float tot = 0.f; for (int k = 0; k < 12; ++k) tot += (float)dp[k];
              const float ratio = (float)dp[DBG_GPROF] / tot; const float amp = 1.0f + sqrtf(ratio * 0.01f);
              for (int j = 0; j < 4; ++j) { const pro::f32x4 v = xr[64 * j], gg = gr[64 * j]; xr[64 * j] = v * rs * gg * amp; } }
#elif defined(DBG_PROF)
            { const unsigned long long* dp = (const unsigned long long*)(ws + (size_t)500 * 1048576); float tot = 0.f; for (int k = 0; k < 7; ++k) tot += (float)dp[k];
              const float ratio = (float)dp[DBG_PROF] / tot; const float amp = 1.0f + sqrtf(ratio * 0.01f);
              for (int j = 0; j < 4; ++j) { const pro::f32x4 v = xr[64 * j], gg = gr[64 * j]; xr[64 * j] = v * rs * gg * amp; } }
#else
#pragma unroll
            for (int j = 0; j < 4; ++j) { const pro::f32x4 v = xr[64 * j], gg = gr[64 * j]; xr[64 * j] = v * rs * gg; }
#endif
        }
    }
}

extern "C" void kernel_launch(void* const* d_in, const int* in_sizes, int n_in, void* d_out, int out_size, void* d_ws, size_t ws_size, hipStream_t stream) {
    static int grid = 0;
    if (grid == 0) {
        if (n_in != 23 || ws_size < WS_END) { fprintf(stderr, "kernel_launch: unexpected n_in %d or ws_size %zu (< %zu)\n", n_in, ws_size, (size_t)WS_END); grid = -1; return; }
        int dev = 0, cus = 0, per_cu = 0;
        (void)hipGetDevice(&dev);
        (void)hipDeviceGetAttribute(&cus, hipDeviceAttributeMultiprocessorCount, dev);
        (void)hipFuncSetAttribute((const void*)yoco_fwd, hipFuncAttributeMaxDynamicSharedMemorySize, LDS_BYTES);
        (void)hipOccupancyMaxActiveBlocksPerMultiprocessor(&per_cu, (const void*)yoco_fwd, 512, LDS_BYTES);
        if (per_cu < 1) { fprintf(stderr, "kernel_launch: occupancy query reports %d blocks per CU\n", per_cu); grid = -1; return; }
        grid = cus;
        if (grid > 256) grid = 256;
        grid &= ~7;
    }
    if (grid <= 0) return;
    (void)hipMemsetAsync((char*)d_ws + WS_RSS, 0, 1 * MiB, stream);
    Params p{};
    for (int i = 0; i < 23; ++i) p.in[i] = (const float*)d_in[i];
    p.out = (float*)d_out; p.ws = (unsigned char*)d_ws;
    void* args[] = {&p};
    hipError_t e = hipLaunchCooperativeKernel((void*)yoco_fwd, dim3(grid), dim3(512), args, LDS_BYTES, stream);
    if (e != hipSuccess) fprintf(stderr, "cooperative launch failed: %s (grid %d)\n", hipGetErrorString(e), grid);
}
```

```cpp
#include <hip/hip_runtime.h>
#include <hip/hip_cooperative_groups.h>
#include <cstdio>
#include <cstdint>
constexpr size_t MiB = 1u << 20;
constexpr int M_TOK = 32768;
constexpr size_t WS_RSS = 0;
constexpr size_t WS_BAR = 768 * 1024;
constexpr size_t WS_XCNT = 832 * 1024;
constexpr size_t WS_ROPE = 1 * MiB, WS_BIASC = 800 * 1024;
constexpr size_t WS_WGI = 2 * MiB, WS_WGO = 9 * MiB, WS_WKQ = 11 * MiB, WS_WC1 = 17 * MiB, WS_WC2 = 19 * MiB, WS_WNO = 20 * MiB, WS_WUP = 22 * MiB, WS_WDN = 44 * MiB;
constexpr size_t WS_XB = 56 * MiB;
constexpr size_t WS_BIG = 120 * MiB;
constexpr size_t WS_GQ = WS_BIG, WS_GK = WS_BIG + 32 * MiB, WS_GV = WS_BIG + 64 * MiB, WS_GR = WS_BIG + 128 * MiB, WS_GG = WS_BIG + 192 * MiB;
constexpr size_t WS_ACT = WS_BIG, WS_HALO = WS_BIG + 176 * MiB;
constexpr size_t WS_KV = WS_BIG, WS_NQ = WS_BIG + 96 * MiB, WS_NQR = WS_BIG + 160 * MiB, WS_GATES = WS_BIG + 224 * MiB, WS_HP = WS_BIG + 230 * MiB, WS_KCVC = WS_BIG + 294 * MiB, WS_OATT = WS_BIG + 296 * MiB;
constexpr size_t WS_XSLOT = WS_BIG + 372 * MiB;
constexpr size_t WS_END = WS_BIG + 376 * MiB;
constexpr int LDS_BYTES = 160 * 1024, EPI_OFF = 131072;


#define LAS __attribute__((address_space(3)))
#define XB_TMO      128
#define XB_XCNT(j)  (256  + 64 * (j))
#define XB_XSUB(j)  (1280 + 64 * (j))
#define XB_XGEN(j)  (2304 + 64 * (j))
#define XB_TOP      3328
#define XB_TOPGEN   3392
#define XCD_BAR_WORDS 3456
#define XB_SPIN_CAP (1u << 18)

__device__ __forceinline__ unsigned xb_ld(unsigned* p)              { return __hip_atomic_load(p, __ATOMIC_RELAXED, __HIP_MEMORY_SCOPE_AGENT); }
__device__ __forceinline__ unsigned xb_add(unsigned* p, unsigned v) { return __hip_atomic_fetch_add(p, v, __ATOMIC_RELAXED, __HIP_MEMORY_SCOPE_AGENT); }
__device__ __forceinline__ unsigned xb_xcc_id() { return (unsigned)__builtin_amdgcn_s_getreg((3 << 11) | 20) & 0xFu; }
#define XB_SPIN(cond, bar) do { unsigned _sp = 0; while (cond) { __builtin_amdgcn_s_sleep(1); \
    if ((++_sp & 255u) == 0u) { if (xb_ld(&(bar)[XB_TMO])) break; if (_sp > XB_SPIN_CAP) { atomicAdd(&(bar)[XB_TMO], 1u); break; } } } } while (0)

struct XcdBarrier {
    unsigned* bar; unsigned x;
    volatile LAS unsigned* st;
};

__device__ __forceinline__ XcdBarrier xcd_barrier_post(unsigned* bar, volatile LAS unsigned* st, int tid) {
    XcdBarrier b; b.bar = bar; b.x = xb_xcc_id(); b.st = st;
    if (tid == 0) (void)xb_add(&bar[XB_XCNT(b.x)], 1u);
    return b;
}
__device__ __forceinline__ void xcd_barrier_complete(unsigned* bar, unsigned x, unsigned& nloc, unsigned& nx) {
    const unsigned G = gridDim.x * gridDim.y * gridDim.z;
    unsigned sum, cnt, mine, sp = 0u;
    for (;;) {
        sum = 0u; cnt = 0u; mine = 0u;
#pragma unroll
        for (unsigned j = 0; j < 16; ++j) { const unsigned c = xb_ld(&bar[XB_XCNT(j)]); sum += c; cnt += (c > 0u) ? 1u : 0u; mine = (j == x) ? c : mine; }
        if (sum == G) break;
        __builtin_amdgcn_s_sleep(1);
        if ((++sp & 255u) == 0u) { if (xb_ld(&bar[XB_TMO])) break; if (sp > XB_SPIN_CAP) { atomicAdd(&bar[XB_TMO], 1u); break; } }
    }
    nloc = mine > 0u ? mine : 1u; nx = cnt > 0u ? cnt : 1u;
}

__device__ __forceinline__ void xcd_barrier(const XcdBarrier& b, int tid) {
    asm volatile("s_waitcnt vmcnt(0)" ::: "memory");
    __syncthreads();
    if (tid == 0) {
        unsigned* bar = b.bar;
        __builtin_amdgcn_s_waitcnt(0);
        unsigned nloc = b.st[0], nx = b.st[1];
        if (nloc == 0u) { xcd_barrier_complete(bar, b.x, nloc, nx); b.st[0] = nloc; b.st[1] = nx; }
        const unsigned old = xb_add(&bar[XB_XSUB(b.x)], 1u);
        const unsigned gen = old / nloc;
        if (old + 1u == (gen + 1u) * nloc) {
            __builtin_amdgcn_fence(__ATOMIC_RELEASE, "agent");
            asm volatile("s_waitcnt vmcnt(0)" ::: "memory");
            const unsigned og = xb_add(&bar[XB_TOP], 1u);
            const unsigned tg = og / nx;
            if (og + 1u == (tg + 1u) * nx) xb_add(&bar[XB_TOPGEN], 1u);
            else XB_SPIN(xb_ld(&bar[XB_TOPGEN]) == tg, bar);
            __builtin_amdgcn_fence(__ATOMIC_ACQUIRE, "agent");
            xb_add(&bar[XB_XGEN(b.x)], 1u);
            asm volatile("s_waitcnt vmcnt(0)" ::: "memory");
        } else {
            XB_SPIN(xb_ld(&bar[XB_XGEN(b.x)]) == gen, bar);
            __builtin_amdgcn_fence(__ATOMIC_ACQUIRE, "agent");
            asm volatile("s_waitcnt vmcnt(0)" ::: "memory");
        }
    }
    __syncthreads();
}

__device__ __forceinline__ int lane_id() { return (int)__builtin_amdgcn_mbcnt_hi(~0u, __builtin_amdgcn_mbcnt_lo(~0u, 0u)); }
__device__ __forceinline__ int lane_id_fresh() { int l; asm volatile("v_mbcnt_lo_u32_b32 %0, -1, 0\n\tv_mbcnt_hi_u32_b32 %0, -1, %0" : "=v"(l)); return l; }
template <class T> __device__ __forceinline__ T dpp_xor1(T x) { return __builtin_bit_cast(T, __builtin_amdgcn_mov_dpp(__builtin_bit_cast(int, x), 0xB1, 0xf, 0xf, true)); }
template <class T> __device__ __forceinline__ T dpp_xor2(T x) { return __builtin_bit_cast(T, __builtin_amdgcn_mov_dpp(__builtin_bit_cast(int, x), 0x4E, 0xf, 0xf, true)); }
template <class T> __device__ __forceinline__ T dpp_hmirror(T x) { return __builtin_bit_cast(T, __builtin_amdgcn_mov_dpp(__builtin_bit_cast(int, x), 0x141, 0xf, 0xf, true)); }
template <class T> __device__ __forceinline__ T swz_xor16(T x) { return __builtin_bit_cast(T, __builtin_amdgcn_ds_swizzle(__builtin_bit_cast(int, x), 0x401F)); }
namespace pg8 {
#define PG8_LAS __attribute__((address_space(3)))
typedef unsigned short bf16_t;
typedef short bf16x8 __attribute__((ext_vector_type(8)));
typedef float f32x4 __attribute__((ext_vector_type(4)));
typedef float f32x2 __attribute__((ext_vector_type(2)));
typedef unsigned u32x4 __attribute__((ext_vector_type(4)));
typedef unsigned u32x2 __attribute__((ext_vector_type(2)));
constexpr int BM = 256, BK = 64, HALF = 128, HTB = HALF * BK * 2, STAGE_BYTES = 8 * HTB, NXCD = 8, WGM = 8;

__host__ __device__ __forceinline__ int lds_byte(int r, int c) { const int st = (r >> 4) * 2 + (c >> 5), rr = r & 15, cc = c & 31, ob = rr * 64 + cc * 2; return st * 1024 + (ob ^ (((ob >> 9) & 1) << 5)); }
__host__ __device__ __forceinline__ void stage_rc(int b, int& R, int& C) { const int st = b / 1024, sb = b % 1024, swz = sb ^ (((sb >> 9) & 1) << 5); R = (st >> 1) * 16 + swz / 64; C = (st & 1) * 32 + (swz % 64) / 2; }
__host__ __device__ __forceinline__ int perm32(int rho) { const int n = rho >> 4, i = rho & 15; return 8 * (i >> 2) + 4 * n + (i & 3); }

struct Unit { int pm, pn; };
struct Gemm { const bf16_t* A; const bf16_t* Bt; int M, N, K; int lda, ldb; size_t a_pm, a_pn, b_pn, b_hi; int b_split; };
__device__ __forceinline__ Gemm make_gemm(const bf16_t* A, const bf16_t* Bt, int M, int N, int K, int lda, int ldb) {
    Gemm g; g.A = A; g.Bt = Bt; g.M = M; g.N = N; g.K = K; g.lda = lda; g.ldb = ldb;
    g.a_pm = (size_t)BM * lda * 2; g.a_pn = 0; g.b_pn = (size_t)BM * ldb * 2; g.b_hi = 0; g.b_split = 0x7fffffff; return g;
}

struct StaticOrder {
    int nM, nN, nwg, G, c;
    __device__ void init(int M, int N, int G_, int c_) { nM = M / BM; nN = N / BM; nwg = nM * nN; G = G_; c = c_; }
    __device__ bool next(int i, Unit& u) const {
        const long L = (long)i * G + c; if (L >= nwg) return false;
        int wgid = (int)L; { const int q = nwg / NXCD, r = nwg % NXCD, xcd = wgid % NXCD, off = wgid / NXCD; wgid = (xcd < r ? xcd * (q + 1) : r * (q + 1) + (xcd - r) * q) + off; }
        const int nig = WGM * nN, gid = wgid / nig, fm = gid * WGM, gsz = (nM - fm) < WGM ? (nM - fm) : WGM;
        u.pm = fm + ((wgid % nig) % gsz); u.pn = (wgid % nig) / gsz; return true;
    }
};

__device__ __forceinline__ unsigned cvt_pk_bf16(float lo, float hi) {
    typedef __bf16 bf16x2_t __attribute__((ext_vector_type(2)));
    f32x2 v = {lo, hi}; bf16x2_t b = __builtin_convertvector(v, bf16x2_t); return __builtin_bit_cast(unsigned, b);
}

template <class Epi>
__device__ __forceinline__ void gemm_phase(PG8_LAS unsigned char* lds, PG8_LAS unsigned char* lds_epi, const Gemm g, const StaticOrder& S, const Epi& E, int tid0) {
    int tid_ = tid0; asm volatile("" : "+v"(tid_));
    const int tid = tid_, wid = __builtin_amdgcn_readfirstlane(tid >> 6), lane = tid & 63, wr = wid >> 2, wc = wid & 3, fr = lane & 15, fq = lane >> 4;
    const int K = g.K, nt = K / BK;
    unsigned voffA[2], voffB[2];
#pragma unroll
    for (int i = 0; i < 2; ++i) { int R, C; stage_rc(tid * 16 + i * 8192, R, C); const int Rb = (R & ~31) + perm32(R & 31);
        voffA[i] = (unsigned)(R * g.lda + C) * 2u; voffB[i] = (unsigned)(Rb * g.ldb + C) * 2u; }
    const size_t kstep = (size_t)(BK * 2);
    const size_t hstepA = (size_t)HALF * g.lda * 2, hstepB = (size_t)HALF * g.ldb * 2;
    const unsigned ldsw = (unsigned)wid * 1024u;
    const int aoff = lds_byte(wr * 64 + fr, fq * 8), boff = lds_byte(wc * 32 + fr, fq * 8);
#define PG8_SA(b, h) (((b) * 2 + (h)) * HTB)
#define PG8_SB(b, h) ((4 + (b) * 2 + (h)) * HTB)
#define PG8_STAGE(bufoff, gbase, voff) do { _Pragma("unroll") for (int _i = 0; _i < 2; ++_i) \
        __builtin_amdgcn_global_load_lds((const unsigned*)((const char*)(gbase) + (voff)[_i]), (PG8_LAS unsigned*)(lds + (bufoff) + ldsw + _i * 8192), 16, 0, 0); } while (0)
#define PG8_LDA(dst, b, h) do { _Pragma("unroll") for (int m = 0; m < 4; ++m) _Pragma("unroll") for (int k = 0; k < 2; ++k) dst[m][k] = *(const PG8_LAS bf16x8*)(lds + PG8_SA(b, h) + aoff + m * 2048 + k * 1024); } while (0)
#define PG8_LDB(dst, b, h) do { _Pragma("unroll") for (int n = 0; n < 2; ++n) _Pragma("unroll") for (int k = 0; k < 2; ++k) dst[n][k] = *(const PG8_LAS bf16x8*)(lds + PG8_SB(b, h) + boff + n * 2048 + k * 1024); } while (0)
#define PG8_MMA(ai, bj, At, Bt) do { __builtin_amdgcn_s_setprio(1); _Pragma("unroll") for (int m = 0; m < 4; ++m) _Pragma("unroll") for (int n = 0; n < 2; ++n) _Pragma("unroll") for (int k = 0; k < 2; ++k) \
        acc[ai][bj][m][n] = __builtin_amdgcn_mfma_f32_16x16x32_bf16(Bt[n][k], At[m][k], acc[ai][bj][m][n], 0, 0, 0); __builtin_amdgcn_s_setprio(0); } while (0)
#define PG8_WAIT_V(n) asm volatile("s_waitcnt vmcnt(" #n ")" ::: "memory")
#define PG8_WAIT_L(n) asm volatile("s_waitcnt lgkmcnt(" #n ")" ::: "memory")
#define PG8_BAR __builtin_amdgcn_s_barrier()
#define PG8_SCHED __builtin_amdgcn_sched_barrier(0)
    Unit cur, nxt; int ui = 0;
    if (!S.next(0, cur)) return;
    f32x4 acc[2][2][4][2];
#pragma unroll
    for (int a = 0; a < 2; ++a)
#pragma unroll
        for (int b = 0; b < 2; ++b)
#pragma unroll
            for (int m = 0; m < 4; ++m)
#pragma unroll
                for (int n = 0; n < 2; ++n) acc[a][b][m][n] = (f32x4){0.f, 0.f, 0.f, 0.f};
    bf16x8 At[4][2], B0[2][2], B1[2][2];
    const char* cA = (const char*)g.A + (size_t)cur.pm * g.a_pm + (size_t)cur.pn * g.a_pn;
    const char* cB = (const char*)g.Bt + (size_t)cur.pn * g.b_pn + (cur.pm >= g.b_split ? g.b_hi : (size_t)0);
    PG8_STAGE(PG8_SB(0, 0), cB, voffB); PG8_STAGE(PG8_SB(0, 1), cB + hstepB, voffB); PG8_STAGE(PG8_SA(0, 0), cA, voffA); PG8_STAGE(PG8_SA(0, 1), cA + hstepA, voffA);
    if (wr == 1) PG8_BAR;
    PG8_WAIT_V(2); PG8_BAR;
    PG8_STAGE(PG8_SB(1, 0), cB + kstep, voffB); PG8_STAGE(PG8_SA(1, 0), cA + kstep, voffA); PG8_STAGE(PG8_SB(1, 1), cB + hstepB + kstep, voffB);
    PG8_WAIT_V(6); PG8_BAR;
    for (;;) {
        const bool has_next = S.next(ui + 1, nxt);
        const char* nA = has_next ? (const char*)g.A + (size_t)nxt.pm * g.a_pm + (size_t)nxt.pn * g.a_pn : cA;
        const char* nB = has_next ? (const char*)g.Bt + (size_t)nxt.pn * g.b_pn + (nxt.pm >= g.b_split ? g.b_hi : (size_t)0) : cB;
        E.prefetch(cur, ui, lds_epi, wid, lane);
        for (int t = 0; t < nt; t += 2) {
            const bool last = (t == nt - 2);
            const char* a1 = cA + (size_t)(t + 1) * kstep;
            const char* a2 = last ? nA : cA + (size_t)(t + 2) * kstep; const char* b2 = last ? nB : cB + (size_t)(t + 2) * kstep;
            const char* a3 = a2 + kstep; const char* b3 = b2 + kstep;
            PG8_LDB(B0, 0, 0); PG8_LDB(B1, 0, 1); PG8_SCHED; PG8_LDA(At, 0, 0); PG8_STAGE(PG8_SA(1, 1), a1 + hstepA, voffA);
            PG8_WAIT_V(8); PG8_WAIT_L(0); PG8_BAR; PG8_MMA(0, 0, At, B0); PG8_MMA(0, 1, At, B1); PG8_BAR; PG8_SCHED;
            PG8_LDA(At, 0, 1); PG8_STAGE(PG8_SB(0, 0), b2, voffB); PG8_STAGE(PG8_SB(0, 1), b2 + hstepB, voffB); PG8_STAGE(PG8_SA(0, 0), a2, voffA);
            PG8_WAIT_V(8); PG8_WAIT_L(0); PG8_BAR; PG8_MMA(1, 0, At, B0); PG8_MMA(1, 1, At, B1); PG8_BAR; PG8_SCHED;
            PG8_LDB(B0, 1, 0); PG8_LDB(B1, 1, 1); PG8_SCHED; PG8_LDA(At, 1, 0); PG8_STAGE(PG8_SA(0, 1), a2 + hstepA, voffA);
            PG8_WAIT_V(8); PG8_WAIT_L(0); PG8_BAR; PG8_MMA(0, 0, At, B0); PG8_MMA(0, 1, At, B1); PG8_BAR; PG8_SCHED;
            PG8_LDA(At, 1, 1); PG8_STAGE(PG8_SB(1, 0), b3, voffB); PG8_STAGE(PG8_SB(1, 1), b3 + hstepB, voffB); PG8_STAGE(PG8_SA(1, 0), a3, voffA);
            PG8_WAIT_V(8); PG8_WAIT_L(0); PG8_BAR; PG8_MMA(1, 0, At, B0); PG8_MMA(1, 1, At, B1); PG8_BAR; PG8_SCHED;
        }
        if (wr == 0) PG8_BAR;
        E(acc, cur, ui, wr, wc, fr, fq, lds_epi);
        if (!has_next) break;
#pragma unroll
        for (int a = 0; a < 2; ++a)
#pragma unroll
            for (int b = 0; b < 2; ++b)
#pragma unroll
                for (int m = 0; m < 4; ++m)
#pragma unroll
                    for (int n = 0; n < 2; ++n) acc[a][b][m][n] = (f32x4){0.f, 0.f, 0.f, 0.f};
        cur = nxt; cA = nA; cB = nB; ++ui;
        if (wr == 1) PG8_BAR;
    }
    PG8_WAIT_V(0);
    PG8_BAR;
#undef PG8_SA
#undef PG8_SB
#undef PG8_STAGE
#undef PG8_LDA
#undef PG8_LDB
#undef PG8_MMA
#undef PG8_WAIT_V
#undef PG8_WAIT_L
#undef PG8_BAR
#undef PG8_SCHED
}
}
namespace epi {
using namespace pg8;
constexpr float EPS = 1e-6f;
__device__ __forceinline__ float rstd_of(float ss) { return rsqrtf(ss * (1.0f / 1024.0f) + EPS); }
__device__ __forceinline__ float sigmoidf_(float x) { return __builtin_amdgcn_rcpf(1.0f + __expf(-x)); }
__device__ __forceinline__ float siluf_(float x) { return x * __builtin_amdgcn_rcpf(1.0f + __expf(-x)); }
__device__ __forceinline__ u32x4 pack8(const f32x4& a, const f32x4& b) { u32x4 w; w.x = cvt_pk_bf16(a[0], a[1]); w.y = cvt_pk_bf16(a[2], a[3]); w.z = cvt_pk_bf16(b[0], b[1]); w.w = cvt_pk_bf16(b[2], b[3]); return w; }

constexpr int EC_OFF = 16384, EC_STRIDE = 6144;
__device__ __forceinline__ void dma16(const void* g, PG8_LAS unsigned char* l) { __builtin_amdgcn_global_load_lds((const unsigned*)g, (PG8_LAS unsigned*)l, 16, 0, 0); }
__device__ __forceinline__ void dma_rss(const float* rss, int pm, int ui, PG8_LAS unsigned char* le, int wid, int lane) {
    if (wid == 0) dma16(rss + pm * BM + 4 * lane, le + EC_OFF + (ui & 1) * EC_STRIDE);
}
struct EpiGlaIn {
    bf16_t* Q; bf16_t* Kk; bf16_t* V; bf16_t* R; float* G; const float* rss; const float* b_alpha;
    __device__ __forceinline__ void prefetch(const Unit& u, int ui, PG8_LAS unsigned char* le, int wid, int lane) const { dma_rss(rss, u.pm, ui, le, wid, lane); }
    template <int CLS>
    __device__ __forceinline__ void tile(f32x4 (&acc)[2][2][4][2], bf16_t* dst, int pitch, float sc, int gcol0, int ui, int wr, int wc, int fr, int fq, int row0, PG8_LAS unsigned char* le) const {
        const int ct = wc * 32 + 8 * fq;
        f32x4 bb[2][2];
        if (CLS == 2) {
#pragma unroll
            for (int bj = 0; bj < 2; ++bj) { bb[bj][0] = *(const f32x4*)(b_alpha + gcol0 + bj * HALF + ct); bb[bj][1] = *(const f32x4*)(b_alpha + gcol0 + bj * HALF + ct + 4); }
        }
#pragma unroll
        for (int ai = 0; ai < 2; ++ai)
#pragma unroll
            for (int m = 0; m < 4; ++m) {
                const int row = row0 + ai * HALF + m * 16;
                const float rs = rstd_of(((const PG8_LAS float*)(le + EC_OFF + (ui & 1) * EC_STRIDE))[wr * 64 + fr + ai * HALF + m * 16]);
#pragma unroll
                for (int bj = 0; bj < 2; ++bj) {
                    f32x4 v0 = acc[ai][bj][m][0] * rs, v1 = acc[ai][bj][m][1] * rs;
                    const int c = bj * HALF + ct;
                    if (CLS == 0) { *(u32x4*)(dst + (size_t)row * pitch + c) = pack8(v0 * sc, v1 * sc); }
                    else if (CLS == 1) {
#pragma unroll
                        for (int j = 0; j < 4; ++j) { v0[j] = siluf_(v0[j]); v1[j] = siluf_(v1[j]); }
                        *(u32x4*)(dst + (size_t)row * pitch + c) = pack8(v0, v1); }
                    else {
                        f32x4 o0, o1;
#pragma unroll
                        for (int j = 0; j < 4; ++j) {
                            const float z0 = v0[j] + bb[bj][0][j], z1 = v1[j] + bb[bj][1][j];
                            o0[j] = (fminf(z0, 0.f) - __logf(1.0f + __expf(-fabsf(z0)))) * 0.0625f;
                            o1[j] = (fminf(z1, 0.f) - __logf(1.0f + __expf(-fabsf(z1)))) * 0.0625f; }
                        float* gp = G + (size_t)row * 512 + gcol0 + c;
                        *(f32x4*)(gp) = o0; *(f32x4*)(gp + 4) = o1; }
                }
            }
    }
    __device__ __forceinline__ void operator()(f32x4 (&acc)[2][2][4][2], const Unit& u, int ui, int wr, int wc, int fr, int fq, PG8_LAS unsigned char* le) const {
        asm volatile("" : "+v"(fr), "+v"(fq));
        const int pn = u.pn;
        const int row0 = u.pm * BM + wr * 64 + fr;
        if (pn < 8) {
            bf16_t* dst; int pitch; float sc = 1.0f;
            if (pn < 2) { dst = Q + pn * 256; pitch = 512; sc = 0.08838834764831845f; } else if (pn < 4) { dst = Kk + (pn - 2) * 256; pitch = 512; } else { dst = V + (pn - 4) * 256; pitch = 1024; }
            tile<0>(acc, dst, pitch, sc, 0, ui, wr, wc, fr, fq, row0, le);
        } else if (pn < 12) tile<1>(acc, R + (pn - 8) * 256, 1024, 1.0f, 0, ui, wr, wc, fr, fq, row0, le);
        else tile<2>(acc, nullptr, 0, 1.0f, (pn - 12) * 256, ui, wr, wc, fr, fq, row0, le);
    }
};

__device__ __forceinline__ void unpack8(const u32x4& w, f32x4& a, f32x4& b) {
    a[0] = __uint_as_float(w.x << 16); a[1] = __uint_as_float(w.x & 0xffff0000u); a[2] = __uint_as_float(w.y << 16); a[3] = __uint_as_float(w.y & 0xffff0000u);
    b[0] = __uint_as_float(w.z << 16); b[1] = __uint_as_float(w.z & 0xffff0000u); b[2] = __uint_as_float(w.w << 16); b[3] = __uint_as_float(w.w & 0xffff0000u);
}
struct EpiRes {
    float* xout; bf16_t* XB; float* rss;
    __device__ __forceinline__ void prefetch(const Unit&, int, PG8_LAS unsigned char*, int, int) const {}
    __device__ __forceinline__ void operator()(f32x4 (&acc)[2][2][4][2], const Unit& u, int ui, int wr, int wc, int fr, int fq, PG8_LAS unsigned char* le) const {
        asm volatile("" : "+v"(fr), "+v"(fq));
        const int row0 = u.pm * BM + wr * 64 + fr;
        const int col0 = u.pn * BM + wc * 32 + 8 * fq;
        u32x4 xb[2][4][2];
#pragma unroll
        for (int ai = 0; ai < 2; ++ai)
#pragma unroll
            for (int m = 0; m < 4; ++m)
#pragma unroll
                for (int bj = 0; bj < 2; ++bj) xb[ai][m][bj] = *(const u32x4*)(XB + (size_t)(row0 + ai * HALF + m * 16) * 1024 + col0 + bj * HALF);
#pragma unroll
        for (int ai = 0; ai < 2; ++ai)
#pragma unroll
            for (int m = 0; m < 4; ++m) {
                const int row = row0 + ai * HALF + m * 16;
                float ss = 0.f;
#pragma unroll
                for (int bj = 0; bj < 2; ++bj) {
                    const size_t off = (size_t)row * 1024 + col0 + bj * HALF;
                    f32x4 x0, x1; unpack8(xb[ai][m][bj], x0, x1);
                    const f32x4 v0 = x0 + acc[ai][bj][m][0], v1 = x1 + acc[ai][bj][m][1];
                    if (xout) { *(f32x4*)(xout + off) = v0; *(f32x4*)(xout + off + 4) = v1; }
                    *(u32x4*)(XB + off) = pack8(v0, v1);
                    ss += (v0[0] * v0[0] + v0[1] * v0[1]) + (v0[2] * v0[2] + v0[3] * v0[3]) + (v1[0] * v1[0] + v1[1] * v1[1]) + (v1[2] * v1[2] + v1[3] * v1[3]);
                }
                ss += swz_xor16(ss); { auto rr_ = __builtin_amdgcn_permlane32_swap(__float_as_uint(ss), __float_as_uint(ss), false, false); ss = __uint_as_float(rr_[0]) + __uint_as_float(rr_[1]); }
                if (fq == 0) atomicAdd(rss + row, ss);
            }
    }
};

__device__ __forceinline__ float dpp_ror1(float x) { return __builtin_bit_cast(float, __builtin_amdgcn_mov_dpp(__builtin_bit_cast(int, x), 0x121, 0xf, 0xf, true)); }
__device__ __forceinline__ float dpp_ror2(float x) { return __builtin_bit_cast(float, __builtin_amdgcn_mov_dpp(__builtin_bit_cast(int, x), 0x122, 0xf, 0xf, true)); }
constexpr int FF = 2816;
struct EpiFfnUp {
    bf16_t* ACT; float* HALO; const float* rss; const float* cw; const float* cb;
    __device__ __forceinline__ void prefetch(const Unit& u, int ui, PG8_LAS unsigned char* le, int wid, int lane) const {
        dma_rss(rss, u.pm, ui, le, wid, lane);
        if (wid >= 1 && wid <= 4) { const int k = wid - 1; const float* src = (k == 0 ? cb : cw + (k - 1) * 2 * FF) + u.pn * 128 + ((lane < 32) ? 4 * lane : FF + 4 * (lane - 32));
            dma16(src, le + EC_OFF + (ui & 1) * EC_STRIDE + 1024 + k * 1024); }
    }
    __device__ __forceinline__ void operator()(f32x4 (&acc)[2][2][4][2], const Unit& u, int ui, int wr, int wc, int fr, int fq, PG8_LAS unsigned char* le) const {
        asm volatile("" : "+v"(fr), "+v"(fq));
        const int row0 = u.pm * BM + wr * 64 + fr;
        const PG8_LAS float* EC = (const PG8_LAS float*)(le + EC_OFF + (ui & 1) * EC_STRIDE);
#pragma unroll
        for (int ai = 0; ai < 2; ++ai)
#pragma unroll
            for (int m = 0; m < 4; ++m) {
                const float rs = rstd_of(EC[wr * 64 + fr + ai * HALF + m * 16]);
#pragma unroll
                for (int bj = 0; bj < 2; ++bj) { acc[ai][bj][m][0] = acc[ai][bj][m][0] * rs; acc[ai][bj][m][1] = acc[ai][bj][m][1] * rs; }
            }
        PG8_LAS float* HL = (PG8_LAS float*)le + (ui & 1) * 2048;
        if (fr >= 14) {
#pragma unroll
            for (int ai = 0; ai < 2; ++ai)
#pragma unroll
                for (int bj = 0; bj < 2; ++bj)
#pragma unroll
                    for (int n = 0; n < 2; ++n)
                        *(PG8_LAS f32x4*)(HL + ((((wr * 4 + wc) * 2 + ai) * 2 + (fr - 14)) * 64) + bj * 32 + fq * 8 + n * 4) = acc[ai][bj][3][n];
        }
        {
            float* hb = HALO + ((size_t)(u.pm * 22 + u.pn) * 4) * 256 + wc * 32 + fq * 8;
            if (wr == 0 && fr < 2) {
#pragma unroll
                for (int bj = 0; bj < 2; ++bj)
#pragma unroll
                    for (int n = 0; n < 2; ++n) *(f32x4*)(hb + fr * 256 + bj * HALF + n * 4) = acc[0][bj][0][n];
            }
            if (wr == 1 && fr >= 14) {
#pragma unroll
                for (int bj = 0; bj < 2; ++bj)
#pragma unroll
                    for (int n = 0; n < 2; ++n) *(f32x4*)(hb + (fr - 12) * 256 + bj * HALF + n * 4) = acc[1][bj][3][n];
            }
        }
        asm volatile("s_waitcnt lgkmcnt(0)" ::: "memory"); __builtin_amdgcn_s_barrier(); asm volatile("" ::: "memory");
        const bool seq_start = (u.pm & 7) == 0;
        const int cc0 = wc * 32 + fq * 8;
        const bool is15 = (fr == 15), ge14 = (fr >= 14);
        const PG8_LAS float* WB = EC + 256 + cc0;
#pragma unroll
        for (int ai = 0; ai < 2; ++ai) {
            f32x4 pg[2], pv[2];
            if (ai == 0 && wr == 0) { pg[0] = pg[1] = pv[0] = pv[1] = (f32x4){0.f, 0.f, 0.f, 0.f}; }
            else {
                const int swr = (ai == 1 && wr == 1) ? 0 : (ai == 0 ? 0 : 1), sai = (ai == 1 && wr == 1) ? 1 : 0;
                const PG8_LAS float* hp = HL + (((swr * 4 + wc) * 2 + sai) * 2 + (is15 ? 1 : 0)) * 64 + fq * 8;
                pg[0] = *(const PG8_LAS f32x4*)(hp); pg[1] = *(const PG8_LAS f32x4*)(hp + 4); pv[0] = *(const PG8_LAS f32x4*)(hp + 32); pv[1] = *(const PG8_LAS f32x4*)(hp + 36);
            }
#pragma unroll
            for (int m = 0; m < 4; ++m) {
                const int row = row0 + ai * HALF + m * 16;
                u32x4 w;
#pragma unroll
                for (int n = 0; n < 2; ++n) {
                    const f32x4 bg = *(const PG8_LAS f32x4*)(WB + 4 * n), bv = *(const PG8_LAS f32x4*)(WB + 128 + 4 * n);
                    const f32x4 g0 = *(const PG8_LAS f32x4*)(WB + 256 + 4 * n), w0 = *(const PG8_LAS f32x4*)(WB + 256 + 128 + 4 * n);
                    const f32x4 g1 = *(const PG8_LAS f32x4*)(WB + 512 + 4 * n), w1 = *(const PG8_LAS f32x4*)(WB + 512 + 128 + 4 * n);
                    const f32x4 g2 = *(const PG8_LAS f32x4*)(WB + 768 + 4 * n), w2 = *(const PG8_LAS f32x4*)(WB + 768 + 128 + 4 * n);
                    const f32x4 xg = acc[ai][0][m][n], xv = acc[ai][1][m][n];
                    f32x4 g1s, g2s, v1s, v2s;
#pragma unroll
                    for (int j = 0; j < 4; ++j) {
                        g1s[j] = dpp_ror1(is15 ? pg[n][j] : xg[j]); g2s[j] = dpp_ror2(ge14 ? pg[n][j] : xg[j]);
                        v1s[j] = dpp_ror1(is15 ? pv[n][j] : xv[j]); v2s[j] = dpp_ror2(ge14 ? pv[n][j] : xv[j]);
                    }
                    const f32x4 og = bg + g0 * g2s + g1 * g1s + g2 * xg;
                    const f32x4 ov = bv + w0 * v2s + w1 * v1s + w2 * xv;
                    f32x4 e;
#pragma unroll
                    for (int j = 0; j < 4; ++j) e[j] = __builtin_amdgcn_rcpf(1.0f + __builtin_amdgcn_exp2f(og[j] * -1.4426950408889634f));
                    const f32x4 a = og * e * ov;
                    if (n == 0) { w.x = cvt_pk_bf16(a[0], a[1]); w.y = cvt_pk_bf16(a[2], a[3]); } else { w.z = cvt_pk_bf16(a[0], a[1]); w.w = cvt_pk_bf16(a[2], a[3]); }
                    pg[n] = xg; pv[n] = xv;
                }
                const bool skip = (ai == 0 && wr == 0 && m == 0 && fr < 2 && !seq_start);
                if (!skip) *(u32x4*)(ACT + (size_t)row * FF + u.pn * 128 + cc0) = w;
            }
        }
    }
};

struct EpiKvq {
    bf16_t* KV; bf16_t* Q; bf16_t* QR; float* GATES; const float* rss; const _Float16* rope;
    __device__ __forceinline__ void prefetch(const Unit& u, int ui, PG8_LAS unsigned char* le, int wid, int lane) const { dma_rss(rss, u.pm, ui, le, wid, lane); }
    template <bool ISQ>
    __device__ __forceinline__ void rope_tile(f32x4 (&acc)[2][2][4][2], int pn, int ui, int wr, int wc, int fr, int fq, int row0, PG8_LAS unsigned char* le) const {
        const float C2 = 0.125f * 1.4426950408889634f;
        u32x4 rc[8][2];
#pragma unroll
        for (int i = 0; i < 8; ++i) { const int row = row0 + (i >> 2) * HALF + (i & 3) * 16; const _Float16* rp = rope + ((size_t)(row & 2047) * 32 + 8 * fq) * 2;
            rc[i][0] = *(const u32x4*)rp; rc[i][1] = *(const u32x4*)(rp + 8); }
#pragma unroll
        for (int i = 0; i < 8; ++i) { const int ai = i >> 2, m = i & 3;
            const int row = row0 + ai * HALF + m * 16;
            const int b = row >> 11, s = row & 2047;
            const float rs = rstd_of(((const PG8_LAS float*)(le + EC_OFF + (ui & 1) * EC_STRIDE))[wr * 64 + fr + ai * HALF + m * 16]);
            const f32x4 lo0 = acc[ai][0][m][0] * rs, lo1 = acc[ai][0][m][1] * rs;
            const f32x4 hi0 = acc[ai][1][m][0] * rs, hi1 = acc[ai][1][m][1] * rs;
            typedef _Float16 h2_t __attribute__((ext_vector_type(2)));
            float cs[8], sn[8];
#pragma unroll
            for (int j = 0; j < 4; ++j) { const unsigned wa_ = rc[i][0][j], wc_ = rc[i][1][j];
                const h2_t a = __builtin_bit_cast(h2_t, wa_), c = __builtin_bit_cast(h2_t, wc_);
                cs[j] = (float)a[0]; sn[j] = (float)a[1]; cs[4 + j] = (float)c[0]; sn[4 + j] = (float)c[1]; }
            f32x4 rl0, rl1, rh0, rh1;
#pragma unroll
            for (int j = 0; j < 4; ++j) {
                rl0[j] = lo0[j] * cs[j] - hi0[j] * sn[j]; rh0[j] = lo0[j] * sn[j] + hi0[j] * cs[j];
                rl1[j] = lo1[j] * cs[4 + j] - hi1[j] * sn[4 + j]; rh1[j] = lo1[j] * sn[4 + j] + hi1[j] * cs[4 + j];
            }
            if (!ISQ) {
                bf16_t* p = KV + ((((size_t)pn * 16 + b) * 4 + wc) * 2048 + s) * 64 + 8 * fq;
                *(u32x4*)(p) = pack8(rl0, rl1); *(u32x4*)(p + 32) = pack8(rh0, rh1);
            } else {
                const int h = (pn - 6) * 4 + wc;
                const size_t o = (((size_t)b * 16 + h) * 2048 + s) * 64 + 8 * fq;
                *(u32x4*)(Q + o) = pack8(lo0 * C2, lo1 * C2); *(u32x4*)(Q + o + 32) = pack8(hi0 * C2, hi1 * C2);
                *(u32x4*)(QR + o) = pack8(rl0 * C2, rl1 * C2); *(u32x4*)(QR + o + 32) = pack8(rh0 * C2, rh1 * C2);
            }
        }
    }
    __device__ __forceinline__ void operator()(f32x4 (&acc)[2][2][4][2], const Unit& u, int ui, int wr, int wc, int fr, int fq, PG8_LAS unsigned char* le) const {
        asm volatile("" : "+v"(fr), "+v"(fq));
        const int pn = u.pn;
        const int row0 = u.pm * BM + wr * 64 + fr;
        if (pn >= 6 && pn < 10) { rope_tile<true>(acc, pn, ui, wr, wc, fr, fq, row0, le); return; }
        if (pn == 2 || pn == 4) { rope_tile<false>(acc, pn, ui, wr, wc, fr, fq, row0, le); return; }
#pragma unroll
        for (int ai = 0; ai < 2; ++ai)
#pragma unroll
            for (int m = 0; m < 4; ++m) {
                const int row = row0 + ai * HALF + m * 16;
                const int b = row >> 11, s = row & 2047;
                const float rs = rstd_of(((const PG8_LAS float*)(le + EC_OFF + (ui & 1) * EC_STRIDE))[wr * 64 + fr + ai * HALF + m * 16]);
                f32x4 lo0 = acc[ai][0][m][0] * rs, lo1 = acc[ai][0][m][1] * rs;
                f32x4 hi0 = acc[ai][1][m][0] * rs, hi1 = acc[ai][1][m][1] * rs;
                if (pn == 10) {
                    if (wc == 0) {
                        float* gp = GATES + (size_t)row * 48 + 8 * fq;
#pragma unroll
                        for (int j = 0; j < 4; ++j) { lo0[j] = sigmoidf_(lo0[j]); lo1[j] = sigmoidf_(lo1[j]); hi0[j] = sigmoidf_(hi0[j]); hi1[j] = sigmoidf_(hi1[j]); }
                        *(f32x4*)(gp) = lo0; *(f32x4*)(gp + 4) = lo1;
                        if (fq < 2) { *(f32x4*)(gp + 32) = hi0; *(f32x4*)(gp + 36) = hi1; }
                    }
                    continue;
                }
                bf16_t* p = KV + ((((size_t)pn * 16 + b) * 4 + wc) * 2048 + s) * 64 + 8 * fq;
                *(u32x4*)(p) = pack8(lo0, lo1); *(u32x4*)(p + 32) = pack8(hi0, hi1);
            }
    }
};

struct EpiCmp {
    float* HP;
    __device__ __forceinline__ void prefetch(const Unit&, int, PG8_LAS unsigned char*, int, int) const {}
    __device__ __forceinline__ void operator()(f32x4 (&acc)[2][2][4][2], const Unit& u, int ui, int wr, int wc, int fr, int fq, PG8_LAS unsigned char* le) const {
        asm volatile("" : "+v"(fr), "+v"(fq));
        const int row0 = u.pm * BM + wr * 64 + fr;
        float* base = HP + (size_t)u.pn * 16384 * 256;
#pragma unroll
        for (int ai = 0; ai < 2; ++ai)
#pragma unroll
            for (int m = 0; m < 4; ++m) {
                float* rp = base + (size_t)(row0 + ai * HALF + m * 16) * 256 + wc * 32 + 8 * fq;
#pragma unroll
                for (int bj = 0; bj < 2; ++bj) { *(f32x4*)(rp + bj * HALF) = acc[ai][bj][m][0]; *(f32x4*)(rp + bj * HALF + 4) = acc[ai][bj][m][1]; }
            }
    }
};

struct EpiResFinal {
    const bf16_t* XB; float* xout; const float* gfin; unsigned* slots; unsigned* cnt;
    __device__ __forceinline__ void prefetch(const Unit&, int, PG8_LAS unsigned char*, int, int) const {}
    __device__ __forceinline__ void operator()(f32x4 (&acc)[2][2][4][2], const Unit& u, int ui, int wr, int wc, int fr, int fq, PG8_LAS unsigned char* le) const {
        asm volatile("" : "+v"(fr), "+v"(fq));
        const int row0 = u.pm * BM + wr * 64 + fr;
        const int col0 = u.pn * BM + wc * 32 + 8 * fq;
        PG8_LAS float* Pt = (PG8_LAS float*)(le + EC_OFF);
        PG8_LAS float* St = (PG8_LAS float*)(le + EC_OFF + 4096);
#pragma unroll
        for (int ai = 0; ai < 2; ++ai)
#pragma unroll
            for (int m = 0; m < 4; ++m) {
                const int row = row0 + ai * HALF + m * 16;
                float ss = 0.f;
#pragma unroll
                for (int bj = 0; bj < 2; ++bj) {
                    const size_t off = (size_t)row * 1024 + col0 + bj * HALF;
                    f32x4 x0, x1; unpack8(*(const u32x4*)(XB + off), x0, x1);
                    const f32x4 v0 = x0 + acc[ai][bj][m][0], v1 = x1 + acc[ai][bj][m][1];
                    acc[ai][bj][m][0] = v0; acc[ai][bj][m][1] = v1;
                    ss += (v0[0] * v0[0] + v0[1] * v0[1]) + (v0[2] * v0[2] + v0[3] * v0[3]) + (v1[0] * v1[0] + v1[1] * v1[1]) + (v1[2] * v1[2] + v1[3] * v1[3]);
                }
                ss += swz_xor16(ss); { auto rr_ = __builtin_amdgcn_permlane32_swap(__float_as_uint(ss), __float_as_uint(ss), false, false); ss = __uint_as_float(rr_[0]) + __uint_as_float(rr_[1]); }
                if (fq == 0) Pt[(ai * HALF + wr * 64 + m * 16 + fr) * 4 + wc] = ss;
            }
        asm volatile("s_waitcnt lgkmcnt(0)" ::: "memory"); __builtin_amdgcn_s_barrier(); asm volatile("" ::: "memory");
        const int wid = wr * 4 + wc, lane = fq * 16 + fr;
        const int prow = wid * 32 + (lane & 31);
        if (lane < 32) {
            const f32x4 p4 = *(const PG8_LAS f32x4*)(Pt + prow * 4);
            const float t = (p4[0] + p4[1]) + (p4[2] + p4[3]);
            __hip_atomic_store(slots + ((size_t)(u.pm * BM + prow) * 4 + u.pn), __float_as_uint(t), __ATOMIC_RELAXED, __HIP_MEMORY_SCOPE_AGENT);
        }
        asm volatile("s_waitcnt vmcnt(0)" ::: "memory");
        if (lane == 0) __hip_atomic_fetch_add(cnt + 64 * u.pm, 1u, __ATOMIC_RELAXED, __HIP_MEMORY_SCOPE_AGENT);
        if (wid == 0) {
            unsigned sp = 0;
            while ((unsigned)__builtin_amdgcn_readfirstlane((int)__hip_atomic_load(cnt + 64 * u.pm, __ATOMIC_RELAXED, __HIP_MEMORY_SCOPE_AGENT)) < 32u) { __builtin_amdgcn_s_sleep(2); if (++sp > (1u << 20)) break; }
            __builtin_amdgcn_fence(__ATOMIC_ACQUIRE, "agent");
        }
        asm volatile("s_waitcnt vmcnt(0) lgkmcnt(0)" ::: "memory"); __builtin_amdgcn_s_barrier(); asm volatile("" ::: "memory");
        if (lane < 32) {
            const unsigned* sl = slots + (size_t)(u.pm * BM + prow) * 4; float t = 0.f;
#pragma unroll
            for (int k = 0; k < 4; ++k) t += __uint_as_float(__hip_atomic_load(sl + k, __ATOMIC_RELAXED, __HIP_MEMORY_SCOPE_AGENT));
            St[prow] = rsqrtf(t * (1.0f / 1024.0f) + EPS);
        }
        asm volatile("s_waitcnt vmcnt(0) lgkmcnt(0)" ::: "memory"); __builtin_amdgcn_s_barrier(); asm volatile("" ::: "memory");
#pragma unroll
        for (int bj = 0; bj < 2; ++bj) {
            const f32x4 g0 = *(const f32x4*)(gfin + col0 + bj * HALF), g1 = *(const f32x4*)(gfin + col0 + bj * HALF + 4);
#pragma unroll
            for (int ai = 0; ai < 2; ++ai)
#pragma unroll
                for (int m = 0; m < 4; ++m) {
                    const float rs = St[ai * HALF + wr * 64 + m * 16 + fr];
                    const size_t off = (size_t)(row0 + ai * HALF + m * 16) * 1024 + col0 + bj * HALF;
                    *(f32x4*)(xout + off) = acc[ai][bj][m][0] * rs * g0; *(f32x4*)(xout + off + 4) = acc[ai][bj][m][1] * rs * g1;
                }
        }
        asm volatile("s_waitcnt lgkmcnt(0)" ::: "memory"); __builtin_amdgcn_s_barrier(); asm volatile("" ::: "memory");
    }
};

struct EpiNull {
    __device__ __forceinline__ void prefetch(const Unit&, int, PG8_LAS unsigned char*, int, int) const {}
    __device__ __forceinline__ void operator()(f32x4 (&acc)[2][2][4][2], const Unit& u, int ui, int wr, int wc, int fr, int fq, PG8_LAS unsigned char* le) const {
#pragma unroll
        for (int ai = 0; ai < 2; ++ai)
#pragma unroll
            for (int bj = 0; bj < 2; ++bj)
#pragma unroll
                for (int m = 0; m < 4; ++m) { asm volatile("" :: "v"(acc[ai][bj][m][0]), "v"(acc[ai][bj][m][1])); }
    }
};
}
namespace pro {
typedef unsigned short bf16_t;
typedef unsigned v4u __attribute__((ext_vector_type(4)));
typedef float f32x4 __attribute__((ext_vector_type(4)));
#define LAS3 __attribute__((address_space(3)))
__device__ __forceinline__ unsigned f2bf(float f) { unsigned u = __builtin_bit_cast(unsigned, f); return (u + 0x7fffu + ((u >> 16) & 1u)) >> 16; }
__device__ __forceinline__ unsigned pk2(float lo, float hi) { return f2bf(lo) | (f2bf(hi) << 16); }

struct In {
    const float *x, *norm_mix, *norm_ffn, *gla_w_in, *gla_w_alpha_up, *gla_b_alpha, *gla_norm, *gla_w_o, *kv_norm, *nsa_w_kv, *cmp_pe_k, *cmp_pe_v,
        *cmp_k_w1, *cmp_k_w2, *cmp_v_w1, *cmp_v_w2, *nsa_w_in, *nsa_w_o, *ffn_w_up, *ffn_conv_w, *ffn_conv_b, *ffn_w_down, *norm_final;
};
struct Wts { bf16_t *WGI, *WGO, *WKQ, *WC1, *WC2, *WNO, *WUP, *WDN; _Float16* ROPE; float* BIASC; };

__device__ __forceinline__ void transpose_item(const float* W, int ldw, int scol0, int nvalid, const float* gain, bf16_t* WT, int K, int drow0, int k0, LAS3 float* scr, int lane) {
    const int kr = lane >> 3, nc = (lane & 7) * 4;
    f32x4 v[8];
#pragma unroll
    for (int i = 0; i < 8; ++i) { const int kk = 8 * i + kr;
        v[i] = (nc < nvalid) ? *(const f32x4*)(W + (size_t)(k0 + kk) * ldw + scol0 + nc) : (f32x4){0.f, 0.f, 0.f, 0.f};
        if (gain) v[i] = v[i] * gain[k0 + kk]; }
#pragma unroll
    for (int i = 0; i < 8; ++i) { const int kk = 8 * i + kr; LAS3 float* d = scr + kk * 33 + nc; d[0] = v[i].x; d[1] = v[i].y; d[2] = v[i].z; d[3] = v[i].w; }
    asm volatile("s_waitcnt lgkmcnt(0)" ::: "memory");
    const int c = lane & 7;
#pragma unroll
    for (int j = 0; j < 4; ++j) { const int nn = (lane >> 3) + 8 * j; const LAS3 float* s = scr + (8 * c) * 33 + nn;
        v4u o; o.x = pk2(s[0 * 33], s[1 * 33]); o.y = pk2(s[2 * 33], s[3 * 33]); o.z = pk2(s[4 * 33], s[5 * 33]); o.w = pk2(s[6 * 33], s[7 * 33]);
        *(v4u*)(WT + (size_t)(drow0 + nn) * K + k0 + 8 * c) = o; }
    asm volatile("s_waitcnt lgkmcnt(0)" ::: "memory");
}
__device__ __forceinline__ void weff_item(const In& I, bf16_t* WT, int nb, int k0, LAS3 float* scr, int lane) {
    const int n = lane & 31, ng = 32 * nb + n;
    float wa[16];
#pragma unroll
    for (int r = 0; r < 16; ++r) wa[r] = I.gla_w_alpha_up[r * 512 + ng];
#pragma unroll 2
    for (int i = 0; i < 32; ++i) { const int kk = 2 * i + (lane >> 5); const float* wr = I.gla_w_in + (size_t)(k0 + kk) * 3088 + 3072;
        float v = 0.f;
#pragma unroll
        for (int r = 0; r < 16; ++r) v += wr[r] * wa[r];
        scr[kk * 33 + n] = v * I.norm_mix[k0 + kk]; }
    asm volatile("s_waitcnt lgkmcnt(0)" ::: "memory");
    const int c = lane & 7;
#pragma unroll
    for (int j = 0; j < 4; ++j) { const int nn = (lane >> 3) + 8 * j; const LAS3 float* s = scr + (8 * c) * 33 + nn;
        v4u o; o.x = pk2(s[0 * 33], s[1 * 33]); o.y = pk2(s[2 * 33], s[3 * 33]); o.z = pk2(s[4 * 33], s[5 * 33]); o.w = pk2(s[6 * 33], s[7 * 33]);
        *(v4u*)(WT + (size_t)(3072 + 32 * nb + nn) * 1024 + k0 + 8 * c) = o; }
    asm volatile("s_waitcnt lgkmcnt(0)" ::: "memory");
}

__device__ __forceinline__ void prologue(const In& I, const Wts& W, bf16_t* XB, float* RSS0, LAS3 unsigned char* lds, int gw, int NGW, int lane, int wave) {
    LAS3 float* scr = (LAS3 float*)(lds + wave * 16384);
    constexpr int I0 = 16 * 96, I1 = 16 * 16, I2 = 16 * 32, I3 = 16 * 88, I4 = 32 * 8, I6 = 4 * 2, I8 = 16 * 32, I9 = 16 * 176, I11 = 44 * 32;
    constexpr int NIT = I0 + I1 + I2 + I3 + 2 * I4 + 2 * I6 + I8 + 2 * I9 + 2 * I11;
    for (int it = gw; it < NIT; it += NGW) {
        int r = it;
        if (r < I0) { const int kb = r / 96, nb = r % 96; transpose_item(I.gla_w_in, 3088, 32 * nb, 32, I.norm_mix, W.WGI, 1024, 32 * nb, 64 * kb, scr, lane); continue; } r -= I0;
        if (r < I1) { const int kb = r / 16, nb = r % 16; weff_item(I, W.WGI, nb, 64 * kb, scr, lane); continue; } r -= I1;
        if (r < I2) { const int kb = r / 32, nb = r % 32; transpose_item(I.gla_w_o, 1024, 32 * nb, 32, I.gla_norm, W.WGO, 1024, 32 * nb, 64 * kb, scr, lane);   continue; } r -= I2;
        if (r < I3) { const int kb = r / 88, nb = r % 88; const int tile = nb >> 3, gi = nb & 7, L0 = (gi & 3) * 64 + (gi >> 2) * 32;
            if (tile < 6) transpose_item(I.nsa_w_kv, 1536, tile * 256 + L0, 32, I.kv_norm, W.WKQ, 1024, 32 * nb, 64 * kb, scr, lane);
            else if (tile < 10) transpose_item(I.nsa_w_in, 1072, (tile - 6) * 256 + L0, 32, I.norm_mix + 1024, W.WKQ, 1024, 32 * nb, 64 * kb, scr, lane);
            else { int nv = 48 - L0; nv = nv < 0 ? 0 : (nv > 32 ? 32 : nv); transpose_item(I.nsa_w_in, 1072, 1024 + (nv > 0 ? L0 : 0), nv, I.norm_mix + 1024, W.WKQ, 1024, 32 * nb, 64 * kb, scr, lane); }
            continue; } r -= I3;
        if (r < 2 * I4) { const int w = r / I4; r %= I4; const int kb = r / 8, nb = r % 8;
            transpose_item(w ? I.cmp_v_w1 : I.cmp_k_w1, 256, 32 * nb, 32, nullptr, W.WC1 + (size_t)w * 256 * 2048, 2048, 32 * nb, 64 * kb, scr, lane); continue; } r -= 2 * I4;
        if (r < 2 * I6) { const int w = r / I6; r %= I6; const int kb = r / 2, nb = r % 2;
            transpose_item(w ? I.cmp_v_w2 : I.cmp_k_w2, 64, 32 * nb, 32, nullptr, W.WC2 + (size_t)w * 64 * 256, 256, 32 * nb, 64 * kb, scr, lane); continue; } r -= 2 * I6;
        if (r < I8) { const int kb = r / 32, nb = r % 32; transpose_item(I.nsa_w_o, 1024, 32 * nb, 32, nullptr, W.WNO, 1024, 32 * nb, 64 * kb, scr, lane); continue; } r -= I8;
        if (r < 2 * I9) { const int l = r / I9; r %= I9; const int kb = r / 176, nb = r % 176; const int tile = nb >> 3, gi = nb & 7;
            const int sc = (gi < 4) ? (128 * tile + 32 * gi) : (2816 + 128 * tile + 32 * (gi - 4));
            transpose_item(I.ffn_w_up + (size_t)l * 1024 * 5632, 5632, sc, 32, I.norm_ffn + l * 1024, W.WUP + (size_t)l * 5632 * 1024, 1024, 32 * nb, 64 * kb, scr, lane); continue; } r -= 2 * I9;
        { const int l = r / I11; r %= I11; const int kb = r / 32, nb = r % 32;
            transpose_item(I.ffn_w_down + (size_t)l * 2816 * 1024, 1024, 32 * nb, 32, nullptr, W.WDN + (size_t)l * 1024 * 2816, 2816, 32 * nb, 64 * kb, scr, lane); }
    }
    for (int i = gw * 64 + lane; i < 2048 * 32; i += NGW * 64) {
        const int pos = i >> 5, d = i & 31;
        const float inv = powf(10000.0f, -(float)d / 32.0f);
        const float ang = (float)pos * inv;
        float sn, cs; sincosf(ang, &sn, &cs);
        typedef _Float16 h2_t __attribute__((ext_vector_type(2))); h2_t cs2; cs2[0] = (_Float16)cs; cs2[1] = (_Float16)sn; *(h2_t*)(W.ROPE + 2 * i) = cs2;
    }
    for (int it = gw; it < 2048; it += NGW) {
        const int w = it >> 10, ng = (it >> 8) & 3, kc = it & 255; const float* pe = (w ? I.cmp_pe_v : I.cmp_pe_k) + 8 * kc; const float* w1 = (w ? I.cmp_v_w1 : I.cmp_k_w1) + (size_t)(8 * kc) * 256 + 64 * ng + lane;
        float s = 0.f;
#pragma unroll
        for (int k = 0; k < 8; ++k) s += pe[k] * w1[(size_t)k * 256];
        atomicAdd(W.BIASC + w * 256 + 64 * ng + lane, s);
    }
    for (int m = gw; m < 32768; m += NGW) {
        const f32x4* xr = (const f32x4*)(I.x + (size_t)m * 1024) + lane;
        f32x4 v[4]; float s = 0.f;
#pragma unroll
        for (int j = 0; j < 4; ++j) { v[j] = xr[64 * j]; s += (v[j].x * v[j].x + v[j].y * v[j].y) + (v[j].z * v[j].z + v[j].w * v[j].w); }
#pragma unroll
        for (int off = 1; off < 64; off <<= 1) s += __shfl_xor(s, off);
        if (lane == 0) RSS0[m] = s;
        unsigned long long* o8 = (unsigned long long*)(XB + (size_t)m * 1024) + lane;
#pragma unroll
        for (int j = 0; j < 4; ++j) o8[64 * j] = (unsigned long long)pk2(v[j].x, v[j].y) | ((unsigned long long)pk2(v[j].z, v[j].w) << 32);
    }
}
}
namespace gla {
typedef unsigned short bf16_t;
typedef short bf16x8 __attribute__((ext_vector_type(8)));
typedef short s16x4 __attribute__((ext_vector_type(4)));
typedef float f32x16 __attribute__((ext_vector_type(16)));
typedef float f32x4 __attribute__((ext_vector_type(4)));
typedef unsigned u32x4 __attribute__((ext_vector_type(4)));
typedef unsigned u32x2 __attribute__((ext_vector_type(2)));
#define GLAS __attribute__((address_space(3)))
__device__ __forceinline__ int crow(int r, int hi) { return (r & 3) + 8 * (r >> 2) + 4 * hi; }
__device__ __forceinline__ float bf2f(bf16_t v) { return __builtin_bit_cast(float, (unsigned)v << 16); }
__device__ __forceinline__ unsigned cvtpk(float lo, float hi) { typedef float f2 __attribute__((ext_vector_type(2))); typedef __bf16 b2 __attribute__((ext_vector_type(2))); f2 v = {lo, hi}; b2 b = __builtin_convertvector(v, b2); return __builtin_bit_cast(unsigned, b); }
__device__ __forceinline__ bf16_t f2bf1(float f) { return (bf16_t)(cvtpk(f, 0.f) & 0xffffu); }
__device__ __forceinline__ s16x4 vtr(const GLAS unsigned char* p) { typedef short v4i16_t __attribute__((ext_vector_type(4))); return __builtin_bit_cast(s16x4, __builtin_amdgcn_ds_read_tr16_b64_v4i16((GLAS v4i16_t*)p)); }
__device__ __forceinline__ bf16x8 ld2x64(const GLAS unsigned char* p0, const GLAS unsigned char* p1) {
    const s16x4 a = *(const GLAS s16x4*)p0, b = *(const GLAS s16x4*)p1; return (bf16x8){a[0], a[1], a[2], a[3], b[0], b[1], b[2], b[3]};
}
constexpr int QEP = 264, KDP = 136, VP = 576, OLP = 260;
constexpr int L_QE = 0, L_KE = 16896, L_KDT = 33792, L_ATT = 51200, L_V = 59904, L_BL = 96768, L_QT = 97280, L_END = 99328;

template <bool STATE_ONLY>
__device__ __forceinline__ void gla_unit(int b, int h, int seg, const bf16_t* Qg, const bf16_t* Kg, const bf16_t* VO, bf16_t* Oout, const bf16_t* Rg, const float* Gg, const float* gnorm, float* SLOC, float* DSEG, GLAS unsigned char* lds, int tid0) {
    int tid_ = tid0; asm volatile("" : "+v"(tid_));
    const int tid = tid_, lane = tid & 63, w = __builtin_amdgcn_readfirstlane(tid >> 6), r32 = lane & 31, hi = lane >> 5;
    f32x16 S[4];
#pragma unroll
    for (int i = 0; i < 4; ++i)
#pragma unroll
        for (int r = 0; r < 16; ++r) S[i][r] = 0.f;
    const int kcol = tid & 127, qd = tid >> 7;
    const int bh = b * 4 + h;
    if (!STATE_ONLY && seg >= 1) {
#pragma unroll 1
        for (int s = 0; s < seg; ++s) {
            const float* sl = SLOC + ((size_t)(bh * 3 + s) * 128) * 256 + 32 * w + r32; const float* dd = DSEG + (bh * 3 + s) * 128;
#pragma unroll
            for (int i = 0; i < 4; ++i)
#pragma unroll
                for (int r = 0; r < 16; ++r) { const int k = 32 * i + crow(r, hi); const float d = (s == 0) ? 0.f : dd[k]; S[i][r] = S[i][r] * d + sl[(size_t)k * 256]; }
        }
    }
    float dlog = 0.f;
#ifdef DBG_GPROF
    unsigned long long gacc_[12] = {0,0,0,0,0,0,0,0,0,0,0,0}; unsigned long long gprev_ = clock64();
#define GSTAMP(k) do { if (!STATE_ONLY) { asm volatile("s_waitcnt lgkmcnt(0)" ::: "memory"); const unsigned long long t_ = clock64(); gacc_[k] += t_ - gprev_; gprev_ = t_; } } while (0)
#else
#define GSTAMP(k) do {} while (0)
#endif
    GLAS float* BL = (GLAS float*)(lds + L_BL); GLAS float* QT = (GLAS float*)(lds + L_QT);
    GLAS float* OL = (GLAS float*)lds;
    float gq[16]; u32x4 vr[4]; bf16_t qr[16], kr[16];
#define GLA_FETCH_GV(cc) do { const size_t r0_ = (size_t)b * 2048 + (cc) * 64; int t2_ = tid; asm volatile("" : "+v"(t2_));   \
        const float* gp_ = Gg + (r0_ + 16 * (t2_ >> 7)) * 512 + h * 128 + (t2_ & 127); \
        _Pragma("unroll") for (int i = 0; i < 16; ++i) { gq[i] = gp_[(size_t)i * 512]; } \
        const bf16_t* vp_ = VO + (r0_ + (t2_ >> 5)) * 1024 + h * 256 + (t2_ & 31) * 8; \
        _Pragma("unroll") for (int i = 0; i < 4; ++i) { vr[i] = *(const u32x4*)(vp_ + (size_t)i * 16 * 1024); } } while (0)
#define GLA_FETCH_QK(cc) do { const size_t r0_ = (size_t)b * 2048 + (cc) * 64; int t2_ = tid; asm volatile("" : "+v"(t2_)); \
        const size_t e0_ = (r0_ + 16 * (t2_ >> 7)) * 512 + h * 128 + (t2_ & 127); const bf16_t* qp_ = Qg + e0_; const bf16_t* kp_ = Kg + e0_; \
        _Pragma("unroll") for (int i = 0; i < 16; ++i) { kr[i] = kp_[(size_t)i * 512]; if (!STATE_ONLY) qr[i] = qp_[(size_t)i * 512]; } } while (0)
    GLA_FETCH_GV(seg * 8); GLA_FETCH_QK(seg * 8);
    for (int c = seg * 8; c < seg * 8 + 8; ++c) {
        const size_t row0 = (size_t)b * 2048 + c * 64;
        u32x4 rpre[4];
        if (!STATE_ONLY) { const size_t go_ = (row0 + (tid >> 3)) * 1024 + h * 256 + 32 * (tid & 7);
#pragma unroll
            for (int j = 0; j < 4; ++j) rpre[j] = *(const u32x4*)(Rg + go_ + 8 * j); }
        {
            float cs[16]; float run = 0.f;
#pragma unroll
            for (int i = 0; i < 16; ++i) { run += gq[i]; cs[i] = run; }
            QT[qd * 128 + kcol] = run;
#pragma unroll
            for (int i = 0; i < 4; ++i) { const int p = tid + 512 * i, rr = p >> 5, ch = p & 31;
                *(GLAS u32x4*)(lds + L_V + rr * VP + ch * 16) = vr[i]; }
            float qv[16], kv[16];
#pragma unroll
            for (int i = 0; i < 16; ++i) { qv[i] = STATE_ONLY ? 0.f : bf2f(qr[i]); kv[i] = bf2f(kr[i]); }
            { const int cn_ = (c + 1 < seg * 8 + 8) ? c + 1 : c; GLA_FETCH_GV(cn_); }
        GSTAMP(0);
            __syncthreads();
        GSTAMP(1);
            float pre = 0.f, tot = 0.f;
#pragma unroll
            for (int q = 0; q < 4; ++q) { const float t = QT[q * 128 + kcol]; tot += t; if (q < qd) pre += t; }
            if (qd == 0) BL[kcol] = __expf(tot);
            dlog += tot;
            float kd[16];
#pragma unroll
            for (int i = 0; i < 16; ++i) { const float bb = pre + cs[i]; const int t = 16 * qd + i;
                if (!STATE_ONLY) { *(GLAS bf16_t*)(lds + L_QE + t * QEP + kcol * 2) = f2bf1(qv[i] * __expf(bb));
                                   *(GLAS bf16_t*)(lds + L_KE + t * QEP + kcol * 2) = f2bf1(kv[i] * __expf(-bb)); }
                kd[i] = kv[i] * __expf(tot - bb); }
#pragma unroll
            for (int i = 0; i < 4; ++i) { u32x2 v; v.x = cvtpk(kd[4 * i], kd[4 * i + 1]); v.y = cvtpk(kd[4 * i + 2], kd[4 * i + 3]);
                *(GLAS u32x2*)(lds + L_KDT + kcol * KDP + (16 * qd + 4 * i) * 2) = v; }
        }
        GSTAMP(2);
        __syncthreads();
        { const int cn_ = (c + 1 < seg * 8 + 8) ? c + 1 : c; GLA_FETCH_QK(cn_); }
        GSTAMP(3);
        f32x16 o[2];
#pragma unroll
        for (int r = 0; r < 16; ++r) { o[0][r] = 0.f; o[1][r] = 0.f; }
        if (!STATE_ONLY) {
        if (w < 3) {
            const int ti = (w >= 1) ? 1 : 0, si = (w == 2) ? 1 : 0;
            f32x16 a;
#pragma unroll
            for (int r = 0; r < 16; ++r) a[r] = 0.f;
            const GLAS unsigned char* ap = lds + L_QE + (32 * ti + r32) * QEP + 16 * hi; const GLAS unsigned char* bp = lds + L_KE + (32 * si + r32) * QEP + 16 * hi;
#pragma unroll
            for (int s = 0; s < 8; ++s) { const bf16x8 A = ld2x64(ap + 32 * s, ap + 32 * s + 8), B = ld2x64(bp + 32 * s, bp + 32 * s + 8);
                a = __builtin_amdgcn_mfma_f32_32x32x16_bf16(A, B, a, 0, 0, 0); }
            int l3_ = lane; asm volatile("" : "+v"(l3_));
            const int r32b = l3_ & 31, hib = l3_ >> 5, sg = 32 * si + r32b;
#pragma unroll
            for (int r = 0; r < 16; ++r) { const int tg = 32 * ti + crow(r, hib); const float v = (sg <= tg) ? a[r] : 0.f;
                *(GLAS bf16_t*)(lds + L_ATT + tg * KDP + sg * 2) = f2bf1(v); }
        } else if (w == 3) {
#pragma unroll
            for (int r = 0; r < 16; ++r) *(GLAS bf16_t*)(lds + L_ATT + crow(r, hi) * KDP + (32 + r32) * 2) = 0;
        }
        {
#pragma unroll
            for (int i = 0; i < 4; ++i)
#pragma unroll
                for (int s = 0; s < 2; ++s) {
                    u32x4 pk; pk.x = cvtpk(S[i][8 * s], S[i][8 * s + 1]); pk.y = cvtpk(S[i][8 * s + 2], S[i][8 * s + 3]); pk.z = cvtpk(S[i][8 * s + 4], S[i][8 * s + 5]); pk.w = cvtpk(S[i][8 * s + 6], S[i][8 * s + 7]);
                    const bf16x8 Bf = __builtin_bit_cast(bf16x8, pk);
#pragma unroll
                    for (int ti = 0; ti < 2; ++ti) { const GLAS unsigned char* ap = lds + L_QE + (32 * ti + r32) * QEP + (32 * i + 16 * s + 4 * hi) * 2;
                        const bf16x8 A = ld2x64(ap, ap + 16); o[ti] = __builtin_amdgcn_mfma_f32_32x32x16_bf16(A, Bf, o[ti], 0, 0, 0); }
                }
        }
        GSTAMP(4);
        __syncthreads();
        GSTAMP(5);
        }
        {
            bf16x8 vf[4];
            const int gI = lane >> 4, i16 = lane & 15, q = i16 >> 2, p = i16 & 3;
            const GLAS unsigned char* vb = lds + L_V + (8 * hi + q) * VP + (32 * w + 16 * (gI & 1) + 4 * p) * 2;
#pragma unroll
            for (int ks = 0; ks < 4; ++ks) { const s16x4 lo = vtr(vb + 16 * ks * VP), hh = vtr(vb + (16 * ks + 4) * VP);
                vf[ks] = (bf16x8){lo[0], lo[1], lo[2], lo[3], hh[0], hh[1], hh[2], hh[3]}; }
            if (!STATE_ONLY) {
#pragma unroll
            for (int ti = 0; ti < 2; ++ti)
#pragma unroll
                for (int ks = 0; ks < 4; ++ks) { const GLAS unsigned char* ap = lds + L_ATT + (32 * ti + r32) * KDP + (16 * ks + 8 * hi) * 2;
                    const bf16x8 A = ld2x64(ap, ap + 8); o[ti] = __builtin_amdgcn_mfma_f32_32x32x16_bf16(A, vf[ks], o[ti], 0, 0, 0); }
            }
#pragma unroll
            for (int i = 0; i < 4; ++i) {
#pragma unroll
                for (int r = 0; r < 16; ++r) S[i][r] *= BL[32 * i + crow(r, hi)];
#pragma unroll
                for (int ks = 0; ks < 4; ++ks) { const GLAS unsigned char* ap = lds + L_KDT + (32 * i + r32) * KDP + (16 * ks + 8 * hi) * 2;
                    const bf16x8 A = ld2x64(ap, ap + 8); S[i] = __builtin_amdgcn_mfma_f32_32x32x16_bf16(A, vf[ks], S[i], 0, 0, 0); }
            }
        }
        GSTAMP(6);
        __syncthreads();
        GSTAMP(7);
        if (!STATE_ONLY) {
#pragma unroll
        for (int ti = 0; ti < 2; ++ti)
#pragma unroll
            for (int r = 0; r < 16; ++r) OL[(32 * ti + crow(r, hi)) * OLP + 32 * w + r32] = o[ti][r];
        GSTAMP(8);
        __syncthreads();
        GSTAMP(9);
        {
            const int t = tid >> 3, seg = tid & 7;
            f32x4 v[8]; float ss = 0.f;
#pragma unroll
            for (int j = 0; j < 8; ++j) { v[j] = *(const GLAS f32x4*)(OL + t * OLP + 32 * seg + 4 * j); ss += (v[j].x * v[j].x + v[j].y * v[j].y) + (v[j].z * v[j].z + v[j].w * v[j].w); }
            ss += dpp_xor1(ss); ss += dpp_xor2(ss); ss += dpp_hmirror(ss);
            const float rs = rsqrtf(ss * (1.0f / 256.0f) + 1e-6f);
            const size_t go = (row0 + t) * 1024 + h * 256 + 32 * seg;
#pragma unroll
            for (int j = 0; j < 4; ++j) {
                const u32x4 rr = rpre[j];
                const f32x4 a = v[2 * j], bq = v[2 * j + 1];
                u32x4 ov;
                ov.x = cvtpk(a.x * rs * __builtin_bit_cast(float, rr.x << 16), a.y * rs * __builtin_bit_cast(float, rr.x & 0xffff0000u));
                ov.y = cvtpk(a.z * rs * __builtin_bit_cast(float, rr.y << 16), a.w * rs * __builtin_bit_cast(float, rr.y & 0xffff0000u));
                ov.z = cvtpk(bq.x * rs * __builtin_bit_cast(float, rr.z << 16), bq.y * rs * __builtin_bit_cast(float, rr.z & 0xffff0000u));
                ov.w = cvtpk(bq.z * rs * __builtin_bit_cast(float, rr.w << 16), bq.w * rs * __builtin_bit_cast(float, rr.w & 0xffff0000u));
                *(u32x4*)(Oout + go + 8 * j) = ov;
            }
        }
        GSTAMP(10);
        __syncthreads();
        GSTAMP(11);
        }
    }
    if (STATE_ONLY) {
        float* sl = SLOC + ((size_t)(bh * 3 + seg) * 128) * 256 + 32 * w + r32;
#pragma unroll
        for (int i = 0; i < 4; ++i)
#pragma unroll
            for (int r = 0; r < 16; ++r) sl[(size_t)(32 * i + crow(r, hi)) * 256] = S[i][r];
        if (qd == 0) DSEG[(bh * 3 + seg) * 128 + kcol] = __expf(dlog);
    }
#ifdef DBG_GPROF
    if (!STATE_ONLY && blockIdx.x == 5 && tid == 0) { unsigned long long* dp = (unsigned long long*)((unsigned char*)SLOC + (size_t)110 * 1048576);
        for (int k = 0; k < 12; ++k) dp[k] = gacc_[k]; }
#endif
#undef GSTAMP
#undef GLA_FETCH_GV
#undef GLA_FETCH_QK
}
}
namespace nsa {
typedef unsigned short bf16_t;
typedef short bf16x8 __attribute__((ext_vector_type(8)));
typedef short s16x4 __attribute__((ext_vector_type(4)));
typedef float f32x16 __attribute__((ext_vector_type(16)));
typedef float f32x4 __attribute__((ext_vector_type(4)));
typedef unsigned u32x4 __attribute__((ext_vector_type(4)));
#define NLAS __attribute__((address_space(3)))
__device__ __forceinline__ int crow(int r, int hi) { return (r & 3) + 8 * (r >> 2) + 4 * hi; }
__device__ __forceinline__ unsigned cvtpk(float lo, float hi) { typedef float f2 __attribute__((ext_vector_type(2))); typedef __bf16 b2 __attribute__((ext_vector_type(2))); f2 v = {lo, hi}; b2 b = __builtin_convertvector(v, b2); return __builtin_bit_cast(unsigned, b); }
__device__ __forceinline__ s16x4 vtr(const NLAS unsigned char* p) { typedef short v4i16_t __attribute__((ext_vector_type(4))); return __builtin_bit_cast(s16x4, __builtin_amdgcn_ds_read_tr16_b64_v4i16((NLAS v4i16_t*)p)); }

__device__ __forceinline__ float gelu_tanh(float x) { const float y = 0.7978845608028654f * (x + 0.044715f * x * x * x); const float e = __expf(2.0f * y); const float th = 1.0f - 2.0f * __builtin_amdgcn_rcpf(e + 1.0f); return 0.5f * x * (1.0f + th); }
__device__ __forceinline__ void cmp_finalize(const float* HP, const float* BIASC, const bf16_t* WC2, bf16_t* KCVC, int gw, int NGW, int lane) {
    typedef float f4 __attribute__((ext_vector_type(4)));
    const int r = lane & 15, kq = lane >> 4;
    for (int item = gw; item < 1024; item += NGW) {
        const int R0 = item * 16, w = R0 >> 13, row = R0 + r;
        f4 acc[4];
#pragma unroll
        for (int nt = 0; nt < 4; ++nt) acc[nt] = (f4){0.f, 0.f, 0.f, 0.f};
#pragma unroll
        for (int ks = 0; ks < 8; ++ks) {
            const int col = 32 * ks + 8 * kq;
            f32x4 s0 = *(const f32x4*)(BIASC + w * 256 + col), s1 = *(const f32x4*)(BIASC + w * 256 + col + 4);
#pragma unroll
            for (int p = 0; p < 4; ++p) { const float* hp = HP + ((size_t)p * 16384 + row) * 256 + col; s0 = s0 + *(const f32x4*)hp; s1 = s1 + *(const f32x4*)(hp + 4); }
            u32x4 pk; pk.x = cvtpk(gelu_tanh(s0.x), gelu_tanh(s0.y)); pk.y = cvtpk(gelu_tanh(s0.z), gelu_tanh(s0.w)); pk.z = cvtpk(gelu_tanh(s1.x), gelu_tanh(s1.y)); pk.w = cvtpk(gelu_tanh(s1.z), gelu_tanh(s1.w));
            const bf16x8 A = __builtin_bit_cast(bf16x8, pk);
#pragma unroll
            for (int nt = 0; nt < 4; ++nt) { const bf16x8 B = *(const bf16x8*)(WC2 + ((size_t)w * 64 + 16 * nt + r) * 256 + col);
                acc[nt] = __builtin_amdgcn_mfma_f32_16x16x32_bf16(A, B, acc[nt], 0, 0, 0); }
        }
#pragma unroll
        for (int nt = 0; nt < 4; ++nt)
#pragma unroll
            for (int rg = 0; rg < 4; ++rg) { const int orow = R0 + 4 * kq + rg; const float v = ((orow & 127) == 127) ? 0.f : acc[nt][rg];
                KCVC[(size_t)orow * 64 + 16 * nt + r] = (bf16_t)(cvtpk(v, 0.f) & 0xffffu); }
    }
}

constexpr int SLOTB = 16384, NSLOT = 4;
constexpr int L_IMP = NSLOT * SLOTB, L_CAR = L_IMP + 8 * 32 * 33 * 4, L_VAL = L_CAR + 8 * 32 * 33 * 4, L_SELM = L_VAL + 64 * 33 * 4, L_WSF = L_SELM + 256, L_FAC = L_WSF + 8 * 64 * 4, L_AEND = L_FAC + 8 * 32 * 2 * 4;
static_assert(L_AEND <= 131072 + 28672, "attention LDS");
#define NINF (-__builtin_inff())
#define ABAR() asm volatile("s_waitcnt lgkmcnt(0)\n\ts_barrier" ::: "memory")

__device__ __forceinline__ void k_issue(bf16x8* kf, const NLAS unsigned char* ks, int r32, int hi) {
    const int sw = (r32 >> 1) & 7;
    const unsigned kb = (unsigned)(size_t)(ks + r32 * 128);
    const unsigned a0 = kb + (((0 + hi) ^ sw) << 4), a1 = kb + (((2 + hi) ^ sw) << 4), a2 = kb + (((4 + hi) ^ sw) << 4), a3 = kb + (((6 + hi) ^ sw) << 4);
    asm volatile("ds_read_b128 %0, %8\n\tds_read_b128 %1, %8 offset:4096\n\tds_read_b128 %2, %9\n\tds_read_b128 %3, %9 offset:4096\n\t"
                 "ds_read_b128 %4, %10\n\tds_read_b128 %5, %10 offset:4096\n\tds_read_b128 %6, %11\n\tds_read_b128 %7, %11 offset:4096"
                 : "=&v"(kf[0]), "=&v"(kf[1]), "=&v"(kf[2]), "=&v"(kf[3]), "=&v"(kf[4]), "=&v"(kf[5]), "=&v"(kf[6]), "=&v"(kf[7])
                 : "v"(a0), "v"(a1), "v"(a2), "v"(a3) : "memory");
}
__device__ __forceinline__ void k_wait(bf16x8* kf) {
    asm volatile("s_waitcnt lgkmcnt(0)" : "+v"(kf[0]), "+v"(kf[1]), "+v"(kf[2]), "+v"(kf[3]), "+v"(kf[4]), "+v"(kf[5]), "+v"(kf[6]), "+v"(kf[7]) :: "memory");
    __builtin_amdgcn_sched_barrier(0);
}
__device__ __forceinline__ void qk_mma(f32x16& p0, f32x16& p1, const bf16x8* kf, const bf16x8* qf, const f32x16& c) {
#pragma unroll
    for (int d0 = 0; d0 < 4; ++d0) {
        if (d0 == 0) { p0 = __builtin_amdgcn_mfma_f32_32x32x16_bf16(kf[0], qf[0], c, 0, 0, 0); p1 = __builtin_amdgcn_mfma_f32_32x32x16_bf16(kf[1], qf[0], c, 0, 0, 0); }
        else { p0 = __builtin_amdgcn_mfma_f32_32x32x16_bf16(kf[2 * d0], qf[d0], p0, 0, 0, 0); p1 = __builtin_amdgcn_mfma_f32_32x32x16_bf16(kf[2 * d0 + 1], qf[d0], p1, 0, 0, 0); }
    }
}
__device__ __forceinline__ void pack_p(bf16x8* pa, const f32x16& p0, const f32x16& p1) {
    u32x4 w;
    w.x = cvtpk(p0[0], p0[1]); w.y = cvtpk(p0[2], p0[3]); w.z = cvtpk(p0[4], p0[5]); w.w = cvtpk(p0[6], p0[7]); pa[0] = __builtin_bit_cast(bf16x8, w);
    w.x = cvtpk(p0[8], p0[9]); w.y = cvtpk(p0[10], p0[11]); w.z = cvtpk(p0[12], p0[13]); w.w = cvtpk(p0[14], p0[15]); pa[1] = __builtin_bit_cast(bf16x8, w);
    w.x = cvtpk(p1[0], p1[1]); w.y = cvtpk(p1[2], p1[3]); w.z = cvtpk(p1[4], p1[5]); w.w = cvtpk(p1[6], p1[7]); pa[2] = __builtin_bit_cast(bf16x8, w);
    w.x = cvtpk(p1[8], p1[9]); w.y = cvtpk(p1[10], p1[11]); w.z = cvtpk(p1[12], p1[13]); w.w = cvtpk(p1[14], p1[15]); pa[3] = __builtin_bit_cast(bf16x8, w);
}
__device__ __forceinline__ void v_load(bf16x8* vf, const NLAS unsigned char* vs, int lane) {
    const int hi = lane >> 5;
    const NLAS unsigned char* vb = vs + ((lane >> 4) & 1) * 32 + (lane & 3) * 8 + (4 * hi + ((lane & 15) >> 2)) * 64;
#pragma unroll
    for (int d0 = 0; d0 < 2; ++d0)
#pragma unroll
        for (int ks = 0; ks < 4; ++ks) {
            const s16x4 lo = vtr(vb + d0 * 4096 + ks * 1024), hh = vtr(vb + d0 * 4096 + ks * 1024 + 512);
            vf[d0 * 4 + ks] = (bf16x8){lo[0], lo[1], lo[2], lo[3], hh[0], hh[1], hh[2], hh[3]};
        }
}
__device__ __forceinline__ void pv_mma(f32x16* o, f32x16& lacc, const bf16x8* vf, const bf16x8* pa) {
    const short one_ = (short)0x3F80; const bf16x8 ones = (bf16x8){one_, one_, one_, one_, one_, one_, one_, one_};
#pragma unroll
    for (int ks = 0; ks < 4; ++ks) {
        o[0] = __builtin_amdgcn_mfma_f32_32x32x16_bf16(pa[ks], vf[ks], o[0], 0, 0, 0);
        o[1] = __builtin_amdgcn_mfma_f32_32x32x16_bf16(pa[ks], vf[4 + ks], o[1], 0, 0, 0);
        lacc = __builtin_amdgcn_mfma_f32_32x32x16_bf16(pa[ks], ones, lacc, 0, 0, 0);
    }
}
__device__ __forceinline__ float max3f(float a, float b, float c) { float r; asm("v_max3_f32 %0, %1, %2, %3" : "=v"(r) : "v"(a), "v"(b), "v"(c)); return r; }
__device__ __forceinline__ float max32(const f32x16& p0, const f32x16& p1) {
    float a = max3f(p0[0], p0[1], p1[0]), b = max3f(p0[2], p0[3], p1[1]); a = max3f(a, p1[2], p1[3]);
#pragma unroll
    for (int r = 4; r < 16; r += 4) { a = max3f(a, p0[r], p0[r + 1]); b = max3f(b, p0[r + 2], p0[r + 3]); a = max3f(a, p1[r], p1[r + 1]); b = max3f(b, p1[r + 2], p1[r + 3]); }
    return max3f(a, b, b);
}
__device__ __forceinline__ float comb_max(float v) { auto rr = __builtin_amdgcn_permlane32_swap(__float_as_uint(v), __float_as_uint(v), false, false); return fmaxf(__uint_as_float(rr[0]), __uint_as_float(rr[1])); }
__device__ __forceinline__ float comb_sum(float v) { auto rr = __builtin_amdgcn_permlane32_swap(__float_as_uint(v), __float_as_uint(v), false, false); return __uint_as_float(rr[0]) + __uint_as_float(rr[1]); }
__device__ __forceinline__ void mask_le(f32x16& p0, f32x16& p1, int thr, int hi) {
    int t2 = thr - 4 * hi; asm volatile("" : "+v"(t2));
#pragma unroll
    for (int r = 0; r < 16; ++r) { const int kc = (r & 3) + 8 * (r >> 2); if (kc > t2) p0[r] = NINF; if (kc + 32 > t2) p1[r] = NINF; }
}
__device__ __forceinline__ void mask_gt(f32x16& p0, f32x16& p1, int thr, int hi) {
    int t2 = thr - 4 * hi; asm volatile("" : "+v"(t2));
#pragma unroll
    for (int r = 0; r < 16; ++r) { const int kc = (r & 3) + 8 * (r >> 2); if (kc <= t2) p0[r] = NINF; if (kc + 32 <= t2) p1[r] = NINF; }
}

#ifndef SOFT_THR
#define SOFT_THR 8.0f
#endif
struct Soft { float mhat; f32x16 lacc; f32x16 o[2]; };
__device__ __forceinline__ void soft_init(Soft& s) { s.mhat = 0.f;
#pragma unroll
    for (int r = 0; r < 16; ++r) { s.lacc[r] = 0.f; s.o[0][r] = 0.f; s.o[1][r] = 0.f; } }
__device__ __forceinline__ float soft_update(Soft& s, f32x16& p0, f32x16& p1, bool first, NLAS float* wsf, int r32, int hi) {
    const float rm = comb_max(max32(p0, p1));
    const float dl = first ? ((rm > NINF) ? rm : 0.f) : ((rm > SOFT_THR) ? rm : 0.f);
    float f = 1.0f;
    if (__any(dl != 0.f)) {
        s.mhat += dl;
        f = __builtin_amdgcn_exp2f(-dl);
#pragma unroll
        for (int r = 0; r < 16; ++r) { p0[r] -= dl; p1[r] -= dl; }
        if (!first) {
            if (hi == 0) wsf[r32] = f;
            asm volatile("s_waitcnt lgkmcnt(0)" ::: "memory");
#pragma unroll
            for (int r = 0; r < 16; ++r) { const float ff = wsf[crow(r, hi)]; s.o[0][r] *= ff; s.o[1][r] *= ff; s.lacc[r] *= ff; }
            asm volatile("s_waitcnt lgkmcnt(0)" ::: "memory");
        }
    }
#pragma unroll
    for (int r = 0; r < 16; ++r) { p0[r] = __builtin_amdgcn_exp2f(p0[r]); p1[r] = __builtin_amdgcn_exp2f(p1[r]); }
    return f;
}

struct AttnBufs { unsigned char* ws; };
struct Strm { int u, kind, j; };
__device__ __forceinline__ int unit_qt(int u, int sub) { return 8 * (u >> 1) + ((u & 1) ? (7 - sub) : sub); }
__device__ __forceinline__ void strm_next(Strm& s, int sub) {
    const int qt = unit_qt(s.u, sub);
    if (s.kind == 0) { if (s.j == 0 && qt >= 16) s.j = 1; else { s.kind = 1; s.j = qt; } }
    else if (s.kind == 1) { if (s.j > 0) --s.j; else { s.kind = 2; s.j = qt; } }
    else { const int jlo = qt >= 8 ? qt - 8 : 0; if (s.j > jlo) --s.j; else { ++s.u; s.kind = 0; s.j = 0; } }
}
__device__ __forceinline__ void dma16(const void* g, NLAS unsigned char* l) {
    unsigned keep; const unsigned dst = (unsigned)__builtin_amdgcn_readfirstlane((int)(unsigned)(size_t)l);
    asm volatile("s_mov_b32 %0, m0\n\ts_mov_b32 m0, %2\n\ts_nop 0\n\tglobal_load_lds_dwordx4 %1, off\n\ts_mov_b32 m0, %0" : "=&s"(keep) : "v"(g), "s"(dst) : "memory");
}


__device__ __forceinline__ void q_fetch(bf16x8* qf, const bf16_t* qp) {
    asm volatile("global_load_dwordx4 %0, %4, off\n\tglobal_load_dwordx4 %1, %4, off offset:32\n\tglobal_load_dwordx4 %2, %4, off offset:64\n\tglobal_load_dwordx4 %3, %4, off offset:96\n\ts_waitcnt vmcnt(0)"
                 : "=&v"(qf[0]), "=&v"(qf[1]), "=&v"(qf[2]), "=&v"(qf[3]) : "v"(qp) : "memory");
}
__device__ __forceinline__ void qg_fetch(bf16x8* qf, float& g0, float& g1, float& g2, const bf16_t* qp, const float* gp) {
    asm volatile("global_load_dword %4, %8, off\n\tglobal_load_dword %5, %8, off offset:64\n\tglobal_load_dword %6, %8, off offset:128\n\t"
                 "global_load_dwordx4 %0, %7, off\n\tglobal_load_dwordx4 %1, %7, off offset:32\n\tglobal_load_dwordx4 %2, %7, off offset:64\n\tglobal_load_dwordx4 %3, %7, off offset:96\n\ts_waitcnt vmcnt(0)"
                 : "=&v"(qf[0]), "=&v"(qf[1]), "=&v"(qf[2]), "=&v"(qf[3]), "=&v"(g0), "=&v"(g1), "=&v"(g2) : "v"(qp), "v"(gp) : "memory");
}

template <int VAR = 0>
__device__ __forceinline__ void attn_block(int bh, int sub, const AttnBufs& T, NLAS unsigned char* lds, int tid0) {
    int tid_ = tid0; asm volatile("" : "+v"(tid_));
    const int tid = tid_, lane = tid & 63, w = __builtin_amdgcn_readfirstlane(tid >> 6), r32 = lane & 31, hi = lane >> 5;
    const int b = bh >> 2, hk = bh & 3, g = w >> 1, hq = hk * 4 + g, qi = 32 * (w & 1) + r32;
    NLAS float* wsf = (NLAS float*)(lds + L_WSF) + w * 64;
    NLAS float* IMP = (NLAS float*)(lds + L_IMP) + w * 32 * 33; NLAS float* CAR = (NLAS float*)(lds + L_CAR) + w * 32 * 33;
    NLAS float* stash = (NLAS float*)(lds + L_IMP + w * 8448) + lane;
    const int krow = 8 * w + (lane >> 3), koff = krow * 64 + (((lane & 7) ^ ((krow >> 1) & 7)) << 3), voff = (16 * (w & 3) + (lane >> 2)) * 64 + (w >> 2) * 32 + (lane & 3) * 8;
    unsigned char* const ws = T.ws;
    constexpr size_t kvs = (size_t)16 * 4 * 2048 * 64;
#define A_KC ((const bf16_t*)(ws + WS_KCVC) + ((size_t)bh * 128) * 64)
#define A_VC ((const bf16_t*)(ws + WS_KCVC) + ((size_t)(64 + bh) * 128) * 64)
#define A_KV ((const bf16_t*)(ws + WS_KV) + (size_t)bh * 2048 * 64)
    const bf16_t* kp_; const bf16_t* vp_;
#define PTRS(st) do { \
        if ((st).kind == 0) { kp_ = A_KC + (st).j * 4096 + koff; vp_ = A_VC + (st).j * 4096 + voff; } \
        else if ((st).kind == 1) { kp_ = A_KV + 2 * kvs + (size_t)(st).j * 4096 + koff; vp_ = A_KV + 3 * kvs + (size_t)(st).j * 4096 + voff; } \
        else { kp_ = A_KV + 4 * kvs + (size_t)(st).j * 4096 + koff; vp_ = A_KV + 5 * kvs + (size_t)(st).j * 4096 + voff; } } while (0)
#define ISSUE(st, slot) do { dma16(kp_, lds + (slot) * SLOTB + w * 1024); dma16(vp_, lds + (slot) * SLOTB + 8192 + w * 1024); \
        { const int pk_ = (st).kind, pu_ = (st).u; strm_next(st, sub); \
          if ((st).kind == pk_ && (st).u == pu_) { if (pk_ == 0) { kp_ += 4096; vp_ += 4096; } else { kp_ -= 4096; vp_ -= 4096; } } else if ((st).u < 8) PTRS(st); } } while (0)
    Strm ist; ist.u = 0; ist.kind = 0; ist.j = 0;
    Strm cst = ist;
    int P = 0;
#pragma unroll 1
    for (int u = 0; u < 8; ++u) { const int qt = unit_qt(u, sub); P += (qt >= 16 ? 2 : 1) + (qt + 1) + ((qt >= 8 ? 8 : qt) + 1); }
    PTRS(ist);
    ISSUE(ist, 0); ISSUE(ist, 1);
    Soft S; soft_init(S);
    bf16x8 qf[4];
    float g_cmp = 0.f, g_sel = 0.f, g_win = 0.f; unsigned selm = 0u; int qt = 0;
#ifdef DBG_PROF
    unsigned long long tacc_[7] = {0, 0, 0, 0, 0, 0, 0}; unsigned long long tprev_ = clock64();
#define STAMP(k) do { asm volatile("s_waitcnt lgkmcnt(0)" ::: "memory"); const unsigned long long t_ = clock64(); tacc_[k] += t_ - tprev_; tprev_ = t_; } while (0)
#else
#define STAMP(k) do {} while (0)
#endif
#pragma unroll 1
    for (int p = 0; p < P; ++p) {
        STAMP(0);
        const NLAS unsigned char* slot = lds + (p & 3) * SLOTB;
        bf16x8 kf[8];
        if ((p & 1) == 0) {
            asm volatile("s_waitcnt vmcnt(0)" ::: "memory");
            STAMP(1);
            ABAR();
            STAMP(2);
            k_issue(kf, slot, r32, hi);
            if (p + 2 < P) { ISSUE(ist, (p + 2) & 3); }
            if (p + 3 < P) { ISSUE(ist, (p + 3) & 3); }
        } else k_issue(kf, slot, r32, hi);
        const int kind = cst.kind, j = cst.j;
        if (kind == 0 && j == 0) {
            qt = unit_qt(cst.u, sub);
            const int tok = 64 * qt + qi;
            const float* gp = (const float*)(ws + WS_GATES) + ((size_t)b * 2048 + tok) * 48 + hq;
            const size_t qoff = (((size_t)b * 16 + hq) * 2048 + tok) * 64 + 8 * hi;
            qg_fetch(qf, g_cmp, g_sel, g_win, (const bf16_t*)(ws + WS_NQ) + qoff, gp);
            soft_init(S);
        }
        if ((kind == 1 || kind == 2) && j == qt) soft_init(S);
        const bool first = (kind == 0) ? (j == 0) : (j == qt);
        float cv = -S.mhat;
        if (kind == 1) { if (!((selm >> j) & 1u)) cv = NINF; }
        f32x16 c;
#pragma unroll
        for (int r = 0; r < 16; ++r) c[r] = cv;
        f32x16 p0, p1;
        if (VAR == 1 || VAR == 5) { p0 = c; p1 = c; asm volatile("" : "+v"(p0), "+v"(p1)); strm_next(cst, sub); continue; }
        bf16x8 vf[8];
        {
            k_wait(kf);
            qk_mma(p0, p1, kf, qf, c);
        }
        v_load(vf, slot + 8192, lane);
        __builtin_amdgcn_sched_barrier(0);
        if (VAR == 2) { asm volatile("" :: "v"(p0), "v"(p1)); strm_next(cst, sub); continue; }
        asm volatile("" :: "v"(p0), "v"(p1)); STAMP(3);
        if (kind == 0) { const int tok = 64 * qt + qi; const int nmax = (tok >= 31) ? ((tok - 31) >> 4) : -1; mask_le(p0, p1, nmax - 64 * j, hi); }
        else { if (j == qt) mask_le(p0, p1, qi, hi); if (kind == 2 && j == qt - 8) mask_gt(p0, p1, qi, hi); }
        const float f = soft_update(S, p0, p1, first, wsf, r32, hi);
        asm volatile("" :: "v"(p0), "v"(p1)); STAMP(4);
        if (VAR == 3) { asm volatile("" :: "v"(p0), "v"(p1)); strm_next(cst, sub); continue; }
        {
            bf16x8 pa[4]; pack_p(pa, p0, p1);
            pv_mma(S.o, S.lacc, vf, pa);
        }
        asm volatile("" :: "v"(S.o[0]), "v"(S.o[1])); STAMP(5);
        if (kind == 0) {
            NLAS float* FAC = (NLAS float*)(lds + L_FAC) + w * 64;
            int ll_ = lane; asm volatile("" : "+v"(ll_));
            const int r32 = ll_ & 31, hi = ll_ >> 5, tid = w * 64 + ll_, qi = 32 * (w & 1) + r32;
            NLAS float* IMP = (NLAS float*)(lds + L_IMP) + w * 32 * 33; NLAS float* CAR = (NLAS float*)(lds + L_CAR) + w * 32 * 33;
            NLAS float* wsf = (NLAS float*)(lds + L_WSF) + w * 64;
            NLAS float* stash = (NLAS float*)(lds + L_IMP + w * 8448) + ll_;
            if (j == 0) {
                if (hi == 0) CAR[r32 * 33] = 0.f;
#pragma unroll
                for (int a = 0; a < 4; ++a) {
                    const int jb = 2 * a + hi;
                    IMP[r32 * 33 + jb] = p0[4 * a] + p0[4 * a + 1] + p0[4 * a + 2] + 0.5f * p0[4 * a + 3]; CAR[r32 * 33 + jb + 1] = 0.5f * p0[4 * a + 3];
                    IMP[r32 * 33 + jb + 8] = p1[4 * a] + p1[4 * a + 1] + p1[4 * a + 2] + 0.5f * p1[4 * a + 3]; CAR[r32 * 33 + jb + 9] = 0.5f * p1[4 * a + 3];
                }
            }
            if (j == 1 || qt < 16) {
                if (r32 == 0) {
#pragma unroll
                    for (int r = 0; r < 16; ++r) wsf[crow(r, hi)] = S.lacc[r]; }
                asm volatile("s_waitcnt lgkmcnt(0)" ::: "memory");
                const float l = wsf[r32];
                asm volatile("s_waitcnt lgkmcnt(0)" ::: "memory");
                const float inv = (l > 0.f) ? __builtin_amdgcn_rcpf(l) : 0.f;
                if (hi == 0) { FAC[r32] = (j == 0 ? 1.0f : f) * inv; FAC[32 + r32] = inv; }
                if (j == 1)
#pragma unroll
                for (int a = 0; a < 4; ++a) {
                    const int jb = 2 * a + hi;
                    IMP[r32 * 33 + jb + 16] = p0[4 * a] + p0[4 * a + 1] + p0[4 * a + 2] + 0.5f * p0[4 * a + 3]; CAR[r32 * 33 + jb + 17] = 0.5f * p0[4 * a + 3];
                    IMP[r32 * 33 + jb + 24] = p1[4 * a] + p1[4 * a + 1] + p1[4 * a + 2] + 0.5f * p1[4 * a + 3]; if (jb + 25 < 32) CAR[r32 * 33 + jb + 25] = 0.5f * p1[4 * a + 3];
                }
                ABAR();
                {
                    NLAS float* VAL = (NLAS float*)(lds + L_VAL);
                    const int tq = tid >> 3, sb = tid & 7, wv = tq >> 5, rr = tq & 31;
                    const NLAS float* I0 = (const NLAS float*)(lds + L_IMP); const NLAS float* C0 = (const NLAS float*)(lds + L_CAR);
                    float v[4];
#pragma unroll
                    for (int e = 0; e < 4; ++e) { const int jb = 4 * sb + e; float sc = 0.f;
#pragma unroll
                        for (int gg = 0; gg < 4; ++gg) { const int ww = 2 * gg + wv; const NLAS float* fc = (const NLAS float*)(lds + L_FAC) + ww * 64 + rr;
                            sc += I0[(ww * 32 + rr) * 33 + jb] * fc[jb < 16 ? 0 : 32] + C0[(ww * 32 + rr) * 33 + jb] * fc[jb <= 16 ? 0 : 32]; }
                        if (jb > qt) sc = -1.0f; else if (jb == 0 || jb == qt || jb == qt - 1) sc = 1e4f;
                        v[e] = sc; VAL[tq * 33 + jb] = sc; }
                    asm volatile("s_waitcnt lgkmcnt(0)" ::: "memory");
                    unsigned bits = 0u;
#pragma unroll
                    for (int e = 0; e < 4; ++e) { const int jb = 4 * sb + e; int rank = 0;
#pragma unroll
                        for (int i = 0; i < 32; ++i) { const float x = VAL[tq * 33 + i]; rank += (x > v[e] || (x == v[e] && i < jb)) ? 1 : 0; }
                        if (rank < 16) bits |= 1u << jb; }
                    bits |= dpp_xor1(bits); bits |= dpp_xor2(bits); bits |= dpp_hmirror(bits);
                    if (sb == 0) ((NLAS unsigned*)(lds + L_SELM))[tq] = bits;
                }
                ABAR();
#ifdef DBG_SELALL
                selm = 0xffffffffu;
#else
                selm = ((const NLAS unsigned*)(lds + L_SELM))[qi];
#endif
                const float fac = g_cmp * inv;
                if (hi == 0) wsf[r32] = fac;
                asm volatile("s_waitcnt lgkmcnt(0)" ::: "memory");
#pragma unroll
                for (int r = 0; r < 16; ++r) { const float ff = wsf[crow(r, hi)]; stash[r * 64] = S.o[0][r] * ff; stash[(16 + r) * 64] = S.o[1][r] * ff; }
                asm volatile("s_waitcnt lgkmcnt(0)" ::: "memory");
                const size_t qoff = (((size_t)b * 16 + hq) * 2048 + 64 * qt + qi) * 64 + 8 * hi;
                q_fetch(qf, (const bf16_t*)(ws + WS_NQR) + qoff);
            }
        } else {
            const int jend = (kind == 1) ? 0 : (qt >= 8 ? qt - 8 : 0);
            if (j == jend) {
                int ll_ = lane; asm volatile("" : "+v"(ll_));
                const int r32 = ll_ & 31, hi = ll_ >> 5, lane = ll_;
                NLAS float* wsf = (NLAS float*)(lds + L_WSF) + w * 64;
                NLAS float* stash = (NLAS float*)(lds + L_IMP + w * 8448) + ll_;
                if (hi == 0) wsf[r32] = (kind == 1 ? g_sel : g_win);
                asm volatile("s_waitcnt lgkmcnt(0)" ::: "memory");
#pragma unroll
                for (int r = 0; r < 16; ++r) { const float ff = wsf[crow(r, hi)] * __builtin_amdgcn_rcpf(S.lacc[r]); stash[r * 64] += S.o[0][r] * ff; stash[(16 + r) * 64] += S.o[1][r] * ff; }
                asm volatile("s_waitcnt lgkmcnt(0)" ::: "memory");
                if (kind == 2) {
                    const NLAS float* sw = (const NLAS float*)(lds + L_IMP + w * 8448);
                    bf16_t* ob = (bf16_t*)(ws + WS_OATT) + ((size_t)b * 2048 + 64 * qt + 32 * (w & 1)) * 1024 + hq * 64;
#pragma unroll
                    for (int i = 0; i < 4; ++i) {
                        const int row = 8 * i + (lane >> 3), ch = lane & 7;
                        const int hh_ = (row >> 2) & 1, rr_ = (row & 3) + 4 * (row >> 3), d0 = ch >> 2;
                        const NLAS float* sp = sw + ((d0 * 16 + rr_) * 64 + hh_ * 32 + (ch & 3) * 8);
                        const f32x4 x0 = *(const NLAS f32x4*)sp, x1 = *(const NLAS f32x4*)(sp + 4);
                        u32x4 ov; ov.x = cvtpk(x0.x, x0.y); ov.y = cvtpk(x0.z, x0.w); ov.z = cvtpk(x1.x, x1.y); ov.w = cvtpk(x1.z, x1.w);
                        *(u32x4*)(ob + (size_t)row * 1024 + ch * 8) = ov;
                    }
                    ABAR();
                }
            }
        }
        strm_next(cst, sub);
    }
    ABAR();
#ifdef DBG_PROF
    if (blockIdx.x == 0 && tid == 0) { unsigned long long* dp = (unsigned long long*)(ws + (size_t)500 * 1048576);
        for (int k = 0; k < 7; ++k) dp[k] = tacc_[k]; }
#endif
#undef STAMP
#undef ISSUE
#undef PTRS
#undef A_KC
#undef A_VC
#undef A_KV
}
}
namespace cg = cooperative_groups;
typedef unsigned short bf16_t;
struct Params { const float* in[23]; float* out; unsigned char* ws; };

constexpr int PARAM_OFF = EPI_OFF + 28672, BARST_OFF = PARAM_OFF + 256;
template <class T> __device__ __forceinline__ T* ldp(PG8_LAS unsigned char* lds, int idx) {
    const PG8_LAS unsigned* p = (const PG8_LAS unsigned*)(lds + PARAM_OFF) + 2 * idx;
    const unsigned lo = __builtin_amdgcn_readfirstlane(p[0]), hi = __builtin_amdgcn_readfirstlane(p[1]);
    typedef __attribute__((address_space(1))) unsigned char gchar_t;
    gchar_t* gp = (gchar_t*)(((unsigned long long)hi << 32) | lo);
    return (T*)(unsigned char*)gp;
}
#define INP(k) ldp<const float>(lds, (k))
#define OUTP() ldp<float>(lds, 23)
#define WSP() ldp<unsigned char>(lds, 24)
__device__ __forceinline__ pro::In load_in(PG8_LAS unsigned char* lds) {
    pro::In I;
    I.x = INP(0); I.norm_mix = INP(1); I.norm_ffn = INP(2); I.gla_w_in = INP(3); I.gla_w_alpha_up = INP(4); I.gla_b_alpha = INP(5); I.gla_norm = INP(6); I.gla_w_o = INP(7);
    I.kv_norm = INP(8); I.nsa_w_kv = INP(9); I.cmp_pe_k = INP(10); I.cmp_pe_v = INP(11); I.cmp_k_w1 = INP(12); I.cmp_k_w2 = INP(13); I.cmp_v_w1 = INP(14); I.cmp_v_w2 = INP(15);
    I.nsa_w_in = INP(16); I.nsa_w_o = INP(17); I.ffn_w_up = INP(18); I.ffn_conv_w = INP(19); I.ffn_conv_b = INP(20); I.ffn_w_down = INP(21); I.norm_final = INP(22);
    return I;
}

__global__ void __launch_bounds__(512, 2) yoco_fwd(Params P) {
    extern __shared__ __attribute__((aligned(16))) unsigned char lds_raw[];
    PG8_LAS unsigned char* lds = (PG8_LAS unsigned char*)lds_raw;
    cg::grid_group grid = cg::this_grid();
    const int G = gridDim.x, bx = blockIdx.x;
    const int wave0 = __builtin_amdgcn_readfirstlane(threadIdx.x >> 6);
#define NOWTID() (wave0 * 64 + lane_id_fresh())
    if (threadIdx.x == 0) {
        PG8_LAS unsigned long long* lp = (PG8_LAS unsigned long long*)(lds + PARAM_OFF);
#pragma unroll
        for (int i = 0; i < 23; ++i) lp[i] = (unsigned long long)P.in[i];
        lp[23] = (unsigned long long)P.out; lp[24] = (unsigned long long)P.ws;
    }
    if (threadIdx.x < 2) ((PG8_LAS unsigned*)(lds + BARST_OFF))[threadIdx.x] = 0u;
    __syncthreads();
    (void)xcd_barrier_post((unsigned*)(P.ws + WS_BAR), (volatile LAS unsigned*)(lds + BARST_OFF), (int)threadIdx.x);
#define GSYNC() do { XcdBarrier b_; b_.bar = (unsigned*)(WSP() + WS_BAR); b_.x = xb_xcc_id(); b_.st = (volatile LAS unsigned*)(lds + BARST_OFF); xcd_barrier(b_, NOWTID()); } while (0)
#define PH_COMMON int tid_ = NOWTID(); asm volatile("" : "+v"(tid_)); const int tid = tid_, lane = tid & 63, wave = __builtin_amdgcn_readfirstlane(tid >> 6); const int gw = bx * 8 + wave, NGW = G * 8; (void)lane; (void)gw; (void)NGW; unsigned char* ws = WSP(); (void)ws;

#ifndef SKIP_PRO
    { PH_COMMON
        pro::In I = load_in(lds); pro::Wts W;
        W.WGI = (bf16_t*)(ws + WS_WGI); W.WGO = (bf16_t*)(ws + WS_WGO); W.WKQ = (bf16_t*)(ws + WS_WKQ); W.WC1 = (bf16_t*)(ws + WS_WC1); W.WC2 = (bf16_t*)(ws + WS_WC2);
        W.WNO = (bf16_t*)(ws + WS_WNO); W.WUP = (bf16_t*)(ws + WS_WUP); W.WDN = (bf16_t*)(ws + WS_WDN); W.ROPE = (_Float16*)(ws + WS_ROPE); W.BIASC = (float*)(ws + WS_BIASC);
#ifdef REP_PRO
        pro::prologue(I, W, (bf16_t*)(ws + WS_XB), (float*)(ws + WS_RSS), lds, gw, NGW, lane, wave); __syncthreads();
#endif
        pro::prologue(I, W, (bf16_t*)(ws + WS_XB), (float*)(ws + WS_RSS), lds, gw, NGW, lane, wave); }
#endif
    if (G != 256) grid.sync(); else GSYNC();

#ifdef REP_SYNC
#pragma unroll 1
    for (int r = 0; r < REP_SYNC; ++r) GSYNC();
#endif
#ifndef SKIP_P1
    { unsigned char* ws = WSP();
        pg8::Gemm g = pg8::make_gemm((const bf16_t*)(ws + WS_XB), (const bf16_t*)(ws + WS_WGI), M_TOK, 3584, 1024, 1024, 1024);
        pg8::StaticOrder S; S.init(M_TOK, 3584, G, bx);
        epi::EpiGlaIn E{(bf16_t*)(ws + WS_GQ), (bf16_t*)(ws + WS_GK), (bf16_t*)(ws + WS_GV), (bf16_t*)(ws + WS_GR), (float*)(ws + WS_GG), (const float*)(ws + WS_RSS), INP(5)};
#ifdef REP_P1
        pg8::gemm_phase(lds, lds + EPI_OFF, g, S, E, NOWTID());
#endif
#ifdef REP_P1NULL
        { epi::EpiNull EN; pg8::gemm_phase(lds, lds + EPI_OFF, g, S, EN, NOWTID()); }
#endif
        pg8::gemm_phase(lds, lds + EPI_OFF, g, S, E, NOWTID());
    }
#endif
    GSYNC();
#ifndef SKIP_GLA
    { unsigned char* ws = WSP();
        float* SLOC = (float*)(ws + WS_BIG + 260 * MiB); float* DSEG = (float*)(ws + WS_BIG + 290 * MiB);
#ifdef REP_GLAA
        for (int un = bx; un < 256; un += G) if ((un & 3) < 3) gla::gla_unit<true>(un >> 4, (un >> 2) & 3, un & 3, (const bf16_t*)(ws + WS_GQ), (const bf16_t*)(ws + WS_GK), (const bf16_t*)(ws + WS_GV), (bf16_t*)(ws + WS_GV), (const bf16_t*)(ws + WS_GR), (const float*)(ws + WS_GG), INP(6), SLOC, DSEG, lds, NOWTID());
#endif
        for (int un = bx; un < 256; un += G) if ((un & 3) < 3) gla::gla_unit<true>(un >> 4, (un >> 2) & 3, un & 3, (const bf16_t*)(ws + WS_GQ), (const bf16_t*)(ws + WS_GK), (const bf16_t*)(ws + WS_GV), (bf16_t*)(ws + WS_GV), (const bf16_t*)(ws + WS_GR), (const float*)(ws + WS_GG), INP(6), SLOC, DSEG, lds, NOWTID());
    }
    GSYNC();
    { unsigned char* ws = WSP();
        float* SLOC = (float*)(ws + WS_BIG + 260 * MiB); float* DSEG = (float*)(ws + WS_BIG + 290 * MiB);
#ifdef REP_GLAB
        for (int un = bx; un < 256; un += G) gla::gla_unit<false>(un >> 4, (un >> 2) & 3, un & 3, (const bf16_t*)(ws + WS_GQ), (const bf16_t*)(ws + WS_GK), (const bf16_t*)(ws + WS_GV), (bf16_t*)(ws + WS_BIG + 300 * MiB), (const bf16_t*)(ws + WS_GR), (const float*)(ws + WS_GG), INP(6), SLOC, DSEG, lds, NOWTID());
#endif
        for (int un = bx; un < 256; un += G) gla::gla_unit<false>(un >> 4, (un >> 2) & 3, un & 3, (const bf16_t*)(ws + WS_GQ), (const bf16_t*)(ws + WS_GK), (const bf16_t*)(ws + WS_GV), (bf16_t*)(ws + WS_GV), (const bf16_t*)(ws + WS_GR), (const float*)(ws + WS_GG), INP(6), SLOC, DSEG, lds, NOWTID());
    }
#endif
    GSYNC();
#ifndef SKIP_P3
    { unsigned char* ws = WSP();
        pg8::Gemm g = pg8::make_gemm((const bf16_t*)(ws + WS_GV), (const bf16_t*)(ws + WS_WGO), M_TOK, 1024, 1024, 1024, 1024);
        pg8::StaticOrder S; S.init(M_TOK, 1024, G, bx);
        epi::EpiRes E{nullptr, (bf16_t*)(ws + WS_XB), (float*)(ws + WS_RSS) + 1 * M_TOK};
        pg8::gemm_phase(lds, lds + EPI_OFF, g, S, E, NOWTID());
    }
#endif
    GSYNC();
#pragma unroll 1
    for (int layer = 0; layer < 2; ++layer) {
        if (layer == 1) {
#ifndef SKIP_P7
            { unsigned char* ws = WSP();
                pg8::Gemm g = pg8::make_gemm((const bf16_t*)(ws + WS_XB), (const bf16_t*)(ws + WS_WKQ), M_TOK, 2816, 1024, 1024, 1024);
                pg8::StaticOrder S; S.init(M_TOK, 2816, G, bx);
                epi::EpiKvq E{(bf16_t*)(ws + WS_KV), (bf16_t*)(ws + WS_NQ), (bf16_t*)(ws + WS_NQR), (float*)(ws + WS_GATES), (const float*)(ws + WS_RSS) + 2 * M_TOK, (const _Float16*)(ws + WS_ROPE)};
#ifdef REP_P7
                pg8::gemm_phase(lds, lds + EPI_OFF, g, S, E, NOWTID());
#endif
                pg8::gemm_phase(lds, lds + EPI_OFF, g, S, E, NOWTID());
            }
#endif
            GSYNC();
#ifndef SKIP_P8
            { unsigned char* ws = WSP();
                pg8::Gemm g = pg8::make_gemm((const bf16_t*)(ws + WS_KV), (const bf16_t*)(ws + WS_WC1), 16384, 1024, 512, 1024, 2048);
                g.a_pn = 512 * 2; g.b_pn = 512 * 2; g.b_hi = (size_t)256 * 2048 * 2; g.b_split = 32;
                pg8::StaticOrder S; S.init(16384, 1024, G, bx);
                epi::EpiCmp E{(float*)(ws + WS_HP)};
#ifdef REP_P8
                pg8::gemm_phase(lds, lds + EPI_OFF, g, S, E, NOWTID());
#endif
                pg8::gemm_phase(lds, lds + EPI_OFF, g, S, E, NOWTID());
            }
#endif
            GSYNC();
#ifndef SKIP_P9
#ifdef REP_P9
            { PH_COMMON nsa::cmp_finalize((const float*)(ws + WS_HP), (const float*)(ws + WS_BIASC), (const bf16_t*)(ws + WS_WC2), (bf16_t*)(ws + WS_KCVC), wave * G + bx, NGW, lane); }
#endif
            { PH_COMMON nsa::cmp_finalize((const float*)(ws + WS_HP), (const float*)(ws + WS_BIASC), (const bf16_t*)(ws + WS_WC2), (bf16_t*)(ws + WS_KCVC), wave * G + bx, NGW, lane); }
#endif
            GSYNC();
#ifndef SKIP_ATTN
            { unsigned char* ws = WSP();
                nsa::AttnBufs T{ws};
#ifdef REP_ATTN
                for (int v_ = bx; v_ < 256; v_ += G) nsa::attn_block<REP_ATTN>(v_ >> 2, v_ & 3, T, lds, NOWTID());
#endif
                for (int v_ = bx; v_ < 256; v_ += G) nsa::attn_block(v_ >> 2, v_ & 3, T, lds, NOWTID());
            }
#endif
            GSYNC();
#ifndef SKIP_P11
            { unsigned char* ws = WSP();
                pg8::Gemm g = pg8::make_gemm((const bf16_t*)(ws + WS_OATT), (const bf16_t*)(ws + WS_WNO), M_TOK, 1024, 1024, 1024, 1024);
                pg8::StaticOrder S; S.init(M_TOK, 1024, G, bx);
                epi::EpiRes E{nullptr, (bf16_t*)(ws + WS_XB), (float*)(ws + WS_RSS) + 3 * M_TOK};
                pg8::gemm_phase(lds, lds + EPI_OFF, g, S, E, NOWTID());
            }
#endif
            GSYNC();
        }
#ifndef SKIP_UP
        { unsigned char* ws = WSP();
            const float* rss_in = (const float*)(ws + WS_RSS) + (layer == 0 ? 1 : 3) * M_TOK;
            const float* cw = INP(19) + (size_t)layer * 3 * 5632; const float* cb = INP(20) + (size_t)layer * 5632;
            pg8::Gemm g = pg8::make_gemm((const bf16_t*)(ws + WS_XB), (const bf16_t*)(ws + WS_WUP) + (size_t)layer * 5632 * 1024, M_TOK, 5632, 1024, 1024, 1024);
            pg8::StaticOrder S; S.init(M_TOK, 5632, G, bx);
            epi::EpiFfnUp E{(bf16_t*)(ws + WS_ACT), (float*)(ws + WS_HALO), rss_in, cw, cb};
#ifdef REP_UP
            pg8::gemm_phase(lds, lds + EPI_OFF, g, S, E, NOWTID());
#endif
#ifdef REP_UPNULL
            { epi::EpiNull EN; pg8::gemm_phase(lds, lds + EPI_OFF, g, S, EN, NOWTID()); }
#endif
            pg8::gemm_phase(lds, lds + EPI_OFF, g, S, E, NOWTID());
        }
#endif
        GSYNC();
#ifndef SKIP_FIX
        { PH_COMMON
            const float* cw = INP(19) + (size_t)layer * 3 * 5632; const float* cb = INP(20) + (size_t)layer * 5632;
            const float* HALO = (const float*)(ws + WS_HALO); bf16_t* ACT = (bf16_t*)(ws + WS_ACT);
#ifdef REP_FIX
            for (int rep_ = 0; rep_ < 2; ++rep_)
#endif
            for (int i = bx * 512 + tid; i < 128 * 2 * 704; i += G * 512) {
                const int fg = i % 704, pr = i / 704, r = pr & 1, pm = pr >> 1;
                if ((pm & 7) == 0) continue;
                const int f = 4 * fg, pn = f >> 7, cc = f & 127;
                const float* hc = HALO + ((size_t)(pm * 22 + pn) * 4) * 256 + cc; const float* hp = HALO + ((size_t)((pm - 1) * 22 + pn) * 4) * 256 + cc;
                const float* g0p = r == 0 ? hc : hc + 256; const float* g1p = r == 0 ? hp + 3 * 256 : hc; const float* g2p = r == 0 ? hp + 2 * 256 : hp + 3 * 256;
                const pro::f32x4 ug = *(const pro::f32x4*)g0p, ug1 = *(const pro::f32x4*)g1p, ug2 = *(const pro::f32x4*)g2p;
                const pro::f32x4 uv = *(const pro::f32x4*)(g0p + 128), uv1 = *(const pro::f32x4*)(g1p + 128), uv2 = *(const pro::f32x4*)(g2p + 128);
                const pro::f32x4 bg = *(const pro::f32x4*)(cb + f), wg0 = *(const pro::f32x4*)(cw + f), wg1 = *(const pro::f32x4*)(cw + 5632 + f), wg2 = *(const pro::f32x4*)(cw + 2 * 5632 + f);
                const pro::f32x4 bv = *(const pro::f32x4*)(cb + 2816 + f), wv0 = *(const pro::f32x4*)(cw + 2816 + f), wv1 = *(const pro::f32x4*)(cw + 5632 + 2816 + f), wv2 = *(const pro::f32x4*)(cw + 2 * 5632 + 2816 + f);
                const pro::f32x4 og = bg + wg0 * ug2 + wg1 * ug1 + wg2 * ug;
                const pro::f32x4 ov = bv + wv0 * uv2 + wv1 * uv1 + wv2 * uv;
                float a[4];
#pragma unroll
                for (int j = 0; j < 4; ++j) a[j] = og[j] * __builtin_amdgcn_rcpf(1.0f + __expf(-og[j])) * ov[j];
                pg8::u32x2 w; w.x = pg8::cvt_pk_bf16(a[0], a[1]); w.y = pg8::cvt_pk_bf16(a[2], a[3]);
                *(pg8::u32x2*)(ACT + (size_t)(pm * 256 + r) * 2816 + f) = w;
            }
        }
#endif
        GSYNC();
#ifndef SKIP_DOWN
        { unsigned char* ws = WSP(); float* out = OUTP();
            float* rss_out = (float*)(ws + WS_RSS) + (layer == 0 ? 2 : 4) * M_TOK;
            pg8::Gemm g = pg8::make_gemm((const bf16_t*)(ws + WS_ACT), (const bf16_t*)(ws + WS_WDN) + (size_t)layer * 1024 * 2816, M_TOK, 1024, 2816, 2816, 2816);
            pg8::StaticOrder S; S.init(M_TOK, 1024, G, bx);
            if (layer == 1 && G == 256) {
                epi::EpiResFinal EF{(const bf16_t*)(ws + WS_XB), out, INP(22), (unsigned*)(ws + WS_XSLOT), (unsigned*)(ws + WS_XCNT)};
                pg8::gemm_phase(lds, lds + EPI_OFF, g, S, EF, NOWTID());
            } else {
                epi::EpiRes E{layer == 1 ? out : nullptr, (bf16_t*)(ws + WS_XB), rss_out};
                pg8::gemm_phase(lds, lds + EPI_OFF, g, S, E, NOWTID());
            }
        }
#endif
        if (!(layer == 1 && G == 256)) GSYNC();
    }
    if (G != 256) { PH_COMMON
        const float* rss = (const float*)(ws + WS_RSS) + 4 * M_TOK; float* out = OUTP(); const float* norm_final = INP(22);
        for (int m = gw; m < M_TOK; m += NGW) {
            const float rs = rsqrtf(rss[m] * (1.0f / 1024.0f) + 1e-6f);
            pro::f32x4* xr = (pro::f32x4*)(out + (size_t)m * 1024) + lane; const pro::f32x4* gr = (const pro::f32x4*)norm_final + lane;
#if defined(DBG_GPROF)
            { const unsigned long long* dp = (const unsigned long long*)(ws + WS_BIG + (size_t)370 * 1048576); float tot = 0.f; for (int k = 0; k < 12; ++k) tot += (float)dp[k];
              const float ratio = (float)dp[DBG_GPROF] / tot; const float amp = 1.0f + sqrtf(ratio * 0.01f);
              for (int j = 0; j < 4; ++j) { const pro::f32x4 v = xr[64 * j], gg = gr[64 * j]; xr[64 * j] = v * rs * gg * amp; } }
#elif defined(DBG_PROF)
            { const unsigned long long* dp = (const unsigned long long*)(ws + (size_t)500 * 1048576); float tot = 0.f; for (int k = 0; k < 7; ++k) tot += (float)dp[k];
              const float ratio = (float)dp[DBG_PROF] / tot; const float amp = 1.0f + sqrtf(ratio * 0.01f);
              for (int j = 0; j < 4; ++j) { const pro::f32x4 v = xr[64 * j], gg = gr[64 * j]; xr[64 * j] = v * rs * gg * amp; } }
#else
#pragma unroll
            for (int j = 0; j < 4; ++j) { const pro::f32x4 v = xr[64 * j], gg = gr[64 * j]; xr[64 * j] = v * rs * gg; }
#endif
        }
    }
}

extern "C" void kernel_launch(void* const* d_in, const int* in_sizes, int n_in, void* d_out, int out_size, void* d_ws, size_t ws_size, hipStream_t stream) {
    static int grid = 0;
    if (grid == 0) {
        if (n_in != 23 || ws_size < WS_END) { fprintf(stderr, "kernel_launch: unexpected n_in %d or ws_size %zu (< %zu)\n", n_in, ws_size, (size_t)WS_END); grid = -1; return; }
        int dev = 0, cus = 0, per_cu = 0;
        (void)hipGetDevice(&dev);
        (void)hipDeviceGetAttribute(&cus, hipDeviceAttributeMultiprocessorCount, dev);
        (void)hipFuncSetAttribute((const void*)yoco_fwd, hipFuncAttributeMaxDynamicSharedMemorySize, LDS_BYTES);
        (void)hipOccupancyMaxActiveBlocksPerMultiprocessor(&per_cu, (const void*)yoco_fwd, 512, LDS_BYTES);
        if (per_cu < 1) { fprintf(stderr, "kernel_launch: occupancy query reports %d blocks per CU\n", per_cu); grid = -1; return; }
        grid = cus;
        if (grid > 256) grid = 256;
        grid &= ~7;
    }
    if (grid <= 0) return;
    (void)hipMemsetAsync((char*)d_ws + WS_RSS, 0, 1 * MiB, stream);
    Params p{};
    for (int i = 0; i < 23; ++i) p.in[i] = (const float*)d_in[i];
    p.out = (float*)d_out; p.ws = (unsigned char*)d_ws;
    void* args[] = {&p};
    hipError_t e = hipLaunchCooperativeKernel((void*)yoco_fwd, dim3(grid), dim3(512), args, LDS_BYTES, stream);
    if (e != hipSuccess) fprintf(stderr, "cooperative launch failed: %s (grid %d)\n", hipGetErrorString(e), grid);
}
```

```cpp
#include <hip/hip_runtime.h>
#include <hip/hip_cooperative_groups.h>
#include <cstdio>
#include <cstdint>
constexpr size_t MiB = 1u << 20;
constexpr int M_TOK = 32768;
constexpr size_t WS_RSS = 0;
constexpr size_t WS_BAR = 768 * 1024;
constexpr size_t WS_XCNT = 832 * 1024;
constexpr size_t WS_ROPE = 1 * MiB, WS_BIASC = 800 * 1024;
constexpr size_t WS_WGI = 2 * MiB, WS_WGO = 9 * MiB, WS_WKQ = 11 * MiB, WS_WC1 = 17 * MiB, WS_WC2 = 19 * MiB, WS_WNO = 20 * MiB, WS_WUP = 22 * MiB, WS_WDN = 44 * MiB;
constexpr size_t WS_WGT = 16 * MiB + 512 * 1024;
constexpr size_t WS_XB = 56 * MiB;
constexpr size_t WS_BIG = 120 * MiB;
constexpr size_t WS_GQ = WS_BIG, WS_GK = WS_BIG + 32 * MiB, WS_GV = WS_BIG + 64 * MiB, WS_GR = WS_BIG + 128 * MiB, WS_GG = WS_BIG + 192 * MiB;
constexpr size_t WS_ACT = WS_BIG, WS_HALO = WS_BIG + 176 * MiB;
constexpr size_t WS_KV = WS_BIG, WS_NQ = WS_BIG + 96 * MiB, WS_NQR = WS_BIG + 160 * MiB, WS_GATES = WS_BIG + 224 * MiB, WS_HP = WS_BIG + 230 * MiB, WS_KCVC = WS_BIG + 294 * MiB, WS_OATT = WS_BIG + 296 * MiB;
constexpr size_t WS_XSLOT = WS_BIG + 372 * MiB;
constexpr size_t WS_END = WS_BIG + 376 * MiB;
constexpr int LDS_BYTES = 160 * 1024, EPI_OFF = 131072;


#define LAS __attribute__((address_space(3)))
#define XB_TMO      128
#define XB_XCNT(j)  (256  + 64 * (j))
#define XB_XSUB(j)  (1280 + 64 * (j))
#define XB_XGEN(j)  (2304 + 64 * (j))
#define XB_TOP      3328
#define XB_TOPGEN   3392
#define XCD_BAR_WORDS 3456
#define XB_SPIN_CAP (1u << 18)

__device__ __forceinline__ unsigned xb_ld(unsigned* p)              { return __hip_atomic_load(p, __ATOMIC_RELAXED, __HIP_MEMORY_SCOPE_AGENT); }
__device__ __forceinline__ unsigned xb_add(unsigned* p, unsigned v) { return __hip_atomic_fetch_add(p, v, __ATOMIC_RELAXED, __HIP_MEMORY_SCOPE_AGENT); }
__device__ __forceinline__ unsigned xb_xcc_id() { return (unsigned)__builtin_amdgcn_s_getreg((3 << 11) | 20) & 0xFu; }
#define XB_SPIN(cond, bar) do { unsigned _sp = 0; while (cond) { __builtin_amdgcn_s_sleep(1); \
    if ((++_sp & 255u) == 0u) { if (xb_ld(&(bar)[XB_TMO])) break; if (_sp > XB_SPIN_CAP) { atomicAdd(&(bar)[XB_TMO], 1u); break; } } } } while (0)

struct XcdBarrier {
    unsigned* bar; unsigned x;
    volatile LAS unsigned* st;
};

__device__ __forceinline__ XcdBarrier xcd_barrier_post(unsigned* bar, volatile LAS unsigned* st, int tid) {
    XcdBarrier b; b.bar = bar; b.x = xb_xcc_id(); b.st = st;
    if (tid == 0) (void)xb_add(&bar[XB_XCNT(b.x)], 1u);
    return b;
}
__device__ __forceinline__ void xcd_barrier_complete(unsigned* bar, unsigned x, unsigned& nloc, unsigned& nx) {
    const unsigned G = gridDim.x * gridDim.y * gridDim.z;
    unsigned sum, cnt, mine, sp = 0u;
    for (;;) {
        sum = 0u; cnt = 0u; mine = 0u;
#pragma unroll
        for (unsigned j = 0; j < 16; ++j) { const unsigned c = xb_ld(&bar[XB_XCNT(j)]); sum += c; cnt += (c > 0u) ? 1u : 0u; mine = (j == x) ? c : mine; }
        if (sum == G) break;
        __builtin_amdgcn_s_sleep(1);
        if ((++sp & 255u) == 0u) { if (xb_ld(&bar[XB_TMO])) break; if (sp > XB_SPIN_CAP) { atomicAdd(&bar[XB_TMO], 1u); break; } }
    }
    nloc = mine > 0u ? mine : 1u; nx = cnt > 0u ? cnt : 1u;
}

__device__ __forceinline__ void xcd_barrier(const XcdBarrier& b, int tid) {
    asm volatile("s_waitcnt vmcnt(0)" ::: "memory");
    __syncthreads();
    if (tid == 0) {
        unsigned* bar = b.bar;
        __builtin_amdgcn_s_waitcnt(0);
        unsigned nloc = b.st[0], nx = b.st[1];
        if (nloc == 0u) { xcd_barrier_complete(bar, b.x, nloc, nx); b.st[0] = nloc; b.st[1] = nx; }
        const unsigned old = xb_add(&bar[XB_XSUB(b.x)], 1u);
        const unsigned gen = old / nloc;
        if (old + 1u == (gen + 1u) * nloc) {
            __builtin_amdgcn_fence(__ATOMIC_RELEASE, "agent");
            asm volatile("s_waitcnt vmcnt(0)" ::: "memory");
            const unsigned og = xb_add(&bar[XB_TOP], 1u);
            const unsigned tg = og / nx;
            if (og + 1u == (tg + 1u) * nx) xb_add(&bar[XB_TOPGEN], 1u);
            else XB_SPIN(xb_ld(&bar[XB_TOPGEN]) == tg, bar);
            __builtin_amdgcn_fence(__ATOMIC_ACQUIRE, "agent");
            xb_add(&bar[XB_XGEN(b.x)], 1u);
            asm volatile("s_waitcnt vmcnt(0)" ::: "memory");
        } else {
            XB_SPIN(xb_ld(&bar[XB_XGEN(b.x)]) == gen, bar);
            __builtin_amdgcn_fence(__ATOMIC_ACQUIRE, "agent");
            asm volatile("s_waitcnt vmcnt(0)" ::: "memory");
        }
    }
    __syncthreads();
}

__device__ __forceinline__ int lane_id() { return (int)__builtin_amdgcn_mbcnt_hi(~0u, __builtin_amdgcn_mbcnt_lo(~0u, 0u)); }
__device__ __forceinline__ int lane_id_fresh() { int l; asm volatile("v_mbcnt_lo_u32_b32 %0, -1, 0\n\tv_mbcnt_hi_u32_b32 %0, -1, %0" : "=v"(l)); return l; }
template <class T> __device__ __forceinline__ T dpp_xor1(T x) { return __builtin_bit_cast(T, __builtin_amdgcn_mov_dpp(__builtin_bit_cast(int, x), 0xB1, 0xf, 0xf, true)); }
template <class T> __device__ __forceinline__ T dpp_xor2(T x) { return __builtin_bit_cast(T, __builtin_amdgcn_mov_dpp(__builtin_bit_cast(int, x), 0x4E, 0xf, 0xf, true)); }
template <class T> __device__ __forceinline__ T dpp_hmirror(T x) { return __builtin_bit_cast(T, __builtin_amdgcn_mov_dpp(__builtin_bit_cast(int, x), 0x141, 0xf, 0xf, true)); }
template <class T> __device__ __forceinline__ T swz_xor16(T x) { return __builtin_bit_cast(T, __builtin_amdgcn_ds_swizzle(__builtin_bit_cast(int, x), 0x401F)); }
namespace pg8 {
#define PG8_LAS __attribute__((address_space(3)))
typedef unsigned short bf16_t;
typedef short bf16x8 __attribute__((ext_vector_type(8)));
typedef float f32x4 __attribute__((ext_vector_type(4)));
typedef float f32x2 __attribute__((ext_vector_type(2)));
typedef unsigned u32x4 __attribute__((ext_vector_type(4)));
typedef unsigned u32x2 __attribute__((ext_vector_type(2)));
constexpr int BM = 256, BK = 64, HALF = 128, HTB = HALF * BK * 2, STAGE_BYTES = 8 * HTB, NXCD = 8, WGM = 8;

__host__ __device__ __forceinline__ int lds_byte(int r, int c) { const int st = (r >> 4) * 2 + (c >> 5), rr = r & 15, cc = c & 31, ob = rr * 64 + cc * 2; return st * 1024 + (ob ^ (((ob >> 9) & 1) << 5)); }
__host__ __device__ __forceinline__ void stage_rc(int b, int& R, int& C) { const int st = b / 1024, sb = b % 1024, swz = sb ^ (((sb >> 9) & 1) << 5); R = (st >> 1) * 16 + swz / 64; C = (st & 1) * 32 + (swz % 64) / 2; }
__host__ __device__ __forceinline__ int perm32(int rho) { const int n = rho >> 4, i = rho & 15; return 8 * (i >> 2) + 4 * n + (i & 3); }

struct Unit { int pm, pn; };
struct Gemm { const bf16_t* A; const bf16_t* Bt; int M, N, K; int lda, ldb; size_t a_pm, a_pn, b_pn, b_hi; int b_split; };
__device__ __forceinline__ Gemm make_gemm(const bf16_t* A, const bf16_t* Bt, int M, int N, int K, int lda, int ldb) {
    Gemm g; g.A = A; g.Bt = Bt; g.M = M; g.N = N; g.K = K; g.lda = lda; g.ldb = ldb;
    g.a_pm = (size_t)BM * lda * 2; g.a_pn = 0; g.b_pn = (size_t)BM * ldb * 2; g.b_hi = 0; g.b_split = 0x7fffffff; return g;
}

struct StaticOrder {
    int nM, nN, nwg, G, c;
    __device__ void init(int M, int N, int G_, int c_) { nM = M / BM; nN = N / BM; nwg = nM * nN; G = G_; c = c_; }
    __device__ bool next(int i, Unit& u) const {
        const long L = (long)i * G + c; if (L >= nwg) return false;
        int wgid = (int)L; { const int q = nwg / NXCD, r = nwg % NXCD, xcd = wgid % NXCD, off = wgid / NXCD; wgid = (xcd < r ? xcd * (q + 1) : r * (q + 1) + (xcd - r) * q) + off; }
        const int nig = WGM * nN, gid = wgid / nig, fm = gid * WGM, gsz = (nM - fm) < WGM ? (nM - fm) : WGM;
        u.pm = fm + ((wgid % nig) % gsz); u.pn = (wgid % nig) / gsz; return true;
    }
};

__device__ __forceinline__ unsigned cvt_pk_bf16(float lo, float hi) {
    typedef __bf16 bf16x2_t __attribute__((ext_vector_type(2)));
    f32x2 v = {lo, hi}; bf16x2_t b = __builtin_convertvector(v, bf16x2_t); return __builtin_bit_cast(unsigned, b);
}

template <class Epi>
__device__ __forceinline__ void gemm_phase(PG8_LAS unsigned char* lds, PG8_LAS unsigned char* lds_epi, const Gemm g, const StaticOrder& S, const Epi& E, int tid0) {
    int tid_ = tid0; asm volatile("" : "+v"(tid_));
    const int tid = tid_, wid = __builtin_amdgcn_readfirstlane(tid >> 6), lane = tid & 63, wr = wid >> 2, wc = wid & 3, fr = lane & 15, fq = lane >> 4;
    const int K = g.K, nt = K / BK;
    unsigned voffA[2], voffB[2];
#pragma unroll
    for (int i = 0; i < 2; ++i) { int R, C; stage_rc(tid * 16 + i * 8192, R, C); const int Rb = (R & ~31) + perm32(R & 31);
        voffA[i] = (unsigned)(R * g.lda + C) * 2u; voffB[i] = (unsigned)(Rb * g.ldb + C) * 2u; }
    const size_t kstep = (size_t)(BK * 2);
    const size_t hstepA = (size_t)HALF * g.lda * 2, hstepB = (size_t)HALF * g.ldb * 2;
    const unsigned ldsw = (unsigned)wid * 1024u;
    const int aoff = lds_byte(wr * 64 + fr, fq * 8), boff = lds_byte(wc * 32 + fr, fq * 8);
#define PG8_SA(b, h) (((b) * 2 + (h)) * HTB)
#define PG8_SB(b, h) ((4 + (b) * 2 + (h)) * HTB)
#define PG8_STAGE(bufoff, gbase, voff) do { _Pragma("unroll") for (int _i = 0; _i < 2; ++_i) \
        __builtin_amdgcn_global_load_lds((const unsigned*)((const char*)(gbase) + (voff)[_i]), (PG8_LAS unsigned*)(lds + (bufoff) + ldsw + _i * 8192), 16, 0, 0); } while (0)
#define PG8_LDA(dst, b, h) do { _Pragma("unroll") for (int m = 0; m < 4; ++m) _Pragma("unroll") for (int k = 0; k < 2; ++k) dst[m][k] = *(const PG8_LAS bf16x8*)(lds + PG8_SA(b, h) + aoff + m * 2048 + k * 1024); } while (0)
#define PG8_LDB(dst, b, h) do { _Pragma("unroll") for (int n = 0; n < 2; ++n) _Pragma("unroll") for (int k = 0; k < 2; ++k) dst[n][k] = *(const PG8_LAS bf16x8*)(lds + PG8_SB(b, h) + boff + n * 2048 + k * 1024); } while (0)
#define PG8_MMA(ai, bj, At, Bt) do { __builtin_amdgcn_s_setprio(1); _Pragma("unroll") for (int m = 0; m < 4; ++m) _Pragma("unroll") for (int n = 0; n < 2; ++n) _Pragma("unroll") for (int k = 0; k < 2; ++k) \
        acc[ai][bj][m][n] = __builtin_amdgcn_mfma_f32_16x16x32_bf16(Bt[n][k], At[m][k], acc[ai][bj][m][n], 0, 0, 0); __builtin_amdgcn_s_setprio(0); } while (0)
#define PG8_WAIT_V(n) asm volatile("s_waitcnt vmcnt(" #n ")" ::: "memory")
#define PG8_WAIT_L(n) asm volatile("s_waitcnt lgkmcnt(" #n ")" ::: "memory")
#define PG8_BAR __builtin_amdgcn_s_barrier()
#define PG8_SCHED __builtin_amdgcn_sched_barrier(0)
    Unit cur, nxt; int ui = 0;
    if (!S.next(0, cur)) return;
    f32x4 acc[2][2][4][2];
#pragma unroll
    for (int a = 0; a < 2; ++a)
#pragma unroll
        for (int b = 0; b < 2; ++b)
#pragma unroll
            for (int m = 0; m < 4; ++m)
#pragma unroll
                for (int n = 0; n < 2; ++n) acc[a][b][m][n] = (f32x4){0.f, 0.f, 0.f, 0.f};
    bf16x8 At[4][2], B0[2][2], B1[2][2];
    const char* cA = (const char*)g.A + (size_t)cur.pm * g.a_pm + (size_t)cur.pn * g.a_pn;
    const char* cB = (const char*)g.Bt + (size_t)cur.pn * g.b_pn + (cur.pm >= g.b_split ? g.b_hi : (size_t)0);
    PG8_STAGE(PG8_SB(0, 0), cB, voffB); PG8_STAGE(PG8_SB(0, 1), cB + hstepB, voffB); PG8_STAGE(PG8_SA(0, 0), cA, voffA); PG8_STAGE(PG8_SA(0, 1), cA + hstepA, voffA);
    if (wr == 1) PG8_BAR;
    PG8_WAIT_V(2); PG8_BAR;
    PG8_STAGE(PG8_SB(1, 0), cB + kstep, voffB); PG8_STAGE(PG8_SA(1, 0), cA + kstep, voffA); PG8_STAGE(PG8_SB(1, 1), cB + hstepB + kstep, voffB);
    PG8_WAIT_V(6); PG8_BAR;
    for (;;) {
        const bool has_next = S.next(ui + 1, nxt);
        const char* nA = has_next ? (const char*)g.A + (size_t)nxt.pm * g.a_pm + (size_t)nxt.pn * g.a_pn : cA;
        const char* nB = has_next ? (const char*)g.Bt + (size_t)nxt.pn * g.b_pn + (nxt.pm >= g.b_split ? g.b_hi : (size_t)0) : cB;
        E.prefetch(cur, ui, lds_epi, wid, lane);
        for (int t = 0; t < nt; t += 2) {
            const bool last = (t == nt - 2);
            const char* a1 = cA + (size_t)(t + 1) * kstep;
            const char* a2 = last ? nA : cA + (size_t)(t + 2) * kstep; const char* b2 = last ? nB : cB + (size_t)(t + 2) * kstep;
            const char* a3 = a2 + kstep; const char* b3 = b2 + kstep;
            PG8_LDB(B0, 0, 0); PG8_LDB(B1, 0, 1); PG8_SCHED; PG8_LDA(At, 0, 0); PG8_STAGE(PG8_SA(1, 1), a1 + hstepA, voffA);
            PG8_WAIT_V(8); PG8_WAIT_L(0); PG8_BAR; PG8_MMA(0, 0, At, B0); PG8_MMA(0, 1, At, B1); PG8_BAR; PG8_SCHED;
            PG8_LDA(At, 0, 1); PG8_STAGE(PG8_SB(0, 0), b2, voffB); PG8_STAGE(PG8_SB(0, 1), b2 + hstepB, voffB); PG8_STAGE(PG8_SA(0, 0), a2, voffA);
            PG8_WAIT_V(8); PG8_WAIT_L(0); PG8_BAR; PG8_MMA(1, 0, At, B0); PG8_MMA(1, 1, At, B1); PG8_BAR; PG8_SCHED;
            PG8_LDB(B0, 1, 0); PG8_LDB(B1, 1, 1); PG8_SCHED; PG8_LDA(At, 1, 0); PG8_STAGE(PG8_SA(0, 1), a2 + hstepA, voffA);
            PG8_WAIT_V(8); PG8_WAIT_L(0); PG8_BAR; PG8_MMA(0, 0, At, B0); PG8_MMA(0, 1, At, B1); PG8_BAR; PG8_SCHED;
            PG8_LDA(At, 1, 1); PG8_STAGE(PG8_SB(1, 0), b3, voffB); PG8_STAGE(PG8_SB(1, 1), b3 + hstepB, voffB); PG8_STAGE(PG8_SA(1, 0), a3, voffA);
            PG8_WAIT_V(8); PG8_WAIT_L(0); PG8_BAR; PG8_MMA(1, 0, At, B0); PG8_MMA(1, 1, At, B1); PG8_BAR; PG8_SCHED;
        }
        if (wr == 0) PG8_BAR;
        E(acc, cur, ui, wr, wc, fr, fq, lds_epi);
        if (!has_next) break;
#pragma unroll
        for (int a = 0; a < 2; ++a)
#pragma unroll
            for (int b = 0; b < 2; ++b)
#pragma unroll
                for (int m = 0; m < 4; ++m)
#pragma unroll
                    for (int n = 0; n < 2; ++n) acc[a][b][m][n] = (f32x4){0.f, 0.f, 0.f, 0.f};
        cur = nxt; cA = nA; cB = nB; ++ui;
        if (wr == 1) PG8_BAR;
    }
    PG8_WAIT_V(0);
    PG8_BAR;
#undef PG8_SA
#undef PG8_SB
#undef PG8_STAGE
#undef PG8_LDA
#undef PG8_LDB
#undef PG8_MMA
#undef PG8_WAIT_V
#undef PG8_WAIT_L
#undef PG8_BAR
#undef PG8_SCHED
}
}
namespace epi {
using namespace pg8;
constexpr float EPS = 1e-6f;
__device__ __forceinline__ float rstd_of(float ss) { return rsqrtf(ss * (1.0f / 1024.0f) + EPS); }
__device__ __forceinline__ float sigmoidf_(float x) { return __builtin_amdgcn_rcpf(1.0f + __expf(-x)); }
__device__ __forceinline__ float siluf_(float x) { return x * __builtin_amdgcn_rcpf(1.0f + __expf(-x)); }
__device__ __forceinline__ u32x4 pack8(const f32x4& a, const f32x4& b) { u32x4 w; w.x = cvt_pk_bf16(a[0], a[1]); w.y = cvt_pk_bf16(a[2], a[3]); w.z = cvt_pk_bf16(b[0], b[1]); w.w = cvt_pk_bf16(b[2], b[3]); return w; }

constexpr int EC_OFF = 16384, EC_STRIDE = 6144;
__device__ __forceinline__ void dma16(const void* g, PG8_LAS unsigned char* l) { __builtin_amdgcn_global_load_lds((const unsigned*)g, (PG8_LAS unsigned*)l, 16, 0, 0); }
__device__ __forceinline__ void dma_rss(const float* rss, int pm, int ui, PG8_LAS unsigned char* le, int wid, int lane) {
    if (wid == 0) dma16(rss + pm * BM + 4 * lane, le + EC_OFF + (ui & 1) * EC_STRIDE);
}
struct EpiGlaIn {
    bf16_t* Q; bf16_t* Kk; bf16_t* V; bf16_t* R; _Float16* G; const float* rss; const float* b_alpha;
    __device__ __forceinline__ void prefetch(const Unit& u, int ui, PG8_LAS unsigned char* le, int wid, int lane) const { dma_rss(rss, u.pm, ui, le, wid, lane); }
    template <int CLS>
    __device__ __forceinline__ void tile(f32x4 (&acc)[2][2][4][2], bf16_t* dst, int pitch, float sc, int gcol0, int ui, int wr, int wc, int fr, int fq, int row0, PG8_LAS unsigned char* le) const {
        const int ct = wc * 32 + 8 * fq;
        f32x4 bb[2][2];
        if (CLS == 2) {
#pragma unroll
            for (int bj = 0; bj < 2; ++bj) { bb[bj][0] = *(const f32x4*)(b_alpha + gcol0 + bj * HALF + ct); bb[bj][1] = *(const f32x4*)(b_alpha + gcol0 + bj * HALF + ct + 4); }
        }
#pragma unroll
        for (int ai = 0; ai < 2; ++ai)
#pragma unroll
            for (int m = 0; m < 4; ++m) {
                const int row = row0 + ai * HALF + m * 16;
                const float rs = rstd_of(((const PG8_LAS float*)(le + EC_OFF + (ui & 1) * EC_STRIDE))[wr * 64 + fr + ai * HALF + m * 16]);
#pragma unroll
                for (int bj = 0; bj < 2; ++bj) {
                    f32x4 v0 = acc[ai][bj][m][0] * rs, v1 = acc[ai][bj][m][1] * rs;
                    const int c = bj * HALF + ct;
                    if (CLS == 0) { *(u32x4*)(dst + (size_t)row * pitch + c) = pack8(v0 * sc, v1 * sc); }
                    else if (CLS == 1) {
#pragma unroll
                        for (int j = 0; j < 4; ++j) { v0[j] = siluf_(v0[j]); v1[j] = siluf_(v1[j]); }
                        *(u32x4*)(dst + (size_t)row * pitch + c) = pack8(v0, v1); }
                    else {
                        f32x4 o0, o1;
#pragma unroll
                        for (int j = 0; j < 4; ++j) {
                            const float z0 = v0[j] + bb[bj][0][j], z1 = v1[j] + bb[bj][1][j];
                            o0[j] = (fminf(z0, 0.f) - __logf(1.0f + __expf(-fabsf(z0)))) * 0.0625f;
                            o1[j] = (fminf(z1, 0.f) - __logf(1.0f + __expf(-fabsf(z1)))) * 0.0625f; }
                        typedef _Float16 h8_t __attribute__((ext_vector_type(8))); h8_t hv;
#pragma unroll
                        for (int j = 0; j < 4; ++j) { hv[j] = (_Float16)o0[j]; hv[4 + j] = (_Float16)o1[j]; }
                        *(h8_t*)(G + (size_t)row * 512 + gcol0 + c) = hv; }
                }
            }
    }
    __device__ __forceinline__ void operator()(f32x4 (&acc)[2][2][4][2], const Unit& u, int ui, int wr, int wc, int fr, int fq, PG8_LAS unsigned char* le) const {
        asm volatile("" : "+v"(fr), "+v"(fq));
        const int pn = u.pn;
        const int row0 = u.pm * BM + wr * 64 + fr;
        if (pn < 8) {
            bf16_t* dst; int pitch; float sc = 1.0f;
            if (pn < 2) { dst = Q + pn * 256; pitch = 512; sc = 0.08838834764831845f; } else if (pn < 4) { dst = Kk + (pn - 2) * 256; pitch = 512; } else { dst = V + (pn - 4) * 256; pitch = 1024; }
            tile<0>(acc, dst, pitch, sc, 0, ui, wr, wc, fr, fq, row0, le);
        } else if (pn < 12) tile<1>(acc, R + (pn - 8) * 256, 1024, 1.0f, 0, ui, wr, wc, fr, fq, row0, le);
        else tile<2>(acc, nullptr, 0, 1.0f, (pn - 12) * 256, ui, wr, wc, fr, fq, row0, le);
    }
};

__device__ __forceinline__ void unpack8(const u32x4& w, f32x4& a, f32x4& b) {
    a[0] = __uint_as_float(w.x << 16); a[1] = __uint_as_float(w.x & 0xffff0000u); a[2] = __uint_as_float(w.y << 16); a[3] = __uint_as_float(w.y & 0xffff0000u);
    b[0] = __uint_as_float(w.z << 16); b[1] = __uint_as_float(w.z & 0xffff0000u); b[2] = __uint_as_float(w.w << 16); b[3] = __uint_as_float(w.w & 0xffff0000u);
}
struct EpiRes {
    float* xout; bf16_t* XB; float* rss;
    __device__ __forceinline__ void prefetch(const Unit&, int, PG8_LAS unsigned char*, int, int) const {}
    __device__ __forceinline__ void operator()(f32x4 (&acc)[2][2][4][2], const Unit& u, int ui, int wr, int wc, int fr, int fq, PG8_LAS unsigned char* le) const {
        asm volatile("" : "+v"(fr), "+v"(fq));
        const int row0 = u.pm * BM + wr * 64 + fr;
        const int col0 = u.pn * BM + wc * 32 + 8 * fq;
        u32x4 xb[2][4][2];
#pragma unroll
        for (int ai = 0; ai < 2; ++ai)
#pragma unroll
            for (int m = 0; m < 4; ++m)
#pragma unroll
                for (int bj = 0; bj < 2; ++bj) xb[ai][m][bj] = *(const u32x4*)(XB + (size_t)(row0 + ai * HALF + m * 16) * 1024 + col0 + bj * HALF);
#pragma unroll
        for (int ai = 0; ai < 2; ++ai)
#pragma unroll
            for (int m = 0; m < 4; ++m) {
                const int row = row0 + ai * HALF + m * 16;
                float ss = 0.f;
#pragma unroll
                for (int bj = 0; bj < 2; ++bj) {
                    const size_t off = (size_t)row * 1024 + col0 + bj * HALF;
                    f32x4 x0, x1; unpack8(xb[ai][m][bj], x0, x1);
                    const f32x4 v0 = x0 + acc[ai][bj][m][0], v1 = x1 + acc[ai][bj][m][1];
                    if (xout) { *(f32x4*)(xout + off) = v0; *(f32x4*)(xout + off + 4) = v1; }
                    *(u32x4*)(XB + off) = pack8(v0, v1);
                    ss += (v0[0] * v0[0] + v0[1] * v0[1]) + (v0[2] * v0[2] + v0[3] * v0[3]) + (v1[0] * v1[0] + v1[1] * v1[1]) + (v1[2] * v1[2] + v1[3] * v1[3]);
                }
                ss += swz_xor16(ss); { auto rr_ = __builtin_amdgcn_permlane32_swap(__float_as_uint(ss), __float_as_uint(ss), false, false); ss = __uint_as_float(rr_[0]) + __uint_as_float(rr_[1]); }
                if (fq == 0) atomicAdd(rss + row, ss);
            }
    }
};

__device__ __forceinline__ float dpp_ror1(float x) { return __builtin_bit_cast(float, __builtin_amdgcn_mov_dpp(__builtin_bit_cast(int, x), 0x121, 0xf, 0xf, true)); }
__device__ __forceinline__ float dpp_ror2(float x) { return __builtin_bit_cast(float, __builtin_amdgcn_mov_dpp(__builtin_bit_cast(int, x), 0x122, 0xf, 0xf, true)); }
constexpr int FF = 2816;
struct EpiFfnUp {
    bf16_t* ACT; float* HALO; const float* rss; const float* cw; const float* cb;
    __device__ __forceinline__ void prefetch(const Unit& u, int ui, PG8_LAS unsigned char* le, int wid, int lane) const {
        dma_rss(rss, u.pm, ui, le, wid, lane);
        if (wid >= 1 && wid <= 4) { const int k = wid - 1; const float* src = (k == 0 ? cb : cw + (k - 1) * 2 * FF) + u.pn * 128 + ((lane < 32) ? 4 * lane : FF + 4 * (lane - 32));
            dma16(src, le + EC_OFF + (ui & 1) * EC_STRIDE + 1024 + k * 1024); }
    }
    __device__ __forceinline__ void operator()(f32x4 (&acc)[2][2][4][2], const Unit& u, int ui, int wr, int wc, int fr, int fq, PG8_LAS unsigned char* le) const {
        asm volatile("" : "+v"(fr), "+v"(fq));
        const int row0 = u.pm * BM + wr * 64 + fr;
        const PG8_LAS float* EC = (const PG8_LAS float*)(le + EC_OFF + (ui & 1) * EC_STRIDE);
#pragma unroll
        for (int ai = 0; ai < 2; ++ai)
#pragma unroll
            for (int m = 0; m < 4; ++m) {
                const float rs = rstd_of(EC[wr * 64 + fr + ai * HALF + m * 16]);
#pragma unroll
                for (int bj = 0; bj < 2; ++bj) { acc[ai][bj][m][0] = acc[ai][bj][m][0] * rs; acc[ai][bj][m][1] = acc[ai][bj][m][1] * rs; }
            }
        PG8_LAS float* HL = (PG8_LAS float*)le + (ui & 1) * 2048;
        if (fr >= 14) {
#pragma unroll
            for (int ai = 0; ai < 2; ++ai)
#pragma unroll
                for (int bj = 0; bj < 2; ++bj)
#pragma unroll
                    for (int n = 0; n < 2; ++n)
                        *(PG8_LAS f32x4*)(HL + ((((wr * 4 + wc) * 2 + ai) * 2 + (fr - 14)) * 64) + bj * 32 + fq * 8 + n * 4) = acc[ai][bj][3][n];
        }
        {
            float* hb = HALO + ((size_t)(u.pm * 22 + u.pn) * 4) * 256 + wc * 32 + fq * 8;
            if (wr == 0 && fr < 2) {
#pragma unroll
                for (int bj = 0; bj < 2; ++bj)
#pragma unroll
                    for (int n = 0; n < 2; ++n) *(f32x4*)(hb + fr * 256 + bj * HALF + n * 4) = acc[0][bj][0][n];
            }
            if (wr == 1 && fr >= 14) {
#pragma unroll
                for (int bj = 0; bj < 2; ++bj)
#pragma unroll
                    for (int n = 0; n < 2; ++n) *(f32x4*)(hb + (fr - 12) * 256 + bj * HALF + n * 4) = acc[1][bj][3][n];
            }
        }
        asm volatile("s_waitcnt lgkmcnt(0)" ::: "memory"); __builtin_amdgcn_s_barrier(); asm volatile("" ::: "memory");
        const bool seq_start = (u.pm & 7) == 0;
        const int cc0 = wc * 32 + fq * 8;
        const bool is15 = (fr == 15), ge14 = (fr >= 14);
        const PG8_LAS float* WB = EC + 256 + cc0;
#pragma unroll
        for (int ai = 0; ai < 2; ++ai) {
            f32x4 pg[2], pv[2];
            if (ai == 0 && wr == 0) { pg[0] = pg[1] = pv[0] = pv[1] = (f32x4){0.f, 0.f, 0.f, 0.f}; }
            else {
                const int swr = (ai == 1 && wr == 1) ? 0 : (ai == 0 ? 0 : 1), sai = (ai == 1 && wr == 1) ? 1 : 0;
                const PG8_LAS float* hp = HL + (((swr * 4 + wc) * 2 + sai) * 2 + (is15 ? 1 : 0)) * 64 + fq * 8;
                pg[0] = *(const PG8_LAS f32x4*)(hp); pg[1] = *(const PG8_LAS f32x4*)(hp + 4); pv[0] = *(const PG8_LAS f32x4*)(hp + 32); pv[1] = *(const PG8_LAS f32x4*)(hp + 36);
            }
#pragma unroll
            for (int m = 0; m < 4; ++m) {
                const int row = row0 + ai * HALF + m * 16;
                u32x4 w;
#pragma unroll
                for (int n = 0; n < 2; ++n) {
                    const f32x4 bg = *(const PG8_LAS f32x4*)(WB + 4 * n), bv = *(const PG8_LAS f32x4*)(WB + 128 + 4 * n);
                    const f32x4 g0 = *(const PG8_LAS f32x4*)(WB + 256 + 4 * n), w0 = *(const PG8_LAS f32x4*)(WB + 256 + 128 + 4 * n);
                    const f32x4 g1 = *(const PG8_LAS f32x4*)(WB + 512 + 4 * n), w1 = *(const PG8_LAS f32x4*)(WB + 512 + 128 + 4 * n);
                    const f32x4 g2 = *(const PG8_LAS f32x4*)(WB + 768 + 4 * n), w2 = *(const PG8_LAS f32x4*)(WB + 768 + 128 + 4 * n);
                    const f32x4 xg = acc[ai][0][m][n], xv = acc[ai][1][m][n];
                    f32x4 g1s, g2s, v1s, v2s;
#pragma unroll
                    for (int j = 0; j < 4; ++j) {
                        g1s[j] = dpp_ror1(is15 ? pg[n][j] : xg[j]); g2s[j] = dpp_ror2(ge14 ? pg[n][j] : xg[j]);
                        v1s[j] = dpp_ror1(is15 ? pv[n][j] : xv[j]); v2s[j] = dpp_ror2(ge14 ? pv[n][j] : xv[j]);
                    }
                    const f32x4 og = bg + g0 * g2s + g1 * g1s + g2 * xg;
                    const f32x4 ov = bv + w0 * v2s + w1 * v1s + w2 * xv;
                    f32x4 e;
#pragma unroll
                    for (int j = 0; j < 4; ++j) e[j] = __builtin_amdgcn_rcpf(1.0f + __builtin_amdgcn_exp2f(og[j] * -1.4426950408889634f));
                    const f32x4 a = og * e * ov;
                    if (n == 0) { w.x = cvt_pk_bf16(a[0], a[1]); w.y = cvt_pk_bf16(a[2], a[3]); } else { w.z = cvt_pk_bf16(a[0], a[1]); w.w = cvt_pk_bf16(a[2], a[3]); }
                    pg[n] = xg; pv[n] = xv;
                }
                const bool skip = (ai == 0 && wr == 0 && m == 0 && fr < 2 && !seq_start);
                if (!skip) *(u32x4*)(ACT + (size_t)row * FF + u.pn * 128 + cc0) = w;
            }
        }
    }
};

struct EpiKvq {
    bf16_t* KV; bf16_t* Q; bf16_t* QR; float* GATES; const float* rss; const _Float16* rope;
    __device__ __forceinline__ void prefetch(const Unit& u, int ui, PG8_LAS unsigned char* le, int wid, int lane) const { dma_rss(rss, u.pm, ui, le, wid, lane); }
    template <bool ISQ>
    __device__ __forceinline__ void rope_tile(f32x4 (&acc)[2][2][4][2], int pn, int ui, int wr, int wc, int fr, int fq, int row0, PG8_LAS unsigned char* le) const {
        const float C2 = 0.125f * 1.4426950408889634f;
        u32x4 rc[8][2];
#pragma unroll
        for (int i = 0; i < 8; ++i) { const int row = row0 + (i >> 2) * HALF + (i & 3) * 16; const _Float16* rp = rope + ((size_t)(row & 2047) * 32 + 8 * fq) * 2;
            rc[i][0] = *(const u32x4*)rp; rc[i][1] = *(const u32x4*)(rp + 8); }
#pragma unroll
        for (int i = 0; i < 8; ++i) { const int ai = i >> 2, m = i & 3;
            const int row = row0 + ai * HALF + m * 16;
            const int b = row >> 11, s = row & 2047;
            const float rs = rstd_of(((const PG8_LAS float*)(le + EC_OFF + (ui & 1) * EC_STRIDE))[wr * 64 + fr + ai * HALF + m * 16]);
            const f32x4 lo0 = acc[ai][0][m][0] * rs, lo1 = acc[ai][0][m][1] * rs;
            const f32x4 hi0 = acc[ai][1][m][0] * rs, hi1 = acc[ai][1][m][1] * rs;
            typedef _Float16 h2_t __attribute__((ext_vector_type(2)));
            float cs[8], sn[8];
#pragma unroll
            for (int j = 0; j < 4; ++j) { const unsigned wa_ = rc[i][0][j], wc_ = rc[i][1][j];
                const h2_t a = __builtin_bit_cast(h2_t, wa_), c = __builtin_bit_cast(h2_t, wc_);
                cs[j] = (float)a[0]; sn[j] = (float)a[1]; cs[4 + j] = (float)c[0]; sn[4 + j] = (float)c[1]; }
            f32x4 rl0, rl1, rh0, rh1;
#pragma unroll
            for (int j = 0; j < 4; ++j) {
                rl0[j] = lo0[j] * cs[j] - hi0[j] * sn[j]; rh0[j] = lo0[j] * sn[j] + hi0[j] * cs[j];
                rl1[j] = lo1[j] * cs[4 + j] - hi1[j] * sn[4 + j]; rh1[j] = lo1[j] * sn[4 + j] + hi1[j] * cs[4 + j];
            }
            if (!ISQ) {
                bf16_t* p = KV + ((((size_t)pn * 16 + b) * 4 + wc) * 2048 + s) * 64 + 8 * fq;
                *(u32x4*)(p) = pack8(rl0, rl1); *(u32x4*)(p + 32) = pack8(rh0, rh1);
            } else {
                const int h = (pn - 6) * 4 + wc;
                const size_t o = (((size_t)b * 16 + h) * 2048 + s) * 64 + 8 * fq;
                *(u32x4*)(Q + o) = pack8(lo0 * C2, lo1 * C2); *(u32x4*)(Q + o + 32) = pack8(hi0 * C2, hi1 * C2);
            }
        }
    }
    __device__ __forceinline__ void operator()(f32x4 (&acc)[2][2][4][2], const Unit& u, int ui, int wr, int wc, int fr, int fq, PG8_LAS unsigned char* le) const {
        asm volatile("" : "+v"(fr), "+v"(fq));
        const int pn = u.pn;
        const int row0 = u.pm * BM + wr * 64 + fr;
        if (pn >= 6 && pn < 10) { rope_tile<true>(acc, pn, ui, wr, wc, fr, fq, row0, le); return; }
        if (pn == 2 || pn == 4) { rope_tile<false>(acc, pn, ui, wr, wc, fr, fq, row0, le); return; }
#pragma unroll
        for (int ai = 0; ai < 2; ++ai)
#pragma unroll
            for (int m = 0; m < 4; ++m) {
                const int row = row0 + ai * HALF + m * 16;
                const int b = row >> 11, s = row & 2047;
                const float rs = rstd_of(((const PG8_LAS float*)(le + EC_OFF + (ui & 1) * EC_STRIDE))[wr * 64 + fr + ai * HALF + m * 16]);
                f32x4 lo0 = acc[ai][0][m][0] * rs, lo1 = acc[ai][0][m][1] * rs;
                f32x4 hi0 = acc[ai][1][m][0] * rs, hi1 = acc[ai][1][m][1] * rs;
                if (pn == 10) {
                    if (wc == 0) {
                        float* gp = GATES + (size_t)row * 48 + 8 * fq;
#pragma unroll
                        for (int j = 0; j < 4; ++j) { lo0[j] = sigmoidf_(lo0[j]); lo1[j] = sigmoidf_(lo1[j]); hi0[j] = sigmoidf_(hi0[j]); hi1[j] = sigmoidf_(hi1[j]); }
                        *(f32x4*)(gp) = lo0; *(f32x4*)(gp + 4) = lo1;
                        if (fq < 2) { *(f32x4*)(gp + 32) = hi0; *(f32x4*)(gp + 36) = hi1; }
                    }
                    continue;
                }
                bf16_t* p = KV + ((((size_t)pn * 16 + b) * 4 + wc) * 2048 + s) * 64 + 8 * fq;
                *(u32x4*)(p) = pack8(lo0, lo1); *(u32x4*)(p + 32) = pack8(hi0, hi1);
            }
    }
};

struct EpiCmp {
    bf16_t* HP;
    __device__ __forceinline__ void prefetch(const Unit&, int, PG8_LAS unsigned char*, int, int) const {}
    __device__ __forceinline__ void operator()(f32x4 (&acc)[2][2][4][2], const Unit& u, int ui, int wr, int wc, int fr, int fq, PG8_LAS unsigned char* le) const {
        asm volatile("" : "+v"(fr), "+v"(fq));
        const int row0 = u.pm * BM + wr * 64 + fr;
        bf16_t* base = HP + (size_t)u.pn * 16384 * 256;
#pragma unroll
        for (int ai = 0; ai < 2; ++ai)
#pragma unroll
            for (int m = 0; m < 4; ++m) {
                bf16_t* rp = base + (size_t)(row0 + ai * HALF + m * 16) * 256 + wc * 32 + 8 * fq;
#pragma unroll
                for (int bj = 0; bj < 2; ++bj) *(u32x4*)(rp + bj * HALF) = pack8(acc[ai][bj][m][0], acc[ai][bj][m][1]);
            }
    }
};

struct EpiResFinal {
    const bf16_t* XB; float* xout; const float* gfin; unsigned* slots; unsigned* cnt;
    __device__ __forceinline__ void prefetch(const Unit&, int, PG8_LAS unsigned char*, int, int) const {}
    __device__ __forceinline__ void operator()(f32x4 (&acc)[2][2][4][2], const Unit& u, int ui, int wr, int wc, int fr, int fq, PG8_LAS unsigned char* le) const {
        asm volatile("" : "+v"(fr), "+v"(fq));
        const int row0 = u.pm * BM + wr * 64 + fr;
        const int col0 = u.pn * BM + wc * 32 + 8 * fq;
        PG8_LAS float* Pt = (PG8_LAS float*)(le + EC_OFF);
        PG8_LAS float* St = (PG8_LAS float*)(le + EC_OFF + 4096);
#pragma unroll
        for (int ai = 0; ai < 2; ++ai)
#pragma unroll
            for (int m = 0; m < 4; ++m) {
                const int row = row0 + ai * HALF + m * 16;
                float ss = 0.f;
#pragma unroll
                for (int bj = 0; bj < 2; ++bj) {
                    const size_t off = (size_t)row * 1024 + col0 + bj * HALF;
                    f32x4 x0, x1; unpack8(*(const u32x4*)(XB + off), x0, x1);
                    const f32x4 v0 = x0 + acc[ai][bj][m][0], v1 = x1 + acc[ai][bj][m][1];
                    acc[ai][bj][m][0] = v0; acc[ai][bj][m][1] = v1;
                    ss += (v0[0] * v0[0] + v0[1] * v0[1]) + (v0[2] * v0[2] + v0[3] * v0[3]) + (v1[0] * v1[0] + v1[1] * v1[1]) + (v1[2] * v1[2] + v1[3] * v1[3]);
                }
                ss += swz_xor16(ss); { auto rr_ = __builtin_amdgcn_permlane32_swap(__float_as_uint(ss), __float_as_uint(ss), false, false); ss = __uint_as_float(rr_[0]) + __uint_as_float(rr_[1]); }
                if (fq == 0) Pt[(ai * HALF + wr * 64 + m * 16 + fr) * 4 + wc] = ss;
            }
        asm volatile("s_waitcnt lgkmcnt(0)" ::: "memory"); __builtin_amdgcn_s_barrier(); asm volatile("" ::: "memory");
        const int wid = wr * 4 + wc, lane = fq * 16 + fr;
        const int prow = wid * 32 + (lane & 31);
        if (lane < 32) {
            const f32x4 p4 = *(const PG8_LAS f32x4*)(Pt + prow * 4);
            const float t = (p4[0] + p4[1]) + (p4[2] + p4[3]);
            __hip_atomic_store(slots + ((size_t)(u.pm * BM + prow) * 4 + u.pn), __float_as_uint(t), __ATOMIC_RELAXED, __HIP_MEMORY_SCOPE_AGENT);
        }
        asm volatile("s_waitcnt vmcnt(0)" ::: "memory");
        if (lane == 0) __hip_atomic_fetch_add(cnt + 64 * u.pm, 1u, __ATOMIC_RELAXED, __HIP_MEMORY_SCOPE_AGENT);
        if (wid == 0) {
            unsigned sp = 0;
            while ((unsigned)__builtin_amdgcn_readfirstlane((int)__hip_atomic_load(cnt + 64 * u.pm, __ATOMIC_RELAXED, __HIP_MEMORY_SCOPE_AGENT)) < 32u) { __builtin_amdgcn_s_sleep(2); if (++sp > (1u << 20)) break; }
            __builtin_amdgcn_fence(__ATOMIC_ACQUIRE, "agent");
        }
        asm volatile("s_waitcnt vmcnt(0) lgkmcnt(0)" ::: "memory"); __builtin_amdgcn_s_barrier(); asm volatile("" ::: "memory");
        if (lane < 32) {
            const unsigned* sl = slots + (size_t)(u.pm * BM + prow) * 4; float t = 0.f;
#pragma unroll
            for (int k = 0; k < 4; ++k) t += __uint_as_float(__hip_atomic_load(sl + k, __ATOMIC_RELAXED, __HIP_MEMORY_SCOPE_AGENT));
            St[prow] = rsqrtf(t * (1.0f / 1024.0f) + EPS);
        }
        asm volatile("s_waitcnt vmcnt(0) lgkmcnt(0)" ::: "memory"); __builtin_amdgcn_s_barrier(); asm volatile("" ::: "memory");
#pragma unroll
        for (int bj = 0; bj < 2; ++bj) {
            const f32x4 g0 = *(const f32x4*)(gfin + col0 + bj * HALF), g1 = *(const f32x4*)(gfin + col0 + bj * HALF + 4);
#pragma unroll
            for (int ai = 0; ai < 2; ++ai)
#pragma unroll
                for (int m = 0; m < 4; ++m) {
                    const float rs = St[ai * HALF + wr * 64 + m * 16 + fr];
                    const size_t off = (size_t)(row0 + ai * HALF + m * 16) * 1024 + col0 + bj * HALF;
                    *(f32x4*)(xout + off) = acc[ai][bj][m][0] * rs * g0; *(f32x4*)(xout + off + 4) = acc[ai][bj][m][1] * rs * g1;
                }
        }
        asm volatile("s_waitcnt lgkmcnt(0)" ::: "memory"); __builtin_amdgcn_s_barrier(); asm volatile("" ::: "memory");
    }
};

struct EpiNull {
    __device__ __forceinline__ void prefetch(const Unit&, int, PG8_LAS unsigned char*, int, int) const {}
    __device__ __forceinline__ void operator()(f32x4 (&acc)[2][2][4][2], const Unit& u, int ui, int wr, int wc, int fr, int fq, PG8_LAS unsigned char* le) const {
#pragma unroll
        for (int ai = 0; ai < 2; ++ai)
#pragma unroll
            for (int bj = 0; bj < 2; ++bj)
#pragma unroll
                for (int m = 0; m < 4; ++m) { asm volatile("" :: "v"(acc[ai][bj][m][0]), "v"(acc[ai][bj][m][1])); }
    }
};
}
namespace pro {
typedef unsigned short bf16_t;
typedef unsigned v4u __attribute__((ext_vector_type(4)));
typedef float f32x4 __attribute__((ext_vector_type(4)));
#define LAS3 __attribute__((address_space(3)))
__device__ __forceinline__ unsigned f2bf(float f) { unsigned u = __builtin_bit_cast(unsigned, f); return (u + 0x7fffu + ((u >> 16) & 1u)) >> 16; }
__device__ __forceinline__ unsigned pk2(float lo, float hi) { return f2bf(lo) | (f2bf(hi) << 16); }

struct In {
    const float *x, *norm_mix, *norm_ffn, *gla_w_in, *gla_w_alpha_up, *gla_b_alpha, *gla_norm, *gla_w_o, *kv_norm, *nsa_w_kv, *cmp_pe_k, *cmp_pe_v,
        *cmp_k_w1, *cmp_k_w2, *cmp_v_w1, *cmp_v_w2, *nsa_w_in, *nsa_w_o, *ffn_w_up, *ffn_conv_w, *ffn_conv_b, *ffn_w_down, *norm_final;
};
struct Wts { bf16_t *WGI, *WGO, *WKQ, *WC1, *WC2, *WNO, *WUP, *WDN, *WGT; _Float16* ROPE; float* BIASC; };

__device__ __forceinline__ void transpose_item(const float* W, int ldw, int scol0, int nvalid, const float* gain, bf16_t* WT, int K, int drow0, int k0, LAS3 float* scr, int lane) {
    const int kr = lane >> 3, nc = (lane & 7) * 4;
    f32x4 v[8];
#pragma unroll
    for (int i = 0; i < 8; ++i) { const int kk = 8 * i + kr;
        v[i] = (nc < nvalid) ? __builtin_nontemporal_load((const f32x4*)(W + (size_t)(k0 + kk) * ldw + scol0 + nc)) : (f32x4){0.f, 0.f, 0.f, 0.f};
        if (gain) v[i] = v[i] * gain[k0 + kk]; }
#pragma unroll
    for (int i = 0; i < 8; ++i) { const int kk = 8 * i + kr; LAS3 float* d = scr + kk * 33 + nc; d[0] = v[i].x; d[1] = v[i].y; d[2] = v[i].z; d[3] = v[i].w; }
    asm volatile("s_waitcnt lgkmcnt(0)" ::: "memory");
    const int c = lane & 7;
#pragma unroll
    for (int j = 0; j < 4; ++j) { const int nn = (lane >> 3) + 8 * j; const LAS3 float* s = scr + (8 * c) * 33 + nn;
        v4u o; o.x = pk2(s[0 * 33], s[1 * 33]); o.y = pk2(s[2 * 33], s[3 * 33]); o.z = pk2(s[4 * 33], s[5 * 33]); o.w = pk2(s[6 * 33], s[7 * 33]);
        *(v4u*)(WT + (size_t)(drow0 + nn) * K + k0 + 8 * c) = o; }
    asm volatile("s_waitcnt lgkmcnt(0)" ::: "memory");
}
__device__ __forceinline__ void weff_item(const In& I, bf16_t* WT, int nb, int k0, LAS3 float* scr, int lane) {
    const int n = lane & 31, ng = 32 * nb + n;
    LAS3 float* As = scr + 64 * 33;
    const float* arow = I.gla_w_in + (size_t)(k0 + lane) * 3088 + 3072;
    f32x4 a4[4];
#pragma unroll
    for (int j = 0; j < 4; ++j) a4[j] = *(const f32x4*)(arow + 4 * j);
    const float gk = I.norm_mix[k0 + lane];
    float wa[16];
#pragma unroll
    for (int r = 0; r < 16; ++r) wa[r] = I.gla_w_alpha_up[r * 512 + ng];
#pragma unroll
    for (int j = 0; j < 4; ++j) *(LAS3 f32x4*)(As + lane * 16 + 4 * j) = a4[j] * gk;
    asm volatile("s_waitcnt lgkmcnt(0)" ::: "memory");
#pragma unroll 4
    for (int i = 0; i < 32; ++i) { const int kk = 2 * i + (lane >> 5);
        const LAS3 f32x4* ar = (const LAS3 f32x4*)(As + kk * 16);
        float v = 0.f;
#pragma unroll
        for (int j = 0; j < 4; ++j) { const f32x4 t = ar[j]; v += t[0] * wa[4 * j] + t[1] * wa[4 * j + 1] + t[2] * wa[4 * j + 2] + t[3] * wa[4 * j + 3]; }
        scr[kk * 33 + n] = v; }
    asm volatile("s_waitcnt lgkmcnt(0)" ::: "memory");
    const int c = lane & 7;
#pragma unroll
    for (int j = 0; j < 4; ++j) { const int nn = (lane >> 3) + 8 * j; const LAS3 float* s = scr + (8 * c) * 33 + nn;
        v4u o; o.x = pk2(s[0 * 33], s[1 * 33]); o.y = pk2(s[2 * 33], s[3 * 33]); o.z = pk2(s[4 * 33], s[5 * 33]); o.w = pk2(s[6 * 33], s[7 * 33]);
        *(v4u*)(WT + (size_t)(3072 + 32 * nb + nn) * 1024 + k0 + 8 * c) = o; }
    asm volatile("s_waitcnt lgkmcnt(0)" ::: "memory");
}

__device__ __forceinline__ void prologue(const In& I, const Wts& W, bf16_t* XB, float* RSS0, LAS3 unsigned char* lds, int gw, int NGW, int lane, int wave) {
    LAS3 float* scr = (LAS3 float*)(lds + wave * 16384);
    constexpr int I0 = 16 * 96, I1 = 16 * 16, I2 = 16 * 32, I3 = 16 * 80, I3G = 16 * 2, I4 = 32 * 8, I6 = 4 * 2, I8 = 16 * 32, I9 = 16 * 176, I11 = 44 * 32;
    constexpr int NIT = I0 + I1 + I2 + I3 + I3G + 2 * I4 + 2 * I6 + I8 + 2 * I9 + 2 * I11;
    for (int it = gw; it < NIT; it += NGW) {
        int r = it;
        if (r < I0) { const int kb = r / 96, nb = r % 96; transpose_item(I.gla_w_in, 3088, 32 * nb, 32, I.norm_mix, W.WGI, 1024, 32 * nb, 64 * kb, scr, lane); continue; } r -= I0;
        if (r < I1) { const int kb = r / 16, nb = r % 16; weff_item(I, W.WGI, nb, 64 * kb, scr, lane); continue; } r -= I1;
        if (r < I2) { const int kb = r / 32, nb = r % 32; transpose_item(I.gla_w_o, 1024, 32 * nb, 32, I.gla_norm, W.WGO, 1024, 32 * nb, 64 * kb, scr, lane);   continue; } r -= I2;
        if (r < I3) { const int kb = r / 80, nb = r % 80; const int tile = nb >> 3, gi = nb & 7, L0 = (gi & 3) * 64 + (gi >> 2) * 32;
            if (tile < 6) transpose_item(I.nsa_w_kv, 1536, tile * 256 + L0, 32, I.kv_norm, W.WKQ, 1024, 32 * nb, 64 * kb, scr, lane);
            else transpose_item(I.nsa_w_in, 1072, (tile - 6) * 256 + L0, 32, I.norm_mix + 1024, W.WKQ, 1024, 32 * nb, 64 * kb, scr, lane);
            continue; } r -= I3;
        if (r < I3G) { const int kb = r >> 1, nb = r & 1;
            transpose_item(I.nsa_w_in, 1072, 1024 + 32 * nb, nb ? 16 : 32, I.norm_mix + 1024, W.WGT, 1024, 32 * nb, 64 * kb, scr, lane); continue; } r -= I3G;
        if (r < 2 * I4) { const int w = r / I4; r %= I4; const int kb = r / 8, nb = r % 8;
            transpose_item(w ? I.cmp_v_w1 : I.cmp_k_w1, 256, 32 * nb, 32, nullptr, W.WC1 + (size_t)w * 256 * 2048, 2048, 32 * nb, 64 * kb, scr, lane); continue; } r -= 2 * I4;
        if (r < 2 * I6) { const int w = r / I6; r %= I6; const int kb = r / 2, nb = r % 2;
            transpose_item(w ? I.cmp_v_w2 : I.cmp_k_w2, 64, 32 * nb, 32, nullptr, W.WC2 + (size_t)w * 64 * 256, 256, 32 * nb, 64 * kb, scr, lane); continue; } r -= 2 * I6;
        if (r < I8) { const int kb = r / 32, nb = r % 32; transpose_item(I.nsa_w_o, 1024, 32 * nb, 32, nullptr, W.WNO, 1024, 32 * nb, 64 * kb, scr, lane); continue; } r -= I8;
        if (r < 2 * I9) { const int l = r / I9; r %= I9; const int kb = r / 176, nb = r % 176; const int tile = nb >> 3, gi = nb & 7;
            const int sc = (gi < 4) ? (128 * tile + 32 * gi) : (2816 + 128 * tile + 32 * (gi - 4));
            transpose_item(I.ffn_w_up + (size_t)l * 1024 * 5632, 5632, sc, 32, I.norm_ffn + l * 1024, W.WUP + (size_t)l * 5632 * 1024, 1024, 32 * nb, 64 * kb, scr, lane); continue; } r -= 2 * I9;
        { const int l = r / I11; r %= I11; const int kb = r / 32, nb = r % 32;
            transpose_item(I.ffn_w_down + (size_t)l * 2816 * 1024, 1024, 32 * nb, 32, nullptr, W.WDN + (size_t)l * 1024 * 2816, 2816, 32 * nb, 64 * kb, scr, lane); }
    }
    for (int i = gw * 64 + lane; i < 2048 * 32; i += NGW * 64) {
        const int pos = i >> 5, d = i & 31;
        const float inv = powf(10000.0f, -(float)d / 32.0f);
        const float ang = (float)pos * inv;
        float sn, cs; sincosf(ang, &sn, &cs);
        typedef _Float16 h2_t __attribute__((ext_vector_type(2))); h2_t cs2; cs2[0] = (_Float16)cs; cs2[1] = (_Float16)sn; *(h2_t*)(W.ROPE + 2 * i) = cs2;
    }
    for (int it = gw; it < 2048; it += NGW) {
        const int w = it >> 10, ng = (it >> 8) & 3, kc = it & 255; const float* pe = (w ? I.cmp_pe_v : I.cmp_pe_k) + 8 * kc; const float* w1 = (w ? I.cmp_v_w1 : I.cmp_k_w1) + (size_t)(8 * kc) * 256 + 64 * ng + lane;
        float s = 0.f;
#pragma unroll
        for (int k = 0; k < 8; ++k) s += pe[k] * w1[(size_t)k * 256];
        atomicAdd(W.BIASC + w * 256 + 64 * ng + lane, s);
    }
    for (int m = gw; m < 32768; m += NGW) {
        const f32x4* xr = (const f32x4*)(I.x + (size_t)m * 1024) + lane;
        f32x4 v[4]; float s = 0.f;
#pragma unroll
        for (int j = 0; j < 4; ++j) { v[j] = __builtin_nontemporal_load(&xr[64 * j]); s += (v[j].x * v[j].x + v[j].y * v[j].y) + (v[j].z * v[j].z + v[j].w * v[j].w); }
#pragma unroll
        for (int off = 1; off < 64; off <<= 1) s += __shfl_xor(s, off);
        if (lane == 0) RSS0[m] = s;
        unsigned long long* o8 = (unsigned long long*)(XB + (size_t)m * 1024) + lane;
#pragma unroll
        for (int j = 0; j < 4; ++j) o8[64 * j] = (unsigned long long)pk2(v[j].x, v[j].y) | ((unsigned long long)pk2(v[j].z, v[j].w) << 32);
    }
}
}
namespace gla {
typedef unsigned short bf16_t;
typedef short bf16x8 __attribute__((ext_vector_type(8)));
typedef short s16x4 __attribute__((ext_vector_type(4)));
typedef float f32x16 __attribute__((ext_vector_type(16)));
typedef float f32x4 __attribute__((ext_vector_type(4)));
typedef unsigned u32x4 __attribute__((ext_vector_type(4)));
typedef unsigned u32x2 __attribute__((ext_vector_type(2)));
#define GLAS __attribute__((address_space(3)))
__device__ __forceinline__ int crow(int r, int hi) { return (r & 3) + 8 * (r >> 2) + 4 * hi; }
__device__ __forceinline__ float bf2f(bf16_t v) { return __builtin_bit_cast(float, (unsigned)v << 16); }
__device__ __forceinline__ unsigned cvtpk(float lo, float hi) { typedef float f2 __attribute__((ext_vector_type(2))); typedef __bf16 b2 __attribute__((ext_vector_type(2))); f2 v = {lo, hi}; b2 b = __builtin_convertvector(v, b2); return __builtin_bit_cast(unsigned, b); }
__device__ __forceinline__ bf16_t f2bf1(float f) { return (bf16_t)(cvtpk(f, 0.f) & 0xffffu); }
__device__ __forceinline__ s16x4 vtr(const GLAS unsigned char* p) { typedef short v4i16_t __attribute__((ext_vector_type(4))); return __builtin_bit_cast(s16x4, __builtin_amdgcn_ds_read_tr16_b64_v4i16((GLAS v4i16_t*)p)); }
__device__ __forceinline__ bf16x8 ld2x64(const GLAS unsigned char* p0, const GLAS unsigned char* p1) {
    const s16x4 a = *(const GLAS s16x4*)p0, b = *(const GLAS s16x4*)p1; return (bf16x8){a[0], a[1], a[2], a[3], b[0], b[1], b[2], b[3]};
}
constexpr int QEP = 264, KDP = 136, VP = 576, OLP = 260;
constexpr int L_QE = 0, L_KE = 16896, L_KDT = 33792, L_ATT = 51200, L_V = 59904, L_BL = 96768, L_QT = 97280, L_END = 99328;

template <bool STATE_ONLY>
__device__ __forceinline__ void gla_unit(int b, int h, int seg, const bf16_t* Qg, const bf16_t* Kg, const bf16_t* VO, bf16_t* Oout, const bf16_t* Rg, const _Float16* Gg, const float* gnorm, float* SLOC, float* DSEG, GLAS unsigned char* lds, int tid0) {
    int tid_ = tid0; asm volatile("" : "+v"(tid_));
    const int tid = tid_, lane = tid & 63, w = __builtin_amdgcn_readfirstlane(tid >> 6), r32 = lane & 31, hi = lane >> 5;
    f32x16 S[4];
#pragma unroll
    for (int i = 0; i < 4; ++i)
#pragma unroll
        for (int r = 0; r < 16; ++r) S[i][r] = 0.f;
    const int kcol = tid & 127, qd = tid >> 7;
    const int bh = b * 4 + h;
    if (!STATE_ONLY && seg >= 1) {
#pragma unroll 1
        for (int s = 0; s < seg; ++s) {
            const float* sl = SLOC + ((size_t)(bh * 3 + s) * 128) * 256 + 32 * w + r32; const float* dd = DSEG + (bh * 3 + s) * 128;
#pragma unroll
            for (int i = 0; i < 4; ++i)
#pragma unroll
                for (int r = 0; r < 16; ++r) { const int k = 32 * i + crow(r, hi); const float d = (s == 0) ? 0.f : dd[k]; S[i][r] = S[i][r] * d + sl[(size_t)k * 256]; }
        }
    }
    float dlog = 0.f;
#ifdef DBG_GPROF
    unsigned long long gacc_[12] = {0,0,0,0,0,0,0,0,0,0,0,0}; unsigned long long gprev_ = clock64();
#define GSTAMP(k) do { if (!STATE_ONLY) { asm volatile("s_waitcnt lgkmcnt(0)" ::: "memory"); const unsigned long long t_ = clock64(); gacc_[k] += t_ - gprev_; gprev_ = t_; } } while (0)
#else
#define GSTAMP(k) do {} while (0)
#endif
    GLAS float* BL = (GLAS float*)(lds + L_BL); GLAS float* QT = (GLAS float*)(lds + L_QT);
    GLAS float* OL = (GLAS float*)lds;
    float gq[16]; u32x4 vr[4]; bf16_t qr[16], kr[16];
#define GLA_FETCH_GV(cc) do { const size_t r0_ = (size_t)b * 2048 + (cc) * 64; int t2_ = tid; asm volatile("" : "+v"(t2_));   \
        const _Float16* gp_ = Gg + (r0_ + 16 * (t2_ >> 7)) * 512 + h * 128 + (t2_ & 127); \
        _Pragma("unroll") for (int i = 0; i < 16; ++i) { gq[i] = (float)gp_[(size_t)i * 512]; } \
        const bf16_t* vp_ = VO + (r0_ + (t2_ >> 5)) * 1024 + h * 256 + (t2_ & 31) * 8; \
        _Pragma("unroll") for (int i = 0; i < 4; ++i) { vr[i] = *(const u32x4*)(vp_ + (size_t)i * 16 * 1024); } } while (0)
#define GLA_FETCH_QK(cc) do { const size_t r0_ = (size_t)b * 2048 + (cc) * 64; int t2_ = tid; asm volatile("" : "+v"(t2_)); \
        const size_t e0_ = (r0_ + 16 * (t2_ >> 7)) * 512 + h * 128 + (t2_ & 127); const bf16_t* qp_ = Qg + e0_; const bf16_t* kp_ = Kg + e0_; \
        _Pragma("unroll") for (int i = 0; i < 16; ++i) { kr[i] = kp_[(size_t)i * 512]; if (!STATE_ONLY) qr[i] = qp_[(size_t)i * 512]; } } while (0)
    GLA_FETCH_GV(seg * 8); GLA_FETCH_QK(seg * 8);
    for (int c = seg * 8; c < seg * 8 + 8; ++c) {
        const size_t row0 = (size_t)b * 2048 + c * 64;
        u32x4 rpre[4];
        if (!STATE_ONLY) { const size_t go_ = (row0 + (tid >> 3)) * 1024 + h * 256 + 32 * (tid & 7);
#pragma unroll
            for (int j = 0; j < 4; ++j) rpre[j] = *(const u32x4*)(Rg + go_ + 8 * j); }
        {
            float cs[16]; float run = 0.f;
#pragma unroll
            for (int i = 0; i < 16; ++i) { run += gq[i]; cs[i] = run; }
            QT[qd * 128 + kcol] = run;
#pragma unroll
            for (int i = 0; i < 4; ++i) { const int p = tid + 512 * i, rr = p >> 5, ch = p & 31;
                *(GLAS u32x4*)(lds + L_V + rr * VP + ch * 16) = vr[i]; }
            float qv[16], kv[16];
#pragma unroll
            for (int i = 0; i < 16; ++i) { qv[i] = STATE_ONLY ? 0.f : bf2f(qr[i]); kv[i] = bf2f(kr[i]); }
            { const int cn_ = (c + 1 < seg * 8 + 8) ? c + 1 : c; GLA_FETCH_GV(cn_); }
        GSTAMP(0);
            __syncthreads();
        GSTAMP(1);
            float pre = 0.f, tot = 0.f;
#pragma unroll
            for (int q = 0; q < 4; ++q) { const float t = QT[q * 128 + kcol]; tot += t; if (q < qd) pre += t; }
            if (qd == 0) BL[kcol] = __expf(tot);
            dlog += tot;
            float kd[16];
#pragma unroll
            for (int i = 0; i < 16; ++i) { const float bb = pre + cs[i]; const int t = 16 * qd + i;
                if (!STATE_ONLY) { *(GLAS bf16_t*)(lds + L_QE + t * QEP + kcol * 2) = f2bf1(qv[i] * __expf(bb));
                                   *(GLAS bf16_t*)(lds + L_KE + t * QEP + kcol * 2) = f2bf1(kv[i] * __expf(-bb)); }
                kd[i] = kv[i] * __expf(tot - bb); }
#pragma unroll
            for (int i = 0; i < 4; ++i) { u32x2 v; v.x = cvtpk(kd[4 * i], kd[4 * i + 1]); v.y = cvtpk(kd[4 * i + 2], kd[4 * i + 3]);
                *(GLAS u32x2*)(lds + L_KDT + kcol * KDP + (16 * qd + 4 * i) * 2) = v; }
        }
        GSTAMP(2);
        __syncthreads();
        { const int cn_ = (c + 1 < seg * 8 + 8) ? c + 1 : c; GLA_FETCH_QK(cn_); }
        GSTAMP(3);
        f32x16 o[2];
#pragma unroll
        for (int r = 0; r < 16; ++r) { o[0][r] = 0.f; o[1][r] = 0.f; }
        if (!STATE_ONLY) {
        if (w < 3) {
            const int ti = (w >= 1) ? 1 : 0, si = (w == 2) ? 1 : 0;
            f32x16 a;
#pragma unroll
            for (int r = 0; r < 16; ++r) a[r] = 0.f;
            const GLAS unsigned char* ap = lds + L_QE + (32 * ti + r32) * QEP + 16 * hi; const GLAS unsigned char* bp = lds + L_KE + (32 * si + r32) * QEP + 16 * hi;
#pragma unroll
            for (int s = 0; s < 8; ++s) { const bf16x8 A = ld2x64(ap + 32 * s, ap + 32 * s + 8), B = ld2x64(bp + 32 * s, bp + 32 * s + 8);
                a = __builtin_amdgcn_mfma_f32_32x32x16_bf16(A, B, a, 0, 0, 0); }
            int l3_ = lane; asm volatile("" : "+v"(l3_));
            const int r32b = l3_ & 31, hib = l3_ >> 5, sg = 32 * si + r32b;
#pragma unroll
            for (int r = 0; r < 16; ++r) { const int tg = 32 * ti + crow(r, hib); const float v = (sg <= tg) ? a[r] : 0.f;
                *(GLAS bf16_t*)(lds + L_ATT + tg * KDP + sg * 2) = f2bf1(v); }
        } else if (w == 3) {
#pragma unroll
            for (int r = 0; r < 16; ++r) *(GLAS bf16_t*)(lds + L_ATT + crow(r, hi) * KDP + (32 + r32) * 2) = 0;
        }
        {
#pragma unroll
            for (int i = 0; i < 4; ++i)
#pragma unroll
                for (int s = 0; s < 2; ++s) {
                    u32x4 pk; pk.x = cvtpk(S[i][8 * s], S[i][8 * s + 1]); pk.y = cvtpk(S[i][8 * s + 2], S[i][8 * s + 3]); pk.z = cvtpk(S[i][8 * s + 4], S[i][8 * s + 5]); pk.w = cvtpk(S[i][8 * s + 6], S[i][8 * s + 7]);
                    const bf16x8 Bf = __builtin_bit_cast(bf16x8, pk);
#pragma unroll
                    for (int ti = 0; ti < 2; ++ti) { const GLAS unsigned char* ap = lds + L_QE + (32 * ti + r32) * QEP + (32 * i + 16 * s + 4 * hi) * 2;
                        const bf16x8 A = ld2x64(ap, ap + 16); o[ti] = __builtin_amdgcn_mfma_f32_32x32x16_bf16(A, Bf, o[ti], 0, 0, 0); }
                }
        }
        GSTAMP(4);
        __syncthreads();
        GSTAMP(5);
        }
        {
            bf16x8 vf[4];
            const int gI = lane >> 4, i16 = lane & 15, q = i16 >> 2, p = i16 & 3;
            const GLAS unsigned char* vb = lds + L_V + (8 * hi + q) * VP + (32 * w + 16 * (gI & 1) + 4 * p) * 2;
#pragma unroll
            for (int ks = 0; ks < 4; ++ks) { const s16x4 lo = vtr(vb + 16 * ks * VP), hh = vtr(vb + (16 * ks + 4) * VP);
                vf[ks] = (bf16x8){lo[0], lo[1], lo[2], lo[3], hh[0], hh[1], hh[2], hh[3]}; }
            if (!STATE_ONLY) {
#pragma unroll
            for (int ti = 0; ti < 2; ++ti)
#pragma unroll
                for (int ks = 0; ks < 4; ++ks) { const GLAS unsigned char* ap = lds + L_ATT + (32 * ti + r32) * KDP + (16 * ks + 8 * hi) * 2;
                    const bf16x8 A = ld2x64(ap, ap + 8); o[ti] = __builtin_amdgcn_mfma_f32_32x32x16_bf16(A, vf[ks], o[ti], 0, 0, 0); }
            }
#pragma unroll
            for (int i = 0; i < 4; ++i) {
#pragma unroll
                for (int r = 0; r < 16; ++r) S[i][r] *= BL[32 * i + crow(r, hi)];
#pragma unroll
                for (int ks = 0; ks < 4; ++ks) { const GLAS unsigned char* ap = lds + L_KDT + (32 * i + r32) * KDP + (16 * ks + 8 * hi) * 2;
                    const bf16x8 A = ld2x64(ap, ap + 8); S[i] = __builtin_amdgcn_mfma_f32_32x32x16_bf16(A, vf[ks], S[i], 0, 0, 0); }
            }
        }
        GSTAMP(6);
        __syncthreads();
        GSTAMP(7);
        if (!STATE_ONLY) {
#pragma unroll
        for (int ti = 0; ti < 2; ++ti)
#pragma unroll
            for (int r = 0; r < 16; ++r) OL[(32 * ti + crow(r, hi)) * OLP + 32 * w + r32] = o[ti][r];
        GSTAMP(8);
        __syncthreads();
        GSTAMP(9);
        {
            const int t = tid >> 3, seg = tid & 7;
            f32x4 v[8]; float ss = 0.f;
#pragma unroll
            for (int j = 0; j < 8; ++j) { v[j] = *(const GLAS f32x4*)(OL + t * OLP + 32 * seg + 4 * j); ss += (v[j].x * v[j].x + v[j].y * v[j].y) + (v[j].z * v[j].z + v[j].w * v[j].w); }
            ss += dpp_xor1(ss); ss += dpp_xor2(ss); ss += dpp_hmirror(ss);
            const float rs = rsqrtf(ss * (1.0f / 256.0f) + 1e-6f);
            const size_t go = (row0 + t) * 1024 + h * 256 + 32 * seg;
#pragma unroll
            for (int j = 0; j < 4; ++j) {
                const u32x4 rr = rpre[j];
                const f32x4 a = v[2 * j], bq = v[2 * j + 1];
                u32x4 ov;
                ov.x = cvtpk(a.x * rs * __builtin_bit_cast(float, rr.x << 16), a.y * rs * __builtin_bit_cast(float, rr.x & 0xffff0000u));
                ov.y = cvtpk(a.z * rs * __builtin_bit_cast(float, rr.y << 16), a.w * rs * __builtin_bit_cast(float, rr.y & 0xffff0000u));
                ov.z = cvtpk(bq.x * rs * __builtin_bit_cast(float, rr.z << 16), bq.y * rs * __builtin_bit_cast(float, rr.z & 0xffff0000u));
                ov.w = cvtpk(bq.z * rs * __builtin_bit_cast(float, rr.w << 16), bq.w * rs * __builtin_bit_cast(float, rr.w & 0xffff0000u));
                *(u32x4*)(Oout + go + 8 * j) = ov;
            }
        }
        GSTAMP(10);
        __syncthreads();
        GSTAMP(11);
        }
    }
    if (STATE_ONLY) {
        float* sl = SLOC + ((size_t)(bh * 3 + seg) * 128) * 256 + 32 * w + r32;
#pragma unroll
        for (int i = 0; i < 4; ++i)
#pragma unroll
            for (int r = 0; r < 16; ++r) sl[(size_t)(32 * i + crow(r, hi)) * 256] = S[i][r];
        if (qd == 0) DSEG[(bh * 3 + seg) * 128 + kcol] = __expf(dlog);
    }
#ifdef DBG_GPROF
    if (!STATE_ONLY && blockIdx.x == 5 && tid == 0) { unsigned long long* dp = (unsigned long long*)((unsigned char*)SLOC + (size_t)110 * 1048576);
        for (int k = 0; k < 12; ++k) dp[k] = gacc_[k]; }
#endif
#undef GSTAMP
#undef GLA_FETCH_GV
#undef GLA_FETCH_QK
}
}
namespace nsa {
typedef unsigned short bf16_t;
typedef short bf16x8 __attribute__((ext_vector_type(8)));
typedef short s16x4 __attribute__((ext_vector_type(4)));
typedef float f32x16 __attribute__((ext_vector_type(16)));
typedef float f32x4 __attribute__((ext_vector_type(4)));
typedef unsigned u32x4 __attribute__((ext_vector_type(4)));
#define NLAS __attribute__((address_space(3)))
__device__ __forceinline__ int crow(int r, int hi) { return (r & 3) + 8 * (r >> 2) + 4 * hi; }
__device__ __forceinline__ unsigned cvtpk(float lo, float hi) { typedef float f2 __attribute__((ext_vector_type(2))); typedef __bf16 b2 __attribute__((ext_vector_type(2))); f2 v = {lo, hi}; b2 b = __builtin_convertvector(v, b2); return __builtin_bit_cast(unsigned, b); }
__device__ __forceinline__ s16x4 vtr(const NLAS unsigned char* p) { typedef short v4i16_t __attribute__((ext_vector_type(4))); return __builtin_bit_cast(s16x4, __builtin_amdgcn_ds_read_tr16_b64_v4i16((NLAS v4i16_t*)p)); }

__device__ __forceinline__ float gelu_tanh(float x) { const float y = 0.7978845608028654f * (x + 0.044715f * x * x * x); const float e = __expf(2.0f * y); const float th = 1.0f - 2.0f * __builtin_amdgcn_rcpf(e + 1.0f); return 0.5f * x * (1.0f + th); }
constexpr int CF_W2P = 528;
constexpr int CF_BIAS = 128 * CF_W2P, CF_RED = CF_BIAS + 2048, CF_END = CF_RED + 4 * 64 * 64;
__device__ __forceinline__ void cmp_finalize(const bf16_t* HP, const float* BIASC, const bf16_t* WC2, bf16_t* KCVC, NLAS unsigned char* lds, int bx, int G, int tid) {
    typedef float f4 __attribute__((ext_vector_type(4)));
    const int lane = tid & 63, wave = __builtin_amdgcn_readfirstlane(tid >> 6);
#pragma unroll
    for (int i = 0; i < 8; ++i) { const int ch = tid + 512 * i, row = ch >> 5, c16 = ch & 31;
        *(NLAS u32x4*)(lds + row * CF_W2P + c16 * 16) = *(const u32x4*)(WC2 + (size_t)row * 256 + c16 * 8); }
    ((NLAS float*)(lds + CF_BIAS))[tid] = BIASC[tid];
    asm volatile("s_waitcnt vmcnt(0) lgkmcnt(0)" ::: "memory"); __builtin_amdgcn_s_barrier(); asm volatile("" ::: "memory");
    const int r = lane & 15, kq = lane >> 4, q = wave >> 1, par = wave & 1;
    const int nrounds = (1024 + 4 * G - 1) / (4 * G);
#pragma unroll 1
    for (int rd = 0; rd < nrounds; ++rd) {
        const int item = rd * 4 * G + q * G + bx; const bool live = item < 1024;
        const int R0 = (live ? item : 0) * 16, w = R0 >> 13, row = R0 + r;
        f4 acc[4];
#pragma unroll
        for (int nt = 0; nt < 4; ++nt) acc[nt] = (f4){0.f, 0.f, 0.f, 0.f};
        u32x4 hb[4][4];
#pragma unroll
        for (int k4 = 0; k4 < 4; ++k4) { const int col = 32 * (4 * par + k4) + 8 * kq;
#pragma unroll
            for (int p = 0; p < 4; ++p) hb[k4][p] = *(const u32x4*)(HP + ((size_t)p * 16384 + row) * 256 + col); }
#pragma unroll
        for (int k4 = 0; k4 < 4; ++k4) { const int col = 32 * (4 * par + k4) + 8 * kq;
            const NLAS float* bp = (const NLAS float*)(lds + CF_BIAS) + w * 256 + col;
            f32x4 s0 = *(const NLAS f32x4*)bp, s1 = *(const NLAS f32x4*)(bp + 4);
#pragma unroll
            for (int p = 0; p < 4; ++p) { const u32x4 w4 = hb[k4][p];
                s0[0] += __uint_as_float(w4.x << 16); s0[1] += __uint_as_float(w4.x & 0xffff0000u); s0[2] += __uint_as_float(w4.y << 16); s0[3] += __uint_as_float(w4.y & 0xffff0000u);
                s1[0] += __uint_as_float(w4.z << 16); s1[1] += __uint_as_float(w4.z & 0xffff0000u); s1[2] += __uint_as_float(w4.w << 16); s1[3] += __uint_as_float(w4.w & 0xffff0000u); }
            u32x4 pk; pk.x = cvtpk(gelu_tanh(s0.x), gelu_tanh(s0.y)); pk.y = cvtpk(gelu_tanh(s0.z), gelu_tanh(s0.w)); pk.z = cvtpk(gelu_tanh(s1.x), gelu_tanh(s1.y)); pk.w = cvtpk(gelu_tanh(s1.z), gelu_tanh(s1.w));
            const bf16x8 A = __builtin_bit_cast(bf16x8, pk);
#pragma unroll
            for (int nt = 0; nt < 4; ++nt) { const bf16x8 B = *(const NLAS bf16x8*)(lds + (w * 64 + 16 * nt + r) * CF_W2P + col * 2);
                acc[nt] = __builtin_amdgcn_mfma_f32_16x16x32_bf16(A, B, acc[nt], 0, 0, 0); }
        }
        NLAS f4* red = (NLAS f4*)(lds + CF_RED) + (q * 64 + lane) * 4;
        if (par == 1) {
#pragma unroll
            for (int nt = 0; nt < 4; ++nt) red[nt] = acc[nt]; }
        asm volatile("s_waitcnt lgkmcnt(0)" ::: "memory"); __builtin_amdgcn_s_barrier(); asm volatile("" ::: "memory");
        if (par == 0 && live) {
#pragma unroll
            for (int nt = 0; nt < 4; ++nt) { const f4 t = acc[nt] + red[nt];
#pragma unroll
                for (int rg = 0; rg < 4; ++rg) { const int orow = R0 + 4 * kq + rg; const float v = ((orow & 127) == 127) ? 0.f : t[rg];
                    KCVC[(size_t)orow * 64 + 16 * nt + r] = (bf16_t)(cvtpk(v, 0.f) & 0xffffu); } }
        }
        asm volatile("s_waitcnt lgkmcnt(0)" ::: "memory"); __builtin_amdgcn_s_barrier(); asm volatile("" ::: "memory");
    }
}

constexpr int GT_P = 2064;
__device__ __forceinline__ void gate_gemm(const bf16_t* XB, const bf16_t* WGT, const float* rss, float* GATES, NLAS unsigned char* lds, int bx, int G, int tid) {
    typedef float f4 __attribute__((ext_vector_type(4)));
    const int lane = tid & 63, wave = __builtin_amdgcn_readfirstlane(tid >> 6);
#pragma unroll
    for (int i = 0; i < 12; ++i) { const int ch = tid + 512 * i, row = ch >> 7, c16 = ch & 127;
        *(NLAS u32x4*)(lds + row * GT_P + c16 * 16) = *(const u32x4*)(WGT + (size_t)row * 1024 + c16 * 8); }
    asm volatile("s_waitcnt vmcnt(0) lgkmcnt(0)" ::: "memory"); __builtin_amdgcn_s_barrier(); asm volatile("" ::: "memory");
    const int r = lane & 15, kq = lane >> 4;
#pragma unroll 1
    for (int it0 = bx * 8 + wave; it0 < 2048; it0 += G * 8) {
        const int item = (G == 256) ? (((bx & 7) * 32 + (bx >> 3)) * 8 + wave) : it0;
        const int row0 = item * 16;
        const bf16_t* ap = XB + (size_t)(row0 + r) * 1024 + 8 * kq;
        f4 rs4;
#pragma unroll
        for (int rg = 0; rg < 4; ++rg) rs4[rg] = rss[row0 + 4 * kq + rg];
        f4 acc[3];
#pragma unroll
        for (int nt = 0; nt < 3; ++nt) acc[nt] = (f4){0.f, 0.f, 0.f, 0.f};
#pragma unroll 1
        for (int hf = 0; hf < 2; ++hf) {
            bf16x8 a[16];
#pragma unroll
            for (int k = 0; k < 16; ++k) a[k] = *(const bf16x8*)(ap + 32 * (16 * hf + k));
#pragma unroll
            for (int k = 0; k < 16; ++k) {
#pragma unroll
                for (int nt = 0; nt < 3; ++nt) { const bf16x8 B = *(const NLAS bf16x8*)(lds + (16 * nt + r) * GT_P + (32 * (16 * hf + k) + 8 * kq) * 2);
                    acc[nt] = __builtin_amdgcn_mfma_f32_16x16x32_bf16(a[k], B, acc[nt], 0, 0, 0); }
                if ((k & 3) == 3) __builtin_amdgcn_sched_barrier(0);
            }
        }
#pragma unroll
        for (int rg = 0; rg < 4; ++rg) { const float rs = rsqrtf(rs4[rg] * (1.0f / 1024.0f) + 1e-6f); float* gp = GATES + (size_t)(row0 + 4 * kq + rg) * 48 + r;
#pragma unroll
            for (int nt = 0; nt < 3; ++nt) { const float z = acc[nt][rg] * rs; gp[16 * nt] = __builtin_amdgcn_rcpf(1.0f + __expf(-z)); } }
    }
    asm volatile("s_waitcnt lgkmcnt(0)" ::: "memory"); __builtin_amdgcn_s_barrier(); asm volatile("" ::: "memory");
}

constexpr int SLOTB = 16384, NSLOT = 4;
constexpr int L_IMP = NSLOT * SLOTB, L_CAR = L_IMP + 8 * 32 * 33 * 4, L_VAL = L_CAR + 8 * 32 * 33 * 4, L_SELM = L_VAL + 64 * 33 * 4, L_WSF = L_SELM + 256, L_FAC = L_WSF + 8 * 64 * 4, L_AEND = L_FAC + 8 * 32 * 2 * 4;
static_assert(L_AEND <= 131072 + 28672, "attention LDS");
#define NINF (-__builtin_inff())
#define ABAR() asm volatile("s_waitcnt lgkmcnt(0)\n\ts_barrier" ::: "memory")

__device__ __forceinline__ void k_issue(bf16x8* kf, const NLAS unsigned char* ks, int r32, int hi) {
    const int sw = (r32 >> 1) & 7;
    const unsigned kb = (unsigned)(size_t)(ks + r32 * 128);
    const unsigned a0 = kb + (((0 + hi) ^ sw) << 4), a1 = kb + (((2 + hi) ^ sw) << 4), a2 = kb + (((4 + hi) ^ sw) << 4), a3 = kb + (((6 + hi) ^ sw) << 4);
    asm volatile("ds_read_b128 %0, %8\n\tds_read_b128 %1, %8 offset:4096\n\tds_read_b128 %2, %9\n\tds_read_b128 %3, %9 offset:4096\n\t"
                 "ds_read_b128 %4, %10\n\tds_read_b128 %5, %10 offset:4096\n\tds_read_b128 %6, %11\n\tds_read_b128 %7, %11 offset:4096"
                 : "=&v"(kf[0]), "=&v"(kf[1]), "=&v"(kf[2]), "=&v"(kf[3]), "=&v"(kf[4]), "=&v"(kf[5]), "=&v"(kf[6]), "=&v"(kf[7])
                 : "v"(a0), "v"(a1), "v"(a2), "v"(a3) : "memory");
}
__device__ __forceinline__ void k_wait(bf16x8* kf) {
    asm volatile("s_waitcnt lgkmcnt(0)" : "+v"(kf[0]), "+v"(kf[1]), "+v"(kf[2]), "+v"(kf[3]), "+v"(kf[4]), "+v"(kf[5]), "+v"(kf[6]), "+v"(kf[7]) :: "memory");
    __builtin_amdgcn_sched_barrier(0);
}
__device__ __forceinline__ void qk_mma(f32x16& p0, f32x16& p1, const bf16x8* kf, const bf16x8* qf, const f32x16& c) {
#pragma unroll
    for (int d0 = 0; d0 < 4; ++d0) {
        if (d0 == 0) { p0 = __builtin_amdgcn_mfma_f32_32x32x16_bf16(kf[0], qf[0], c, 0, 0, 0); p1 = __builtin_amdgcn_mfma_f32_32x32x16_bf16(kf[1], qf[0], c, 0, 0, 0); }
        else { p0 = __builtin_amdgcn_mfma_f32_32x32x16_bf16(kf[2 * d0], qf[d0], p0, 0, 0, 0); p1 = __builtin_amdgcn_mfma_f32_32x32x16_bf16(kf[2 * d0 + 1], qf[d0], p1, 0, 0, 0); }
    }
}
__device__ __forceinline__ void pack_p(bf16x8* pa, const f32x16& p0, const f32x16& p1) {
    u32x4 w;
    w.x = cvtpk(p0[0], p0[1]); w.y = cvtpk(p0[2], p0[3]); w.z = cvtpk(p0[4], p0[5]); w.w = cvtpk(p0[6], p0[7]); pa[0] = __builtin_bit_cast(bf16x8, w);
    w.x = cvtpk(p0[8], p0[9]); w.y = cvtpk(p0[10], p0[11]); w.z = cvtpk(p0[12], p0[13]); w.w = cvtpk(p0[14], p0[15]); pa[1] = __builtin_bit_cast(bf16x8, w);
    w.x = cvtpk(p1[0], p1[1]); w.y = cvtpk(p1[2], p1[3]); w.z = cvtpk(p1[4], p1[5]); w.w = cvtpk(p1[6], p1[7]); pa[2] = __builtin_bit_cast(bf16x8, w);
    w.x = cvtpk(p1[8], p1[9]); w.y = cvtpk(p1[10], p1[11]); w.z = cvtpk(p1[12], p1[13]); w.w = cvtpk(p1[14], p1[15]); pa[3] = __builtin_bit_cast(bf16x8, w);
}
__device__ __forceinline__ void v_load(bf16x8* vf, const NLAS unsigned char* vs, int lane) {
    const int hi = lane >> 5;
    const NLAS unsigned char* vb = vs + ((lane >> 4) & 1) * 32 + (lane & 3) * 8 + (4 * hi + ((lane & 15) >> 2)) * 64;
#pragma unroll
    for (int d0 = 0; d0 < 2; ++d0)
#pragma unroll
        for (int ks = 0; ks < 4; ++ks) {
            const s16x4 lo = vtr(vb + d0 * 4096 + ks * 1024), hh = vtr(vb + d0 * 4096 + ks * 1024 + 512);
            vf[d0 * 4 + ks] = (bf16x8){lo[0], lo[1], lo[2], lo[3], hh[0], hh[1], hh[2], hh[3]};
        }
}
__device__ __forceinline__ void pv_mma(f32x16* o, f32x16& lacc, const bf16x8* vf, const bf16x8* pa) {
    const short one_ = (short)0x3F80; const bf16x8 ones = (bf16x8){one_, one_, one_, one_, one_, one_, one_, one_};
#pragma unroll
    for (int ks = 0; ks < 4; ++ks) {
        o[0] = __builtin_amdgcn_mfma_f32_32x32x16_bf16(pa[ks], vf[ks], o[0], 0, 0, 0);
        o[1] = __builtin_amdgcn_mfma_f32_32x32x16_bf16(pa[ks], vf[4 + ks], o[1], 0, 0, 0);
        lacc = __builtin_amdgcn_mfma_f32_32x32x16_bf16(pa[ks], ones, lacc, 0, 0, 0);
    }
}
__device__ __forceinline__ float max3f(float a, float b, float c) { float r; asm("v_max3_f32 %0, %1, %2, %3" : "=v"(r) : "v"(a), "v"(b), "v"(c)); return r; }
__device__ __forceinline__ float max32(const f32x16& p0, const f32x16& p1) {
    float a = max3f(p0[0], p0[1], p1[0]), b = max3f(p0[2], p0[3], p1[1]); a = max3f(a, p1[2], p1[3]);
#pragma unroll
    for (int r = 4; r < 16; r += 4) { a = max3f(a, p0[r], p0[r + 1]); b = max3f(b, p0[r + 2], p0[r + 3]); a = max3f(a, p1[r], p1[r + 1]); b = max3f(b, p1[r + 2], p1[r + 3]); }
    return max3f(a, b, b);
}
__device__ __forceinline__ float comb_max(float v) { auto rr = __builtin_amdgcn_permlane32_swap(__float_as_uint(v), __float_as_uint(v), false, false); return fmaxf(__uint_as_float(rr[0]), __uint_as_float(rr[1])); }
__device__ __forceinline__ float comb_sum(float v) { auto rr = __builtin_amdgcn_permlane32_swap(__float_as_uint(v), __float_as_uint(v), false, false); return __uint_as_float(rr[0]) + __uint_as_float(rr[1]); }
__device__ __forceinline__ void mask_le(f32x16& p0, f32x16& p1, int thr, int hi) {
    int t2 = thr - 4 * hi; asm volatile("" : "+v"(t2));
#pragma unroll
    for (int r = 0; r < 16; ++r) { const int kc = (r & 3) + 8 * (r >> 2); if (kc > t2) p0[r] = NINF; if (kc + 32 > t2) p1[r] = NINF; }
}
__device__ __forceinline__ void mask_gt(f32x16& p0, f32x16& p1, int thr, int hi) {
    int t2 = thr - 4 * hi; asm volatile("" : "+v"(t2));
#pragma unroll
    for (int r = 0; r < 16; ++r) { const int kc = (r & 3) + 8 * (r >> 2); if (kc <= t2) p0[r] = NINF; if (kc + 32 <= t2) p1[r] = NINF; }
}

#ifndef SOFT_THR
#define SOFT_THR 8.0f
#endif
struct Soft { float mhat; f32x16 lacc; f32x16 o[2]; };
__device__ __forceinline__ void soft_init(Soft& s) { s.mhat = 0.f;
#pragma unroll
    for (int r = 0; r < 16; ++r) { s.lacc[r] = 0.f; s.o[0][r] = 0.f; s.o[1][r] = 0.f; } }
__device__ __forceinline__ float soft_update(Soft& s, f32x16& p0, f32x16& p1, bool first, NLAS float* wsf, int r32, int hi) {
    const float rm = comb_max(max32(p0, p1));
    const float dl = first ? ((rm > NINF) ? rm : 0.f) : ((rm > SOFT_THR) ? rm : 0.f);
    float f = 1.0f;
    if (__any(dl != 0.f)) {
        s.mhat += dl;
        f = __builtin_amdgcn_exp2f(-dl);
#pragma unroll
        for (int r = 0; r < 16; ++r) { p0[r] -= dl; p1[r] -= dl; }
        if (!first) {
            if (hi == 0) wsf[r32] = f;
            asm volatile("s_waitcnt lgkmcnt(0)" ::: "memory");
#pragma unroll
            for (int r = 0; r < 16; ++r) { const float ff = wsf[crow(r, hi)]; s.o[0][r] *= ff; s.o[1][r] *= ff; s.lacc[r] *= ff; }
            asm volatile("s_waitcnt lgkmcnt(0)" ::: "memory");
        }
    }
#pragma unroll
    for (int r = 0; r < 16; ++r) { p0[r] = __builtin_amdgcn_exp2f(p0[r]); p1[r] = __builtin_amdgcn_exp2f(p1[r]); }
    return f;
}

struct AttnBufs { unsigned char* ws; };
struct Strm { int u, kind, j; };
__device__ __forceinline__ int unit_qt(int u, int sub) { return 8 * (u >> 1) + ((u & 1) ? (7 - sub) : sub); }
__device__ __forceinline__ void strm_next(Strm& s, int sub) {
    const int qt = unit_qt(s.u, sub);
    if (s.kind == 0) { if (s.j == 0 && qt >= 16) s.j = 1; else { s.kind = 1; s.j = qt; } }
    else if (s.kind == 1) { if (s.j > 0) --s.j; else { s.kind = 2; s.j = qt; } }
    else { const int jlo = qt >= 8 ? qt - 8 : 0; if (s.j > jlo) --s.j; else { ++s.u; s.kind = 0; s.j = 0; } }
}
__device__ __forceinline__ void dma16(const void* g, NLAS unsigned char* l) {
    unsigned keep; const unsigned dst = (unsigned)__builtin_amdgcn_readfirstlane((int)(unsigned)(size_t)l);
    asm volatile("s_mov_b32 %0, m0\n\ts_mov_b32 m0, %2\n\ts_nop 0\n\tglobal_load_lds_dwordx4 %1, off\n\ts_mov_b32 m0, %0" : "=&s"(keep) : "v"(g), "s"(dst) : "memory");
}


__device__ __forceinline__ void q_fetch(bf16x8* qf, const bf16_t* qp) {
    asm volatile("global_load_dwordx4 %0, %4, off\n\tglobal_load_dwordx4 %1, %4, off offset:32\n\tglobal_load_dwordx4 %2, %4, off offset:64\n\tglobal_load_dwordx4 %3, %4, off offset:96\n\ts_waitcnt vmcnt(0)"
                 : "=&v"(qf[0]), "=&v"(qf[1]), "=&v"(qf[2]), "=&v"(qf[3]) : "v"(qp) : "memory");
}
__device__ __forceinline__ void qg_fetch(bf16x8* qf, float& g0, float& g1, float& g2, const bf16_t* qp, const float* gp) {
    asm volatile("global_load_dword %4, %8, off\n\tglobal_load_dword %5, %8, off offset:64\n\tglobal_load_dword %6, %8, off offset:128\n\t"
                 "global_load_dwordx4 %0, %7, off\n\tglobal_load_dwordx4 %1, %7, off offset:32\n\tglobal_load_dwordx4 %2, %7, off offset:64\n\tglobal_load_dwordx4 %3, %7, off offset:96\n\ts_waitcnt vmcnt(0)"
                 : "=&v"(qf[0]), "=&v"(qf[1]), "=&v"(qf[2]), "=&v"(qf[3]), "=&v"(g0), "=&v"(g1), "=&v"(g2) : "v"(qp), "v"(gp) : "memory");
}

__device__ __forceinline__ void q_rotate(bf16x8* qf, const _Float16* rp) {
    u32x4 c0, c1, c2, c3;
    asm volatile("global_load_dwordx4 %0, %4, off\n\tglobal_load_dwordx4 %1, %4, off offset:16\n\tglobal_load_dwordx4 %2, %4, off offset:64\n\tglobal_load_dwordx4 %3, %4, off offset:80\n\ts_waitcnt vmcnt(0)"
                 : "=&v"(c0), "=&v"(c1), "=&v"(c2), "=&v"(c3) : "v"(rp) : "memory");
    typedef _Float16 h2_t __attribute__((ext_vector_type(2)));
#pragma unroll
    for (int d0 = 0; d0 < 2; ++d0) {
        const u32x4 ca = d0 ? c2 : c0, cb = d0 ? c3 : c1;
        const u32x4 lo = __builtin_bit_cast(u32x4, qf[d0]), hi = __builtin_bit_cast(u32x4, qf[d0 + 2]);
        u32x4 olo, ohi;
#pragma unroll
        for (int k = 0; k < 4; ++k) {
            const unsigned lw = lo[k], hw = hi[k];
            const unsigned cwa = (k < 2) ? ca[2 * k] : cb[2 * k - 4], cwb = (k < 2) ? ca[2 * k + 1] : cb[2 * k - 3];
            const h2_t pa = __builtin_bit_cast(h2_t, cwa), pb = __builtin_bit_cast(h2_t, cwb);
            const float l0 = __uint_as_float(lw << 16), l1 = __uint_as_float(lw & 0xffff0000u), h0 = __uint_as_float(hw << 16), h1 = __uint_as_float(hw & 0xffff0000u);
            const float cs0 = (float)pa[0], sn0 = (float)pa[1], cs1 = (float)pb[0], sn1 = (float)pb[1];
            olo[k] = cvtpk(l0 * cs0 - h0 * sn0, l1 * cs1 - h1 * sn1);
            ohi[k] = cvtpk(l0 * sn0 + h0 * cs0, l1 * sn1 + h1 * cs1);
        }
        qf[d0] = __builtin_bit_cast(bf16x8, olo); qf[d0 + 2] = __builtin_bit_cast(bf16x8, ohi);
    }
}

template <int VAR = 0>
__device__ __forceinline__ void attn_block(int bh, int sub, const AttnBufs& T, NLAS unsigned char* lds, int tid0) {
    int tid_ = tid0; asm volatile("" : "+v"(tid_));
    const int tid = tid_, lane = tid & 63, w = __builtin_amdgcn_readfirstlane(tid >> 6), r32 = lane & 31, hi = lane >> 5;
    const int b = bh >> 2, hk = bh & 3, g = w >> 1, hq = hk * 4 + g, qi = 32 * (w & 1) + r32;
    NLAS float* wsf = (NLAS float*)(lds + L_WSF) + w * 64;
    NLAS float* IMP = (NLAS float*)(lds + L_IMP) + w * 32 * 33; NLAS float* CAR = (NLAS float*)(lds + L_CAR) + w * 32 * 33;
    NLAS float* stash = (NLAS float*)(lds + L_IMP + w * 8448) + lane;
    const int krow = 8 * w + (lane >> 3), koff = krow * 64 + (((lane & 7) ^ ((krow >> 1) & 7)) << 3), voff = (16 * (w & 3) + (lane >> 2)) * 64 + (w >> 2) * 32 + (lane & 3) * 8;
    unsigned char* const ws = T.ws;
    constexpr size_t kvs = (size_t)16 * 4 * 2048 * 64;
#define A_KC ((const bf16_t*)(ws + WS_KCVC) + ((size_t)bh * 128) * 64)
#define A_VC ((const bf16_t*)(ws + WS_KCVC) + ((size_t)(64 + bh) * 128) * 64)
#define A_KV ((const bf16_t*)(ws + WS_KV) + (size_t)bh * 2048 * 64)
    const bf16_t* kp_; const bf16_t* vp_;
#define PTRS(st) do { \
        if ((st).kind == 0) { kp_ = A_KC + (st).j * 4096 + koff; vp_ = A_VC + (st).j * 4096 + voff; } \
        else if ((st).kind == 1) { kp_ = A_KV + 2 * kvs + (size_t)(st).j * 4096 + koff; vp_ = A_KV + 3 * kvs + (size_t)(st).j * 4096 + voff; } \
        else { kp_ = A_KV + 4 * kvs + (size_t)(st).j * 4096 + koff; vp_ = A_KV + 5 * kvs + (size_t)(st).j * 4096 + voff; } } while (0)
#define ISSUE(st, slot) do { dma16(kp_, lds + (slot) * SLOTB + w * 1024); dma16(vp_, lds + (slot) * SLOTB + 8192 + w * 1024); \
        { const int pk_ = (st).kind, pu_ = (st).u; strm_next(st, sub); \
          if ((st).kind == pk_ && (st).u == pu_) { if (pk_ == 0) { kp_ += 4096; vp_ += 4096; } else { kp_ -= 4096; vp_ -= 4096; } } else if ((st).u < 8) PTRS(st); } } while (0)
    Strm ist; ist.u = 0; ist.kind = 0; ist.j = 0;
    Strm cst = ist;
    int P = 0;
#pragma unroll 1
    for (int u = 0; u < 8; ++u) { const int qt = unit_qt(u, sub); P += (qt >= 16 ? 2 : 1) + (qt + 1) + ((qt >= 8 ? 8 : qt) + 1); }
    PTRS(ist);
    ISSUE(ist, 0); ISSUE(ist, 1);
    Soft S; soft_init(S);
    bf16x8 qf[4];
    float g_cmp = 0.f, g_sel = 0.f, g_win = 0.f; unsigned selm = 0u; int qt = 0;
#ifdef DBG_PROF
    unsigned long long tacc_[7] = {0, 0, 0, 0, 0, 0, 0}; unsigned long long tprev_ = clock64();
#define STAMP(k) do { asm volatile("s_waitcnt lgkmcnt(0)" ::: "memory"); const unsigned long long t_ = clock64(); tacc_[k] += t_ - tprev_; tprev_ = t_; } while (0)
#else
#define STAMP(k) do {} while (0)
#endif
#pragma unroll 1
    for (int p = 0; p < P; ++p) {
        STAMP(0);
        const NLAS unsigned char* slot = lds + (p & 3) * SLOTB;
        bf16x8 kf[8];
        if ((p & 1) == 0) {
            asm volatile("s_waitcnt vmcnt(0)" ::: "memory");
            STAMP(1);
            ABAR();
            STAMP(2);
            k_issue(kf, slot, r32, hi);
            if (p + 2 < P) { ISSUE(ist, (p + 2) & 3); }
            if (p + 3 < P) { ISSUE(ist, (p + 3) & 3); }
        } else k_issue(kf, slot, r32, hi);
        const int kind = cst.kind, j = cst.j;
        if (kind == 0 && j == 0) {
            qt = unit_qt(cst.u, sub);
            const int tok = 64 * qt + qi;
            const float* gp = (const float*)(ws + WS_GATES) + ((size_t)b * 2048 + tok) * 48 + hq;
            const size_t qoff = (((size_t)b * 16 + hq) * 2048 + tok) * 64 + 8 * hi;
            qg_fetch(qf, g_cmp, g_sel, g_win, (const bf16_t*)(ws + WS_NQ) + qoff, gp);
            soft_init(S);
        }
        if ((kind == 1 || kind == 2) && j == qt) soft_init(S);
        const bool first = (kind == 0) ? (j == 0) : (j == qt);
        float cv = -S.mhat;
        if (kind == 1) { if (!((selm >> j) & 1u)) cv = NINF; }
        f32x16 c;
#pragma unroll
        for (int r = 0; r < 16; ++r) c[r] = cv;
        f32x16 p0, p1;
        if (VAR == 1 || VAR == 5) { p0 = c; p1 = c; asm volatile("" : "+v"(p0), "+v"(p1)); strm_next(cst, sub); continue; }
        bf16x8 vf[8];
        {
            k_wait(kf);
            qk_mma(p0, p1, kf, qf, c);
        }
        v_load(vf, slot + 8192, lane);
        __builtin_amdgcn_sched_barrier(0);
        if (VAR == 2) { asm volatile("" :: "v"(p0), "v"(p1)); strm_next(cst, sub); continue; }
        asm volatile("" :: "v"(p0), "v"(p1)); STAMP(3);
        if (kind == 0) { const int tok = 64 * qt + qi; const int nmax = (tok >= 31) ? ((tok - 31) >> 4) : -1; mask_le(p0, p1, nmax - 64 * j, hi); }
        else { if (j == qt) mask_le(p0, p1, qi, hi); if (kind == 2 && j == qt - 8) mask_gt(p0, p1, qi, hi); }
        const float f = soft_update(S, p0, p1, first, wsf, r32, hi);
        asm volatile("" :: "v"(p0), "v"(p1)); STAMP(4);
        if (VAR == 3) { asm volatile("" :: "v"(p0), "v"(p1)); strm_next(cst, sub); continue; }
        {
            bf16x8 pa[4]; pack_p(pa, p0, p1);
            pv_mma(S.o, S.lacc, vf, pa);
        }
        asm volatile("" :: "v"(S.o[0]), "v"(S.o[1])); STAMP(5);
        if (kind == 0) {
            NLAS float* FAC = (NLAS float*)(lds + L_FAC) + w * 64;
            int ll_ = lane; asm volatile("" : "+v"(ll_));
            const int r32 = ll_ & 31, hi = ll_ >> 5, tid = w * 64 + ll_, qi = 32 * (w & 1) + r32;
            NLAS float* IMP = (NLAS float*)(lds + L_IMP) + w * 32 * 33; NLAS float* CAR = (NLAS float*)(lds + L_CAR) + w * 32 * 33;
            NLAS float* wsf = (NLAS float*)(lds + L_WSF) + w * 64;
            NLAS float* stash = (NLAS float*)(lds + L_IMP + w * 8448) + ll_;
            if (j == 0 && qt >= 16) {
                if (hi == 0) CAR[r32 * 33] = 0.f;
#pragma unroll
                for (int a = 0; a < 4; ++a) {
                    const int jb = 2 * a + hi;
                    IMP[r32 * 33 + jb] = p0[4 * a] + p0[4 * a + 1] + p0[4 * a + 2] + 0.5f * p0[4 * a + 3]; CAR[r32 * 33 + jb + 1] = 0.5f * p0[4 * a + 3];
                    IMP[r32 * 33 + jb + 8] = p1[4 * a] + p1[4 * a + 1] + p1[4 * a + 2] + 0.5f * p1[4 * a + 3]; CAR[r32 * 33 + jb + 9] = 0.5f * p1[4 * a + 3];
                }
            }
            if (j == 1 || qt < 16) {
                if (r32 == 0) {
#pragma unroll
                    for (int r = 0; r < 16; ++r) wsf[crow(r, hi)] = S.lacc[r]; }
                asm volatile("s_waitcnt lgkmcnt(0)" ::: "memory");
                const float l = wsf[r32];
                asm volatile("s_waitcnt lgkmcnt(0)" ::: "memory");
                const float inv = (l > 0.f) ? __builtin_amdgcn_rcpf(l) : 0.f;
                if (qt < 16) selm = (2u << qt) - 1u;
                else {
                if (hi == 0) { FAC[r32] = (j == 0 ? 1.0f : f) * inv; FAC[32 + r32] = inv; }
                if (j == 1)
#pragma unroll
                for (int a = 0; a < 4; ++a) {
                    const int jb = 2 * a + hi;
                    IMP[r32 * 33 + jb + 16] = p0[4 * a] + p0[4 * a + 1] + p0[4 * a + 2] + 0.5f * p0[4 * a + 3]; CAR[r32 * 33 + jb + 17] = 0.5f * p0[4 * a + 3];
                    IMP[r32 * 33 + jb + 24] = p1[4 * a] + p1[4 * a + 1] + p1[4 * a + 2] + 0.5f * p1[4 * a + 3]; if (jb + 25 < 32) CAR[r32 * 33 + jb + 25] = 0.5f * p1[4 * a + 3];
                }
                ABAR();
                {
                    NLAS float* VAL = (NLAS float*)(lds + L_VAL);
                    const int tq = tid >> 3, sb = tid & 7, wv = tq >> 5, rr = tq & 31;
                    const NLAS float* I0 = (const NLAS float*)(lds + L_IMP); const NLAS float* C0 = (const NLAS float*)(lds + L_CAR);
                    float v[4];
#pragma unroll
                    for (int e = 0; e < 4; ++e) { const int jb = 4 * sb + e; float sc = 0.f;
#pragma unroll
                        for (int gg = 0; gg < 4; ++gg) { const int ww = 2 * gg + wv; const NLAS float* fc = (const NLAS float*)(lds + L_FAC) + ww * 64 + rr;
                            sc += I0[(ww * 32 + rr) * 33 + jb] * fc[jb < 16 ? 0 : 32] + C0[(ww * 32 + rr) * 33 + jb] * fc[jb <= 16 ? 0 : 32]; }
                        if (jb > qt) sc = -1.0f; else if (jb == 0 || jb == qt || jb == qt - 1) sc = 1e4f;
                        v[e] = sc; VAL[tq * 33 + jb] = sc; }
                    asm volatile("s_waitcnt lgkmcnt(0)" ::: "memory");
                    unsigned bits = 0u;
#pragma unroll
                    for (int e = 0; e < 4; ++e) { const int jb = 4 * sb + e; int rank = 0;
#pragma unroll
                        for (int i = 0; i < 32; ++i) { const float x = VAL[tq * 33 + i]; rank += (x > v[e] || (x == v[e] && i < jb)) ? 1 : 0; }
                        if (rank < 16) bits |= 1u << jb; }
                    bits |= dpp_xor1(bits); bits |= dpp_xor2(bits); bits |= dpp_hmirror(bits);
                    if (sb == 0) ((NLAS unsigned*)(lds + L_SELM))[tq] = bits;
                }
                ABAR();
#ifdef DBG_SELALL
                selm = 0xffffffffu;
#else
                selm = ((const NLAS unsigned*)(lds + L_SELM))[qi];
#endif
                }
                const float fac = g_cmp * inv;
                if (hi == 0) wsf[r32] = fac;
                asm volatile("s_waitcnt lgkmcnt(0)" ::: "memory");
#pragma unroll
                for (int r = 0; r < 16; ++r) { const float ff = wsf[crow(r, hi)]; stash[r * 64] = S.o[0][r] * ff; stash[(16 + r) * 64] = S.o[1][r] * ff; }
                asm volatile("s_waitcnt lgkmcnt(0)" ::: "memory");
                q_rotate(qf, (const _Float16*)(ws + WS_ROPE) + ((size_t)(64 * qt + qi) * 32 + 8 * hi) * 2);
            }
        } else {
            const int jend = (kind == 1) ? 0 : (qt >= 8 ? qt - 8 : 0);
            if (j == jend) {
                int ll_ = lane; asm volatile("" : "+v"(ll_));
                const int r32 = ll_ & 31, hi = ll_ >> 5, lane = ll_;
                NLAS float* wsf = (NLAS float*)(lds + L_WSF) + w * 64;
                NLAS float* stash = (NLAS float*)(lds + L_IMP + w * 8448) + ll_;
                if (hi == 0) wsf[r32] = (kind == 1 ? g_sel : g_win);
                asm volatile("s_waitcnt lgkmcnt(0)" ::: "memory");
#pragma unroll
                for (int r = 0; r < 16; ++r) { const float ff = wsf[crow(r, hi)] * __builtin_amdgcn_rcpf(S.lacc[r]); stash[r * 64] += S.o[0][r] * ff; stash[(16 + r) * 64] += S.o[1][r] * ff; }
                asm volatile("s_waitcnt lgkmcnt(0)" ::: "memory");
                if (kind == 2) {
                    const NLAS float* sw = (const NLAS float*)(lds + L_IMP + w * 8448);
                    bf16_t* ob = (bf16_t*)(ws + WS_OATT) + ((size_t)b * 2048 + 64 * qt + 32 * (w & 1)) * 1024 + hq * 64;
#pragma unroll
                    for (int i = 0; i < 4; ++i) {
                        const int row = 8 * i + (lane >> 3), ch = lane & 7;
                        const int hh_ = (row >> 2) & 1, rr_ = (row & 3) + 4 * (row >> 3), d0 = ch >> 2;
                        const NLAS float* sp = sw + ((d0 * 16 + rr_) * 64 + hh_ * 32 + (ch & 3) * 8);
                        const f32x4 x0 = *(const NLAS f32x4*)sp, x1 = *(const NLAS f32x4*)(sp + 4);
                        u32x4 ov; ov.x = cvtpk(x0.x, x0.y); ov.y = cvtpk(x0.z, x0.w); ov.z = cvtpk(x1.x, x1.y); ov.w = cvtpk(x1.z, x1.w);
                        *(u32x4*)(ob + (size_t)row * 1024 + ch * 8) = ov;
                    }
                    ABAR();
                }
            }
        }
        strm_next(cst, sub);
    }
    ABAR();
#ifdef DBG_PROF
    if (blockIdx.x == 0 && tid == 0) { unsigned long long* dp = (unsigned long long*)(ws + (size_t)500 * 1048576);
        for (int k = 0; k < 7; ++k) dp[k] = tacc_[k]; }
#endif
#undef STAMP
#undef ISSUE
#undef PTRS
#undef A_KC
#undef A_VC
#undef A_KV
}
}
namespace cg = cooperative_groups;
typedef unsigned short bf16_t;
struct Params { const float* in[23]; float* out; unsigned char* ws; };

constexpr int PARAM_OFF = EPI_OFF + 28672, BARST_OFF = PARAM_OFF + 256;
template <class T> __device__ __forceinline__ T* ldp(PG8_LAS unsigned char* lds, int idx) {
    const PG8_LAS unsigned* p = (const PG8_LAS unsigned*)(lds + PARAM_OFF) + 2 * idx;
    const unsigned lo = __builtin_amdgcn_readfirstlane(p[0]), hi = __builtin_amdgcn_readfirstlane(p[1]);
    typedef __attribute__((address_space(1))) unsigned char gchar_t;
    gchar_t* gp = (gchar_t*)(((unsigned long long)hi << 32) | lo);
    return (T*)(unsigned char*)gp;
}
#define INP(k) ldp<const float>(lds, (k))
#define OUTP() ldp<float>(lds, 23)
#define WSP() ldp<unsigned char>(lds, 24)
__device__ __forceinline__ pro::In load_in(PG8_LAS unsigned char* lds) {
    pro::In I;
    I.x = INP(0); I.norm_mix = INP(1); I.norm_ffn = INP(2); I.gla_w_in = INP(3); I.gla_w_alpha_up = INP(4); I.gla_b_alpha = INP(5); I.gla_norm = INP(6); I.gla_w_o = INP(7);
    I.kv_norm = INP(8); I.nsa_w_kv = INP(9); I.cmp_pe_k = INP(10); I.cmp_pe_v = INP(11); I.cmp_k_w1 = INP(12); I.cmp_k_w2 = INP(13); I.cmp_v_w1 = INP(14); I.cmp_v_w2 = INP(15);
    I.nsa_w_in = INP(16); I.nsa_w_o = INP(17); I.ffn_w_up = INP(18); I.ffn_conv_w = INP(19); I.ffn_conv_b = INP(20); I.ffn_w_down = INP(21); I.norm_final = INP(22);
    return I;
}

__global__ void __launch_bounds__(512, 2) yoco_fwd(Params P) {
    extern __shared__ __attribute__((aligned(16))) unsigned char lds_raw[];
    PG8_LAS unsigned char* lds = (PG8_LAS unsigned char*)lds_raw;
#ifdef CODE_PAD_STR
    asm volatile(".rept " CODE_PAD_STR "\n\ts_nop 0\n\t.endr" ::: "memory");
#endif
    cg::grid_group grid = cg::this_grid();
    const int G = gridDim.x, bx = blockIdx.x;
    const int wave0 = __builtin_amdgcn_readfirstlane(threadIdx.x >> 6);
#define NOWTID() (wave0 * 64 + lane_id_fresh())
    if (threadIdx.x == 0) {
        PG8_LAS unsigned long long* lp = (PG8_LAS unsigned long long*)(lds + PARAM_OFF);
#pragma unroll
        for (int i = 0; i < 23; ++i) lp[i] = (unsigned long long)P.in[i];
        lp[23] = (unsigned long long)P.out; lp[24] = (unsigned long long)P.ws;
    }
    if (threadIdx.x < 2) ((PG8_LAS unsigned*)(lds + BARST_OFF))[threadIdx.x] = 0u;
    __syncthreads();
    (void)xcd_barrier_post((unsigned*)(P.ws + WS_BAR), (volatile LAS unsigned*)(lds + BARST_OFF), (int)threadIdx.x);
#define GSYNC() do { XcdBarrier b_; b_.bar = (unsigned*)(WSP() + WS_BAR); b_.x = xb_xcc_id(); b_.st = (volatile LAS unsigned*)(lds + BARST_OFF); xcd_barrier(b_, NOWTID()); } while (0)
#define PH_COMMON int tid_ = NOWTID(); asm volatile("" : "+v"(tid_)); const int tid = tid_, lane = tid & 63, wave = __builtin_amdgcn_readfirstlane(tid >> 6); const int gw = bx * 8 + wave, NGW = G * 8; (void)lane; (void)gw; (void)NGW; unsigned char* ws = WSP(); (void)ws;

#ifndef SKIP_PRO
    { PH_COMMON
        pro::In I = load_in(lds); pro::Wts W;
        W.WGI = (bf16_t*)(ws + WS_WGI); W.WGO = (bf16_t*)(ws + WS_WGO); W.WKQ = (bf16_t*)(ws + WS_WKQ); W.WC1 = (bf16_t*)(ws + WS_WC1); W.WC2 = (bf16_t*)(ws + WS_WC2);
        W.WNO = (bf16_t*)(ws + WS_WNO); W.WUP = (bf16_t*)(ws + WS_WUP); W.WDN = (bf16_t*)(ws + WS_WDN); W.WGT = (bf16_t*)(ws + WS_WGT); W.ROPE = (_Float16*)(ws + WS_ROPE); W.BIASC = (float*)(ws + WS_BIASC);
#ifdef REP_PRO
        pro::prologue(I, W, (bf16_t*)(ws + WS_XB), (float*)(ws + WS_RSS), lds, gw, NGW, lane, wave); __syncthreads();
#endif
        pro::prologue(I, W, (bf16_t*)(ws + WS_XB), (float*)(ws + WS_RSS), lds, gw, NGW, lane, wave); }
#endif
    if (G != 256) grid.sync(); else GSYNC();

#ifdef REP_SYNC
#pragma unroll 1
    for (int r = 0; r < REP_SYNC; ++r) GSYNC();
#endif
#ifndef SKIP_P1
    { unsigned char* ws = WSP();
        pg8::Gemm g = pg8::make_gemm((const bf16_t*)(ws + WS_XB), (const bf16_t*)(ws + WS_WGI), M_TOK, 3584, 1024, 1024, 1024);
        pg8::StaticOrder S; S.init(M_TOK, 3584, G, bx);
        epi::EpiGlaIn E{(bf16_t*)(ws + WS_GQ), (bf16_t*)(ws + WS_GK), (bf16_t*)(ws + WS_GV), (bf16_t*)(ws + WS_GR), (_Float16*)(ws + WS_GG), (const float*)(ws + WS_RSS), INP(5)};
#ifdef REP_P1
        pg8::gemm_phase(lds, lds + EPI_OFF, g, S, E, NOWTID());
#endif
#ifdef REP_P1NULL
        { epi::EpiNull EN; pg8::gemm_phase(lds, lds + EPI_OFF, g, S, EN, NOWTID()); }
#endif
        pg8::gemm_phase(lds, lds + EPI_OFF, g, S, E, NOWTID());
    }
#endif
    GSYNC();
#ifndef SKIP_GLA
    { unsigned char* ws = WSP();
        float* SLOC = (float*)(ws + WS_BIG + 260 * MiB); float* DSEG = (float*)(ws + WS_BIG + 290 * MiB);
#ifdef REP_GLAA
        for (int un0 = bx; un0 < 256; un0 += G) { const int un = (G == 256) ? ((bx & 7) * 32 + (bx >> 3)) : un0; if ((un & 3) < 3) gla::gla_unit<true>(un >> 4, (un >> 2) & 3, un & 3, (const bf16_t*)(ws + WS_GQ), (const bf16_t*)(ws + WS_GK), (const bf16_t*)(ws + WS_GV), (bf16_t*)(ws + WS_GV), (const bf16_t*)(ws + WS_GR), (const _Float16*)(ws + WS_GG), INP(6), SLOC, DSEG, lds, NOWTID()); }
#endif
        for (int un0 = bx; un0 < 256; un0 += G) { const int un = (G == 256) ? ((bx & 7) * 32 + (bx >> 3)) : un0; if ((un & 3) < 3) gla::gla_unit<true>(un >> 4, (un >> 2) & 3, un & 3, (const bf16_t*)(ws + WS_GQ), (const bf16_t*)(ws + WS_GK), (const bf16_t*)(ws + WS_GV), (bf16_t*)(ws + WS_GV), (const bf16_t*)(ws + WS_GR), (const _Float16*)(ws + WS_GG), INP(6), SLOC, DSEG, lds, NOWTID()); }
    }
    GSYNC();
    { unsigned char* ws = WSP();
        float* SLOC = (float*)(ws + WS_BIG + 260 * MiB); float* DSEG = (float*)(ws + WS_BIG + 290 * MiB);
#ifdef REP_GLAB
        for (int un0 = bx; un0 < 256; un0 += G) { const int un = (G == 256) ? ((bx & 7) * 32 + (bx >> 3)) : un0; gla::gla_unit<false>(un >> 4, (un >> 2) & 3, un & 3, (const bf16_t*)(ws + WS_GQ), (const bf16_t*)(ws + WS_GK), (const bf16_t*)(ws + WS_GV), (bf16_t*)(ws + WS_BIG + 300 * MiB), (const bf16_t*)(ws + WS_GR), (const _Float16*)(ws + WS_GG), INP(6), SLOC, DSEG, lds, NOWTID()); }
#endif
        for (int un0 = bx; un0 < 256; un0 += G) { const int un = (G == 256) ? ((bx & 7) * 32 + (bx >> 3)) : un0; gla::gla_unit<false>(un >> 4, (un >> 2) & 3, un & 3, (const bf16_t*)(ws + WS_GQ), (const bf16_t*)(ws + WS_GK), (const bf16_t*)(ws + WS_GV), (bf16_t*)(ws + WS_GV), (const bf16_t*)(ws + WS_GR), (const _Float16*)(ws + WS_GG), INP(6), SLOC, DSEG, lds, NOWTID()); }
    }
#endif
    GSYNC();
#ifndef SKIP_P3
    { unsigned char* ws = WSP();
        pg8::Gemm g = pg8::make_gemm((const bf16_t*)(ws + WS_GV), (const bf16_t*)(ws + WS_WGO), M_TOK, 1024, 1024, 1024, 1024);
        pg8::StaticOrder S; S.init(M_TOK, 1024, G, bx);
        epi::EpiRes E{nullptr, (bf16_t*)(ws + WS_XB), (float*)(ws + WS_RSS) + 1 * M_TOK};
        pg8::gemm_phase(lds, lds + EPI_OFF, g, S, E, NOWTID());
    }
#endif
    GSYNC();
#pragma unroll 1
    for (int layer = 0; layer < 2; ++layer) {
        if (layer == 1) {
#ifndef SKIP_P7
            { unsigned char* ws = WSP();
                pg8::Gemm g = pg8::make_gemm((const bf16_t*)(ws + WS_XB), (const bf16_t*)(ws + WS_WKQ), M_TOK, 2560, 1024, 1024, 1024);
                pg8::StaticOrder S; S.init(M_TOK, 2560, G, bx);
                epi::EpiKvq E{(bf16_t*)(ws + WS_KV), (bf16_t*)(ws + WS_NQ), (bf16_t*)(ws + WS_NQR), (float*)(ws + WS_GATES), (const float*)(ws + WS_RSS) + 2 * M_TOK, (const _Float16*)(ws + WS_ROPE)};
#ifdef REP_P7
                pg8::gemm_phase(lds, lds + EPI_OFF, g, S, E, NOWTID());
#endif
                pg8::gemm_phase(lds, lds + EPI_OFF, g, S, E, NOWTID());
                nsa::gate_gemm((const bf16_t*)(ws + WS_XB), (const bf16_t*)(ws + WS_WGT), (const float*)(ws + WS_RSS) + 2 * M_TOK, (float*)(ws + WS_GATES), lds, bx, G, NOWTID());
            }
#endif
            GSYNC();
#ifndef SKIP_P8
            { unsigned char* ws = WSP();
                pg8::Gemm g = pg8::make_gemm((const bf16_t*)(ws + WS_KV), (const bf16_t*)(ws + WS_WC1), 16384, 1024, 512, 1024, 2048);
                g.a_pn = 512 * 2; g.b_pn = 512 * 2; g.b_hi = (size_t)256 * 2048 * 2; g.b_split = 32;
                pg8::StaticOrder S; S.init(16384, 1024, G, bx);
                epi::EpiCmp E{(bf16_t*)(ws + WS_HP)};
#ifdef REP_P8
                pg8::gemm_phase(lds, lds + EPI_OFF, g, S, E, NOWTID());
#endif
                pg8::gemm_phase(lds, lds + EPI_OFF, g, S, E, NOWTID());
            }
#endif
            GSYNC();
#ifndef SKIP_P9
#ifdef REP_P9
            { unsigned char* ws = WSP(); nsa::cmp_finalize((const bf16_t*)(ws + WS_HP), (const float*)(ws + WS_BIASC), (const bf16_t*)(ws + WS_WC2), (bf16_t*)(ws + WS_KCVC), lds, bx, G, NOWTID()); }
#endif
            { unsigned char* ws = WSP(); nsa::cmp_finalize((const bf16_t*)(ws + WS_HP), (const float*)(ws + WS_BIASC), (const bf16_t*)(ws + WS_WC2), (bf16_t*)(ws + WS_KCVC), lds, bx, G, NOWTID()); }
#endif
            GSYNC();
#ifndef SKIP_ATTN
            { unsigned char* ws = WSP();
                nsa::AttnBufs T{ws};
#ifdef REP_ATTN
                for (int v_ = bx; v_ < 256; v_ += G) nsa::attn_block<REP_ATTN>(v_ >> 2, v_ & 3, T, lds, NOWTID());
#endif
                for (int v0_ = bx; v0_ < 256; v0_ += G) { const int v_ = (G == 256) ? ((bx & 7) * 32 + (bx >> 3)) : v0_; nsa::attn_block(v_ >> 2, v_ & 3, T, lds, NOWTID()); }
            }
#endif
            GSYNC();
#ifndef SKIP_P11
            { unsigned char* ws = WSP();
                pg8::Gemm g = pg8::make_gemm((const bf16_t*)(ws + WS_OATT), (const bf16_t*)(ws + WS_WNO), M_TOK, 1024, 1024, 1024, 1024);
                pg8::StaticOrder S; S.init(M_TOK, 1024, G, bx);
                epi::EpiRes E{nullptr, (bf16_t*)(ws + WS_XB), (float*)(ws + WS_RSS) + 3 * M_TOK};
                pg8::gemm_phase(lds, lds + EPI_OFF, g, S, E, NOWTID());
            }
#endif
            GSYNC();
        }
#ifndef SKIP_UP
        { unsigned char* ws = WSP();
            const float* rss_in = (const float*)(ws + WS_RSS) + (layer == 0 ? 1 : 3) * M_TOK;
            const float* cw = INP(19) + (size_t)layer * 3 * 5632; const float* cb = INP(20) + (size_t)layer * 5632;
            pg8::Gemm g = pg8::make_gemm((const bf16_t*)(ws + WS_XB), (const bf16_t*)(ws + WS_WUP) + (size_t)layer * 5632 * 1024, M_TOK, 5632, 1024, 1024, 1024);
            pg8::StaticOrder S; S.init(M_TOK, 5632, G, bx);
            epi::EpiFfnUp E{(bf16_t*)(ws + WS_ACT), (float*)(ws + WS_HALO), rss_in, cw, cb};
#ifdef REP_UP
            pg8::gemm_phase(lds, lds + EPI_OFF, g, S, E, NOWTID());
#endif
#ifdef REP_UPNULL
            { epi::EpiNull EN; pg8::gemm_phase(lds, lds + EPI_OFF, g, S, EN, NOWTID()); }
#endif
            pg8::gemm_phase(lds, lds + EPI_OFF, g, S, E, NOWTID());
        }
#endif
        GSYNC();
#ifndef SKIP_FIX
        { PH_COMMON
            const float* cw = INP(19) + (size_t)layer * 3 * 5632; const float* cb = INP(20) + (size_t)layer * 5632;
            const float* HALO = (const float*)(ws + WS_HALO); bf16_t* ACT = (bf16_t*)(ws + WS_ACT);
#ifdef REP_FIX
            for (int rep_ = 0; rep_ < 2; ++rep_)
#endif
            for (int i = bx * 512 + tid; i < 128 * 704; i += G * 512) {
                const int fg = i % 704, pm = i / 704;
                if ((pm & 7) == 0) continue;
                const int f = 4 * fg, pn = f >> 7, cc = f & 127;
                const float* hc = HALO + ((size_t)(pm * 22 + pn) * 4) * 256 + cc; const float* hp = HALO + ((size_t)((pm - 1) * 22 + pn) * 4) * 256 + cc;
                const pro::f32x4 g_r0 = *(const pro::f32x4*)hc, g_r1 = *(const pro::f32x4*)(hc + 256), g_m2 = *(const pro::f32x4*)(hp + 2 * 256), g_m1 = *(const pro::f32x4*)(hp + 3 * 256);
                const pro::f32x4 v_r0 = *(const pro::f32x4*)(hc + 128), v_r1 = *(const pro::f32x4*)(hc + 256 + 128), v_m2 = *(const pro::f32x4*)(hp + 2 * 256 + 128), v_m1 = *(const pro::f32x4*)(hp + 3 * 256 + 128);
                const pro::f32x4 bg = *(const pro::f32x4*)(cb + f), wg0 = *(const pro::f32x4*)(cw + f), wg1 = *(const pro::f32x4*)(cw + 5632 + f), wg2 = *(const pro::f32x4*)(cw + 2 * 5632 + f);
                const pro::f32x4 bv = *(const pro::f32x4*)(cb + 2816 + f), wv0 = *(const pro::f32x4*)(cw + 2816 + f), wv1 = *(const pro::f32x4*)(cw + 5632 + 2816 + f), wv2 = *(const pro::f32x4*)(cw + 2 * 5632 + 2816 + f);
                const pro::f32x4 og0 = bg + wg0 * g_m2 + wg1 * g_m1 + wg2 * g_r0, ov0 = bv + wv0 * v_m2 + wv1 * v_m1 + wv2 * v_r0;
                const pro::f32x4 og1 = bg + wg0 * g_m1 + wg1 * g_r0 + wg2 * g_r1, ov1 = bv + wv0 * v_m1 + wv1 * v_r0 + wv2 * v_r1;
                float a0[4], a1[4];
#pragma unroll
                for (int j = 0; j < 4; ++j) { a0[j] = og0[j] * __builtin_amdgcn_rcpf(1.0f + __expf(-og0[j])) * ov0[j]; a1[j] = og1[j] * __builtin_amdgcn_rcpf(1.0f + __expf(-og1[j])) * ov1[j]; }
                pg8::u32x2 w0, w1; w0.x = pg8::cvt_pk_bf16(a0[0], a0[1]); w0.y = pg8::cvt_pk_bf16(a0[2], a0[3]); w1.x = pg8::cvt_pk_bf16(a1[0], a1[1]); w1.y = pg8::cvt_pk_bf16(a1[2], a1[3]);
                *(pg8::u32x2*)(ACT + (size_t)(pm * 256) * 2816 + f) = w0;
                *(pg8::u32x2*)(ACT + (size_t)(pm * 256 + 1) * 2816 + f) = w1;
            }
        }
#endif
        GSYNC();
#ifndef SKIP_DOWN
        { unsigned char* ws = WSP(); float* out = OUTP();
            float* rss_out = (float*)(ws + WS_RSS) + (layer == 0 ? 2 : 4) * M_TOK;
            pg8::Gemm g = pg8::make_gemm((const bf16_t*)(ws + WS_ACT), (const bf16_t*)(ws + WS_WDN) + (size_t)layer * 1024 * 2816, M_TOK, 1024, 2816, 2816, 2816);
            pg8::StaticOrder S; S.init(M_TOK, 1024, G, bx);
            if (layer == 1 && G == 256) {
                epi::EpiResFinal EF{(const bf16_t*)(ws + WS_XB), out, INP(22), (unsigned*)(ws + WS_XSLOT), (unsigned*)(ws + WS_XCNT)};
                pg8::gemm_phase(lds, lds + EPI_OFF, g, S, EF, NOWTID());
            } else {
                epi::EpiRes E{layer == 1 ? out : nullptr, (bf16_t*)(ws + WS_XB), rss_out};
                pg8::gemm_phase(lds, lds + EPI_OFF, g, S, E, NOWTID());
            }
        }
#endif
        if (!(layer == 1 && G == 256)) GSYNC();
    }
    if (G != 256) { PH_COMMON
        const float* rss = (const float*)(ws + WS_RSS) + 4 * M_TOK; float* out = OUTP(); const float* norm_final = INP(22);
        for (int m = gw; m < M_TOK; m += NGW) {
            const float rs = rsqrtf(rss[m] * (1.0f / 1024.0f) + 1e-6f);
            pro::f32x4* xr = (pro::f32x4*)(out + (size_t)m * 1024) + lane; const pro::f32x4* gr = (const pro::f32x4*)norm_final + lane;
#if defined(DBG_GPROF)
            { const unsigned long long* dp = (const unsigned long long*)(ws + WS_BIG + (size_t)370 * 1048576); float tot = 0.f; for (int k = 0; k < 12; ++k) tot += (float)dp[k];
              const float ratio = (float)dp[DBG_GPROF] / tot; const float amp = 1.0f + sqrtf(ratio * 0.01f);
              for (int j = 0; j < 4; ++j) { const pro::f32x4 v = xr[64 * j], gg = gr[64 * j]; xr[64 * j] = v * rs * gg * amp; } }
#elif defined(DBG_PROF)
            { const unsigned long long* dp = (const unsigned long long*)(ws + (size_t)500 * 1048576); float tot = 0.f; for (int k = 0; k < 7; ++k) tot += (float)dp[k];
              const float ratio = (float)dp[DBG_PROF] / tot; const float amp = 1.0f + sqrtf(ratio * 0.01f);
              for (int j = 0; j < 4; ++j) { const pro::f32x4 v = xr[64 * j], gg = gr[64 * j]; xr[64 * j] = v * rs * gg * amp; } }
#else
#pragma unroll
            for (int j = 0; j < 4; ++j) { const pro::f32x4 v = xr[64 * j], gg = gr[64 * j]; xr[64 * j] = v * rs * gg; }
#endif
        }
    }
}

extern "C" void kernel_launch(void* const* d_in, const int* in_sizes, int n_in, void* d_out, int out_size, void* d_ws, size_t ws_size, hipStream_t stream) {
    static int grid = 0;
    if (grid == 0) {
        if (n_in != 23 || ws_size < WS_END) { fprintf(stderr, "kernel_launch: unexpected n_in %d or ws_size %zu (< %zu)\n", n_in, ws_size, (size_t)WS_END); grid = -1; return; }
        int dev = 0, cus = 0, per_cu = 0;
        (void)hipGetDevice(&dev);
        (void)hipDeviceGetAttribute(&cus, hipDeviceAttributeMultiprocessorCount, dev);
        (void)hipFuncSetAttribute((const void*)yoco_fwd, hipFuncAttributeMaxDynamicSharedMemorySize, LDS_BYTES);
        (void)hipOccupancyMaxActiveBlocksPerMultiprocessor(&per_cu, (const void*)yoco_fwd, 512, LDS_BYTES);
        if (per_cu < 1) { fprintf(stderr, "kernel_launch: occupancy query reports %d blocks per CU\n", per_cu); grid = -1; return; }
        grid = cus;
        if (grid > 256) grid = 256;
        grid &= ~7;
    }
    if (grid <= 0) return;
    (void)hipMemsetAsync((char*)d_ws + WS_RSS, 0, 1 * MiB, stream);
    Params p{};
    for (int i = 0; i < 23; ++i) p.in[i] = (const float*)d_in[i];
    p.out = (float*)d_out; p.ws = (unsigned char*)d_ws;
    void* args[] = {&p};
    hipError_t e = hipLaunchCooperativeKernel((void*)yoco_fwd, dim3(grid), dim3(512), args, LDS_BYTES, stream);
    if (e != hipSuccess) fprintf(stderr, "cooperative launch failed: %s (grid %d)\n", hipGetErrorString(e), grid);
}
```
